# Optimizing an MI355X kernel written in HIP

```python
import jax
import jax.numpy as jnp
from jax import lax
import numpy as np


D_MODEL = 1024
BATCH = 8
SEQ = 4096
DEPTH = 4

N_MIXERS = 2
EPS = 1e-6
HG_EXPAND = 128
HG_HEADS = D_MODEL // HG_EXPAND
HG_DK = HG_EXPAND
HG_DV = D_MODEL // HG_HEADS
HG_CHUNK = 64
MB_HEADS = 8
MB_HEAD_DIM = D_MODEL // MB_HEADS
MB_BLOCK = 256
MB_TOPK = 3
MB_QCHUNK = 16
ROPE_THETA = 10000.0
FFN_DIM = 3 * D_MODEL
CONV_WIDTH = 3
N_HGRN_LAYERS = len(range(0, DEPTH, N_MIXERS))
N_MOBA_LAYERS = DEPTH - N_HGRN_LAYERS

kernel_name = 'hgrn2_moba_convglu_hybrid'


def rms_norm(x, gain):
    xf = x.astype(jnp.float32)
    y = xf * lax.rsqrt(jnp.mean(xf * xf, axis=-1, keepdims=True) + EPS) * gain
    return y.astype(x.dtype)


def rope_tables(seq):
    inv = 1.0 / (ROPE_THETA ** (jnp.arange(0, MB_HEAD_DIM, 2, dtype=jnp.float32) / MB_HEAD_DIM))
    ang = jnp.arange(seq, dtype=jnp.float32)[:, None] * inv[None, :]
    ang = jnp.concatenate([ang, ang], axis=-1)
    return jnp.cos(ang), jnp.sin(ang)


def apply_rope(t, cos, sin):
    t1, t2 = jnp.split(t, 2, axis=-1)
    return t * cos + jnp.concatenate([-t2, t1], axis=-1) * sin


def hgrn2_mixer(h, w_in, lb, out_gain, w_out):
    bsz, seq, _ = h.shape
    nc = seq // HG_CHUNK
    hk, hv = HG_HEADS * HG_DK, HG_HEADS * HG_DV

    def heads(t, d):
        t = t.reshape(bsz, seq, HG_HEADS, d).transpose(0, 2, 1, 3)
        return t.reshape(bsz, HG_HEADS, nc, HG_CHUNK, d)

    q, fz, v, g = jnp.split(h @ w_in, [hk, 2 * hk, 2 * hk + hv], axis=-1)
    q = heads(q, HG_DK).astype(jnp.float32) * HG_DK ** -0.5
    fz = heads(fz, HG_DK).astype(jnp.float32)
    v = heads(v, HG_DV)
    lb = lb.astype(jnp.float32).reshape(1, HG_HEADS, 1, 1, HG_DK)
    log_f = jnp.logaddexp(jnp.log(lb), jnp.log1p(-lb) + jax.nn.log_sigmoid(fz))
    k = (1.0 - lb) * jax.nn.sigmoid(-fz)
    G = jnp.cumsum(log_f, axis=3)

    g_mid = G[:, :, :, HG_CHUNK // 2 - 1:HG_CHUNK // 2]
    q_rel = q * jnp.exp(G - g_mid)
    k_rel = k * jnp.exp(g_mid - G)
    causal = jnp.tril(jnp.ones((HG_CHUNK, HG_CHUNK), dtype=bool))
    att = jnp.where(causal, jnp.einsum('bhncd,bhnsd->bhncs', q_rel, k_rel), 0.0)
    o_intra = jnp.einsum('bhncs,bhnsv->bhncv', att, v)

    g_last = G[:, :, :, -1]
    q_in = q * jnp.exp(G)
    k_st = k * jnp.exp(g_last[:, :, :, None, :] - G)
    decay = jnp.exp(g_last)
    xs = tuple(jnp.moveaxis(t, 2, 0) for t in (q_in, k_st, v, decay))

    def step(state, inp):
        qi, ks, vc, dc = inp
        o = jnp.einsum('bhcd,bhdv->bhcv', qi, state)
        state = (dc[..., None] * state + jnp.einsum('bhcd,bhcv->bhdv', ks, vc)).astype(jnp.float32)
        return state, o

    s0 = jnp.zeros((bsz, HG_HEADS, HG_DK, HG_DV), jnp.float32)
    _, o_inter = lax.scan(step, s0, xs)
    o = (o_intra + jnp.moveaxis(o_inter, 0, 2)).reshape(bsz, HG_HEADS, seq, HG_DV)

    g = g.reshape(bsz, seq, HG_HEADS, HG_DV).transpose(0, 2, 1, 3).astype(jnp.float32)
    o = rms_norm(o, out_gain) * jax.nn.silu(g)
    o = o.transpose(0, 2, 1, 3).reshape(bsz, seq, hv).astype(h.dtype)
    return o @ w_out


def moba_mixer(h, w_qkv, q_gain, k_gain, w_out, cos, sin):
    bsz, seq, _ = h.shape
    qkv = (h @ w_qkv).reshape(bsz, seq, 3, MB_HEADS, MB_HEAD_DIM).transpose(2, 0, 3, 1, 4)
    q, k, v = qkv[0], qkv[1], qkv[2]
    q = apply_rope(rms_norm(q, q_gain), cos, sin) * MB_HEAD_DIM ** -0.5
    k = apply_rope(rms_norm(k, k_gain), cos, sin)

    n_blk = -(-seq // MB_BLOCK)
    pad = n_blk * MB_BLOCK - seq
    kb = jnp.pad(k, ((0, 0), (0, 0), (0, pad), (0, 0))).reshape(bsz, MB_HEADS, n_blk, MB_BLOCK, MB_HEAD_DIM)
    vb = jnp.pad(v, ((0, 0), (0, 0), (0, pad), (0, 0))).reshape(bsz, MB_HEADS, n_blk, MB_BLOCK, MB_HEAD_DIM)

    k_mean = jnp.mean(kb, axis=3)
    q_blk = jnp.arange(seq) // MB_BLOCK
    past = jnp.arange(n_blk)[None, :] < q_blk[:, None]
    gate = jnp.where(past, jnp.einsum('bhsd,bhnd->bhsn', q, k_mean), -jnp.inf)
    top = min(MB_TOPK, n_blk)
    _, sel = lax.top_k(gate, top)

    nq = seq // MB_QCHUNK
    q_c = q.reshape(bsz, MB_HEADS, nq, MB_QCHUNK, MB_HEAD_DIM).transpose(2, 0, 1, 3, 4)
    sel_c = sel.reshape(bsz, MB_HEADS, nq, MB_QCHUNK, top).transpose(2, 0, 1, 3, 4)
    b_idx = jnp.arange(bsz)[:, None, None, None]
    h_idx = jnp.arange(MB_HEADS)[None, :, None, None]

    def attend_chunk(args):
        qc, selc, c = args
        blk = (c * MB_QCHUNK) // MB_BLOCK
        k_sel = kb[b_idx, h_idx, selc]
        v_sel = vb[b_idx, h_idx, selc]
        k_own = lax.dynamic_index_in_dim(kb, blk, axis=2, keepdims=False)
        v_own = lax.dynamic_index_in_dim(vb, blk, axis=2, keepdims=False)
        ok_sel = (jnp.arange(top) < blk)[:, None]
        s_sel = jnp.where(ok_sel, jnp.einsum('bhqd,bhqnkd->bhqnk', qc, k_sel), -jnp.inf)
        s_sel = s_sel.reshape(bsz, MB_HEADS, MB_QCHUNK, top * MB_BLOCK)
        q_pos = c * MB_QCHUNK + jnp.arange(MB_QCHUNK)
        k_pos = blk * MB_BLOCK + jnp.arange(MB_BLOCK)
        s_own = jnp.where(k_pos[None, :] <= q_pos[:, None],
                          jnp.einsum('bhqd,bhkd->bhqk', qc, k_own), -jnp.inf)
        p = jax.nn.softmax(jnp.concatenate([s_sel, s_own], axis=-1).astype(jnp.float32), axis=-1)
        p_sel = p[..., :top * MB_BLOCK].reshape(bsz, MB_HEADS, MB_QCHUNK, top, MB_BLOCK)
        p_own = p[..., top * MB_BLOCK:]
        return (jnp.einsum('bhqnk,bhqnkd->bhqd', p_sel, v_sel)
                + jnp.einsum('bhqk,bhkd->bhqd', p_own, v_own))

    o = lax.map(attend_chunk, (q_c, sel_c, jnp.arange(nq)))
    o = o.transpose(1, 0, 3, 2, 4).reshape(bsz, seq, MB_HEADS * MB_HEAD_DIM).astype(h.dtype)
    return o @ w_out


def conv_glu_ffn(h, w_up, conv_w, conv_b, w_down):
    seq = h.shape[1]
    a, u = jnp.split(h @ w_up, 2, axis=-1)
    a_pad = jnp.pad(a, ((0, 0), (CONV_WIDTH - 1, 0), (0, 0)))
    a = sum(conv_w[j] * a_pad[:, j:j + seq] for j in range(CONV_WIDTH)) + conv_b
    return (jax.nn.silu(a) * u) @ w_down


def setup_inputs(seed: int = 0) -> dict:
    key = jax.random.key(seed)
    ks = jax.random.split(key, 16)

    def nrm(k, shape, scale):
        return jax.random.normal(k, shape, jnp.float32) * scale

    hk, hv = HG_HEADS * HG_DK, HG_HEADS * HG_DV
    mb_w = MB_HEADS * MB_HEAD_DIM
    return {
        'x': nrm(ks[0], (BATCH, SEQ, D_MODEL), 1.0),
        'attn_norm': 1.0 + nrm(ks[1], (DEPTH, D_MODEL), 0.02),
        'ffn_norm': 1.0 + nrm(ks[2], (DEPTH, D_MODEL), 0.02),
        'hgrn_w_in': nrm(ks[3], (N_HGRN_LAYERS, D_MODEL, 2 * hk + 2 * hv), D_MODEL ** -0.5),
        'hgrn_lb': nrm(ks[4], (N_HGRN_LAYERS, hk), 0.1),
        'hgrn_out_norm': 1.0 + nrm(ks[5], (N_HGRN_LAYERS, HG_DV), 0.02),
        'hgrn_w_out': nrm(ks[6], (N_HGRN_LAYERS, hv, D_MODEL), hv ** -0.5),
        'moba_w_qkv': nrm(ks[7], (N_MOBA_LAYERS, D_MODEL, 3 * mb_w), D_MODEL ** -0.5),
        'moba_q_norm': 1.0 + nrm(ks[8], (N_MOBA_LAYERS, MB_HEAD_DIM), 0.02),
        'moba_k_norm': 1.0 + nrm(ks[9], (N_MOBA_LAYERS, MB_HEAD_DIM), 0.02),
        'moba_w_out': nrm(ks[10], (N_MOBA_LAYERS, mb_w, D_MODEL), mb_w ** -0.5),
        'ffn_w_up': nrm(ks[11], (DEPTH, D_MODEL, 2 * FFN_DIM), D_MODEL ** -0.5),
        'ffn_conv_w': nrm(ks[12], (DEPTH, CONV_WIDTH, FFN_DIM), CONV_WIDTH ** -0.5),
        'ffn_conv_b': nrm(ks[13], (DEPTH, FFN_DIM), 0.01),
        'ffn_w_down': nrm(ks[14], (DEPTH, FFN_DIM, D_MODEL), FFN_DIM ** -0.5),
    }


def reference(x, attn_norm, ffn_norm, hgrn_w_in, hgrn_lb, hgrn_out_norm, hgrn_w_out,
              moba_w_qkv, moba_q_norm, moba_k_norm, moba_w_out,
              ffn_w_up, ffn_conv_w, ffn_conv_b, ffn_w_down):
    seq = x.shape[1]
    cos, sin = rope_tables(seq)
    lb_cum = jnp.cumsum(jax.nn.softmax(hgrn_lb.astype(jnp.float32), axis=0), axis=0)
    lower_bounds = lb_cum - lb_cum[0]
    for layer in range(DEPTH):
        slot = layer // N_MIXERS
        h = rms_norm(x, attn_norm[layer])
        if layer % N_MIXERS == 0:
            mix = hgrn2_mixer(h, hgrn_w_in[slot], lower_bounds[slot], hgrn_out_norm[slot], hgrn_w_out[slot])
        else:
            mix = moba_mixer(h, moba_w_qkv[slot], moba_q_norm[slot], moba_k_norm[slot], moba_w_out[slot], cos, sin)
        x = x + mix.astype(x.dtype)
        ffn = conv_glu_ffn(rms_norm(x, ffn_norm[layer]), ffn_w_up[layer], ffn_conv_w[layer],
                           ffn_conv_b[layer], ffn_w_down[layer])
        x = x + ffn.astype(x.dtype)
    return x
```

```cpp
#include <hip/hip_runtime.h>
#include <cstdio>
#include <cstdint>
#include <cmath>
namespace pg8 {
#define PG8_LAS __attribute__((address_space(3)))
typedef unsigned short bf16_t;
typedef short bf16x8 __attribute__((ext_vector_type(8)));
typedef float f32x4 __attribute__((ext_vector_type(4)));
typedef unsigned u32x4 __attribute__((ext_vector_type(4)));
constexpr int BM = 256, BK = 64, HALF = 128, HTB = HALF * BK * 2  , STAGE_BYTES = 8 * HTB, NXCD = 8, WGM = 8;

__host__ __device__ __forceinline__ int lds_byte(int r, int c) { const int st = (r >> 4) * 2 + (c >> 5), rr = r & 15, cc = c & 31, ob = rr * 64 + cc * 2; return st * 1024 + (ob ^ (((ob >> 9) & 1) << 5)); }
__host__ __device__ __forceinline__ void stage_rc(int b, int& R, int& C) { const int st = b / 1024, sb = b % 1024, swz = sb ^ (((sb >> 9) & 1) << 5); R = (st >> 1) * 16 + swz / 64; C = (st & 1) * 32 + (swz % 64) / 2; }
__host__ __device__ __forceinline__ int perm32(int rho) { const int n = rho >> 4, i = rho & 15; return 8 * (i >> 2) + 4 * n + (i & 3); }

struct Unit { int pm, pn; };
struct Gemm { const bf16_t* A; const bf16_t* Bt; int M, N, K, lda; };

struct StaticOrder {
    int nM, nN, nwg, G, c;
    __host__ __device__ void init(int M, int N, int G_, int c_) { nM = M / BM; nN = N / BM; nwg = nM * nN; G = G_; c = c_; }
    __host__ __device__ bool next(int i, Unit& u) const {
        const long L = (long)i * G + c; if (L >= nwg) return false;
        int wgid = (int)L; { const int q = nwg / NXCD, r = nwg % NXCD, xcd = wgid % NXCD, off = wgid / NXCD; wgid = (xcd < r ? xcd * (q + 1) : r * (q + 1) + (xcd - r) * q) + off; }
        const int nig = WGM * nN, gid = wgid / nig, fm = gid * WGM, gsz = (nM - fm) < WGM ? (nM - fm) : WGM;
        u.pm = fm + ((wgid % nig) % gsz); u.pn = (wgid % nig) / gsz; return true;
    }
    __device__ __forceinline__ void a_ready(const Unit&) const {}
    __device__ __forceinline__ void done(const Unit&) const {}
};

__device__ __forceinline__ unsigned cvt_pk_bf16(float lo, float hi) { unsigned r; asm volatile("v_cvt_pk_bf16_f32 %0, %1, %2" : "=v"(r) : "v"(lo), "v"(hi)); return r; }
typedef float f32x2 __attribute__((ext_vector_type(2)));
__device__ __forceinline__ float row_rstd(const float* ss, int row) {
    const f32x4* sp = (const f32x4*)(ss + (size_t)row * 16);
    const f32x4 a = sp[0], b = sp[1], c = sp[2], d = sp[3];
    const float s = ((a[0] + a[1]) + (a[2] + a[3])) + ((b[0] + b[1]) + (b[2] + b[3])) + ((c[0] + c[1]) + (c[2] + c[3])) + ((d[0] + d[1]) + (d[2] + d[3]));
    return __builtin_amdgcn_rsqf(s * (1.0f / 1024.0f) + 1e-6f);
}
struct EpiRowScale {
    static constexpr bool PERM = true, AFTER_DRAIN = false;
    bf16_t* O; const float* ss; int ldc, pad;
    __device__ __forceinline__ void operator()(const f32x4 (&acc)[2][2][4][2], const Unit& u, int wr, int wc, int fr, int fq) const {
        const int row0 = u.pm * BM + wr * 64 + fr; const int col0 = u.pn * BM + wc * 32 + 8 * fq;
#pragma unroll
        for (int ai = 0; ai < 2; ++ai)
#pragma unroll
            for (int m = 0; m < 4; ++m) { const int row = row0 + ai * HALF + m * 16; const float rs = row_rstd(ss, row);
                bf16_t* rowp = O + (size_t)row * ldc + col0;
#pragma unroll
                for (int bj = 0; bj < 2; ++bj) { const f32x4 v0 = acc[ai][bj][m][0] * rs, v1 = acc[ai][bj][m][1] * rs;
                    u32x4 w; w.x = cvt_pk_bf16(v0[0], v0[1]); w.y = cvt_pk_bf16(v0[2], v0[3]); w.z = cvt_pk_bf16(v1[0], v1[1]); w.w = cvt_pk_bf16(v1[2], v1[3]);
                    *(u32x4*)(rowp + bj * HALF) = w; } }
    }
};
typedef unsigned u32x2 __attribute__((ext_vector_type(2)));
struct EpiResid {
    static constexpr bool PERM = false, AFTER_DRAIN = false;
    const float* base; float* out; bf16_t* xb; float* ss;
    __device__ __forceinline__ void operator()(const f32x4 (&acc)[2][2][4][2], const Unit& u, int wr, int wc, int fr, int fq) const {
        const int col0 = u.pn * BM + wc * 32 + 4 * fq;
#pragma unroll
        for (int ai = 0; ai < 2; ++ai)
#pragma unroll
            for (int m = 0; m < 4; ++m) { const int row = u.pm * BM + ai * HALF + wr * 64 + m * 16 + fr; const size_t off = (size_t)row * 1024 + col0; float s = 0.f;
#pragma unroll
                for (int bj = 0; bj < 2; ++bj)
#pragma unroll
                    for (int n = 0; n < 2; ++n) { const f32x4 b = *(const f32x4*)(base + off + bj * HALF + n * 16); const f32x4 o = b + acc[ai][bj][m][n];
                        *(f32x4*)(out + off + bj * HALF + n * 16) = o; s += (o[0] * o[0] + o[1] * o[1]) + (o[2] * o[2] + o[3] * o[3]);
                        u32x2 w; w.x = cvt_pk_bf16(o[0], o[1]); w.y = cvt_pk_bf16(o[2], o[3]); *(u32x2*)(xb + off + bj * HALF + n * 16) = w; }
                s += __shfl_xor(s, 16); s += __shfl_xor(s, 32);
                if (fq == 0) ss[(size_t)row * 16 + u.pn * 4 + wc] = s; }
    }
};
template <class Epi, class Sched, bool ALIGN_EPI = false, bool SP2 = false>
__device__ __forceinline__ void gemm_phase(PG8_LAS unsigned char* lds, const Gemm g, const Sched& S, const Epi& E) {
    const int tid = threadIdx.x, wid = __builtin_amdgcn_readfirstlane(tid >> 6), lane = tid & 63, wr = wid >> 2, wc = wid & 3, fr = lane & 15, fq = lane >> 4;
    const int K = g.K, nt = K / BK;
    unsigned voffA[2], voffB[2];
#pragma unroll
    for (int i = 0; i < 2; ++i) { int R, C; stage_rc(tid * 16 + i * 8192, R, C); const int Rb = Epi::PERM ? ((R & ~31) + perm32(R & 31)) : R;
        voffA[i] = (unsigned)(R * g.lda + C) * 2u; voffB[i] = (unsigned)(Rb * K + C) * 2u; }
    const size_t kstep = (size_t)(BK * 2);
    const size_t hstepB = (size_t)HALF * K * 2, hstepA = (size_t)HALF * g.lda * 2;
    const size_t tstepA = 2 * hstepA, tstepB = 2 * hstepB;
    const unsigned ldsw = (unsigned)wid * 1024u;
    const int aoff = lds_byte(wr * 64 + fr, fq * 8), boff = lds_byte(wc * 32 + fr, fq * 8);
#define PG8_SA(b, h) (((b) * 2 + (h)) * HTB)
#define PG8_SB(b, h) ((4 + (b) * 2 + (h)) * HTB)
#define PG8_STAGE(bufoff, gbase, voff) do { _Pragma("unroll") for (int _i = 0; _i < 2; ++_i) \
        __builtin_amdgcn_global_load_lds((const unsigned*)((const char*)(gbase) + (voff)[_i]), (PG8_LAS unsigned*)(lds + (bufoff) + ldsw + _i * 8192), 16, 0, 0); } while (0)
#define PG8_LDA(dst, b, h) do { _Pragma("unroll") for (int m = 0; m < 4; ++m) _Pragma("unroll") for (int k = 0; k < 2; ++k) dst[m][k] = *(const PG8_LAS bf16x8*)(lds + PG8_SA(b, h) + aoff + m * 2048 + k * 1024); } while (0)
#define PG8_LDB(dst, b, h) do { _Pragma("unroll") for (int n = 0; n < 2; ++n) _Pragma("unroll") for (int k = 0; k < 2; ++k) dst[n][k] = *(const PG8_LAS bf16x8*)(lds + PG8_SB(b, h) + boff + n * 2048 + k * 1024); } while (0)
#define PG8_MMA(ai, bj, At, Bt) do { __builtin_amdgcn_s_setprio(1); _Pragma("unroll") for (int m = 0; m < 4; ++m) _Pragma("unroll") for (int n = 0; n < 2; ++n) _Pragma("unroll") for (int k = 0; k < 2; ++k) \
        acc[ai][bj][m][n] = __builtin_amdgcn_mfma_f32_16x16x32_bf16(Bt[n][k], At[m][k], acc[ai][bj][m][n], 0, 0, 0); __builtin_amdgcn_s_setprio(0); } while (0)
#define PG8_WAIT_V(n) asm volatile("s_waitcnt vmcnt(" #n ")" ::: "memory")
#define PG8_WAIT_L(n) asm volatile("s_waitcnt lgkmcnt(" #n ")" ::: "memory")
#define PG8_BAR __builtin_amdgcn_s_barrier()
#define PG8_SCHED __builtin_amdgcn_sched_barrier(0)
    Unit cur, nxt; int ui = 0;
    if (!S.next(0, cur)) return;
    f32x4 acc[2][2][4][2];
#pragma unroll
    for (int a = 0; a < 2; ++a)
#pragma unroll
        for (int b = 0; b < 2; ++b)
#pragma unroll
            for (int m = 0; m < 4; ++m)
#pragma unroll
                for (int n = 0; n < 2; ++n) acc[a][b][m][n] = (f32x4){0.f, 0.f, 0.f, 0.f};
    bf16x8 At[4][2], B0[2][2], B1[2][2];
    const char* cA = (const char*)g.A + (size_t)cur.pm * tstepA; const char* cB = (const char*)g.Bt + (size_t)cur.pn * tstepB;
    S.a_ready(cur);
    if constexpr (SP2) {
        PG8_STAGE(PG8_SB(0, 0), cB, voffB); PG8_STAGE(PG8_SB(0, 1), cB + hstepB, voffB); PG8_STAGE(PG8_SA(0, 0), cA, voffA); PG8_STAGE(PG8_SA(0, 1), cA + hstepA, voffA);
        if (wr == 1) PG8_BAR;
        PG8_WAIT_V(2); PG8_BAR;
        PG8_STAGE(PG8_SB(1, 0), cB + kstep, voffB); PG8_STAGE(PG8_SA(1, 0), cA + kstep, voffA); PG8_STAGE(PG8_SB(1, 1), cB + hstepB + kstep, voffB);
        PG8_WAIT_V(6); PG8_BAR;
    } else {
        PG8_STAGE(PG8_SB(0, 0), cB, voffB); PG8_STAGE(PG8_SA(0, 0), cA, voffA); PG8_STAGE(PG8_SB(0, 1), cB + hstepB, voffB); PG8_STAGE(PG8_SA(0, 1), cA + hstepA, voffA);
        if (wr == 1) PG8_BAR;
        PG8_WAIT_V(4); PG8_BAR;
        PG8_STAGE(PG8_SB(1, 0), cB + kstep, voffB); PG8_STAGE(PG8_SA(1, 0), cA + kstep, voffA); PG8_STAGE(PG8_SB(1, 1), cB + hstepB + kstep, voffB);
        PG8_WAIT_V(6); PG8_BAR;
    }
    for (;;) {
        const bool has_next = S.next(ui + 1, nxt);
        const char* nA = has_next ? (const char*)g.A + (size_t)nxt.pm * tstepA : cA; const char* nB = has_next ? (const char*)g.Bt + (size_t)nxt.pn * tstepB : cB;
        for (int t = 0; t < nt; t += 2) {
            const bool last = (t == nt - 2);
            const char* a1 = cA + (size_t)(t + 1) * kstep;
            const char* a2 = last ? nA : cA + (size_t)(t + 2) * kstep; const char* b2 = last ? nB : cB + (size_t)(t + 2) * kstep;
            const char* a3 = a2 + kstep; const char* b3 = b2 + kstep;
            if (last && has_next) S.a_ready(nxt);
            if constexpr (SP2) {
            PG8_LDB(B0, 0, 0); PG8_LDB(B1, 0, 1); PG8_SCHED; PG8_LDA(At, 0, 0); PG8_STAGE(PG8_SA(1, 1), a1 + hstepA, voffA);
            PG8_WAIT_V(8); PG8_WAIT_L(0); PG8_BAR; PG8_MMA(0, 0, At, B0); PG8_MMA(0, 1, At, B1); PG8_BAR; PG8_SCHED;
            PG8_LDA(At, 0, 1); PG8_STAGE(PG8_SB(0, 0), b2, voffB); PG8_STAGE(PG8_SB(0, 1), b2 + hstepB, voffB); PG8_STAGE(PG8_SA(0, 0), a2, voffA);
            PG8_WAIT_V(8); PG8_WAIT_L(0); PG8_BAR; PG8_MMA(1, 0, At, B0); PG8_MMA(1, 1, At, B1); PG8_BAR; PG8_SCHED;
            PG8_LDB(B0, 1, 0); PG8_LDB(B1, 1, 1); PG8_SCHED; PG8_LDA(At, 1, 0); PG8_STAGE(PG8_SA(0, 1), a2 + hstepA, voffA);
            PG8_WAIT_V(8); PG8_WAIT_L(0); PG8_BAR; PG8_MMA(0, 0, At, B0); PG8_MMA(0, 1, At, B1); PG8_BAR; PG8_SCHED;
            PG8_LDA(At, 1, 1); PG8_STAGE(PG8_SB(1, 0), b3, voffB); PG8_STAGE(PG8_SB(1, 1), b3 + hstepB, voffB); PG8_STAGE(PG8_SA(1, 0), a3, voffA);
            PG8_WAIT_V(8); PG8_WAIT_L(0); PG8_BAR; PG8_MMA(1, 0, At, B0); PG8_MMA(1, 1, At, B1); PG8_BAR; PG8_SCHED;
            } else {
            PG8_LDB(B0, 0, 0); PG8_SCHED; PG8_LDA(At, 0, 0); PG8_STAGE(PG8_SA(1, 1), a1 + hstepA, voffA);
            PG8_WAIT_L(8); PG8_BAR; PG8_WAIT_L(0); PG8_MMA(0, 0, At, B0); PG8_BAR; PG8_SCHED;
            PG8_LDB(B1, 0, 1); PG8_STAGE(PG8_SB(0, 0), b2, voffB);
            PG8_BAR; PG8_WAIT_L(0); PG8_MMA(0, 1, At, B1); PG8_BAR;
            PG8_LDA(At, 0, 1); PG8_STAGE(PG8_SA(0, 0), a2, voffA);
            PG8_BAR; PG8_WAIT_L(0); PG8_MMA(1, 0, At, B0); PG8_BAR; PG8_SCHED;
            PG8_STAGE(PG8_SB(0, 1), b2 + hstepB, voffB);
            PG8_WAIT_V(6); PG8_BAR; PG8_MMA(1, 1, At, B1); PG8_BAR;
            PG8_LDB(B0, 1, 0); PG8_SCHED; PG8_LDA(At, 1, 0); PG8_STAGE(PG8_SA(0, 1), a2 + hstepA, voffA);
            PG8_WAIT_L(8); PG8_BAR; PG8_WAIT_L(0); PG8_MMA(0, 0, At, B0); PG8_BAR; PG8_SCHED;
            PG8_LDB(B1, 1, 1); PG8_STAGE(PG8_SB(1, 0), b3, voffB);
            PG8_BAR; PG8_WAIT_L(0); PG8_MMA(0, 1, At, B1); PG8_BAR;
            PG8_LDA(At, 1, 1); PG8_STAGE(PG8_SA(1, 0), a3, voffA);
            PG8_BAR; PG8_WAIT_L(0); PG8_MMA(1, 0, At, B0); PG8_BAR; PG8_SCHED;
            PG8_STAGE(PG8_SB(1, 1), b3 + hstepB, voffB);
            PG8_WAIT_V(6); PG8_BAR; PG8_MMA(1, 1, At, B1); PG8_BAR;
            }
        }
        if constexpr (ALIGN_EPI) { if (wr == 0) PG8_BAR; }
        if constexpr (!Epi::AFTER_DRAIN) { E(acc, cur, wr, wc, fr, fq); S.done(cur); }
        if (!has_next) break;
#pragma unroll
        for (int a = 0; a < 2; ++a)
#pragma unroll
            for (int b = 0; b < 2; ++b)
#pragma unroll
                for (int m = 0; m < 4; ++m)
#pragma unroll
                    for (int n = 0; n < 2; ++n) acc[a][b][m][n] = (f32x4){0.f, 0.f, 0.f, 0.f};
        cur = nxt; cA = nA; cB = nB; ++ui;
        if constexpr (ALIGN_EPI) { if (wr == 1) PG8_BAR; }
    }
    PG8_WAIT_V(0);
    if constexpr (!ALIGN_EPI) { if (wr == 0) PG8_BAR; }
    PG8_BAR;
    if constexpr (Epi::AFTER_DRAIN) { E.fused(acc, cur, wr, wc, fr, fq, lds, wid, lane); S.done(cur); }
#undef PG8_SA
#undef PG8_SB
#undef PG8_STAGE
#undef PG8_LDA
#undef PG8_LDB
#undef PG8_MMA
#undef PG8_WAIT_V
#undef PG8_WAIT_L
#undef PG8_BAR
#undef PG8_SCHED
}
}
constexpr int BATCH = 8, SEQ = 4096, DM = 1024, MROWS = BATCH * SEQ, DEPTH = 4;
constexpr int NH = 8, HD = 128;
constexpr int FF = 3072, NBLK = 16, MBLK = 256;
constexpr float QSCALE = 0.08838834764831845f;
typedef unsigned short bf16;
typedef float f32x4 __attribute__((ext_vector_type(4)));
typedef unsigned u32x4 __attribute__((ext_vector_type(4)));

constexpr size_t MiB = 1u << 20;
constexpr size_t WS_CTL = 0, CTL_ZERO_BYTES = 1 * MiB;
constexpr size_t WS_WIN = 2 * MiB, WS_WQKV = 18 * MiB, WS_WOH = 30 * MiB, WS_WOM = 34 * MiB, WS_WUP = 38 * MiB, WS_WDN = 86 * MiB;
constexpr size_t WS_SS = 110 * MiB, WS_COS = 112 * MiB, WS_SIN = 113 * MiB, WS_LBV = 114 * MiB, WS_KMEAN = 115 * MiB;
constexpr size_t WS_XB = 144 * MiB, WS_BIG = 208 * MiB, WS_AU = 400 * MiB, WS_END = 464 * MiB;

__device__ __forceinline__ float bf2f(bf16 v) { return __uint_as_float((unsigned)v << 16); }
__device__ __forceinline__ bf16 f2bf(float f) { unsigned u = __float_as_uint(f); return (bf16)((u + 0x7fffu + ((u >> 16) & 1u)) >> 16); }
__device__ __forceinline__ float wave_sum(float v) {
#pragma unroll
    for (int o = 1; o < 64; o <<= 1) v += __shfl_xor(v, o);
    return v;
}
__device__ __forceinline__ float wave_max(float v) {
#pragma unroll
    for (int o = 1; o < 64; o <<= 1) v = fmaxf(v, __shfl_xor(v, o));
    return v;
}

__global__ void k_convert_w(const float* __restrict__ W, const float* __restrict__ gain, bf16* __restrict__ Wt, int K, int N, int upperm) {
    __shared__ float t[32][33];
    const int n0 = blockIdx.x * 32, k0 = blockIdx.y * 32, tx = threadIdx.x, ty = threadIdx.y;
    int src0 = n0;
    if (upperm) { const int pn = n0 >> 8, r = n0 & 255, bj = r >> 7, c = r & 127; src0 = bj * 3072 + 128 * pn + c; }
#pragma unroll
    for (int j = 0; j < 4; ++j) { const int k = k0 + ty + 8 * j; t[ty + 8 * j][tx] = W[(size_t)k * N + src0 + tx] * (gain ? gain[k] : 1.0f); }
    __syncthreads();
#pragma unroll
    for (int j = 0; j < 4; ++j) { const int n = n0 + ty + 8 * j; Wt[(size_t)n * K + k0 + tx] = f2bf(t[tx][ty + 8 * j]); }
}
__global__ void k_prep_x(const float* __restrict__ x, bf16* __restrict__ xb, float* __restrict__ ss) {
    const int lane = threadIdx.x & 63; const int row = blockIdx.x * 4 + (threadIdx.x >> 6);
    const f32x4* xr = (const f32x4*)(x + (size_t)row * DM); float s = 0.f;
#pragma unroll
    for (int j = 0; j < 4; ++j) { const f32x4 v = xr[lane + 64 * j]; s += (v[0] * v[0] + v[1] * v[1]) + (v[2] * v[2] + v[3] * v[3]);
        unsigned long long w = (unsigned long long)(f2bf(v[0]) | ((unsigned)f2bf(v[1]) << 16)) | ((unsigned long long)(f2bf(v[2]) | ((unsigned)f2bf(v[3]) << 16)) << 32);
        *(unsigned long long*)(xb + (size_t)row * DM + 4 * (lane + 64 * j)) = w; }
    s = wave_sum(s);
    if (lane < 16) ss[(size_t)row * 16 + lane] = lane == 0 ? s : 0.f;
}
__global__ void k_tables(float* __restrict__ cs, float* __restrict__ sn, const float* __restrict__ hgrn_lb, float* __restrict__ lbv) {
    const int idx = blockIdx.x * blockDim.x + threadIdx.x;
    if (idx < SEQ * 64) { const int s = idx >> 6, i = idx & 63; const float inv = 1.0f / powf(10000.0f, (float)(2 * i) / 128.0f); const float ang = (float)s * inv; cs[idx] = cosf(ang); sn[idx] = sinf(ang); }
    if (idx < 1024) { const float l0 = hgrn_lb[idx], l1 = hgrn_lb[1024 + idx]; const float mx = fmaxf(l0, l1), e0 = expf(l0 - mx), e1 = expf(l1 - mx); lbv[idx] = 0.f; lbv[1024 + idx] = e1 / (e0 + e1); }
}

__global__ __launch_bounds__(128) void k_hg_naive(bf16* __restrict__ big, const float* __restrict__ lbv, const float* __restrict__ og) {
    __shared__ float sq[128], sf[128], sk[128], red[2];
    const int b = blockIdx.x >> 3, h = blockIdx.x & 7, tid = threadIdx.x;
    float S[128];
#pragma unroll
    for (int d = 0; d < 128; ++d) S[d] = 0.f;
    const float lb = lbv[h * 128 + tid], gain = og[tid];
    for (int t = 0; t < SEQ; ++t) {
        bf16* r = big + (size_t)(b * SEQ + t) * 4096 + h * 128 + tid;
        const float q = bf2f(r[0]) * QSCALE, z = bf2f(r[1024]), vv = bf2f(r[2048]), gg = bf2f(r[3072]);
        const float sg = 1.0f / (1.0f + expf(-z)); const float f = lb + (1.0f - lb) * sg; const float k = (1.0f - lb) * (1.0f - sg);
        sq[tid] = q; sf[tid] = f; sk[tid] = k;
        __syncthreads();
        float o = 0.f;
#pragma unroll
        for (int d = 0; d < 128; ++d) { S[d] = sf[d] * S[d] + sk[d] * vv; o += sq[d] * S[d]; }
        const float w = wave_sum(o * o);
        if ((tid & 63) == 0) red[tid >> 6] = w;
        __syncthreads();
        const float tot = red[0] + red[1];
        const float on = o * rsqrtf(tot * (1.0f / 128.0f) + 1e-6f) * gain;
        r[3072] = f2bf(on * (gg / (1.0f + expf(-gg))));
    }
}
__global__ void k_qkprep(bf16* __restrict__ qkv, const float* __restrict__ qg, const float* __restrict__ kg, const float* __restrict__ cs, const float* __restrict__ sn) {
    const int lane = threadIdx.x & 63; const long item = (long)blockIdx.x * 4 + (threadIdx.x >> 6);
    const int which = (int)(item & 1), h = (int)((item >> 1) & 7); const long row = item >> 4;
    bf16* p = qkv + row * 3072 + which * 1024 + h * 128;
    const float x1 = bf2f(p[lane]), x2 = bf2f(p[lane + 64]);
    const float r = rsqrtf(wave_sum(x1 * x1 + x2 * x2) * (1.0f / 128.0f) + 1e-6f);
    const float* g = which ? kg : qg;
    const float y1 = x1 * r * g[lane], y2 = x2 * r * g[lane + 64];
    const int pos = (int)(row & (SEQ - 1)); const float c = cs[pos * 64 + lane], s = sn[pos * 64 + lane];
    float o1 = y1 * c - y2 * s, o2 = y2 * c + y1 * s;
    if (!which) { o1 *= QSCALE; o2 *= QSCALE; }
    p[lane] = f2bf(o1); p[lane + 64] = f2bf(o2);
}
__global__ void k_kmean(const bf16* __restrict__ qkv, float* __restrict__ kmean) {
    const int idx = blockIdx.x * blockDim.x + threadIdx.x;
    const int d = idx & 127, j = (idx >> 7) & 15, h = (idx >> 11) & 7, b = idx >> 14;
    const bf16* p = qkv + (size_t)(b * SEQ + j * MBLK) * 3072 + 1024 + h * 128 + d; float s = 0.f;
    for (int kk = 0; kk < MBLK; ++kk) s += bf2f(p[(size_t)kk * 3072]);
    kmean[idx] = s * (1.0f / 256.0f);
}
__global__ __launch_bounds__(256) void k_attn_naive(bf16* __restrict__ qkv, const float* __restrict__ kmean) {
    __shared__ float sq[4][128]; __shared__ float sp[4][1024];
    const int lane = threadIdx.x & 63, wave = threadIdx.x >> 6;
    for (long it0 = (long)blockIdx.x * 4; it0 < (long)MROWS * 8; it0 += (long)gridDim.x * 4) {
        const long item = it0 + wave; const int h = (int)(item & 7); const long row = item >> 3; const int b = (int)(row >> 12), s = (int)(row & (SEQ - 1)), i = s >> 8;
        bf16* qp = qkv + row * 3072 + h * 128;
        __syncthreads();
        sq[wave][lane] = bf2f(qp[lane]); sq[wave][lane + 64] = bf2f(qp[lane + 64]);
        __syncthreads();
        float gv = -INFINITY;
        if (lane < i) { const float* km = kmean + ((size_t)(b * 8 + h) * 16 + lane) * 128; float a = 0.f; for (int d = 0; d < 128; ++d) a += km[d] * sq[wave][d]; gv = a; }
        const int nsel = i < 3 ? i : 3; int s0 = i, s1 = i, s2 = i;
#pragma unroll
        for (int n = 0; n < 3; ++n) {
            if (n < nsel) { const float m = wave_max(gv); const unsigned long long bal = __ballot(gv == m); const int idx = __ffsll((long long)bal) - 1; if (n == 0) s0 = idx; else if (n == 1) s1 = idx; else s2 = idx; if (lane == idx) gv = -INFINITY; } }
#define PICKB(bi) ((bi) == 0 ? s0 : (bi) == 1 ? s1 : (bi) == 2 ? s2 : i)
        float mx = -INFINITY;
        for (int bi = 0; bi <= nsel; ++bi) { const int kb = PICKB(bi) * MBLK;
            for (int c = 0; c < 4; ++c) { const int key = kb + c * 64 + lane;
                const bf16* kp = qkv + (size_t)(b * SEQ + key) * 3072 + 1024 + h * 128; float a = 0.f;
                for (int d8 = 0; d8 < 16; ++d8) { const u32x4 w = *(const u32x4*)(kp + d8 * 8);
                    const unsigned ww[4] = {w.x, w.y, w.z, w.w};
#pragma unroll
                    for (int e = 0; e < 4; ++e) { a += __uint_as_float(ww[e] << 16) * sq[wave][d8 * 8 + 2 * e]; a += __uint_as_float(ww[e] & 0xffff0000u) * sq[wave][d8 * 8 + 2 * e + 1]; } }
                if (bi == nsel && key > s) a = -INFINITY;
                sp[wave][bi * 256 + c * 64 + lane] = a; mx = fmaxf(mx, a); } }
        mx = wave_max(mx);
        float l = 0.f;
        for (int e = lane; e < (nsel + 1) * 256; e += 64) { const float p = __expf(sp[wave][e] - mx); sp[wave][e] = p; l += p; }
        l = wave_sum(l);
        __syncthreads();
        float o0 = 0.f, o1 = 0.f;
        for (int bi = 0; bi <= nsel; ++bi) { const bf16* vp = qkv + (size_t)(b * SEQ + PICKB(bi) * MBLK) * 3072 + 2048 + h * 128 + lane;
            for (int kk = 0; kk < 256; ++kk) { const float p = sp[wave][bi * 256 + kk]; o0 += p * bf2f(vp[(size_t)kk * 3072]); o1 += p * bf2f(vp[(size_t)kk * 3072 + 64]); } }
        const float il = 1.0f / l;
        qp[lane] = f2bf(o0 * il); qp[lane + 64] = f2bf(o1 * il);
    }
}
__global__ void k_convglu(const bf16* __restrict__ au, bf16* __restrict__ g, const float* __restrict__ cw, const float* __restrict__ cb, int r0, int nrows) {
    const long idx = (long)blockIdx.x * blockDim.x + threadIdx.x; if (idx >= (long)nrows * FF) return;
    const int lr = (int)(idx / FF), f = (int)(idx % FF); const int t = (r0 + lr) & (SEQ - 1);
    const int col = 256 * (f >> 7) + (f & 127); const bf16* ap = au + (size_t)lr * 6144 + col;
    const float a0 = bf2f(ap[0]), a1 = t >= 1 ? bf2f(ap[-6144]) : 0.f, a2 = t >= 2 ? bf2f(ap[-2 * 6144]) : 0.f;
    const float c = cw[f] * a2 + cw[FF + f] * a1 + cw[2 * FF + f] * a0 + cb[f];
    const float u = bf2f(ap[128]);
    g[(size_t)(r0 + lr) * FF + f] = f2bf(c / (1.0f + expf(-c)) * u);
}
template <class Epi> __global__ __launch_bounds__(512, 2) void k_gemm(pg8::Gemm g, Epi E) {
    extern __shared__ __attribute__((aligned(16))) unsigned char shm[];
    pg8::StaticOrder S; S.init(g.M, g.N, (int)gridDim.x, (int)blockIdx.x);
    pg8::gemm_phase<Epi, pg8::StaticOrder, true, true>((PG8_LAS unsigned char*)shm, g, S, E);
}
template <class Epi> static void launch_gemm(const pg8::Gemm& g, const Epi& E, int grid, hipStream_t stream) {
    static bool attr = false;
    if (!attr) { (void)hipFuncSetAttribute((const void*)k_gemm<Epi>, hipFuncAttributeMaxDynamicSharedMemorySize, pg8::STAGE_BYTES); attr = true; }
    hipLaunchKernelGGL((k_gemm<Epi>), dim3(grid), dim3(512), pg8::STAGE_BYTES, stream, g, E);
}

extern "C" void kernel_launch(void* const* d_in, const int* in_sizes, int n_in, void* d_out, int out_size, void* d_ws, size_t ws_size, hipStream_t stream) {
    static int grid = 0;
    if (grid == 0) {
        if (n_in != 15 || in_sizes[0] != MROWS * DM || out_size != MROWS * DM || ws_size < WS_END) {
            fprintf(stderr, "kernel_launch: unexpected shapes (n_in %d, in0 %d, out %d, ws %zu < %zu); nothing launched\n", n_in, n_in > 0 ? in_sizes[0] : -1, out_size, ws_size, (size_t)WS_END); grid = -1; return; }
        int dev = 0, cus = 0;
        if (hipGetDevice(&dev) != hipSuccess || hipDeviceGetAttribute(&cus, hipDeviceAttributeMultiprocessorCount, dev) != hipSuccess || cus <= 0) cus = 256;
        grid = cus;
    }
    if (grid < 0) return;
    const float* x = (const float*)d_in[0]; const float* attn_norm = (const float*)d_in[1]; const float* ffn_norm = (const float*)d_in[2];
    const float* hg_win = (const float*)d_in[3]; const float* hg_lb = (const float*)d_in[4]; const float* hg_on = (const float*)d_in[5]; const float* hg_wo = (const float*)d_in[6];
    const float* mb_wqkv = (const float*)d_in[7]; const float* mb_qn = (const float*)d_in[8]; const float* mb_kn = (const float*)d_in[9]; const float* mb_wo = (const float*)d_in[10];
    const float* f_up = (const float*)d_in[11]; const float* f_cw = (const float*)d_in[12]; const float* f_cb = (const float*)d_in[13]; const float* f_dn = (const float*)d_in[14];
    unsigned char* ws = (unsigned char*)d_ws; float* out = (float*)d_out;
    bf16* XB = (bf16*)(ws + WS_XB); bf16* BIG = (bf16*)(ws + WS_BIG); bf16* AU = (bf16*)(ws + WS_AU); float* SS = (float*)(ws + WS_SS);
    float* COS = (float*)(ws + WS_COS); float* SIN = (float*)(ws + WS_SIN); float* LBV = (float*)(ws + WS_LBV); float* KMEAN = (float*)(ws + WS_KMEAN);
    (void)hipMemsetAsync(ws + WS_CTL, 0, CTL_ZERO_BYTES, stream);
    const dim3 tb(32, 8);
    for (int s = 0; s < 2; ++s) {
        k_convert_w<<<dim3(4096 / 32, 1024 / 32), tb, 0, stream>>>(hg_win + (size_t)s * 1024 * 4096, attn_norm + (2 * s) * 1024, (bf16*)(ws + WS_WIN) + (size_t)s * 4096 * 1024, 1024, 4096, 0);
        k_convert_w<<<dim3(3072 / 32, 1024 / 32), tb, 0, stream>>>(mb_wqkv + (size_t)s * 1024 * 3072, attn_norm + (2 * s + 1) * 1024, (bf16*)(ws + WS_WQKV) + (size_t)s * 3072 * 1024, 1024, 3072, 0);
        k_convert_w<<<dim3(1024 / 32, 1024 / 32), tb, 0, stream>>>(hg_wo + (size_t)s * 1024 * 1024, nullptr, (bf16*)(ws + WS_WOH) + (size_t)s * 1024 * 1024, 1024, 1024, 0);
        k_convert_w<<<dim3(1024 / 32, 1024 / 32), tb, 0, stream>>>(mb_wo + (size_t)s * 1024 * 1024, nullptr, (bf16*)(ws + WS_WOM) + (size_t)s * 1024 * 1024, 1024, 1024, 0);
    }
    for (int l = 0; l < DEPTH; ++l) {
        k_convert_w<<<dim3(6144 / 32, 1024 / 32), tb, 0, stream>>>(f_up + (size_t)l * 1024 * 6144, ffn_norm + l * 1024, (bf16*)(ws + WS_WUP) + (size_t)l * 6144 * 1024, 1024, 6144, 1);
        k_convert_w<<<dim3(1024 / 32, 3072 / 32), tb, 0, stream>>>(f_dn + (size_t)l * 3072 * 1024, nullptr, (bf16*)(ws + WS_WDN) + (size_t)l * 1024 * 3072, 3072, 1024, 0);
    }
    k_prep_x<<<MROWS / 4, 256, 0, stream>>>(x, XB, SS);
    k_tables<<<SEQ * 64 / 256, 256, 0, stream>>>(COS, SIN, hg_lb, LBV);
    for (int l = 0; l < DEPTH; ++l) {
        const int slot = l >> 1; const float* base = l == 0 ? x : out;
        if ((l & 1) == 0) {
            launch_gemm(pg8::Gemm{XB, (bf16*)(ws + WS_WIN) + (size_t)slot * 4096 * 1024, MROWS, 4096, 1024, 1024}, pg8::EpiRowScale{BIG, SS, 4096, 0}, grid, stream);
            k_hg_naive<<<64, 128, 0, stream>>>(BIG, LBV + slot * 1024, hg_on + slot * 128);
            launch_gemm(pg8::Gemm{BIG + 3072, (bf16*)(ws + WS_WOH) + (size_t)slot * 1024 * 1024, MROWS, 1024, 1024, 4096}, pg8::EpiResid{base, out, XB, SS}, grid, stream);
        } else {
            launch_gemm(pg8::Gemm{XB, (bf16*)(ws + WS_WQKV) + (size_t)slot * 3072 * 1024, MROWS, 3072, 1024, 1024}, pg8::EpiRowScale{BIG, SS, 3072, 0}, grid, stream);
            k_qkprep<<<MROWS * 16 / 4, 256, 0, stream>>>(BIG, mb_qn + slot * 128, mb_kn + slot * 128, COS, SIN);
            k_kmean<<<BATCH * NH * NBLK * HD / 256, 256, 0, stream>>>(BIG, KMEAN);
            k_attn_naive<<<4096, 256, 0, stream>>>(BIG, KMEAN);
            launch_gemm(pg8::Gemm{BIG, (bf16*)(ws + WS_WOM) + (size_t)slot * 1024 * 1024, MROWS, 1024, 1024, 3072}, pg8::EpiResid{out, out, XB, SS}, grid, stream);
        }
        for (int e = 0; e < BATCH; ++e) {
            launch_gemm(pg8::Gemm{XB + (size_t)e * SEQ * DM, (bf16*)(ws + WS_WUP) + (size_t)l * 6144 * 1024, SEQ, 6144, 1024, 1024}, pg8::EpiRowScale{AU, SS + (size_t)e * SEQ * 16, 6144, 0}, grid, stream);
            k_convglu<<<SEQ * FF / 256, 256, 0, stream>>>(AU, BIG, f_cw + (size_t)l * 3 * FF, f_cb + (size_t)l * FF, e * SEQ, SEQ);
        }
        launch_gemm(pg8::Gemm{BIG, (bf16*)(ws + WS_WDN) + (size_t)l * 1024 * 3072, MROWS, 1024, 3072, 3072}, pg8::EpiResid{out, out, XB, SS}, grid, stream);
    }
}
```

```cpp
#include <hip/hip_runtime.h>
#include <cstdio>
#include <cstdint>
#include <cmath>
namespace pg8 {
#define PG8_LAS __attribute__((address_space(3)))
typedef unsigned short bf16_t;
typedef short bf16x8 __attribute__((ext_vector_type(8)));
typedef float f32x4 __attribute__((ext_vector_type(4)));
typedef unsigned u32x4 __attribute__((ext_vector_type(4)));
constexpr int BM = 256, BK = 64, HALF = 128, HTB = HALF * BK * 2  , STAGE_BYTES = 8 * HTB, NXCD = 8, WGM = 8;

__host__ __device__ __forceinline__ int lds_byte(int r, int c) { const int st = (r >> 4) * 2 + (c >> 5), rr = r & 15, cc = c & 31, ob = rr * 64 + cc * 2; return st * 1024 + (ob ^ (((ob >> 9) & 1) << 5)); }
__host__ __device__ __forceinline__ void stage_rc(int b, int& R, int& C) { const int st = b / 1024, sb = b % 1024, swz = sb ^ (((sb >> 9) & 1) << 5); R = (st >> 1) * 16 + swz / 64; C = (st & 1) * 32 + (swz % 64) / 2; }
__host__ __device__ __forceinline__ int perm32(int rho) { const int n = rho >> 4, i = rho & 15; return 8 * (i >> 2) + 4 * n + (i & 3); }

struct Unit { int pm, pn; };
struct Gemm { const bf16_t* A; const bf16_t* Bt; int M, N, K, lda; };

struct StaticOrder {
    int nM, nN, nwg, G, c;
    __host__ __device__ void init(int M, int N, int G_, int c_) { nM = M / BM; nN = N / BM; nwg = nM * nN; G = G_; c = c_; }
    __host__ __device__ bool next(int i, Unit& u) const {
        const long L = (long)i * G + c; if (L >= nwg) return false;
        int wgid = (int)L; { const int q = nwg / NXCD, r = nwg % NXCD, xcd = wgid % NXCD, off = wgid / NXCD; wgid = (xcd < r ? xcd * (q + 1) : r * (q + 1) + (xcd - r) * q) + off; }
        const int nig = WGM * nN, gid = wgid / nig, fm = gid * WGM, gsz = (nM - fm) < WGM ? (nM - fm) : WGM;
        u.pm = fm + ((wgid % nig) % gsz); u.pn = (wgid % nig) / gsz; return true;
    }
    __device__ __forceinline__ void a_ready(const Unit&) const {}
    __device__ __forceinline__ void done(const Unit&) const {}
};

__device__ __forceinline__ unsigned cvt_pk_bf16(float lo, float hi) { unsigned r; asm volatile("v_cvt_pk_bf16_f32 %0, %1, %2" : "=v"(r) : "v"(lo), "v"(hi)); return r; }
typedef float f32x2 __attribute__((ext_vector_type(2)));
__device__ __forceinline__ float row_rstd(const float* ss, int row, int fq) {
    const f32x4 a = *(const f32x4*)(ss + (size_t)row * 16 + 4 * fq);
    float s = (a[0] + a[1]) + (a[2] + a[3]);
    s += __shfl_xor(s, 16); s += __shfl_xor(s, 32);
    return __builtin_amdgcn_rsqf(s * (1.0f / 1024.0f) + 1e-6f);
}
struct EpiRowScale {
    static constexpr bool PERM = true, AFTER_DRAIN = false;
    bf16_t* O; const float* ss; int ldc, pad;
    __device__ __forceinline__ void operator()(f32x4 (&acc)[2][2][4][2], const Unit& u, int wr, int wc, int fr, int fq, PG8_LAS unsigned char* lds) const {
        const int row0 = u.pm * BM + wr * 64 + fr; const int col0 = u.pn * BM + wc * 32 + 8 * fq;
#pragma unroll
        for (int ai = 0; ai < 2; ++ai)
#pragma unroll
            for (int m = 0; m < 4; ++m) { const int row = row0 + ai * HALF + m * 16; const float rs = row_rstd(ss, row, fq);
                bf16_t* rowp = O + (size_t)row * ldc + col0;
#pragma unroll
                for (int bj = 0; bj < 2; ++bj) { const f32x4 v0 = acc[ai][bj][m][0] * rs, v1 = acc[ai][bj][m][1] * rs;
                    u32x4 w; w.x = cvt_pk_bf16(v0[0], v0[1]); w.y = cvt_pk_bf16(v0[2], v0[3]); w.z = cvt_pk_bf16(v1[0], v1[1]); w.w = cvt_pk_bf16(v1[2], v1[3]);
                    *(u32x4*)(rowp + bj * HALF) = w; } }
    }
};
typedef unsigned u32x2 __attribute__((ext_vector_type(2)));
struct EpiResid {
    static constexpr bool PERM = false, AFTER_DRAIN = false;
    const float* base; float* out; bf16_t* xb; float* ss;
    __device__ __forceinline__ void operator()(f32x4 (&acc)[2][2][4][2], const Unit& u, int wr, int wc, int fr, int fq, PG8_LAS unsigned char* lds) const {
        const int col0 = u.pn * BM + wc * 32 + 4 * fq;
#pragma unroll
        for (int ai = 0; ai < 2; ++ai)
#pragma unroll
            for (int m = 0; m < 4; ++m) { const int row = u.pm * BM + ai * HALF + wr * 64 + m * 16 + fr; const size_t off = (size_t)row * 1024 + col0; float s = 0.f;
#pragma unroll
                for (int bj = 0; bj < 2; ++bj)
#pragma unroll
                    for (int n = 0; n < 2; ++n) { const f32x4 b = *(const f32x4*)(base + off + bj * HALF + n * 16); const f32x4 o = b + acc[ai][bj][m][n];
                        *(f32x4*)(out + off + bj * HALF + n * 16) = o; s += (o[0] * o[0] + o[1] * o[1]) + (o[2] * o[2] + o[3] * o[3]);
                        u32x2 w; w.x = cvt_pk_bf16(o[0], o[1]); w.y = cvt_pk_bf16(o[2], o[3]); *(u32x2*)(xb + off + bj * HALF + n * 16) = w; }
                s += __shfl_xor(s, 16); s += __shfl_xor(s, 32);
                if (fq == 0) ss[(size_t)row * 16 + u.pn * 4 + wc] = s; }
    }
};
template <int CTRL> __device__ __forceinline__ float dpp_mov(float old, float src) {
    return __builtin_bit_cast(float, __builtin_amdgcn_update_dpp(__builtin_bit_cast(int, old), __builtin_bit_cast(int, src), CTRL, 0xf, 0xf, false)); }
__device__ __forceinline__ float silu_f(float c) { return c * __builtin_amdgcn_rcpf(1.0f + __expf(-c)); }
struct EpiGLU {
    static constexpr bool PERM = true, AFTER_DRAIN = false;
    bf16_t* G; const float* ss; const float* cw; const float* cb; float* tail; float* head_a; float* head_u;
    __device__ __forceinline__ void operator()(f32x4 (&acc)[2][2][4][2], const Unit& u, int wr, int wc, int fr, int fq, PG8_LAS unsigned char* lds) const {
        const int f0 = u.pn * 128 + wc * 32 + 8 * fq;
        PG8_LAS float* X = (PG8_LAS float*)(lds + STAGE_BYTES);
#pragma unroll
        for (int ai = 0; ai < 2; ++ai)
#pragma unroll
            for (int m = 0; m < 4; ++m) { const float rs = row_rstd(ss, u.pm * BM + ai * HALF + wr * 64 + m * 16 + fr, fq);
#pragma unroll
                for (int bj = 0; bj < 2; ++bj)
#pragma unroll
                    for (int n = 0; n < 2; ++n) acc[ai][bj][m][n] = acc[ai][bj][m][n] * rs;
                if (m & 1) asm volatile("" ::: "memory"); }
        if (fr >= 14) {
#pragma unroll
            for (int ai = 0; ai < 2; ++ai)
#pragma unroll
                for (int n = 0; n < 2; ++n) *(PG8_LAS f32x4*)(X + ((((ai * 2 + wr) * 4 + wc) * 2 + (fr - 14)) * 32 + 8 * fq + 4 * n)) = acc[ai][0][3][n];
            if (wr == 1) {
#pragma unroll
                for (int n = 0; n < 2; ++n) *(f32x4*)(tail + ((size_t)u.pm * 2 + (fr - 14)) * 3072 + f0 + 4 * n) = acc[1][0][3][n]; }
        }
        if (wr == 0 && fr < 2) {
#pragma unroll
            for (int n = 0; n < 2; ++n) { *(f32x4*)(head_a + ((size_t)u.pm * 2 + fr) * 3072 + f0 + 4 * n) = acc[0][0][0][n]; *(f32x4*)(head_u + ((size_t)u.pm * 2 + fr) * 3072 + f0 + 4 * n) = acc[0][1][0][n]; } }
        asm volatile("s_waitcnt lgkmcnt(0)" ::: "memory"); __builtin_amdgcn_s_barrier(); asm volatile("" ::: "memory");
#pragma unroll
        for (int n = 0; n < 2; ++n) {
            const f32x4 w0 = *(const f32x4*)(cw + f0 + 4 * n), w1 = *(const f32x4*)(cw + 3072 + f0 + 4 * n), w2 = *(const f32x4*)(cw + 6144 + f0 + 4 * n), bb = *(const f32x4*)(cb + f0 + 4 * n);
#pragma unroll
            for (int ai = 0; ai < 2; ++ai) {
                const int blk = ai * 2 + wr;
                f32x4 P1 = (f32x4){0.f, 0.f, 0.f, 0.f}, P2 = P1;
                if (blk > 0) { P2 = *(const PG8_LAS f32x4*)(X + (((blk - 1) * 4 + wc) * 2 + 0) * 32 + 8 * fq + 4 * n); P1 = *(const PG8_LAS f32x4*)(X + (((blk - 1) * 4 + wc) * 2 + 1) * 32 + 8 * fq + 4 * n); }
#pragma unroll
                for (int m = 0; m < 4; ++m) {
                    f32x4 gv;
#pragma unroll
                    for (int j = 0; j < 4; ++j) {
                        const float cur = acc[ai][0][m][n][j]; float o1, o2;
                        if (m == 0) { o1 = P1[j]; o2 = fr == 0 ? P2[j] : P1[j]; }
                        else { const float pv = acc[ai][0][m > 0 ? m - 1 : 0][n][j]; o1 = dpp_mov<0x121>(pv, pv); o2 = dpp_mov<0x122>(pv, pv); }
                        const float x1 = dpp_mov<0x111>(o1, cur), x2 = dpp_mov<0x112>(o2, cur);
                        const float c = w0[j] * x2 + w1[j] * x1 + w2[j] * cur + bb[j];
                        gv[j] = silu_f(c) * acc[ai][1][m][n][j]; }
                    if (!(blk == 0 && m == 0 && fr < 2)) {
                        u32x2 w; w.x = cvt_pk_bf16(gv[0], gv[1]); w.y = cvt_pk_bf16(gv[2], gv[3]);
                        *(u32x2*)(G + (size_t)(u.pm * BM + ai * HALF + wr * 64 + m * 16 + fr) * 3072 + f0 + 4 * n) = w; }
                    asm volatile("" ::: "memory");
                }
            }
        }
    }
};
template <class Epi, class Sched, bool ALIGN_EPI = false, bool SP2 = false>
__device__ __forceinline__ void gemm_phase(PG8_LAS unsigned char* lds, const Gemm g, const Sched& S, const Epi& E) {
    int tid_ = threadIdx.x; asm volatile("" : "+v"(tid_));
    const int tid = tid_, wid = __builtin_amdgcn_readfirstlane(tid >> 6), lane = tid & 63, wr = wid >> 2, wc = wid & 3, fr = lane & 15, fq = lane >> 4;
    const int K = g.K, nt = K / BK;
    unsigned voffA[2], voffB[2];
#pragma unroll
    for (int i = 0; i < 2; ++i) { int R, C; stage_rc(tid * 16 + i * 8192, R, C); const int Rb = Epi::PERM ? ((R & ~31) + perm32(R & 31)) : R;
        voffA[i] = (unsigned)(R * g.lda + C) * 2u; voffB[i] = (unsigned)(Rb * K + C) * 2u; }
    const size_t kstep = (size_t)(BK * 2);
    const size_t hstepB = (size_t)HALF * K * 2, hstepA = (size_t)HALF * g.lda * 2;
    const size_t tstepA = 2 * hstepA, tstepB = 2 * hstepB;
    const unsigned ldsw = (unsigned)wid * 1024u;
    const int aoff = lds_byte(wr * 64 + fr, fq * 8), boff = lds_byte(wc * 32 + fr, fq * 8);
#define PG8_SA(b, h) (((b) * 2 + (h)) * HTB)
#define PG8_SB(b, h) ((4 + (b) * 2 + (h)) * HTB)
#define PG8_STAGE(bufoff, gbase, voff) do { _Pragma("unroll") for (int _i = 0; _i < 2; ++_i) \
        __builtin_amdgcn_global_load_lds((const unsigned*)((const char*)(gbase) + (voff)[_i]), (PG8_LAS unsigned*)(lds + (bufoff) + ldsw + _i * 8192), 16, 0, 0); } while (0)
#define PG8_LDA(dst, b, h) do { _Pragma("unroll") for (int m = 0; m < 4; ++m) _Pragma("unroll") for (int k = 0; k < 2; ++k) dst[m][k] = *(const PG8_LAS bf16x8*)(lds + PG8_SA(b, h) + aoff + m * 2048 + k * 1024); } while (0)
#define PG8_LDB(dst, b, h) do { _Pragma("unroll") for (int n = 0; n < 2; ++n) _Pragma("unroll") for (int k = 0; k < 2; ++k) dst[n][k] = *(const PG8_LAS bf16x8*)(lds + PG8_SB(b, h) + boff + n * 2048 + k * 1024); } while (0)
#define PG8_MMA(ai, bj, At, Bt) do { __builtin_amdgcn_s_setprio(1); _Pragma("unroll") for (int m = 0; m < 4; ++m) _Pragma("unroll") for (int n = 0; n < 2; ++n) _Pragma("unroll") for (int k = 0; k < 2; ++k) \
        acc[ai][bj][m][n] = __builtin_amdgcn_mfma_f32_16x16x32_bf16(Bt[n][k], At[m][k], acc[ai][bj][m][n], 0, 0, 0); __builtin_amdgcn_s_setprio(0); } while (0)
#define PG8_WAIT_V(n) asm volatile("s_waitcnt vmcnt(" #n ")" ::: "memory")
#define PG8_WAIT_L(n) asm volatile("s_waitcnt lgkmcnt(" #n ")" ::: "memory")
#define PG8_BAR __builtin_amdgcn_s_barrier()
#define PG8_SCHED __builtin_amdgcn_sched_barrier(0)
    Unit cur, nxt; int ui = 0;
    if (!S.next(0, cur)) return;
    f32x4 acc[2][2][4][2];
#pragma unroll
    for (int a = 0; a < 2; ++a)
#pragma unroll
        for (int b = 0; b < 2; ++b)
#pragma unroll
            for (int m = 0; m < 4; ++m)
#pragma unroll
                for (int n = 0; n < 2; ++n) acc[a][b][m][n] = (f32x4){0.f, 0.f, 0.f, 0.f};
    bf16x8 At[4][2], B0[2][2], B1[2][2];
    const char* cA = (const char*)g.A + (size_t)cur.pm * tstepA; const char* cB = (const char*)g.Bt + (size_t)cur.pn * tstepB;
    S.a_ready(cur);
    if constexpr (SP2) {
        PG8_STAGE(PG8_SB(0, 0), cB, voffB); PG8_STAGE(PG8_SB(0, 1), cB + hstepB, voffB); PG8_STAGE(PG8_SA(0, 0), cA, voffA); PG8_STAGE(PG8_SA(0, 1), cA + hstepA, voffA);
        if (wr == 1) PG8_BAR;
        PG8_WAIT_V(2); PG8_BAR;
        PG8_STAGE(PG8_SB(1, 0), cB + kstep, voffB); PG8_STAGE(PG8_SA(1, 0), cA + kstep, voffA); PG8_STAGE(PG8_SB(1, 1), cB + hstepB + kstep, voffB);
        PG8_WAIT_V(6); PG8_BAR;
    } else {
        PG8_STAGE(PG8_SB(0, 0), cB, voffB); PG8_STAGE(PG8_SA(0, 0), cA, voffA); PG8_STAGE(PG8_SB(0, 1), cB + hstepB, voffB); PG8_STAGE(PG8_SA(0, 1), cA + hstepA, voffA);
        if (wr == 1) PG8_BAR;
        PG8_WAIT_V(4); PG8_BAR;
        PG8_STAGE(PG8_SB(1, 0), cB + kstep, voffB); PG8_STAGE(PG8_SA(1, 0), cA + kstep, voffA); PG8_STAGE(PG8_SB(1, 1), cB + hstepB + kstep, voffB);
        PG8_WAIT_V(6); PG8_BAR;
    }
    for (;;) {
        const bool has_next = S.next(ui + 1, nxt);
        const char* nA = has_next ? (const char*)g.A + (size_t)nxt.pm * tstepA : cA; const char* nB = has_next ? (const char*)g.Bt + (size_t)nxt.pn * tstepB : cB;
        for (int t = 0; t < nt; t += 2) {
            const bool last = (t == nt - 2);
            const char* a1 = cA + (size_t)(t + 1) * kstep;
            const char* a2 = last ? nA : cA + (size_t)(t + 2) * kstep; const char* b2 = last ? nB : cB + (size_t)(t + 2) * kstep;
            const char* a3 = a2 + kstep; const char* b3 = b2 + kstep;
            if (last && has_next) S.a_ready(nxt);
            if constexpr (SP2) {
            PG8_LDB(B0, 0, 0); PG8_LDB(B1, 0, 1); PG8_SCHED; PG8_LDA(At, 0, 0); PG8_STAGE(PG8_SA(1, 1), a1 + hstepA, voffA);
            PG8_WAIT_V(8); PG8_WAIT_L(0); PG8_BAR; PG8_MMA(0, 0, At, B0); PG8_MMA(0, 1, At, B1); PG8_BAR; PG8_SCHED;
            PG8_LDA(At, 0, 1); PG8_STAGE(PG8_SB(0, 0), b2, voffB); PG8_STAGE(PG8_SB(0, 1), b2 + hstepB, voffB); PG8_STAGE(PG8_SA(0, 0), a2, voffA);
            PG8_WAIT_V(8); PG8_WAIT_L(0); PG8_BAR; PG8_MMA(1, 0, At, B0); PG8_MMA(1, 1, At, B1); PG8_BAR; PG8_SCHED;
            PG8_LDB(B0, 1, 0); PG8_LDB(B1, 1, 1); PG8_SCHED; PG8_LDA(At, 1, 0); PG8_STAGE(PG8_SA(0, 1), a2 + hstepA, voffA);
            PG8_WAIT_V(8); PG8_WAIT_L(0); PG8_BAR; PG8_MMA(0, 0, At, B0); PG8_MMA(0, 1, At, B1); PG8_BAR; PG8_SCHED;
            PG8_LDA(At, 1, 1); PG8_STAGE(PG8_SB(1, 0), b3, voffB); PG8_STAGE(PG8_SB(1, 1), b3 + hstepB, voffB); PG8_STAGE(PG8_SA(1, 0), a3, voffA);
            PG8_WAIT_V(8); PG8_WAIT_L(0); PG8_BAR; PG8_MMA(1, 0, At, B0); PG8_MMA(1, 1, At, B1); PG8_BAR; PG8_SCHED;
            } else {
            PG8_LDB(B0, 0, 0); PG8_SCHED; PG8_LDA(At, 0, 0); PG8_STAGE(PG8_SA(1, 1), a1 + hstepA, voffA);
            PG8_WAIT_L(8); PG8_BAR; PG8_WAIT_L(0); PG8_MMA(0, 0, At, B0); PG8_BAR; PG8_SCHED;
            PG8_LDB(B1, 0, 1); PG8_STAGE(PG8_SB(0, 0), b2, voffB);
            PG8_BAR; PG8_WAIT_L(0); PG8_MMA(0, 1, At, B1); PG8_BAR;
            PG8_LDA(At, 0, 1); PG8_STAGE(PG8_SA(0, 0), a2, voffA);
            PG8_BAR; PG8_WAIT_L(0); PG8_MMA(1, 0, At, B0); PG8_BAR; PG8_SCHED;
            PG8_STAGE(PG8_SB(0, 1), b2 + hstepB, voffB);
            PG8_WAIT_V(6); PG8_BAR; PG8_MMA(1, 1, At, B1); PG8_BAR;
            PG8_LDB(B0, 1, 0); PG8_SCHED; PG8_LDA(At, 1, 0); PG8_STAGE(PG8_SA(0, 1), a2 + hstepA, voffA);
            PG8_WAIT_L(8); PG8_BAR; PG8_WAIT_L(0); PG8_MMA(0, 0, At, B0); PG8_BAR; PG8_SCHED;
            PG8_LDB(B1, 1, 1); PG8_STAGE(PG8_SB(1, 0), b3, voffB);
            PG8_BAR; PG8_WAIT_L(0); PG8_MMA(0, 1, At, B1); PG8_BAR;
            PG8_LDA(At, 1, 1); PG8_STAGE(PG8_SA(1, 0), a3, voffA);
            PG8_BAR; PG8_WAIT_L(0); PG8_MMA(1, 0, At, B0); PG8_BAR; PG8_SCHED;
            PG8_STAGE(PG8_SB(1, 1), b3 + hstepB, voffB);
            PG8_WAIT_V(6); PG8_BAR; PG8_MMA(1, 1, At, B1); PG8_BAR;
            }
        }
        if constexpr (ALIGN_EPI) { if (wr == 0) PG8_BAR; }
        if constexpr (!Epi::AFTER_DRAIN) { E(acc, cur, wr, wc, fr, fq, lds); S.done(cur); }
        if (!has_next) break;
#pragma unroll
        for (int a = 0; a < 2; ++a)
#pragma unroll
            for (int b = 0; b < 2; ++b)
#pragma unroll
                for (int m = 0; m < 4; ++m)
#pragma unroll
                    for (int n = 0; n < 2; ++n) acc[a][b][m][n] = (f32x4){0.f, 0.f, 0.f, 0.f};
        cur = nxt; cA = nA; cB = nB; ++ui;
        if constexpr (ALIGN_EPI) { if (wr == 1) PG8_BAR; }
    }
    PG8_WAIT_V(0);
    if constexpr (!ALIGN_EPI) { if (wr == 0) PG8_BAR; }
    PG8_BAR;
    if constexpr (Epi::AFTER_DRAIN) { E.fused(acc, cur, wr, wc, fr, fq, lds, wid, lane); S.done(cur); }
#undef PG8_SA
#undef PG8_SB
#undef PG8_STAGE
#undef PG8_LDA
#undef PG8_LDB
#undef PG8_MMA
#undef PG8_WAIT_V
#undef PG8_WAIT_L
#undef PG8_BAR
#undef PG8_SCHED
}
}
constexpr int BATCH = 8, SEQ = 4096, DM = 1024, MROWS = BATCH * SEQ, DEPTH = 4;
constexpr int NH = 8, HD = 128;
constexpr int FF = 3072, NBLK = 16, MBLK = 256;
constexpr float QSCALE = 0.08838834764831845f;
typedef unsigned short bf16;
typedef float f32x4 __attribute__((ext_vector_type(4)));
typedef unsigned u32x4 __attribute__((ext_vector_type(4)));

constexpr size_t MiB = 1u << 20;
constexpr size_t WS_CTL = 0, CTL_ZERO_BYTES = 1 * MiB;
constexpr size_t WS_WIN = 2 * MiB, WS_WQKV = 18 * MiB, WS_WOH = 30 * MiB, WS_WOM = 34 * MiB, WS_WUP = 38 * MiB, WS_WDN = 86 * MiB;
constexpr size_t WS_SS = 110 * MiB, WS_COS = 112 * MiB, WS_SIN = 113 * MiB, WS_LBV = 114 * MiB, WS_KMEAN = 115 * MiB;
constexpr size_t WS_TAIL = 132 * MiB, WS_HEADA = 135 * MiB, WS_HEADU = 138 * MiB;
constexpr size_t WS_XB = 144 * MiB, WS_BIG = 208 * MiB, WS_AU = 400 * MiB, WS_END = 464 * MiB;

__device__ __forceinline__ float bf2f(bf16 v) { return __uint_as_float((unsigned)v << 16); }
__device__ __forceinline__ bf16 f2bf(float f) { unsigned u = __float_as_uint(f); return (bf16)((u + 0x7fffu + ((u >> 16) & 1u)) >> 16); }
__device__ __forceinline__ float wave_sum(float v) {
#pragma unroll
    for (int o = 1; o < 64; o <<= 1) v += __shfl_xor(v, o);
    return v;
}
__device__ __forceinline__ float wave_max(float v) {
#pragma unroll
    for (int o = 1; o < 64; o <<= 1) v = fmaxf(v, __shfl_xor(v, o));
    return v;
}

__device__ __forceinline__ void glu_fixup_elem(int pm, int rr, int f, bf16* __restrict__ g, const float* __restrict__ tail, const float* __restrict__ head_a, const float* __restrict__ head_u, const float* __restrict__ cw, const float* __restrict__ cb) {
    const bool first = (pm & 15) == 0;
    const float cur = head_a[((size_t)pm * 2 + rr) * FF + f];
    const float t1 = first ? 0.f : tail[((size_t)(pm - 1) * 2 + 1) * FF + f], t0 = first ? 0.f : tail[((size_t)(pm - 1) * 2 + 0) * FF + f];
    const float prev1 = rr == 0 ? t1 : head_a[((size_t)pm * 2) * FF + f], prev2 = rr == 0 ? t0 : t1;
    const float c = cw[f] * prev2 + cw[FF + f] * prev1 + cw[2 * FF + f] * cur + cb[f];
    g[((size_t)pm * 256 + rr) * FF + f] = f2bf(c / (1.0f + __expf(-c)) * head_u[((size_t)pm * 2 + rr) * FF + f]);
}
#define XB_TMO      128
#define XB_XCNT(j)  (256  + 64 * (j))
#define XB_XSUB(j)  (1280 + 64 * (j))
#define XB_XGEN(j)  (2304 + 64 * (j))
#define XB_TOP      3328
#define XB_TOPGEN   3392
#define XCD_BAR_WORDS 3456
#define XB_SPIN_CAP (1u << 18)
#define LAS __attribute__((address_space(3)))

__device__ __forceinline__ unsigned xb_ld(unsigned* p)              { return __hip_atomic_load(p, __ATOMIC_RELAXED, __HIP_MEMORY_SCOPE_AGENT); }
__device__ __forceinline__ unsigned xb_add(unsigned* p, unsigned v) { return __hip_atomic_fetch_add(p, v, __ATOMIC_RELAXED, __HIP_MEMORY_SCOPE_AGENT); }
__device__ __forceinline__ unsigned xb_xcc_id() { return (unsigned)__builtin_amdgcn_s_getreg((3 << 11) | 20) & 0xFu; }
#define XB_SPIN(cond, bar) do { unsigned _sp = 0; while (cond) { __builtin_amdgcn_s_sleep(1); \
    if ((++_sp & 255u) == 0u) { if (xb_ld(&(bar)[XB_TMO])) break; if (_sp > XB_SPIN_CAP) { atomicAdd(&(bar)[XB_TMO], 1u); break; } } } } while (0)

struct XcdBarrier {
    unsigned* bar; unsigned x;
    volatile LAS unsigned* st;
};

__device__ __forceinline__ XcdBarrier xcd_barrier_post(unsigned* bar, volatile LAS unsigned* st) {
    XcdBarrier b; b.bar = bar; b.x = xb_xcc_id(); b.st = st;
    if (threadIdx.x == 0) (void)xb_add(&bar[XB_XCNT(b.x)], 1u);
    return b;
}
__device__ __forceinline__ void xcd_barrier_complete(unsigned* bar, unsigned x, unsigned& nloc, unsigned& nx) {
    const unsigned G = gridDim.x * gridDim.y * gridDim.z;
    unsigned sum, cnt, mine, sp = 0u;
    for (;;) {
        sum = 0u; cnt = 0u; mine = 0u;
#pragma unroll
        for (unsigned j = 0; j < 16; ++j) { const unsigned c = xb_ld(&bar[XB_XCNT(j)]); sum += c; cnt += (c > 0u) ? 1u : 0u; mine = (j == x) ? c : mine; }
        if (sum == G) break;
        __builtin_amdgcn_s_sleep(1);
        if ((++sp & 255u) == 0u) { if (xb_ld(&bar[XB_TMO])) break; if (sp > XB_SPIN_CAP) { atomicAdd(&bar[XB_TMO], 1u); break; } }
    }
    nloc = mine > 0u ? mine : 1u; nx = cnt > 0u ? cnt : 1u;
}

__device__ __forceinline__ void xcd_barrier(const XcdBarrier& b) {
    asm volatile("s_waitcnt vmcnt(0)" ::: "memory");
    __syncthreads();
    if (threadIdx.x == 0) {
        unsigned* bar = b.bar;
        __builtin_amdgcn_s_waitcnt(0);
        unsigned nloc = b.st[0], nx = b.st[1];
        if (nloc == 0u) { xcd_barrier_complete(bar, b.x, nloc, nx); b.st[0] = nloc; b.st[1] = nx; }
        const unsigned old = xb_add(&bar[XB_XSUB(b.x)], 1u);
        const unsigned gen = old / nloc;
        if (old + 1u == (gen + 1u) * nloc) {
            __builtin_amdgcn_fence(__ATOMIC_RELEASE, "agent");
            asm volatile("s_waitcnt vmcnt(0)" ::: "memory");
            const unsigned og = xb_add(&bar[XB_TOP], 1u);
            const unsigned tg = og / nx;
            if (og + 1u == (tg + 1u) * nx) xb_add(&bar[XB_TOPGEN], 1u);
            else XB_SPIN(xb_ld(&bar[XB_TOPGEN]) == tg, bar);
            __builtin_amdgcn_fence(__ATOMIC_ACQUIRE, "agent");
            xb_add(&bar[XB_XGEN(b.x)], 1u);
            asm volatile("s_waitcnt vmcnt(0)" ::: "memory");
        } else {
            XB_SPIN(xb_ld(&bar[XB_XGEN(b.x)]) == gen, bar);
            __builtin_amdgcn_fence(__ATOMIC_ACQUIRE, "agent");
            asm volatile("s_waitcnt vmcnt(0)" ::: "memory");
        }
    }
    __syncthreads();
}
#define GAS __attribute__((address_space(1)))
constexpr int NWAVES = 8;
constexpr int RING_OFF = 0, RING_BYTES = 131072;
constexpr int XCH_OFF = 131072;
constexpr int MISC_OFF = 135168;
constexpr int LDS_BYTES = 147456;
constexpr int CW_BAR = 4096;
constexpr int N_PHASES = 25;
static_assert(pg8::STAGE_BYTES == RING_BYTES && XCH_OFF == RING_BYTES, "LDS map");

struct Params { const float* in[15]; float* out; unsigned char* ws; int ph_lo, ph_hi, bar_region, pad; };

#define LDS_WAIT() asm volatile("s_waitcnt lgkmcnt(0)" ::: "memory")
#define VM_WAIT() asm volatile("s_waitcnt vmcnt(0)" ::: "memory")

__device__ __forceinline__ void p0_conv_item(const float* __restrict__ W, const float* __restrict__ gain, int K, int N, bf16* __restrict__ WT, int upperm, LAS float* scr, int item, int lane) {
    const int nblk = N / 32, kb = item / nblk, nb = item % nblk, k0 = 64 * kb, n0 = 32 * nb;
    int src0 = n0;
    if (upperm) { const int pn = n0 >> 8, r = n0 & 255, bj = r >> 7, c = r & 127; src0 = bj * 3072 + 128 * pn + c; }
#pragma unroll 8
    for (int i = 0; i < 32; ++i) { const int kk = 2 * i + (lane >> 5); scr[kk * 33 + (lane & 31)] = W[(size_t)(k0 + kk) * N + src0 + (lane & 31)] * (gain ? gain[k0 + kk] : 1.0f); }
    LDS_WAIT(); asm volatile("" ::: "memory");
    const int c = lane & 7;
#pragma unroll
    for (int j = 0; j < 4; ++j) { const int n = (lane >> 3) + 8 * j; const LAS float* s = scr + (8 * c) * 33 + n;
        u32x4 o; o.x = f2bf(s[0 * 33]) | ((unsigned)f2bf(s[1 * 33]) << 16); o.y = f2bf(s[2 * 33]) | ((unsigned)f2bf(s[3 * 33]) << 16);
        o.z = f2bf(s[4 * 33]) | ((unsigned)f2bf(s[5 * 33]) << 16); o.w = f2bf(s[6 * 33]) | ((unsigned)f2bf(s[7 * 33]) << 16);
        *(u32x4*)(WT + (size_t)(n0 + n) * K + k0 + 8 * c) = o; }
    LDS_WAIT(); asm volatile("" ::: "memory");
}
__device__ __forceinline__ void p0_prologue(const Params& p, LAS unsigned char* lds, int gw, int NGW, int lane, int wave) {
    unsigned char* ws = p.ws;
    LAS float* scr = (LAS float*)(lds + RING_OFF + wave * 16384);
    const float* attn_norm = p.in[1]; const float* ffn_norm = p.in[2];
    constexpr int I_IN = 16 * 128, I_QKV = 16 * 96, I_O = 16 * 32, I_UP = 16 * 192, I_DN = 48 * 32;
    constexpr int NITEMS = 2 * I_IN + 2 * I_QKV + 4 * I_O + 4 * I_UP + 4 * I_DN;
    for (int it = gw; it < NITEMS; it += NGW) {
        int r = it;
        if (r < 2 * I_IN) { const int s = r / I_IN; p0_conv_item(p.in[3] + (size_t)s * 1024 * 4096, attn_norm + (2 * s) * 1024, 1024, 4096, (bf16*)(ws + WS_WIN) + (size_t)s * 4096 * 1024, 0, scr, r % I_IN, lane); continue; } r -= 2 * I_IN;
        if (r < 2 * I_QKV) { const int s = r / I_QKV; p0_conv_item(p.in[7] + (size_t)s * 1024 * 3072, attn_norm + (2 * s + 1) * 1024, 1024, 3072, (bf16*)(ws + WS_WQKV) + (size_t)s * 3072 * 1024, 0, scr, r % I_QKV, lane); continue; } r -= 2 * I_QKV;
        if (r < 2 * I_O) { const int s = r / I_O; p0_conv_item(p.in[6] + (size_t)s * 1024 * 1024, nullptr, 1024, 1024, (bf16*)(ws + WS_WOH) + (size_t)s * 1024 * 1024, 0, scr, r % I_O, lane); continue; } r -= 2 * I_O;
        if (r < 2 * I_O) { const int s = r / I_O; p0_conv_item(p.in[10] + (size_t)s * 1024 * 1024, nullptr, 1024, 1024, (bf16*)(ws + WS_WOM) + (size_t)s * 1024 * 1024, 0, scr, r % I_O, lane); continue; } r -= 2 * I_O;
        if (r < 4 * I_UP) { const int l = r / I_UP; p0_conv_item(p.in[11] + (size_t)l * 1024 * 6144, ffn_norm + l * 1024, 1024, 6144, (bf16*)(ws + WS_WUP) + (size_t)l * 6144 * 1024, 1, scr, r % I_UP, lane); continue; } r -= 4 * I_UP;
        { const int l = r / I_DN; p0_conv_item(p.in[14] + (size_t)l * 3072 * 1024, nullptr, 3072, 1024, (bf16*)(ws + WS_WDN) + (size_t)l * 1024 * 3072, 0, scr, r % I_DN, lane); }
    }
    const float* x = p.in[0]; bf16* xb = (bf16*)(ws + WS_XB); float* ss = (float*)(ws + WS_SS);
    for (int row = gw; row < MROWS; row += NGW) {
        const f32x4* xr = (const f32x4*)(x + (size_t)row * DM); float s = 0.f;
#pragma unroll
        for (int j = 0; j < 4; ++j) { const f32x4 v = xr[lane + 64 * j]; s += (v[0] * v[0] + v[1] * v[1]) + (v[2] * v[2] + v[3] * v[3]);
            unsigned long long w = (unsigned long long)(f2bf(v[0]) | ((unsigned)f2bf(v[1]) << 16)) | ((unsigned long long)(f2bf(v[2]) | ((unsigned)f2bf(v[3]) << 16)) << 32);
            *(unsigned long long*)(xb + (size_t)row * DM + 4 * (lane + 64 * j)) = w; }
        s = wave_sum(s);
        if (lane < 16) ss[(size_t)row * 16 + lane] = lane == 0 ? s : 0.f;
    }
    float* cs = (float*)(ws + WS_COS); float* sn = (float*)(ws + WS_SIN); float* lbv = (float*)(ws + WS_LBV); const float* hgrn_lb = p.in[4];
    for (int idx = gw * 64 + lane; idx < SEQ * 64; idx += NGW * 64) { const int s = idx >> 6, i = idx & 63; const float inv = 1.0f / powf(10000.0f, (float)(2 * i) / 128.0f); const float ang = (float)s * inv; cs[idx] = cosf(ang); sn[idx] = sinf(ang); }
    for (int idx = gw * 64 + lane; idx < 1024; idx += NGW * 64) { const float l0 = hgrn_lb[idx], l1 = hgrn_lb[1024 + idx]; const float mx = fmaxf(l0, l1), e0 = expf(l0 - mx), e1 = expf(l1 - mx); lbv[idx] = 0.f; lbv[1024 + idx] = e1 / (e0 + e1); }
}

__device__ __forceinline__ void kprep_phase(bf16* __restrict__ qkv, const float* __restrict__ qg, const float* __restrict__ kg, const float* __restrict__ cs, const float* __restrict__ sn, float* __restrict__ kmean,
                                            LAS unsigned char* lds, int lane, int wave) {
    const int tidk = wave * 64 + lane;
    LAS float* red = (LAS float*)(lds + RING_OFF);
    for (int u = blockIdx.x; u < 2 * BATCH * NH * NBLK; u += gridDim.x) {
        const int which = u & 1, j = (u >> 1) & 15, h = (u >> 5) & 7, b = u >> 8;
        const float* g = which ? kg : qg; const float g1 = g[lane], g2 = g[lane + 64];
        float a1 = 0.f, a2 = 0.f;
        for (int rr = 0; rr < 32; ++rr) {
            const int pos = j * MBLK + wave * 32 + rr;
            bf16* pp = qkv + (size_t)(b * SEQ + pos) * 3072 + which * 1024 + h * 128;
            const float x1 = bf2f(pp[lane]), x2 = bf2f(pp[lane + 64]);
            const float r = rsqrtf(wave_sum(x1 * x1 + x2 * x2) * (1.0f / 128.0f) + 1e-6f);
            const float y1 = x1 * r * g1, y2 = x2 * r * g2;
            const float c = cs[pos * 64 + lane], s = sn[pos * 64 + lane];
            float o1 = y1 * c - y2 * s, o2 = y2 * c + y1 * s;
            if (!which) { o1 *= QSCALE; o2 *= QSCALE; }
            a1 += o1; a2 += o2;
            pp[lane] = f2bf(o1); pp[lane + 64] = f2bf(o2);
        }
        if (which) {
            red[wave * 128 + lane] = a1; red[wave * 128 + 64 + lane] = a2;
            __syncthreads();
            if (tidk < 128) { float s = 0.f;
#pragma unroll
                for (int w = 0; w < 8; ++w) s += red[w * 128 + tidk];
                kmean[((size_t)(b * 8 + h) * 16 + j) * 128 + tidk] = s * (1.0f / 256.0f); }
            __syncthreads();
        }
    }
}

__device__ __forceinline__ void hg_naive_phase(bf16* __restrict__ big, const float* __restrict__ lbv, const float* __restrict__ og, LAS unsigned char* lds, const int tid) {
    LAS float* sq = (LAS float*)(lds + RING_OFF); LAS float* sf = sq + 128; LAS float* sk = sq + 256; LAS float* red = sq + 384;
    for (int u = blockIdx.x; u < BATCH * NH; u += gridDim.x) {
        const int b = u >> 3, h = u & 7;
        float S[128];
#pragma unroll
        for (int d = 0; d < 128; ++d) S[d] = 0.f;
        const float lb = tid < 128 ? lbv[h * 128 + tid] : 0.f, gain = tid < 128 ? og[tid] : 0.f;
        for (int t = 0; t < SEQ; ++t) {
            bf16* r = big + (size_t)(b * SEQ + t) * 4096 + h * 128 + (tid & 127);
            float q = 0.f, vv = 0.f, gg = 0.f;
            if (tid < 128) { q = bf2f(r[0]) * QSCALE; const float z = bf2f(r[1024]); vv = bf2f(r[2048]); gg = bf2f(r[3072]);
                const float sg = 1.0f / (1.0f + expf(-z)); const float f = lb + (1.0f - lb) * sg; const float k = (1.0f - lb) * (1.0f - sg);
                sq[tid] = q; sf[tid] = f; sk[tid] = k; }
            __syncthreads();
            float o = 0.f;
            if (tid < 128) {
#pragma unroll
                for (int d = 0; d < 128; ++d) { S[d] = sf[d] * S[d] + sk[d] * vv; o += sq[d] * S[d]; }
                const float w = wave_sum(o * o);
                if ((tid & 63) == 0) red[tid >> 6] = w; }
            __syncthreads();
            if (tid < 128) { const float tot = red[0] + red[1];
                const float on = o * rsqrtf(tot * (1.0f / 128.0f) + 1e-6f) * gain;
                r[3072] = f2bf(on * (gg / (1.0f + expf(-gg)))); }
        }
    }
}
__device__ __forceinline__ void attn_naive_phase(bf16* __restrict__ qkv, const float* __restrict__ kmean, LAS unsigned char* lds, int lane, int wave) {
    LAS float* sq = (LAS float*)(lds + RING_OFF) + wave * 128;
    LAS float* sp = (LAS float*)(lds + RING_OFF + 4096) + wave * 1024;
    for (long it0 = (long)blockIdx.x * 8; it0 < (long)MROWS * 8; it0 += (long)gridDim.x * 8) {
        const long item = it0 + wave; const int h = (int)(item & 7); const long row = item >> 3; const int b = (int)(row >> 12), s = (int)(row & (SEQ - 1)), i = s >> 8;
        bf16* qp = qkv + row * 3072 + h * 128;
        __syncthreads();
        sq[lane] = bf2f(qp[lane]); sq[lane + 64] = bf2f(qp[lane + 64]);
        __syncthreads();
        float gv = -INFINITY;
        if (lane < i) { const float* km = kmean + ((size_t)(b * 8 + h) * 16 + lane) * 128; float a = 0.f; for (int d = 0; d < 128; ++d) a += km[d] * sq[d]; gv = a; }
        const int nsel = i < 3 ? i : 3; int s0 = i, s1 = i, s2 = i;
#pragma unroll
        for (int n = 0; n < 3; ++n) {
            if (n < nsel) { const float m = wave_max(gv); const unsigned long long bal = __ballot(gv == m); const int idx = __ffsll((long long)bal) - 1; if (n == 0) s0 = idx; else if (n == 1) s1 = idx; else s2 = idx; if (lane == idx) gv = -INFINITY; } }
#define PICKB(bi) ((bi) == 0 ? s0 : (bi) == 1 ? s1 : (bi) == 2 ? s2 : i)
        float mx = -INFINITY;
        for (int bi = 0; bi <= nsel; ++bi) { const int kb = PICKB(bi) * MBLK;
            for (int c = 0; c < 4; ++c) { const int key = kb + c * 64 + lane;
                const bf16* kp = qkv + (size_t)(b * SEQ + key) * 3072 + 1024 + h * 128; float a = 0.f;
                for (int d8 = 0; d8 < 16; ++d8) { const u32x4 w = *(const u32x4*)(kp + d8 * 8);
                    const unsigned ww[4] = {w.x, w.y, w.z, w.w};
#pragma unroll
                    for (int e = 0; e < 4; ++e) { a += __uint_as_float(ww[e] << 16) * sq[d8 * 8 + 2 * e]; a += __uint_as_float(ww[e] & 0xffff0000u) * sq[d8 * 8 + 2 * e + 1]; } }
                if (bi == nsel && key > s) a = -INFINITY;
                sp[bi * 256 + c * 64 + lane] = a; mx = fmaxf(mx, a); } }
        mx = wave_max(mx);
        float l = 0.f;
        for (int e = lane; e < (nsel + 1) * 256; e += 64) { const float pr = __expf(sp[e] - mx); sp[e] = pr; l += pr; }
        l = wave_sum(l);
        __syncthreads();
        float o0 = 0.f, o1 = 0.f;
        for (int bi = 0; bi <= nsel; ++bi) { const bf16* vp = qkv + (size_t)(b * SEQ + PICKB(bi) * MBLK) * 3072 + 2048 + h * 128 + lane;
            for (int kk = 0; kk < 256; ++kk) { const float pr = sp[bi * 256 + kk]; o0 += pr * bf2f(vp[(size_t)kk * 3072]); o1 += pr * bf2f(vp[(size_t)kk * 3072 + 64]); } }
#undef PICKB
        const float il = 1.0f / l;
        qp[lane] = f2bf(o0 * il); qp[lane + 64] = f2bf(o1 * il);
    }
}

__global__ void __launch_bounds__(NWAVES * 64, 2) mega_fwd(Params p) {
    extern __shared__ __attribute__((aligned(16))) unsigned char lds_raw[];
    LAS unsigned char* lds = (LAS unsigned char*)lds_raw;
    const int G = gridDim.x;
    unsigned char* ws = p.ws;
    for (int u = threadIdx.x; u < (LDS_BYTES - MISC_OFF) / 4; u += NWAVES * 64) ((LAS unsigned*)(lds + MISC_OFF))[u] = 0u;
    __syncthreads();
#define PHASE_IDS() int tid = threadIdx.x; asm volatile("" : "+v"(tid)); const int lane = tid & 63, wave = __builtin_amdgcn_readfirstlane(tid >> 6); (void)lane; (void)wave
    const int lo = p.ph_lo, hi = p.ph_hi;
    XcdBarrier bar; bar.bar = (unsigned*)(ws + WS_CTL) + CW_BAR + p.bar_region * XCD_BAR_WORDS; bar.x = 0; bar.st = nullptr;
    if (hi - lo > 1) bar = xcd_barrier_post((unsigned*)(ws + WS_CTL) + CW_BAR + p.bar_region * XCD_BAR_WORDS, (volatile LAS unsigned*)(lds + MISC_OFF));
#define IN(k) (lo <= (k) && (k) < hi)
#define SEAM(k) do { if (IN(k) && IN((k) + 1)) xcd_barrier(bar); } while (0)
    float* out = p.out; bf16* XB = (bf16*)(ws + WS_XB); bf16* BIG = (bf16*)(ws + WS_BIG); float* SS = (float*)(ws + WS_SS);
    const float* COS = (const float*)(ws + WS_COS); const float* SIN = (const float*)(ws + WS_SIN); const float* LBV = (const float*)(ws + WS_LBV); float* KMEAN = (float*)(ws + WS_KMEAN);
    float* TAIL = (float*)(ws + WS_TAIL); float* HEADA = (float*)(ws + WS_HEADA); float* HEADU = (float*)(ws + WS_HEADU);

    if (IN(0)) { PHASE_IDS(); p0_prologue(p, lds, blockIdx.x * NWAVES + wave, G * NWAVES, lane, wave); }
    SEAM(0);
    for (int l = 0; l < DEPTH; ++l) {
        const int pb = 1 + 6 * l, slot = l >> 1; const bool moba = (l & 1) != 0;
        if (IN(pb)) {
            const int N = moba ? 3072 : 4096;
            const bf16* Bt = moba ? (const bf16*)(ws + WS_WQKV) + (size_t)slot * 3072 * 1024 : (const bf16*)(ws + WS_WIN) + (size_t)slot * 4096 * 1024;
            pg8::Gemm g{XB, Bt, MROWS, N, 1024, 1024}; pg8::StaticOrder S; S.init(MROWS, N, G, (int)blockIdx.x);
            pg8::EpiRowScale E{BIG, SS, N, 0};
            pg8::gemm_phase<pg8::EpiRowScale, pg8::StaticOrder, true, true>(lds + RING_OFF, g, S, E);
        }
        SEAM(pb);
        if (moba) {
            if (IN(pb + 1)) { PHASE_IDS(); kprep_phase(BIG, p.in[8] + slot * 128, p.in[9] + slot * 128, COS, SIN, KMEAN, lds, lane, wave); }
            SEAM(pb + 1);
#ifndef NO_ATTN
            if (IN(pb + 2)) { PHASE_IDS(); attn_naive_phase(BIG, KMEAN, lds, lane, wave); }
#endif
            SEAM(pb + 2);
        } else {
            SEAM(pb + 1);
#ifndef NO_HG
            if (IN(pb + 2)) { PHASE_IDS(); hg_naive_phase(BIG, LBV + slot * 1024, p.in[5] + slot * 128, lds, tid); }
#endif
            SEAM(pb + 2);
        }
        if (IN(pb + 3)) {
            const bf16* A = moba ? BIG : BIG + 3072; const int lda = moba ? 3072 : 4096;
            const bf16* Bt = moba ? (const bf16*)(ws + WS_WOM) + (size_t)slot * 1024 * 1024 : (const bf16*)(ws + WS_WOH) + (size_t)slot * 1024 * 1024;
            pg8::Gemm g{A, Bt, MROWS, 1024, 1024, lda}; pg8::StaticOrder S; S.init(MROWS, 1024, G, (int)blockIdx.x);
            pg8::EpiResid E{l == 0 ? p.in[0] : out, out, XB, SS};
            pg8::gemm_phase<pg8::EpiResid, pg8::StaticOrder, true, true>(lds + RING_OFF, g, S, E);
        }
        SEAM(pb + 3);
        const float* cw = p.in[12] + (size_t)l * 3 * FF; const float* cb = p.in[13] + (size_t)l * FF;
#ifndef NO_GLU
        if (IN(pb + 4)) {
            pg8::Gemm g{XB, (const bf16*)(ws + WS_WUP) + (size_t)l * 6144 * 1024, MROWS, 6144, 1024, 1024}; pg8::StaticOrder S; S.init(MROWS, 6144, G, (int)blockIdx.x);
            pg8::EpiGLU E{BIG, SS, cw, cb, TAIL, HEADA, HEADU};
            pg8::gemm_phase<pg8::EpiGLU, pg8::StaticOrder, true, true>(lds + RING_OFF, g, S, E);
        }
#endif
        SEAM(pb + 4);
        if (IN(pb + 5)) {
            pg8::Gemm g{BIG, (const bf16*)(ws + WS_WDN) + (size_t)l * 1024 * 3072, MROWS, 1024, 3072, 3072}; pg8::StaticOrder S; S.init(MROWS, 1024, G, (int)blockIdx.x);
            pg8::Unit u; PHASE_IDS();
            for (int i = 0; S.next(i, u); ++i)
                for (int e = tid; e < 2 * FF; e += NWAVES * 64) glu_fixup_elem(u.pm, e / FF, e % FF, BIG, TAIL, HEADA, HEADU, cw, cb);
            VM_WAIT(); __syncthreads();
            pg8::EpiResid E{out, out, XB, SS};
            pg8::gemm_phase<pg8::EpiResid, pg8::StaticOrder, true, true>(lds + RING_OFF, g, S, E);
        }
        if (l < DEPTH - 1) SEAM(pb + 5);
    }
#undef IN
#undef SEAM
}

#ifndef MK_PER_PHASE
#define MK_PER_PHASE 0
#endif
extern "C" void kernel_launch(void* const* d_in, const int* in_sizes, int n_in, void* d_out, int out_size, void* d_ws, size_t ws_size, hipStream_t stream) {
    static int grid = 0;
    if (grid == 0) {
        if (n_in != 15 || in_sizes[0] != MROWS * DM || out_size != MROWS * DM || ws_size < WS_END) {
            fprintf(stderr, "kernel_launch: unexpected shapes (n_in %d, in0 %d, out %d, ws %zu < %zu); nothing launched\n", n_in, n_in > 0 ? in_sizes[0] : -1, out_size, ws_size, (size_t)WS_END); grid = -1; return; }
        int dev = 0, cus = 0, per_cu = 0;
        if (hipGetDevice(&dev) != hipSuccess || hipDeviceGetAttribute(&cus, hipDeviceAttributeMultiprocessorCount, dev) != hipSuccess || cus <= 0) { fprintf(stderr, "kernel_launch: no device attributes\n"); grid = -1; return; }
        if (hipFuncSetAttribute((const void*)mega_fwd, hipFuncAttributeMaxDynamicSharedMemorySize, LDS_BYTES) != hipSuccess) { fprintf(stderr, "kernel_launch: hipFuncSetAttribute failed\n"); grid = -1; return; }
        if (hipOccupancyMaxActiveBlocksPerMultiprocessor(&per_cu, (const void*)mega_fwd, NWAVES * 64, LDS_BYTES) != hipSuccess || per_cu < 1)
            fprintf(stderr, "kernel_launch: note: occupancy query reports %d workgroups per CU; launching one per CU (144 KiB LDS each admits exactly one)\n", per_cu);
        (void)hipGetLastError();
        grid = cus;
    }
    if (grid < 0) return;
    (void)hipMemsetAsync((char*)d_ws + WS_CTL, 0, CTL_ZERO_BYTES, stream);
    Params p{};
    for (int i = 0; i < 15; ++i) p.in[i] = (const float*)d_in[i];
    p.out = (float*)d_out; p.ws = (unsigned char*)d_ws;
#if MK_PER_PHASE
    for (int k = 0; k < N_PHASES; ++k) { p.ph_lo = k; p.ph_hi = k + 1; p.bar_region = 0; hipLaunchKernelGGL(mega_fwd, dim3(grid), dim3(NWAVES * 64), LDS_BYTES, stream, p); }
#else
    p.ph_lo = 0; p.ph_hi = N_PHASES; p.bar_region = 0;
    hipLaunchKernelGGL(mega_fwd, dim3(grid), dim3(NWAVES * 64), LDS_BYTES, stream, p);
#endif
}
```

```cpp
#include <hip/hip_runtime.h>
#include <cstdio>
#include <cstdint>
#include <cmath>
namespace pg8 {
#define PG8_LAS __attribute__((address_space(3)))
typedef unsigned short bf16_t;
typedef short bf16x8 __attribute__((ext_vector_type(8)));
typedef float f32x4 __attribute__((ext_vector_type(4)));
typedef unsigned u32x4 __attribute__((ext_vector_type(4)));
constexpr int BM = 256, BK = 64, HALF = 128, HTB = HALF * BK * 2  , STAGE_BYTES = 8 * HTB, NXCD = 8, WGM = 8;

__host__ __device__ __forceinline__ int lds_byte(int r, int c) { const int st = (r >> 4) * 2 + (c >> 5), rr = r & 15, cc = c & 31, ob = rr * 64 + cc * 2; return st * 1024 + (ob ^ (((ob >> 9) & 1) << 5)); }
__host__ __device__ __forceinline__ void stage_rc(int b, int& R, int& C) { const int st = b / 1024, sb = b % 1024, swz = sb ^ (((sb >> 9) & 1) << 5); R = (st >> 1) * 16 + swz / 64; C = (st & 1) * 32 + (swz % 64) / 2; }
__host__ __device__ __forceinline__ int perm32(int rho) { const int n = rho >> 4, i = rho & 15; return 8 * (i >> 2) + 4 * n + (i & 3); }

struct Unit { int pm, pn; };
struct Gemm { const bf16_t* A; const bf16_t* Bt; int M, N, K, lda; };

struct StaticOrder {
    int nM, nN, nwg, G, c;
    __host__ __device__ void init(int M, int N, int G_, int c_) { nM = M / BM; nN = N / BM; nwg = nM * nN; G = G_; c = c_; }
    __host__ __device__ bool next(int i, Unit& u) const {
        const long L = (long)i * G + c; if (L >= nwg) return false;
        int wgid = (int)L; { const int q = nwg / NXCD, r = nwg % NXCD, xcd = wgid % NXCD, off = wgid / NXCD; wgid = (xcd < r ? xcd * (q + 1) : r * (q + 1) + (xcd - r) * q) + off; }
        const int nig = WGM * nN, gid = wgid / nig, fm = gid * WGM, gsz = (nM - fm) < WGM ? (nM - fm) : WGM;
        u.pm = fm + ((wgid % nig) % gsz); u.pn = (wgid % nig) / gsz; return true;
    }
    __device__ __forceinline__ void a_ready(const Unit&) const {}
    __device__ __forceinline__ void done(const Unit&) const {}
};

__device__ __forceinline__ unsigned cvt_pk_bf16(float lo, float hi) { unsigned r; asm volatile("v_cvt_pk_bf16_f32 %0, %1, %2" : "=v"(r) : "v"(lo), "v"(hi)); return r; }
typedef float f32x2 __attribute__((ext_vector_type(2)));
__device__ __forceinline__ float row_rstd(const float* ss, int row, int fq) {
    const f32x4 a = *(const f32x4*)(ss + (size_t)row * 16 + 4 * fq);
    float s = (a[0] + a[1]) + (a[2] + a[3]);
    s += __shfl_xor(s, 16); s += __shfl_xor(s, 32);
    return __builtin_amdgcn_rsqf(s * (1.0f / 1024.0f) + 1e-6f);
}
struct EpiRowScale {
    static constexpr bool PERM = true, AFTER_DRAIN = false;
    bf16_t* O; const float* ss; int ldc, pad;
    __device__ __forceinline__ void operator()(f32x4 (&acc)[2][2][4][2], const Unit& u, int wr, int wc, int fr, int fq, PG8_LAS unsigned char* lds) const {
        const int row0 = u.pm * BM + wr * 64 + fr; const int col0 = u.pn * BM + wc * 32 + 8 * fq;
#pragma unroll
        for (int ai = 0; ai < 2; ++ai)
#pragma unroll
            for (int m = 0; m < 4; ++m) { const int row = row0 + ai * HALF + m * 16; const float rs = row_rstd(ss, row, fq);
                bf16_t* rowp = O + (size_t)row * ldc + col0;
#pragma unroll
                for (int bj = 0; bj < 2; ++bj) { const f32x4 v0 = acc[ai][bj][m][0] * rs, v1 = acc[ai][bj][m][1] * rs;
                    u32x4 w; w.x = cvt_pk_bf16(v0[0], v0[1]); w.y = cvt_pk_bf16(v0[2], v0[3]); w.z = cvt_pk_bf16(v1[0], v1[1]); w.w = cvt_pk_bf16(v1[2], v1[3]);
                    *(u32x4*)(rowp + bj * HALF) = w; } }
    }
};
typedef unsigned u32x2 __attribute__((ext_vector_type(2)));
struct EpiResid {
    static constexpr bool PERM = false, AFTER_DRAIN = false;
    const float* base; float* out; bf16_t* xb; float* ss;
    __device__ __forceinline__ void operator()(f32x4 (&acc)[2][2][4][2], const Unit& u, int wr, int wc, int fr, int fq, PG8_LAS unsigned char* lds) const {
        const int col0 = u.pn * BM + wc * 32 + 4 * fq;
#pragma unroll
        for (int ai = 0; ai < 2; ++ai)
#pragma unroll
            for (int m = 0; m < 4; ++m) { const int row = u.pm * BM + ai * HALF + wr * 64 + m * 16 + fr; const size_t off = (size_t)row * 1024 + col0; float s = 0.f;
#pragma unroll
                for (int bj = 0; bj < 2; ++bj)
#pragma unroll
                    for (int n = 0; n < 2; ++n) { const f32x4 b = *(const f32x4*)(base + off + bj * HALF + n * 16); const f32x4 o = b + acc[ai][bj][m][n];
                        *(f32x4*)(out + off + bj * HALF + n * 16) = o; s += (o[0] * o[0] + o[1] * o[1]) + (o[2] * o[2] + o[3] * o[3]);
                        u32x2 w; w.x = cvt_pk_bf16(o[0], o[1]); w.y = cvt_pk_bf16(o[2], o[3]); *(u32x2*)(xb + off + bj * HALF + n * 16) = w; }
                s += __shfl_xor(s, 16); s += __shfl_xor(s, 32);
                if (fq == 0) ss[(size_t)row * 16 + u.pn * 4 + wc] = s; }
    }
};
template <int CTRL> __device__ __forceinline__ float dpp_mov(float old, float src) {
    return __builtin_bit_cast(float, __builtin_amdgcn_update_dpp(__builtin_bit_cast(int, old), __builtin_bit_cast(int, src), CTRL, 0xf, 0xf, false)); }
__device__ __forceinline__ float silu_f(float c) { return c * __builtin_amdgcn_rcpf(1.0f + __expf(-c)); }
struct EpiGLU {
    static constexpr bool PERM = true, AFTER_DRAIN = false;
    bf16_t* G; const float* ss; const float* cw; const float* cb; float* tail; float* head_a; float* head_u;
    __device__ __forceinline__ void operator()(f32x4 (&acc)[2][2][4][2], const Unit& u, int wr, int wc, int fr, int fq, PG8_LAS unsigned char* lds) const {
        const int f0 = u.pn * 128 + wc * 32 + 8 * fq;
        PG8_LAS float* X = (PG8_LAS float*)(lds + STAGE_BYTES);
#pragma unroll
        for (int ai = 0; ai < 2; ++ai)
#pragma unroll
            for (int m = 0; m < 4; ++m) { const float rs = row_rstd(ss, u.pm * BM + ai * HALF + wr * 64 + m * 16 + fr, fq);
#pragma unroll
                for (int bj = 0; bj < 2; ++bj)
#pragma unroll
                    for (int n = 0; n < 2; ++n) acc[ai][bj][m][n] = acc[ai][bj][m][n] * rs;
                if (m & 1) asm volatile("" ::: "memory"); }
        if (fr >= 14) {
#pragma unroll
            for (int ai = 0; ai < 2; ++ai)
#pragma unroll
                for (int n = 0; n < 2; ++n) *(PG8_LAS f32x4*)(X + ((((ai * 2 + wr) * 4 + wc) * 2 + (fr - 14)) * 32 + 8 * fq + 4 * n)) = acc[ai][0][3][n];
            if (wr == 1) {
#pragma unroll
                for (int n = 0; n < 2; ++n) *(f32x4*)(tail + ((size_t)u.pm * 2 + (fr - 14)) * 3072 + f0 + 4 * n) = acc[1][0][3][n]; }
        }
        if (wr == 0 && fr < 2) {
#pragma unroll
            for (int n = 0; n < 2; ++n) { *(f32x4*)(head_a + ((size_t)u.pm * 2 + fr) * 3072 + f0 + 4 * n) = acc[0][0][0][n]; *(f32x4*)(head_u + ((size_t)u.pm * 2 + fr) * 3072 + f0 + 4 * n) = acc[0][1][0][n]; } }
        asm volatile("s_waitcnt lgkmcnt(0)" ::: "memory"); __builtin_amdgcn_s_barrier(); asm volatile("" ::: "memory");
#pragma unroll
        for (int n = 0; n < 2; ++n) {
            const f32x4 w0 = *(const f32x4*)(cw + f0 + 4 * n), w1 = *(const f32x4*)(cw + 3072 + f0 + 4 * n), w2 = *(const f32x4*)(cw + 6144 + f0 + 4 * n), bb = *(const f32x4*)(cb + f0 + 4 * n);
#pragma unroll
            for (int ai = 0; ai < 2; ++ai) {
                const int blk = ai * 2 + wr;
                f32x4 P1 = (f32x4){0.f, 0.f, 0.f, 0.f}, P2 = P1;
                if (blk > 0) { P2 = *(const PG8_LAS f32x4*)(X + (((blk - 1) * 4 + wc) * 2 + 0) * 32 + 8 * fq + 4 * n); P1 = *(const PG8_LAS f32x4*)(X + (((blk - 1) * 4 + wc) * 2 + 1) * 32 + 8 * fq + 4 * n); }
#pragma unroll
                for (int m = 0; m < 4; ++m) {
                    f32x4 gv;
#pragma unroll
                    for (int j = 0; j < 4; ++j) {
                        const float cur = acc[ai][0][m][n][j]; float o1, o2;
                        if (m == 0) { o1 = P1[j]; o2 = fr == 0 ? P2[j] : P1[j]; }
                        else { const float pv = acc[ai][0][m > 0 ? m - 1 : 0][n][j]; o1 = dpp_mov<0x121>(pv, pv); o2 = dpp_mov<0x122>(pv, pv); }
                        const float x1 = dpp_mov<0x111>(o1, cur), x2 = dpp_mov<0x112>(o2, cur);
                        const float c = w0[j] * x2 + w1[j] * x1 + w2[j] * cur + bb[j];
                        gv[j] = silu_f(c) * acc[ai][1][m][n][j]; }
                    if (!(blk == 0 && m == 0 && fr < 2)) {
                        u32x2 w; w.x = cvt_pk_bf16(gv[0], gv[1]); w.y = cvt_pk_bf16(gv[2], gv[3]);
                        *(u32x2*)(G + (size_t)(u.pm * BM + ai * HALF + wr * 64 + m * 16 + fr) * 3072 + f0 + 4 * n) = w; }
                    asm volatile("" ::: "memory");
                }
            }
        }
    }
};
template <class Epi, class Sched, bool ALIGN_EPI = false, bool SP2 = false>
__device__ __forceinline__ void gemm_phase(PG8_LAS unsigned char* lds, const Gemm g, const Sched& S, const Epi& E) {
    int tid_ = threadIdx.x; asm volatile("" : "+v"(tid_));
    const int tid = tid_, wid = __builtin_amdgcn_readfirstlane(tid >> 6), lane = tid & 63, wr = wid >> 2, wc = wid & 3, fr = lane & 15, fq = lane >> 4;
    const int K = g.K, nt = K / BK;
    unsigned voffA[2], voffB[2];
#pragma unroll
    for (int i = 0; i < 2; ++i) { int R, C; stage_rc(tid * 16 + i * 8192, R, C); const int Rb = Epi::PERM ? ((R & ~31) + perm32(R & 31)) : R;
        voffA[i] = (unsigned)(R * g.lda + C) * 2u; voffB[i] = (unsigned)(Rb * K + C) * 2u; }
    const size_t kstep = (size_t)(BK * 2);
    const size_t hstepB = (size_t)HALF * K * 2, hstepA = (size_t)HALF * g.lda * 2;
    const size_t tstepA = 2 * hstepA, tstepB = 2 * hstepB;
    const unsigned ldsw = (unsigned)wid * 1024u;
    const int aoff = lds_byte(wr * 64 + fr, fq * 8), boff = lds_byte(wc * 32 + fr, fq * 8);
#define PG8_SA(b, h) (((b) * 2 + (h)) * HTB)
#define PG8_SB(b, h) ((4 + (b) * 2 + (h)) * HTB)
#define PG8_STAGE(bufoff, gbase, voff) do { _Pragma("unroll") for (int _i = 0; _i < 2; ++_i) \
        __builtin_amdgcn_global_load_lds((const unsigned*)((const char*)(gbase) + (voff)[_i]), (PG8_LAS unsigned*)(lds + (bufoff) + ldsw + _i * 8192), 16, 0, 0); } while (0)
#define PG8_LDA(dst, b, h) do { _Pragma("unroll") for (int m = 0; m < 4; ++m) _Pragma("unroll") for (int k = 0; k < 2; ++k) dst[m][k] = *(const PG8_LAS bf16x8*)(lds + PG8_SA(b, h) + aoff + m * 2048 + k * 1024); } while (0)
#define PG8_LDB(dst, b, h) do { _Pragma("unroll") for (int n = 0; n < 2; ++n) _Pragma("unroll") for (int k = 0; k < 2; ++k) dst[n][k] = *(const PG8_LAS bf16x8*)(lds + PG8_SB(b, h) + boff + n * 2048 + k * 1024); } while (0)
#define PG8_MMA(ai, bj, At, Bt) do { __builtin_amdgcn_s_setprio(1); _Pragma("unroll") for (int m = 0; m < 4; ++m) _Pragma("unroll") for (int n = 0; n < 2; ++n) _Pragma("unroll") for (int k = 0; k < 2; ++k) \
        acc[ai][bj][m][n] = __builtin_amdgcn_mfma_f32_16x16x32_bf16(Bt[n][k], At[m][k], acc[ai][bj][m][n], 0, 0, 0); __builtin_amdgcn_s_setprio(0); } while (0)
#define PG8_WAIT_V(n) asm volatile("s_waitcnt vmcnt(" #n ")" ::: "memory")
#define PG8_WAIT_L(n) asm volatile("s_waitcnt lgkmcnt(" #n ")" ::: "memory")
#define PG8_BAR __builtin_amdgcn_s_barrier()
#define PG8_SCHED __builtin_amdgcn_sched_barrier(0)
    Unit cur, nxt; int ui = 0;
    if (!S.next(0, cur)) return;
    f32x4 acc[2][2][4][2];
#pragma unroll
    for (int a = 0; a < 2; ++a)
#pragma unroll
        for (int b = 0; b < 2; ++b)
#pragma unroll
            for (int m = 0; m < 4; ++m)
#pragma unroll
                for (int n = 0; n < 2; ++n) acc[a][b][m][n] = (f32x4){0.f, 0.f, 0.f, 0.f};
    bf16x8 At[4][2], B0[2][2], B1[2][2];
    const char* cA = (const char*)g.A + (size_t)cur.pm * tstepA; const char* cB = (const char*)g.Bt + (size_t)cur.pn * tstepB;
    S.a_ready(cur);
    if constexpr (SP2) {
        PG8_STAGE(PG8_SB(0, 0), cB, voffB); PG8_STAGE(PG8_SB(0, 1), cB + hstepB, voffB); PG8_STAGE(PG8_SA(0, 0), cA, voffA); PG8_STAGE(PG8_SA(0, 1), cA + hstepA, voffA);
        if (wr == 1) PG8_BAR;
        PG8_WAIT_V(2); PG8_BAR;
        PG8_STAGE(PG8_SB(1, 0), cB + kstep, voffB); PG8_STAGE(PG8_SA(1, 0), cA + kstep, voffA); PG8_STAGE(PG8_SB(1, 1), cB + hstepB + kstep, voffB);
        PG8_WAIT_V(6); PG8_BAR;
    } else {
        PG8_STAGE(PG8_SB(0, 0), cB, voffB); PG8_STAGE(PG8_SA(0, 0), cA, voffA); PG8_STAGE(PG8_SB(0, 1), cB + hstepB, voffB); PG8_STAGE(PG8_SA(0, 1), cA + hstepA, voffA);
        if (wr == 1) PG8_BAR;
        PG8_WAIT_V(4); PG8_BAR;
        PG8_STAGE(PG8_SB(1, 0), cB + kstep, voffB); PG8_STAGE(PG8_SA(1, 0), cA + kstep, voffA); PG8_STAGE(PG8_SB(1, 1), cB + hstepB + kstep, voffB);
        PG8_WAIT_V(6); PG8_BAR;
    }
    for (;;) {
        const bool has_next = S.next(ui + 1, nxt);
        const char* nA = has_next ? (const char*)g.A + (size_t)nxt.pm * tstepA : cA; const char* nB = has_next ? (const char*)g.Bt + (size_t)nxt.pn * tstepB : cB;
        for (int t = 0; t < nt; t += 2) {
            const bool last = (t == nt - 2);
            const char* a1 = cA + (size_t)(t + 1) * kstep;
            const char* a2 = last ? nA : cA + (size_t)(t + 2) * kstep; const char* b2 = last ? nB : cB + (size_t)(t + 2) * kstep;
            const char* a3 = a2 + kstep; const char* b3 = b2 + kstep;
            if (last && has_next) S.a_ready(nxt);
            if constexpr (SP2) {
            PG8_LDB(B0, 0, 0); PG8_LDB(B1, 0, 1); PG8_SCHED; PG8_LDA(At, 0, 0); PG8_STAGE(PG8_SA(1, 1), a1 + hstepA, voffA);
            PG8_WAIT_V(8); PG8_WAIT_L(0); PG8_BAR; PG8_MMA(0, 0, At, B0); PG8_MMA(0, 1, At, B1); PG8_BAR; PG8_SCHED;
            PG8_LDA(At, 0, 1); PG8_STAGE(PG8_SB(0, 0), b2, voffB); PG8_STAGE(PG8_SB(0, 1), b2 + hstepB, voffB); PG8_STAGE(PG8_SA(0, 0), a2, voffA);
            PG8_WAIT_V(8); PG8_WAIT_L(0); PG8_BAR; PG8_MMA(1, 0, At, B0); PG8_MMA(1, 1, At, B1); PG8_BAR; PG8_SCHED;
            PG8_LDB(B0, 1, 0); PG8_LDB(B1, 1, 1); PG8_SCHED; PG8_LDA(At, 1, 0); PG8_STAGE(PG8_SA(0, 1), a2 + hstepA, voffA);
            PG8_WAIT_V(8); PG8_WAIT_L(0); PG8_BAR; PG8_MMA(0, 0, At, B0); PG8_MMA(0, 1, At, B1); PG8_BAR; PG8_SCHED;
            PG8_LDA(At, 1, 1); PG8_STAGE(PG8_SB(1, 0), b3, voffB); PG8_STAGE(PG8_SB(1, 1), b3 + hstepB, voffB); PG8_STAGE(PG8_SA(1, 0), a3, voffA);
            PG8_WAIT_V(8); PG8_WAIT_L(0); PG8_BAR; PG8_MMA(1, 0, At, B0); PG8_MMA(1, 1, At, B1); PG8_BAR; PG8_SCHED;
            } else {
            PG8_LDB(B0, 0, 0); PG8_SCHED; PG8_LDA(At, 0, 0); PG8_STAGE(PG8_SA(1, 1), a1 + hstepA, voffA);
            PG8_WAIT_L(8); PG8_BAR; PG8_WAIT_L(0); PG8_MMA(0, 0, At, B0); PG8_BAR; PG8_SCHED;
            PG8_LDB(B1, 0, 1); PG8_STAGE(PG8_SB(0, 0), b2, voffB);
            PG8_BAR; PG8_WAIT_L(0); PG8_MMA(0, 1, At, B1); PG8_BAR;
            PG8_LDA(At, 0, 1); PG8_STAGE(PG8_SA(0, 0), a2, voffA);
            PG8_BAR; PG8_WAIT_L(0); PG8_MMA(1, 0, At, B0); PG8_BAR; PG8_SCHED;
            PG8_STAGE(PG8_SB(0, 1), b2 + hstepB, voffB);
            PG8_WAIT_V(6); PG8_BAR; PG8_MMA(1, 1, At, B1); PG8_BAR;
            PG8_LDB(B0, 1, 0); PG8_SCHED; PG8_LDA(At, 1, 0); PG8_STAGE(PG8_SA(0, 1), a2 + hstepA, voffA);
            PG8_WAIT_L(8); PG8_BAR; PG8_WAIT_L(0); PG8_MMA(0, 0, At, B0); PG8_BAR; PG8_SCHED;
            PG8_LDB(B1, 1, 1); PG8_STAGE(PG8_SB(1, 0), b3, voffB);
            PG8_BAR; PG8_WAIT_L(0); PG8_MMA(0, 1, At, B1); PG8_BAR;
            PG8_LDA(At, 1, 1); PG8_STAGE(PG8_SA(1, 0), a3, voffA);
            PG8_BAR; PG8_WAIT_L(0); PG8_MMA(1, 0, At, B0); PG8_BAR; PG8_SCHED;
            PG8_STAGE(PG8_SB(1, 1), b3 + hstepB, voffB);
            PG8_WAIT_V(6); PG8_BAR; PG8_MMA(1, 1, At, B1); PG8_BAR;
            }
        }
        if constexpr (ALIGN_EPI) { if (wr == 0) PG8_BAR; }
        if constexpr (!Epi::AFTER_DRAIN) { E(acc, cur, wr, wc, fr, fq, lds); S.done(cur); }
        if (!has_next) break;
#pragma unroll
        for (int a = 0; a < 2; ++a)
#pragma unroll
            for (int b = 0; b < 2; ++b)
#pragma unroll
                for (int m = 0; m < 4; ++m)
#pragma unroll
                    for (int n = 0; n < 2; ++n) acc[a][b][m][n] = (f32x4){0.f, 0.f, 0.f, 0.f};
        cur = nxt; cA = nA; cB = nB; ++ui;
        if constexpr (ALIGN_EPI) { if (wr == 1) PG8_BAR; }
    }
    PG8_WAIT_V(0);
    if constexpr (!ALIGN_EPI) { if (wr == 0) PG8_BAR; }
    PG8_BAR;
    if constexpr (Epi::AFTER_DRAIN) { E.fused(acc, cur, wr, wc, fr, fq, lds, wid, lane); S.done(cur); }
#undef PG8_SA
#undef PG8_SB
#undef PG8_STAGE
#undef PG8_LDA
#undef PG8_LDB
#undef PG8_MMA
#undef PG8_WAIT_V
#undef PG8_WAIT_L
#undef PG8_BAR
#undef PG8_SCHED
}
}
constexpr int BATCH = 8, SEQ = 4096, DM = 1024, MROWS = BATCH * SEQ, DEPTH = 4;
constexpr int NH = 8, HD = 128;
constexpr int FF = 3072, NBLK = 16, MBLK = 256;
constexpr float QSCALE = 0.08838834764831845f;
typedef unsigned short bf16;
typedef float f32x4 __attribute__((ext_vector_type(4)));
typedef unsigned u32x4 __attribute__((ext_vector_type(4)));

constexpr size_t MiB = 1u << 20;
constexpr size_t WS_CTL = 0, CTL_ZERO_BYTES = 1 * MiB;
constexpr size_t WS_WIN = 2 * MiB, WS_WQKV = 18 * MiB, WS_WOH = 30 * MiB, WS_WOM = 34 * MiB, WS_WUP = 38 * MiB, WS_WDN = 86 * MiB;
constexpr size_t WS_SS = 110 * MiB, WS_COS = 112 * MiB, WS_SIN = 113 * MiB, WS_LBV = 114 * MiB, WS_KMEAN = 115 * MiB;
constexpr size_t WS_TAIL = 132 * MiB, WS_HEADA = 135 * MiB, WS_HEADU = 138 * MiB;
constexpr size_t WS_XB = 144 * MiB, WS_BIG = 208 * MiB, WS_AU = 400 * MiB, WS_END = 464 * MiB;

__device__ __forceinline__ float bf2f(bf16 v) { return __uint_as_float((unsigned)v << 16); }
__device__ __forceinline__ bf16 f2bf(float f) { unsigned u = __float_as_uint(f); return (bf16)((u + 0x7fffu + ((u >> 16) & 1u)) >> 16); }
__device__ __forceinline__ float wave_sum(float v) {
#pragma unroll
    for (int o = 1; o < 64; o <<= 1) v += __shfl_xor(v, o);
    return v;
}
__device__ __forceinline__ float wave_max(float v) {
#pragma unroll
    for (int o = 1; o < 64; o <<= 1) v = fmaxf(v, __shfl_xor(v, o));
    return v;
}

__device__ __forceinline__ void glu_fixup_elem(int pm, int rr, int f, bf16* __restrict__ g, const float* __restrict__ tail, const float* __restrict__ head_a, const float* __restrict__ head_u, const float* __restrict__ cw, const float* __restrict__ cb) {
    const bool first = (pm & 15) == 0;
    const float cur = head_a[((size_t)pm * 2 + rr) * FF + f];
    const float t1 = first ? 0.f : tail[((size_t)(pm - 1) * 2 + 1) * FF + f], t0 = first ? 0.f : tail[((size_t)(pm - 1) * 2 + 0) * FF + f];
    const float prev1 = rr == 0 ? t1 : head_a[((size_t)pm * 2) * FF + f], prev2 = rr == 0 ? t0 : t1;
    const float c = cw[f] * prev2 + cw[FF + f] * prev1 + cw[2 * FF + f] * cur + cb[f];
    g[((size_t)pm * 256 + rr) * FF + f] = f2bf(c / (1.0f + __expf(-c)) * head_u[((size_t)pm * 2 + rr) * FF + f]);
}
#define XB_TMO      128
#define XB_XCNT(j)  (256  + 64 * (j))
#define XB_XSUB(j)  (1280 + 64 * (j))
#define XB_XGEN(j)  (2304 + 64 * (j))
#define XB_TOP      3328
#define XB_TOPGEN   3392
#define XCD_BAR_WORDS 3456
#define XB_SPIN_CAP (1u << 18)
#define LAS __attribute__((address_space(3)))

__device__ __forceinline__ unsigned xb_ld(unsigned* p)              { return __hip_atomic_load(p, __ATOMIC_RELAXED, __HIP_MEMORY_SCOPE_AGENT); }
__device__ __forceinline__ unsigned xb_add(unsigned* p, unsigned v) { return __hip_atomic_fetch_add(p, v, __ATOMIC_RELAXED, __HIP_MEMORY_SCOPE_AGENT); }
__device__ __forceinline__ unsigned xb_xcc_id() { return (unsigned)__builtin_amdgcn_s_getreg((3 << 11) | 20) & 0xFu; }
#define XB_SPIN(cond, bar) do { unsigned _sp = 0; while (cond) { __builtin_amdgcn_s_sleep(1); \
    if ((++_sp & 255u) == 0u) { if (xb_ld(&(bar)[XB_TMO])) break; if (_sp > XB_SPIN_CAP) { atomicAdd(&(bar)[XB_TMO], 1u); break; } } } } while (0)

struct XcdBarrier {
    unsigned* bar; unsigned x;
    volatile LAS unsigned* st;
};

__device__ __forceinline__ XcdBarrier xcd_barrier_post(unsigned* bar, volatile LAS unsigned* st) {
    XcdBarrier b; b.bar = bar; b.x = xb_xcc_id(); b.st = st;
    if (threadIdx.x == 0) (void)xb_add(&bar[XB_XCNT(b.x)], 1u);
    return b;
}
__device__ __forceinline__ void xcd_barrier_complete(unsigned* bar, unsigned x, unsigned& nloc, unsigned& nx) {
    const unsigned G = gridDim.x * gridDim.y * gridDim.z;
    unsigned sum, cnt, mine, sp = 0u;
    for (;;) {
        sum = 0u; cnt = 0u; mine = 0u;
#pragma unroll
        for (unsigned j = 0; j < 16; ++j) { const unsigned c = xb_ld(&bar[XB_XCNT(j)]); sum += c; cnt += (c > 0u) ? 1u : 0u; mine = (j == x) ? c : mine; }
        if (sum == G) break;
        __builtin_amdgcn_s_sleep(1);
        if ((++sp & 255u) == 0u) { if (xb_ld(&bar[XB_TMO])) break; if (sp > XB_SPIN_CAP) { atomicAdd(&bar[XB_TMO], 1u); break; } }
    }
    nloc = mine > 0u ? mine : 1u; nx = cnt > 0u ? cnt : 1u;
}

__device__ __forceinline__ void xcd_barrier(const XcdBarrier& b) {
    asm volatile("s_waitcnt vmcnt(0)" ::: "memory");
    __syncthreads();
    if (threadIdx.x == 0) {
        unsigned* bar = b.bar;
        __builtin_amdgcn_s_waitcnt(0);
        unsigned nloc = b.st[0], nx = b.st[1];
        if (nloc == 0u) { xcd_barrier_complete(bar, b.x, nloc, nx); b.st[0] = nloc; b.st[1] = nx; }
        const unsigned old = xb_add(&bar[XB_XSUB(b.x)], 1u);
        const unsigned gen = old / nloc;
        if (old + 1u == (gen + 1u) * nloc) {
            __builtin_amdgcn_fence(__ATOMIC_RELEASE, "agent");
            asm volatile("s_waitcnt vmcnt(0)" ::: "memory");
            const unsigned og = xb_add(&bar[XB_TOP], 1u);
            const unsigned tg = og / nx;
            if (og + 1u == (tg + 1u) * nx) xb_add(&bar[XB_TOPGEN], 1u);
            else XB_SPIN(xb_ld(&bar[XB_TOPGEN]) == tg, bar);
            __builtin_amdgcn_fence(__ATOMIC_ACQUIRE, "agent");
            xb_add(&bar[XB_XGEN(b.x)], 1u);
            asm volatile("s_waitcnt vmcnt(0)" ::: "memory");
        } else {
            XB_SPIN(xb_ld(&bar[XB_XGEN(b.x)]) == gen, bar);
            __builtin_amdgcn_fence(__ATOMIC_ACQUIRE, "agent");
            asm volatile("s_waitcnt vmcnt(0)" ::: "memory");
        }
    }
    __syncthreads();
}
namespace mb {
typedef short bf16x8 __attribute__((ext_vector_type(8)));
typedef short s16x4 __attribute__((ext_vector_type(4)));
typedef float f32x16 __attribute__((ext_vector_type(16)));
constexpr int D = 128, LDR = 3072, NW = 8, QBLK = 32, KVBLK = 64, QB = NW * QBLK;
constexpr int SHM_V = KVBLK * D * 2, SHM_K = KVBLK * D * 2;
constexpr int OFF_WS = 2 * SHM_V + 2 * SHM_K, OFF_KM = OFF_WS + NW * 64 * 4, ATT_LDS_BYTES = OFF_KM + 16 * 128 * 4;
constexpr float THR = 8.f;
#define KSWZ(row, colB) ((row) * 256 + ((colB) ^ (((row) & 7) << 4)))
#define SBAR() __builtin_amdgcn_sched_barrier(0)
__device__ __forceinline__ int v_st(int k, int c) { const int kk = (k & ~0xC) | ((k & 4) << 1) | ((k & 8) >> 1); return ((kk >> 3) * 4 + (c >> 5)) * 512 + ((kk & 7) * 32 + (c & 31)) * 2; }
__device__ __forceinline__ int v_rd_base(int lane) { return ((lane & 3) << 3) | (((lane >> 2) & 3) << 6) | (((lane >> 4) & 1) << 5) | (((lane >> 5) & 1) << 8); }
constexpr int v_rd_off(int d0, int ks, int half) { return d0 * 512 + ks * 4096 + half * 2048; }
__device__ __forceinline__ int crow(int r, int hi) { return (r & 3) + 8 * (r >> 2) + 4 * hi; }
__device__ __forceinline__ unsigned cvtpk(float lo, float hi) { unsigned r; asm volatile("v_cvt_pk_bf16_f32 %0, %1, %2" : "=v"(r) : "v"(lo), "v"(hi)); return r; }
__device__ __forceinline__ bf16x8 load8(const bf16* p) { return *reinterpret_cast<const bf16x8*>(p); }
__device__ __forceinline__ void mask_causal(f32x16& p0, f32x16& p1, int dq) {
    const float NEG = -__builtin_inff();
#pragma unroll
    for (int r = 0; r < 16; ++r) { const int c = (r & 3) + 8 * (r >> 2); if (dq - c < 0) p0[r] = NEG; if (dq - c - 32 < 0) p1[r] = NEG; }
}
__device__ __forceinline__ void mask_all(f32x16& p0, f32x16& p1, bool keep) {
    const float NEG = -__builtin_inff();
#pragma unroll
    for (int r = 0; r < 16; ++r) { p0[r] = keep ? p0[r] : NEG; p1[r] = keep ? p1[r] : NEG; }
}
__device__ __forceinline__ void partialSM(f32x16& p0, f32x16& p1, float& m_reg, float& mn, float& alpha) {
    float pmax = p0[0]; for (int r = 1; r < 16; ++r) pmax = fmaxf(pmax, p0[r]); for (int r = 0; r < 16; ++r) pmax = fmaxf(pmax, p1[r]);
    { auto rr = __builtin_amdgcn_permlane32_swap(__float_as_uint(pmax), __float_as_uint(pmax), false, false);
      pmax = fmaxf(__uint_as_float(rr[0]), __uint_as_float(rr[1])); }
    constexpr float C2 = 1.4426950408889634f;
    if (__builtin_expect(__all((pmax - m_reg) <= THR), 1)) { mn = m_reg; alpha = 1.f; }
    else { mn = fmaxf(m_reg, pmax); alpha = __builtin_amdgcn_exp2f((m_reg - mn) * C2); m_reg = mn; }
    const float mnL = -mn * C2;
    for (int r = 0; r < 16; ++r) p0[r] = fmaf(p0[r], C2, mnL); for (int r = 0; r < 16; ++r) p1[r] = fmaf(p1[r], C2, mnL);
    for (int r = 0; r < 16; ++r) p0[r] = __builtin_amdgcn_exp2f(p0[r]);
}
__device__ __forceinline__ void finishSM(f32x16& p0, f32x16& p1, float alpha, float& l_reg, bf16x8& pa0, bf16x8& pa1, bf16x8& pa2, bf16x8& pa3) {
    for (int r = 0; r < 16; ++r) p1[r] = __builtin_amdgcn_exp2f(p1[r]);
    float ps = 0; for (int r = 0; r < 16; ++r) ps += p0[r]; for (int r = 0; r < 16; ++r) ps += p1[r];
    { auto rr = __builtin_amdgcn_permlane32_swap(__float_as_uint(ps), __float_as_uint(ps), false, false);
      ps = __uint_as_float(rr[0]) + __uint_as_float(rr[1]); }
    l_reg = l_reg * alpha + ps;
#define PK4(P, B_, OUT) do { unsigned a0 = cvtpk(P[B_+0], P[B_+1]), a1 = cvtpk(P[B_+2], P[B_+3]);                          \
        unsigned b0 = cvtpk(P[B_+4], P[B_+5]), b1 = cvtpk(P[B_+6], P[B_+7]);                                             \
        auto r0 = __builtin_amdgcn_permlane32_swap(a0, b0, false, false); auto r1 = __builtin_amdgcn_permlane32_swap(a1, b1, false, false); \
        u32x4 w = {r0[0], r1[0], r0[1], r1[1]}; OUT = *reinterpret_cast<bf16x8*>(&w); } while (0)
    PK4(p0, 0, pa0); PK4(p0, 8, pa1); PK4(p1, 0, pa2); PK4(p1, 8, pa3);
#undef PK4
}
template <int KB>
__device__ __forceinline__ void qkt(f32x16& p0, f32x16& p1, const char* K_lds, int r32, int hi, const bf16x8* qr) {
    p0 = f32x16{}; p1 = f32x16{};
    const char* kb[4];
#pragma unroll
    for (int dd = 0; dd < 4; ++dd) kb[dd] = K_lds + KB * SHM_K + KSWZ(r32, (dd * 16 + hi * 8) * 2);
#pragma unroll
    for (int d0 = 0; d0 < 8; ++d0) { const char* a = kb[d0 & 3] + (d0 >> 2) * 128;
        bf16x8 b0 = *reinterpret_cast<const bf16x8*>(a);
        bf16x8 b1 = *reinterpret_cast<const bf16x8*>(a + 32 * 256);
        p0 = __builtin_amdgcn_mfma_f32_32x32x16_bf16(b0, qr[d0], p0, 0, 0, 0);
        p1 = __builtin_amdgcn_mfma_f32_32x32x16_bf16(b1, qr[d0], p1, 0, 0, 0); }
}
template <int VB>
__device__ __forceinline__ void pv_tile(f32x16* o, int vb0, bf16x8 pa0, bf16x8 pa1, bf16x8 pa2, bf16x8 pa3) {
#define TRRD(dst, off) asm volatile("ds_read_b64_tr_b16 %0, %1 offset:%2" : "=&v"(dst) : "v"(vb0), "i"(off) : "memory")
#define PV_D0(d0) do { s16x4 l0, l1, l2, l3, h0, h1, h2, h3; constexpr int b_ = VB * SHM_V + v_rd_off(d0, 0, 0);   \
        TRRD(l0, b_); TRRD(h0, b_ + 2048); TRRD(l1, b_ + 4096); TRRD(h1, b_ + 6144); TRRD(l2, b_ + 8192); TRRD(h2, b_ + 10240); TRRD(l3, b_ + 12288); TRRD(h3, b_ + 14336); \
        asm volatile("s_waitcnt lgkmcnt(0)" ::: "memory"); SBAR();   \
        o[d0] = __builtin_amdgcn_mfma_f32_32x32x16_bf16(pa0, (bf16x8){l0[0], l0[1], l0[2], l0[3], h0[0], h0[1], h0[2], h0[3]}, o[d0], 0, 0, 0);   \
        o[d0] = __builtin_amdgcn_mfma_f32_32x32x16_bf16(pa1, (bf16x8){l1[0], l1[1], l1[2], l1[3], h1[0], h1[1], h1[2], h1[3]}, o[d0], 0, 0, 0);   \
        o[d0] = __builtin_amdgcn_mfma_f32_32x32x16_bf16(pa2, (bf16x8){l2[0], l2[1], l2[2], l2[3], h2[0], h2[1], h2[2], h2[3]}, o[d0], 0, 0, 0);   \
        o[d0] = __builtin_amdgcn_mfma_f32_32x32x16_bf16(pa3, (bf16x8){l3[0], l3[1], l3[2], l3[3], h3[0], h3[1], h3[2], h3[3]}, o[d0], 0, 0, 0); } while (0)
    PV_D0(0); PV_D0(1); PV_D0(2); PV_D0(3);
#undef PV_D0
#undef TRRD
}

struct BlockRef { const bf16* Q; const bf16* K; const bf16* V; bf16* O; const float* KM; int iblk; };
struct Seam { bf16x8 qr[8]; bf16x8 st_v0, st_v1, st_k0, st_k1; };
#define ROW(p, k0, rr) ((p) + (size_t)((k0) + (rr)) * LDR + sc)
#define VMW() asm volatile("s_waitcnt vmcnt(0)" ::: "memory")
#define VMWN(n) asm volatile("s_waitcnt vmcnt(%0)" :: "i"(n) : "memory")
#define SLOAD_H(Kp, Vp, k0) do { S.st_v0 = load8(ROW(Vp, k0, sr)); S.st_v1 = load8(ROW(Vp, k0, 32 + sr));              \
                         S.st_k0 = load8(ROW(Kp, k0, sr)); S.st_k1 = load8(ROW(Kp, k0, 32 + sr)); } while (0)
#define SWRITE_HK(bf) do { *(bf16x8*)(K_lds + (bf) * SHM_K + kws) = S.st_k0; *(bf16x8*)(K_lds + (bf) * SHM_K + kws + 32 * 256) = S.st_k1; } while (0)
#define SWRITE_HV(bf) do { *(bf16x8*)(V_lds + (bf) * SHM_V + vst0) = S.st_v0; *(bf16x8*)(V_lds + (bf) * SHM_V + vst1) = S.st_v1; } while (0)
#define SWRITE_H(bf) do { SWRITE_HV(bf); SWRITE_HK(bf); } while (0)
__device__ __forceinline__ void moba_prime(const BlockRef& cur, char* lds, Seam& S, int tid) {
    const int wid = __builtin_amdgcn_readfirstlane(tid >> 6), lane = tid & 63, r32 = lane & 31, hi = lane >> 5;
    const int sr = tid >> 4, sc = (tid & 15) * 8, kws = KSWZ(sr, sc * 2); char* K_lds = lds + 2 * SHM_V;
#pragma unroll
    for (int d0 = 0; d0 < 8; ++d0) S.qr[d0] = load8(cur.Q + (size_t)(wid * QBLK + r32) * LDR + d0 * 16 + hi * 8);
    SLOAD_H(cur.K, cur.V, 0); VMW(); SWRITE_HK(0);
    __syncthreads();
}
__device__ __forceinline__ void moba_block(const BlockRef& cur, const BlockRef& nxt, char* lds, Seam& S, int tid) {
    const int wid = __builtin_amdgcn_readfirstlane(tid >> 6), lane = tid & 63, r32 = lane & 31, hi = lane >> 5;
    const int iblk = cur.iblk, NT = 4 * (iblk + 1), P0 = iblk * QB;
    const int qlo = P0 + wid * QBLK, qm = qlo + r32 - 4 * hi;
    unsigned sel = 0u; float* KMs = (float*)(lds + OFF_KM);
    if (iblk > 0) {
        int t4 = tid; asm volatile("" : "+v"(t4));
        *(f32x4*)(KMs + t4 * 4) = *(const f32x4*)(cur.KM + t4 * 4);
        __syncthreads();
        float v1 = -__builtin_inff(), v2 = v1, v3 = v1; int i1 = -1, i2 = -1, i3 = -1;
        for (int j = 0; j < iblk; ++j) {
            const float* km = KMs + j * 128 + 8 * hi; float a = 0.f;
#pragma unroll
            for (int d0 = 0; d0 < 8; ++d0) { const f32x4 k0 = *(const f32x4*)(km + 16 * d0), k1 = *(const f32x4*)(km + 16 * d0 + 4); const bf16x8 q = S.qr[d0];
#pragma unroll
                for (int e = 0; e < 4; ++e) { a = fmaf(__uint_as_float((unsigned)(unsigned short)q[e] << 16), k0[e], a); a = fmaf(__uint_as_float((unsigned)(unsigned short)q[e + 4] << 16), k1[e], a); } }
            a += __shfl_xor(a, 32);
            if (a > v1) { v3 = v2; i3 = i2; v2 = v1; i2 = i1; v1 = a; i1 = j; }
            else if (a > v2) { v3 = v2; i3 = i2; v2 = a; i2 = j; }
            else if (a > v3) { v3 = a; i3 = j; }
        }
        sel = (i1 >= 0 ? 1u << i1 : 0u) | (i2 >= 0 ? 1u << i2 : 0u) | (i3 >= 0 ? 1u << i3 : 0u);
    }
    char* V_lds = lds; char* K_lds = lds + 2 * SHM_V;
    float* ws = (float*)(lds + OFF_WS) + wid * 64; float* li_l = ws, * al_l = ws + 32;
    float m_reg = -1e30f, l_reg = 0; f32x16 o[4] = {};
    const int sr = tid >> 4, sc = (tid & 15) * 8, vst0 = v_st(sr, sc), vst1 = v_st(32 + sr, sc), kws = KSWZ(sr, sc * 2);
    const int vb0 = (int)(uintptr_t)V_lds + v_rd_base(lane);
    const bf16* Kh = cur.K; const bf16* Vh = cur.V;
#define RESC(a) do { if (__any((a) < 1.f)) { if (hi == 0) al_l[r32] = (a); asm volatile("s_waitcnt lgkmcnt(0)" ::: "memory");              \
                     for (int d_ = 0; d_ < 4; ++d_) for (int r = 0; r < 16; ++r) o[d_][r] *= al_l[crow(r, hi)]; } } while (0)
#define KBASE(t) ((t) * KVBLK)
#define MASKT(P0_, P1_, t) do { const int kb_ = KBASE(t); const int bj_ = (t) >> 2; \
        if (bj_ == iblk) { if (kb_ + KVBLK - 1 > qlo) mask_causal(P0_, P1_, qm - kb_); } else mask_all(P0_, P1_, ((sel >> bj_) & 1u) != 0u); } while (0)
    constexpr int NQL = 8;
#define SEAM_K0() do { VMWN(NQL); SWRITE_HK(0); SBAR(); } while (0)
    f32x16 pA0, pA1, pB0, pB1; float mnA, mnB, alA, alB; bf16x8 pa0, pa1, pa2, pa3;
    SWRITE_HV(0); SBAR();
    if (NT > 1) SLOAD_H(Kh, Vh, KBASE(1));
    SBAR(); qkt<0>(pA0, pA1, K_lds, r32, hi, S.qr);
    MASKT(pA0, pA1, 0); partialSM(pA0, pA1, m_reg, mnA, alA);
    if (NT > 1) { VMW(); SWRITE_H(1); }
    __syncthreads();
#define HALF_STEP(PX0, PX1, mnX, alX, PY0, PY1, alY, t, KB, VB, SB) do {                                                      \
        SBAR(); qkt<KB>(PX0, PX1, K_lds, r32, hi, S.qr);                                                                      \
        finishSM(PY0, PY1, alY, l_reg, pa0, pa1, pa2, pa3); SBAR();                                                           \
        if ((t) + 1 < NT) { SLOAD_H(Kh, Vh, KBASE((t) + 1)); SBAR(); }                                                        \
        pv_tile<VB>(o, vb0, pa0, pa1, pa2, pa3); MASKT(PX0, PX1, (t)); partialSM(PX0, PX1, m_reg, mnX, alX);                  \
        __syncthreads();                                                                                                      \
        if ((t) + 1 < NT) { VMW(); SWRITE_H(SB); }                                                                            \
        RESC(alX); __syncthreads(); } while (0)
    for (int t = 1; t + 1 < NT; t += 2) {
        HALF_STEP(pB0, pB1, mnB, alB, pA0, pA1, alA, t, 1, 0, 0);
        HALF_STEP(pA0, pA1, mnA, alA, pB0, pB1, alB, t + 1, 0, 1, 1);
    }
    SBAR(); qkt<1>(pB0, pB1, K_lds, r32, hi, S.qr); SBAR();
    SLOAD_H(nxt.K, nxt.V, 0); SBAR();
#pragma unroll
    for (int d0 = 0; d0 < 8; ++d0) S.qr[d0] = load8(nxt.Q + (size_t)(wid * QBLK + r32) * LDR + d0 * 16 + hi * 8);
    SBAR();
    finishSM(pA0, pA1, alA, l_reg, pa0, pa1, pa2, pa3); SBAR();
    pv_tile<0>(o, vb0, pa0, pa1, pa2, pa3);
    MASKT(pB0, pB1, NT - 1); partialSM(pB0, pB1, m_reg, mnB, alB); __syncthreads(); RESC(alB);
    finishSM(pB0, pB1, alB, l_reg, pa0, pa1, pa2, pa3); SBAR(); pv_tile<1>(o, vb0, pa0, pa1, pa2, pa3);
    SBAR(); SEAM_K0();
    if (hi == 0) li_l[r32] = l_reg; asm volatile("s_waitcnt lgkmcnt(0)" ::: "memory");
    float rli[16];
#pragma unroll
    for (int r = 0; r < 16; ++r) rli[r] = __builtin_amdgcn_rcpf(li_l[crow(r, hi)]);
    bf16* Ow = cur.O + (size_t)(wid * QBLK) * LDR;
    int hi_e = hi; asm volatile("" : "+v"(hi_e));
#pragma unroll
    for (int r = 0; r < 16; ++r) { const int orow = crow(r, hi_e);
#pragma unroll
        for (int d0 = 0; d0 < 4; ++d0) { const float v = o[d0][r] * rli[r];
            const float vn = __shfl_xor(v, 1);
            if ((r32 & 1) == 0) *(unsigned*)(Ow + (size_t)orow * LDR + d0 * 32 + r32) = cvtpk(v, vn); } }
    __syncthreads();
#undef RESC
#undef KBASE
#undef MASKT
#undef SEAM_K0
#undef HALF_STEP
}
#undef ROW
#undef VMW
#undef VMWN
#undef SLOAD_H
#undef SWRITE_HK
#undef SWRITE_HV
#undef SWRITE_H
#undef KSWZ
#undef SBAR

__device__ __forceinline__ void item_decode(int L, int G, int k, int bx, int& bh, int& x) {
    if (G == 256) { const int xcd = bx & 7, q = bx >> 3; bh = ((k * 8 + xcd) << 2) + (q >> 3); x = q & 7; }
    else { bh = L >> 3; x = L & 7; }
}
__device__ __forceinline__ BlockRef make_ref(bf16* qkv, const float* kmean, int bh, int iblk) {
    const int b = bh >> 3, h = bh & 7; BlockRef r; bf16* base = qkv + (size_t)b * SEQ * LDR + h * 128;
    r.Q = base + (size_t)iblk * QB * LDR; r.O = base + (size_t)iblk * QB * LDR; r.K = base + 1024; r.V = base + 2048; r.KM = kmean + (size_t)bh * 16 * 128; r.iblk = iblk; return r;
}
__device__ __forceinline__ void attn_phase(bf16* qkv, const float* kmean, char* lds, int tid) {
    const int G = gridDim.x, bx = blockIdx.x, total = BATCH * NH * 8;
    int L = bx, k = 0; if (L >= total) return;
    int bh, x; item_decode(L, G, k, bx, bh, x); int pass = 0;
    BlockRef cur = make_ref(qkv, kmean, bh, x);
    Seam S;
    moba_prime(cur, lds, S, tid);
    for (;;) {
        const bool more_pass = pass == 0, more_item = L + G < total, last = !more_pass && !more_item;
        int bhn = bh, xn = x, passn = pass + 1, Ln = L, kn = k;
        if (!more_pass) { passn = 0; if (more_item) { Ln = L + G; kn = k + 1; } item_decode(Ln, G, kn, bx, bhn, xn); }
        const BlockRef nxt = last ? cur : make_ref(qkv, kmean, bhn, passn ? 15 - xn : xn);
        moba_block(cur, nxt, lds, S, tid);
        if (last) break;
        cur = nxt; bh = bhn; x = xn; pass = passn; L = Ln; k = kn;
    }
}
}
#define GAS __attribute__((address_space(1)))
constexpr int NWAVES = 8;
constexpr int RING_OFF = 0, RING_BYTES = 131072;
constexpr int XCH_OFF = 131072;
constexpr int MISC_OFF = 135168;
constexpr int LDS_BYTES = 147456;
constexpr int CW_BAR = 4096;
constexpr int N_PHASES = 25;
static_assert(pg8::STAGE_BYTES == RING_BYTES && XCH_OFF == RING_BYTES, "LDS map");

struct Params { const float* in[15]; float* out; unsigned char* ws; int ph_lo, ph_hi, bar_region, pad; };

#define LDS_WAIT() asm volatile("s_waitcnt lgkmcnt(0)" ::: "memory")
#define VM_WAIT() asm volatile("s_waitcnt vmcnt(0)" ::: "memory")

__device__ __forceinline__ void p0_conv_item(const float* __restrict__ W, const float* __restrict__ gain, int K, int N, bf16* __restrict__ WT, int upperm, LAS float* scr, int item, int lane) {
    const int nblk = N / 32, kb = item / nblk, nb = item % nblk, k0 = 64 * kb, n0 = 32 * nb;
    int src0 = n0;
    if (upperm) { const int pn = n0 >> 8, r = n0 & 255, bj = r >> 7, c = r & 127; src0 = bj * 3072 + 128 * pn + c; }
#pragma unroll 8
    for (int i = 0; i < 32; ++i) { const int kk = 2 * i + (lane >> 5); scr[kk * 33 + (lane & 31)] = W[(size_t)(k0 + kk) * N + src0 + (lane & 31)] * (gain ? gain[k0 + kk] : 1.0f); }
    LDS_WAIT(); asm volatile("" ::: "memory");
    const int c = lane & 7;
#pragma unroll
    for (int j = 0; j < 4; ++j) { const int n = (lane >> 3) + 8 * j; const LAS float* s = scr + (8 * c) * 33 + n;
        u32x4 o; o.x = f2bf(s[0 * 33]) | ((unsigned)f2bf(s[1 * 33]) << 16); o.y = f2bf(s[2 * 33]) | ((unsigned)f2bf(s[3 * 33]) << 16);
        o.z = f2bf(s[4 * 33]) | ((unsigned)f2bf(s[5 * 33]) << 16); o.w = f2bf(s[6 * 33]) | ((unsigned)f2bf(s[7 * 33]) << 16);
        *(u32x4*)(WT + (size_t)(n0 + n) * K + k0 + 8 * c) = o; }
    LDS_WAIT(); asm volatile("" ::: "memory");
}
__device__ __forceinline__ void p0_prologue(const Params& p, LAS unsigned char* lds, int gw, int NGW, int lane, int wave) {
    unsigned char* ws = p.ws;
    LAS float* scr = (LAS float*)(lds + RING_OFF + wave * 16384);
    const float* attn_norm = p.in[1]; const float* ffn_norm = p.in[2];
    constexpr int I_IN = 16 * 128, I_QKV = 16 * 96, I_O = 16 * 32, I_UP = 16 * 192, I_DN = 48 * 32;
    constexpr int NITEMS = 2 * I_IN + 2 * I_QKV + 4 * I_O + 4 * I_UP + 4 * I_DN;
    for (int it = gw; it < NITEMS; it += NGW) {
        int r = it;
        if (r < 2 * I_IN) { const int s = r / I_IN; p0_conv_item(p.in[3] + (size_t)s * 1024 * 4096, attn_norm + (2 * s) * 1024, 1024, 4096, (bf16*)(ws + WS_WIN) + (size_t)s * 4096 * 1024, 0, scr, r % I_IN, lane); continue; } r -= 2 * I_IN;
        if (r < 2 * I_QKV) { const int s = r / I_QKV; p0_conv_item(p.in[7] + (size_t)s * 1024 * 3072, attn_norm + (2 * s + 1) * 1024, 1024, 3072, (bf16*)(ws + WS_WQKV) + (size_t)s * 3072 * 1024, 0, scr, r % I_QKV, lane); continue; } r -= 2 * I_QKV;
        if (r < 2 * I_O) { const int s = r / I_O; p0_conv_item(p.in[6] + (size_t)s * 1024 * 1024, nullptr, 1024, 1024, (bf16*)(ws + WS_WOH) + (size_t)s * 1024 * 1024, 0, scr, r % I_O, lane); continue; } r -= 2 * I_O;
        if (r < 2 * I_O) { const int s = r / I_O; p0_conv_item(p.in[10] + (size_t)s * 1024 * 1024, nullptr, 1024, 1024, (bf16*)(ws + WS_WOM) + (size_t)s * 1024 * 1024, 0, scr, r % I_O, lane); continue; } r -= 2 * I_O;
        if (r < 4 * I_UP) { const int l = r / I_UP; p0_conv_item(p.in[11] + (size_t)l * 1024 * 6144, ffn_norm + l * 1024, 1024, 6144, (bf16*)(ws + WS_WUP) + (size_t)l * 6144 * 1024, 1, scr, r % I_UP, lane); continue; } r -= 4 * I_UP;
        { const int l = r / I_DN; p0_conv_item(p.in[14] + (size_t)l * 3072 * 1024, nullptr, 3072, 1024, (bf16*)(ws + WS_WDN) + (size_t)l * 1024 * 3072, 0, scr, r % I_DN, lane); }
    }
    const float* x = p.in[0]; bf16* xb = (bf16*)(ws + WS_XB); float* ss = (float*)(ws + WS_SS);
    for (int row = gw; row < MROWS; row += NGW) {
        const f32x4* xr = (const f32x4*)(x + (size_t)row * DM); float s = 0.f;
#pragma unroll
        for (int j = 0; j < 4; ++j) { const f32x4 v = xr[lane + 64 * j]; s += (v[0] * v[0] + v[1] * v[1]) + (v[2] * v[2] + v[3] * v[3]);
            unsigned long long w = (unsigned long long)(f2bf(v[0]) | ((unsigned)f2bf(v[1]) << 16)) | ((unsigned long long)(f2bf(v[2]) | ((unsigned)f2bf(v[3]) << 16)) << 32);
            *(unsigned long long*)(xb + (size_t)row * DM + 4 * (lane + 64 * j)) = w; }
        s = wave_sum(s);
        if (lane < 16) ss[(size_t)row * 16 + lane] = lane == 0 ? s : 0.f;
    }
    float* cs = (float*)(ws + WS_COS); float* sn = (float*)(ws + WS_SIN); float* lbv = (float*)(ws + WS_LBV); const float* hgrn_lb = p.in[4];
    for (int idx = gw * 64 + lane; idx < SEQ * 64; idx += NGW * 64) { const int s = idx >> 6, i = idx & 63; const float inv = 1.0f / powf(10000.0f, (float)(2 * i) / 128.0f); const float ang = (float)s * inv; cs[idx] = cosf(ang); sn[idx] = sinf(ang); }
    for (int idx = gw * 64 + lane; idx < 1024; idx += NGW * 64) { const float l0 = hgrn_lb[idx], l1 = hgrn_lb[1024 + idx]; const float mx = fmaxf(l0, l1), e0 = expf(l0 - mx), e1 = expf(l1 - mx); lbv[idx] = 0.f; lbv[1024 + idx] = e1 / (e0 + e1); }
}

__device__ __forceinline__ void kprep_phase(bf16* __restrict__ qkv, const float* __restrict__ qg, const float* __restrict__ kg, const float* __restrict__ cs, const float* __restrict__ sn, float* __restrict__ kmean,
                                            LAS unsigned char* lds, int lane, int wave) {
    const int tidk = wave * 64 + lane;
    LAS float* red = (LAS float*)(lds + RING_OFF);
    for (int u = blockIdx.x; u < 2 * BATCH * NH * NBLK; u += gridDim.x) {
        const int which = u & 1, j = (u >> 1) & 15, h = (u >> 5) & 7, b = u >> 8;
        const float* g = which ? kg : qg; const float g1 = g[lane], g2 = g[lane + 64];
        float a1 = 0.f, a2 = 0.f;
        for (int rr = 0; rr < 32; ++rr) {
            const int pos = j * MBLK + wave * 32 + rr;
            bf16* pp = qkv + (size_t)(b * SEQ + pos) * 3072 + which * 1024 + h * 128;
            const float x1 = bf2f(pp[lane]), x2 = bf2f(pp[lane + 64]);
            const float r = rsqrtf(wave_sum(x1 * x1 + x2 * x2) * (1.0f / 128.0f) + 1e-6f);
            const float y1 = x1 * r * g1, y2 = x2 * r * g2;
            const float c = cs[pos * 64 + lane], s = sn[pos * 64 + lane];
            float o1 = y1 * c - y2 * s, o2 = y2 * c + y1 * s;
            if (!which) { o1 *= QSCALE; o2 *= QSCALE; }
            a1 += o1; a2 += o2;
            pp[lane] = f2bf(o1); pp[lane + 64] = f2bf(o2);
        }
        if (which) {
            red[wave * 128 + lane] = a1; red[wave * 128 + 64 + lane] = a2;
            __syncthreads();
            if (tidk < 128) { float s = 0.f;
#pragma unroll
                for (int w = 0; w < 8; ++w) s += red[w * 128 + tidk];
                kmean[((size_t)(b * 8 + h) * 16 + j) * 128 + tidk] = s * (1.0f / 256.0f); }
            __syncthreads();
        }
    }
}

__device__ __forceinline__ void hg_naive_phase(bf16* __restrict__ big, const float* __restrict__ lbv, const float* __restrict__ og, LAS unsigned char* lds, const int tid) {
    LAS float* sq = (LAS float*)(lds + RING_OFF); LAS float* sf = sq + 128; LAS float* sk = sq + 256; LAS float* red = sq + 384;
    for (int u = blockIdx.x; u < BATCH * NH; u += gridDim.x) {
        const int b = u >> 3, h = u & 7;
        float S[128];
#pragma unroll
        for (int d = 0; d < 128; ++d) S[d] = 0.f;
        const float lb = tid < 128 ? lbv[h * 128 + tid] : 0.f, gain = tid < 128 ? og[tid] : 0.f;
        for (int t = 0; t < SEQ; ++t) {
            bf16* r = big + (size_t)(b * SEQ + t) * 4096 + h * 128 + (tid & 127);
            float q = 0.f, vv = 0.f, gg = 0.f;
            if (tid < 128) { q = bf2f(r[0]) * QSCALE; const float z = bf2f(r[1024]); vv = bf2f(r[2048]); gg = bf2f(r[3072]);
                const float sg = 1.0f / (1.0f + expf(-z)); const float f = lb + (1.0f - lb) * sg; const float k = (1.0f - lb) * (1.0f - sg);
                sq[tid] = q; sf[tid] = f; sk[tid] = k; }
            __syncthreads();
            float o = 0.f;
            if (tid < 128) {
#pragma unroll
                for (int d = 0; d < 128; ++d) { S[d] = sf[d] * S[d] + sk[d] * vv; o += sq[d] * S[d]; }
                const float w = wave_sum(o * o);
                if ((tid & 63) == 0) red[tid >> 6] = w; }
            __syncthreads();
            if (tid < 128) { const float tot = red[0] + red[1];
                const float on = o * rsqrtf(tot * (1.0f / 128.0f) + 1e-6f) * gain;
                r[3072] = f2bf(on * (gg / (1.0f + expf(-gg)))); }
        }
    }
}
__device__ __forceinline__ void attn_naive_phase(bf16* __restrict__ qkv, const float* __restrict__ kmean, LAS unsigned char* lds, int lane, int wave) {
    LAS float* sq = (LAS float*)(lds + RING_OFF) + wave * 128;
    LAS float* sp = (LAS float*)(lds + RING_OFF + 4096) + wave * 1024;
    for (long it0 = (long)blockIdx.x * 8; it0 < (long)MROWS * 8; it0 += (long)gridDim.x * 8) {
        const long item = it0 + wave; const int h = (int)(item & 7); const long row = item >> 3; const int b = (int)(row >> 12), s = (int)(row & (SEQ - 1)), i = s >> 8;
        bf16* qp = qkv + row * 3072 + h * 128;
        __syncthreads();
        sq[lane] = bf2f(qp[lane]); sq[lane + 64] = bf2f(qp[lane + 64]);
        __syncthreads();
        float gv = -INFINITY;
        if (lane < i) { const float* km = kmean + ((size_t)(b * 8 + h) * 16 + lane) * 128; float a = 0.f; for (int d = 0; d < 128; ++d) a += km[d] * sq[d]; gv = a; }
        const int nsel = i < 3 ? i : 3; int s0 = i, s1 = i, s2 = i;
#pragma unroll
        for (int n = 0; n < 3; ++n) {
            if (n < nsel) { const float m = wave_max(gv); const unsigned long long bal = __ballot(gv == m); const int idx = __ffsll((long long)bal) - 1; if (n == 0) s0 = idx; else if (n == 1) s1 = idx; else s2 = idx; if (lane == idx) gv = -INFINITY; } }
#define PICKB(bi) ((bi) == 0 ? s0 : (bi) == 1 ? s1 : (bi) == 2 ? s2 : i)
        float mx = -INFINITY;
        for (int bi = 0; bi <= nsel; ++bi) { const int kb = PICKB(bi) * MBLK;
            for (int c = 0; c < 4; ++c) { const int key = kb + c * 64 + lane;
                const bf16* kp = qkv + (size_t)(b * SEQ + key) * 3072 + 1024 + h * 128; float a = 0.f;
                for (int d8 = 0; d8 < 16; ++d8) { const u32x4 w = *(const u32x4*)(kp + d8 * 8);
                    const unsigned ww[4] = {w.x, w.y, w.z, w.w};
#pragma unroll
                    for (int e = 0; e < 4; ++e) { a += __uint_as_float(ww[e] << 16) * sq[d8 * 8 + 2 * e]; a += __uint_as_float(ww[e] & 0xffff0000u) * sq[d8 * 8 + 2 * e + 1]; } }
                if (bi == nsel && key > s) a = -INFINITY;
                sp[bi * 256 + c * 64 + lane] = a; mx = fmaxf(mx, a); } }
        mx = wave_max(mx);
        float l = 0.f;
        for (int e = lane; e < (nsel + 1) * 256; e += 64) { const float pr = __expf(sp[e] - mx); sp[e] = pr; l += pr; }
        l = wave_sum(l);
        __syncthreads();
        float o0 = 0.f, o1 = 0.f;
        for (int bi = 0; bi <= nsel; ++bi) { const bf16* vp = qkv + (size_t)(b * SEQ + PICKB(bi) * MBLK) * 3072 + 2048 + h * 128 + lane;
            for (int kk = 0; kk < 256; ++kk) { const float pr = sp[bi * 256 + kk]; o0 += pr * bf2f(vp[(size_t)kk * 3072]); o1 += pr * bf2f(vp[(size_t)kk * 3072 + 64]); } }
#undef PICKB
        const float il = 1.0f / l;
        qp[lane] = f2bf(o0 * il); qp[lane + 64] = f2bf(o1 * il);
    }
}

__global__ void __launch_bounds__(NWAVES * 64, 2) mega_fwd(Params p) {
    extern __shared__ __attribute__((aligned(16))) unsigned char lds_raw[];
    LAS unsigned char* lds = (LAS unsigned char*)lds_raw;
    const int G = gridDim.x;
    unsigned char* ws = p.ws;
    for (int u = threadIdx.x; u < (LDS_BYTES - MISC_OFF) / 4; u += NWAVES * 64) ((LAS unsigned*)(lds + MISC_OFF))[u] = 0u;
    __syncthreads();
#define PHASE_IDS() int tid = threadIdx.x; asm volatile("" : "+v"(tid)); const int lane = tid & 63, wave = __builtin_amdgcn_readfirstlane(tid >> 6); (void)lane; (void)wave
    const int lo = p.ph_lo, hi = p.ph_hi;
    XcdBarrier bar; bar.bar = (unsigned*)(ws + WS_CTL) + CW_BAR + p.bar_region * XCD_BAR_WORDS; bar.x = 0; bar.st = nullptr;
    if (hi - lo > 1) bar = xcd_barrier_post((unsigned*)(ws + WS_CTL) + CW_BAR + p.bar_region * XCD_BAR_WORDS, (volatile LAS unsigned*)(lds + MISC_OFF));
#define IN(k) (lo <= (k) && (k) < hi)
#define SEAM(k) do { if (IN(k) && IN((k) + 1)) xcd_barrier(bar); } while (0)
#define PHASE_ENV() PHASE_IDS(); const __attribute__((address_space(4))) Params* pp = (const __attribute__((address_space(4))) Params*)__builtin_amdgcn_kernarg_segment_ptr(); asm volatile("" : "+s"(pp)); \
    unsigned char* ws = pp->ws; float* out = pp->out; bf16* XB = (bf16*)(ws + WS_XB); bf16* BIG = (bf16*)(ws + WS_BIG); float* SS = (float*)(ws + WS_SS); \
    const float* COS = (const float*)(ws + WS_COS); const float* SIN = (const float*)(ws + WS_SIN); const float* LBV = (const float*)(ws + WS_LBV); float* KMEAN = (float*)(ws + WS_KMEAN); \
    float* TAIL = (float*)(ws + WS_TAIL); float* HEADA = (float*)(ws + WS_HEADA); float* HEADU = (float*)(ws + WS_HEADU); \
    (void)out; (void)XB; (void)BIG; (void)SS; (void)COS; (void)SIN; (void)LBV; (void)KMEAN; (void)TAIL; (void)HEADA; (void)HEADU

    if (IN(0)) { PHASE_IDS(); p0_prologue(p, lds, blockIdx.x * NWAVES + wave, G * NWAVES, lane, wave); }
    SEAM(0);
    for (int l = 0; l < DEPTH; ++l) {
        const int pb = 1 + 6 * l, slot = l >> 1; const bool moba = (l & 1) != 0;
        if (IN(pb)) { PHASE_ENV();
            const int N = moba ? 3072 : 4096;
            const bf16* Bt = moba ? (const bf16*)(ws + WS_WQKV) + (size_t)slot * 3072 * 1024 : (const bf16*)(ws + WS_WIN) + (size_t)slot * 4096 * 1024;
            pg8::Gemm g{XB, Bt, MROWS, N, 1024, 1024}; pg8::StaticOrder S; S.init(MROWS, N, G, (int)blockIdx.x);
            pg8::EpiRowScale E{BIG, SS, N, 0};
            pg8::gemm_phase<pg8::EpiRowScale, pg8::StaticOrder, true, true>(lds + RING_OFF, g, S, E);
        }
        SEAM(pb);
        if (moba) {
            if (IN(pb + 1)) { PHASE_ENV(); kprep_phase(BIG, pp->in[8] + slot * 128, pp->in[9] + slot * 128, COS, SIN, KMEAN, lds, lane, wave); }
            SEAM(pb + 1);
#if defined(NAIVE_ATTN)
            if (IN(pb + 2)) { PHASE_ENV(); attn_naive_phase(BIG, KMEAN, lds, lane, wave); }
#elif !defined(NO_ATTN)
            if (IN(pb + 2)) { PHASE_ENV(); mb::attn_phase(BIG, KMEAN, (char*)lds_raw, tid); }
#endif
            SEAM(pb + 2);
        } else {
            SEAM(pb + 1);
#ifndef NO_HG
            if (IN(pb + 2)) { PHASE_ENV(); hg_naive_phase(BIG, LBV + slot * 1024, pp->in[5] + slot * 128, lds, tid); }
#endif
            SEAM(pb + 2);
        }
        if (IN(pb + 3)) { PHASE_ENV();
            const bf16* A = moba ? BIG : BIG + 3072; const int lda = moba ? 3072 : 4096;
            const bf16* Bt = moba ? (const bf16*)(ws + WS_WOM) + (size_t)slot * 1024 * 1024 : (const bf16*)(ws + WS_WOH) + (size_t)slot * 1024 * 1024;
            pg8::Gemm g{A, Bt, MROWS, 1024, 1024, lda}; pg8::StaticOrder S; S.init(MROWS, 1024, G, (int)blockIdx.x);
            pg8::EpiResid E{l == 0 ? pp->in[0] : out, out, XB, SS};
            pg8::gemm_phase<pg8::EpiResid, pg8::StaticOrder, true, true>(lds + RING_OFF, g, S, E);
        }
        SEAM(pb + 3);
#ifndef NO_GLU
        if (IN(pb + 4)) { PHASE_ENV();
            const float* cw = pp->in[12] + (size_t)l * 3 * FF; const float* cb = pp->in[13] + (size_t)l * FF;
            pg8::Gemm g{XB, (const bf16*)(ws + WS_WUP) + (size_t)l * 6144 * 1024, MROWS, 6144, 1024, 1024}; pg8::StaticOrder S; S.init(MROWS, 6144, G, (int)blockIdx.x);
            pg8::EpiGLU E{BIG, SS, cw, cb, TAIL, HEADA, HEADU};
            pg8::gemm_phase<pg8::EpiGLU, pg8::StaticOrder, true, true>(lds + RING_OFF, g, S, E);
        }
#endif
        SEAM(pb + 4);
        if (IN(pb + 5)) { PHASE_ENV();
            const float* cw = pp->in[12] + (size_t)l * 3 * FF; const float* cb = pp->in[13] + (size_t)l * FF;
            pg8::Gemm g{BIG, (const bf16*)(ws + WS_WDN) + (size_t)l * 1024 * 3072, MROWS, 1024, 3072, 3072}; pg8::StaticOrder S; S.init(MROWS, 1024, G, (int)blockIdx.x);
            pg8::Unit u;
            for (int i = 0; S.next(i, u); ++i)
                for (int e = tid; e < 2 * FF; e += NWAVES * 64) glu_fixup_elem(u.pm, e / FF, e % FF, BIG, TAIL, HEADA, HEADU, cw, cb);
            VM_WAIT(); __syncthreads();
            pg8::EpiResid E{out, out, XB, SS};
            pg8::gemm_phase<pg8::EpiResid, pg8::StaticOrder, true, true>(lds + RING_OFF, g, S, E);
        }
        if (l < DEPTH - 1) SEAM(pb + 5);
    }
#undef IN
#undef SEAM
}

#ifndef MK_PER_PHASE
#define MK_PER_PHASE 0
#endif
extern "C" void kernel_launch(void* const* d_in, const int* in_sizes, int n_in, void* d_out, int out_size, void* d_ws, size_t ws_size, hipStream_t stream) {
    static int grid = 0;
    if (grid == 0) {
        if (n_in != 15 || in_sizes[0] != MROWS * DM || out_size != MROWS * DM || ws_size < WS_END) {
            fprintf(stderr, "kernel_launch: unexpected shapes (n_in %d, in0 %d, out %d, ws %zu < %zu); nothing launched\n", n_in, n_in > 0 ? in_sizes[0] : -1, out_size, ws_size, (size_t)WS_END); grid = -1; return; }
        int dev = 0, cus = 0, per_cu = 0;
        if (hipGetDevice(&dev) != hipSuccess || hipDeviceGetAttribute(&cus, hipDeviceAttributeMultiprocessorCount, dev) != hipSuccess || cus <= 0) { fprintf(stderr, "kernel_launch: no device attributes\n"); grid = -1; return; }
        if (hipFuncSetAttribute((const void*)mega_fwd, hipFuncAttributeMaxDynamicSharedMemorySize, LDS_BYTES) != hipSuccess) { fprintf(stderr, "kernel_launch: hipFuncSetAttribute failed\n"); grid = -1; return; }
        if (hipOccupancyMaxActiveBlocksPerMultiprocessor(&per_cu, (const void*)mega_fwd, NWAVES * 64, LDS_BYTES) != hipSuccess || per_cu < 1)
            fprintf(stderr, "kernel_launch: note: occupancy query reports %d workgroups per CU; launching one per CU (144 KiB LDS each admits exactly one)\n", per_cu);
        (void)hipGetLastError();
        grid = cus;
    }
    if (grid < 0) return;
    (void)hipMemsetAsync((char*)d_ws + WS_CTL, 0, CTL_ZERO_BYTES, stream);
    Params p{};
    for (int i = 0; i < 15; ++i) p.in[i] = (const float*)d_in[i];
    p.out = (float*)d_out; p.ws = (unsigned char*)d_ws;
#if MK_PER_PHASE
    for (int k = 0; k < N_PHASES; ++k) { p.ph_lo = k; p.ph_hi = k + 1; p.bar_region = 0; hipLaunchKernelGGL(mega_fwd, dim3(grid), dim3(NWAVES * 64), LDS_BYTES, stream, p); }
#else
    p.ph_lo = 0; p.ph_hi = N_PHASES; p.bar_region = 0;
    hipLaunchKernelGGL(mega_fwd, dim3(grid), dim3(NWAVES * 64), LDS_BYTES, stream, p);
#endif
}
```

```cpp
#include <hip/hip_runtime.h>
#include <cstdio>
#include <cstdint>
#include <cmath>
namespace pg8 {
#define PG8_LAS __attribute__((address_space(3)))
typedef unsigned short bf16_t;
typedef short bf16x8 __attribute__((ext_vector_type(8)));
typedef float f32x4 __attribute__((ext_vector_type(4)));
typedef unsigned u32x4 __attribute__((ext_vector_type(4)));
constexpr int BM = 256, BK = 64, HALF = 128, HTB = HALF * BK * 2  , STAGE_BYTES = 8 * HTB, NXCD = 8, WGM = 8;

__host__ __device__ __forceinline__ int lds_byte(int r, int c) { const int st = (r >> 4) * 2 + (c >> 5), rr = r & 15, cc = c & 31, ob = rr * 64 + cc * 2; return st * 1024 + (ob ^ (((ob >> 9) & 1) << 5)); }
__host__ __device__ __forceinline__ void stage_rc(int b, int& R, int& C) { const int st = b / 1024, sb = b % 1024, swz = sb ^ (((sb >> 9) & 1) << 5); R = (st >> 1) * 16 + swz / 64; C = (st & 1) * 32 + (swz % 64) / 2; }
__host__ __device__ __forceinline__ int perm32(int rho) { const int n = rho >> 4, i = rho & 15; return 8 * (i >> 2) + 4 * n + (i & 3); }

struct Unit { int pm, pn; };
struct Gemm { const bf16_t* A; const bf16_t* Bt; int M, N, K, lda; };

struct StaticOrder {
    int nM, nN, nwg, G, c;
    __host__ __device__ void init(int M, int N, int G_, int c_) { nM = M / BM; nN = N / BM; nwg = nM * nN; G = G_; c = c_; }
    __host__ __device__ bool next(int i, Unit& u) const {
        const long L = (long)i * G + c; if (L >= nwg) return false;
        int wgid = (int)L; { const int q = nwg / NXCD, r = nwg % NXCD, xcd = wgid % NXCD, off = wgid / NXCD; wgid = (xcd < r ? xcd * (q + 1) : r * (q + 1) + (xcd - r) * q) + off; }
        const int nig = WGM * nN, gid = wgid / nig, fm = gid * WGM, gsz = (nM - fm) < WGM ? (nM - fm) : WGM;
        u.pm = fm + ((wgid % nig) % gsz); u.pn = (wgid % nig) / gsz; return true;
    }
    __device__ __forceinline__ void a_ready(const Unit&) const {}
    __device__ __forceinline__ void done(const Unit&) const {}
};

__device__ __forceinline__ unsigned cvt_pk_bf16(float lo, float hi) { unsigned r; asm volatile("v_cvt_pk_bf16_f32 %0, %1, %2" : "=v"(r) : "v"(lo), "v"(hi)); return r; }
typedef float f32x2 __attribute__((ext_vector_type(2)));
__device__ __forceinline__ float row_rstd(const float* ss, int row, int fq) {
    const f32x4 a = *(const f32x4*)(ss + (size_t)row * 16 + 4 * fq);
    float s = (a[0] + a[1]) + (a[2] + a[3]);
    s += __shfl_xor(s, 16); s += __shfl_xor(s, 32);
    return __builtin_amdgcn_rsqf(s * (1.0f / 1024.0f) + 1e-6f);
}
struct EpiRowScale {
    static constexpr bool PERM = true, AFTER_DRAIN = false;
    bf16_t* O; const float* ss; int ldc, pad;
    __device__ __forceinline__ void operator()(f32x4 (&acc)[2][2][4][2], const Unit& u, int wr, int wc, int fr, int fq, PG8_LAS unsigned char* lds) const {
        const int row0 = u.pm * BM + wr * 64 + fr; const int col0 = u.pn * BM + wc * 32 + 8 * fq;
#pragma unroll
        for (int ai = 0; ai < 2; ++ai)
#pragma unroll
            for (int m = 0; m < 4; ++m) { const int row = row0 + ai * HALF + m * 16; const float rs = row_rstd(ss, row, fq);
                bf16_t* rowp = O + (size_t)row * ldc + col0;
#pragma unroll
                for (int bj = 0; bj < 2; ++bj) { const f32x4 v0 = acc[ai][bj][m][0] * rs, v1 = acc[ai][bj][m][1] * rs;
                    u32x4 w; w.x = cvt_pk_bf16(v0[0], v0[1]); w.y = cvt_pk_bf16(v0[2], v0[3]); w.z = cvt_pk_bf16(v1[0], v1[1]); w.w = cvt_pk_bf16(v1[2], v1[3]);
                    *(u32x4*)(rowp + bj * HALF) = w; } }
    }
};
typedef unsigned u32x2 __attribute__((ext_vector_type(2)));
struct EpiResid {
    static constexpr bool PERM = false, AFTER_DRAIN = false;
    const float* base; float* out; bf16_t* xb; float* ss;
    __device__ __forceinline__ void operator()(f32x4 (&acc)[2][2][4][2], const Unit& u, int wr, int wc, int fr, int fq, PG8_LAS unsigned char* lds) const {
        const int col0 = u.pn * BM + wc * 32 + 4 * fq;
#pragma unroll
        for (int ai = 0; ai < 2; ++ai)
#pragma unroll
            for (int m = 0; m < 4; ++m) { const int row = u.pm * BM + ai * HALF + wr * 64 + m * 16 + fr; const size_t off = (size_t)row * 1024 + col0; float s = 0.f;
#pragma unroll
                for (int bj = 0; bj < 2; ++bj)
#pragma unroll
                    for (int n = 0; n < 2; ++n) { const f32x4 b = *(const f32x4*)(base + off + bj * HALF + n * 16); const f32x4 o = b + acc[ai][bj][m][n];
                        *(f32x4*)(out + off + bj * HALF + n * 16) = o; s += (o[0] * o[0] + o[1] * o[1]) + (o[2] * o[2] + o[3] * o[3]);
                        u32x2 w; w.x = cvt_pk_bf16(o[0], o[1]); w.y = cvt_pk_bf16(o[2], o[3]); *(u32x2*)(xb + off + bj * HALF + n * 16) = w; }
                s += __shfl_xor(s, 16); s += __shfl_xor(s, 32);
                if (fq == 0) ss[(size_t)row * 16 + u.pn * 4 + wc] = s; }
    }
};
template <int CTRL> __device__ __forceinline__ float dpp_mov(float old, float src) {
    return __builtin_bit_cast(float, __builtin_amdgcn_update_dpp(__builtin_bit_cast(int, old), __builtin_bit_cast(int, src), CTRL, 0xf, 0xf, false)); }
__device__ __forceinline__ float silu_f(float c) { return c * __builtin_amdgcn_rcpf(1.0f + __expf(-c)); }
struct EpiGLU {
    static constexpr bool PERM = true, AFTER_DRAIN = false;
    bf16_t* G; const float* ss; const float* cw; const float* cb; float* tail; float* head_a; float* head_u;
    __device__ __forceinline__ void operator()(f32x4 (&acc)[2][2][4][2], const Unit& u, int wr, int wc, int fr, int fq, PG8_LAS unsigned char* lds) const {
        const int f0 = u.pn * 128 + wc * 32 + 8 * fq;
        PG8_LAS float* X = (PG8_LAS float*)(lds + STAGE_BYTES);
#pragma unroll
        for (int ai = 0; ai < 2; ++ai)
#pragma unroll
            for (int m = 0; m < 4; ++m) { const float rs = row_rstd(ss, u.pm * BM + ai * HALF + wr * 64 + m * 16 + fr, fq);
#pragma unroll
                for (int bj = 0; bj < 2; ++bj)
#pragma unroll
                    for (int n = 0; n < 2; ++n) acc[ai][bj][m][n] = acc[ai][bj][m][n] * rs;
                if (m & 1) asm volatile("" ::: "memory"); }
        if (fr >= 14) {
#pragma unroll
            for (int ai = 0; ai < 2; ++ai)
#pragma unroll
                for (int n = 0; n < 2; ++n) *(PG8_LAS f32x4*)(X + ((((ai * 2 + wr) * 4 + wc) * 2 + (fr - 14)) * 32 + 8 * fq + 4 * n)) = acc[ai][0][3][n];
            if (wr == 1) {
#pragma unroll
                for (int n = 0; n < 2; ++n) *(f32x4*)(tail + ((size_t)u.pm * 2 + (fr - 14)) * 3072 + f0 + 4 * n) = acc[1][0][3][n]; }
        }
        if (wr == 0 && fr < 2) {
#pragma unroll
            for (int n = 0; n < 2; ++n) { *(f32x4*)(head_a + ((size_t)u.pm * 2 + fr) * 3072 + f0 + 4 * n) = acc[0][0][0][n]; *(f32x4*)(head_u + ((size_t)u.pm * 2 + fr) * 3072 + f0 + 4 * n) = acc[0][1][0][n]; } }
        asm volatile("s_waitcnt lgkmcnt(0)" ::: "memory"); __builtin_amdgcn_s_barrier(); asm volatile("" ::: "memory");
#pragma unroll
        for (int n = 0; n < 2; ++n) {
            const f32x4 w0 = *(const f32x4*)(cw + f0 + 4 * n), w1 = *(const f32x4*)(cw + 3072 + f0 + 4 * n), w2 = *(const f32x4*)(cw + 6144 + f0 + 4 * n), bb = *(const f32x4*)(cb + f0 + 4 * n);
#pragma unroll
            for (int ai = 0; ai < 2; ++ai) {
                const int blk = ai * 2 + wr;
                f32x4 P1 = (f32x4){0.f, 0.f, 0.f, 0.f}, P2 = P1;
                if (blk > 0) { P2 = *(const PG8_LAS f32x4*)(X + (((blk - 1) * 4 + wc) * 2 + 0) * 32 + 8 * fq + 4 * n); P1 = *(const PG8_LAS f32x4*)(X + (((blk - 1) * 4 + wc) * 2 + 1) * 32 + 8 * fq + 4 * n); }
#pragma unroll
                for (int m = 0; m < 4; ++m) {
                    f32x4 gv;
#pragma unroll
                    for (int j = 0; j < 4; ++j) {
                        const float cur = acc[ai][0][m][n][j]; float o1, o2;
                        if (m == 0) { o1 = P1[j]; o2 = fr == 0 ? P2[j] : P1[j]; }
                        else { const float pv = acc[ai][0][m > 0 ? m - 1 : 0][n][j]; o1 = dpp_mov<0x121>(pv, pv); o2 = dpp_mov<0x122>(pv, pv); }
                        const float x1 = dpp_mov<0x111>(o1, cur), x2 = dpp_mov<0x112>(o2, cur);
                        const float c = w0[j] * x2 + w1[j] * x1 + w2[j] * cur + bb[j];
                        gv[j] = silu_f(c) * acc[ai][1][m][n][j]; }
                    if (!(blk == 0 && m == 0 && fr < 2)) {
                        u32x2 w; w.x = cvt_pk_bf16(gv[0], gv[1]); w.y = cvt_pk_bf16(gv[2], gv[3]);
                        *(u32x2*)(G + (size_t)(u.pm * BM + ai * HALF + wr * 64 + m * 16 + fr) * 3072 + f0 + 4 * n) = w; }
                    asm volatile("" ::: "memory");
                }
            }
        }
    }
};
template <class Epi, class Sched, bool ALIGN_EPI = false, bool SP2 = false>
__device__ __forceinline__ void gemm_phase(PG8_LAS unsigned char* lds, const Gemm g, const Sched& S, const Epi& E) {
    int tid_ = threadIdx.x; asm volatile("" : "+v"(tid_));
    const int tid = tid_, wid = __builtin_amdgcn_readfirstlane(tid >> 6), lane = tid & 63, wr = wid >> 2, wc = wid & 3, fr = lane & 15, fq = lane >> 4;
    const int K = g.K, nt = K / BK;
    unsigned voffA[2], voffB[2];
#pragma unroll
    for (int i = 0; i < 2; ++i) { int R, C; stage_rc(tid * 16 + i * 8192, R, C); const int Rb = Epi::PERM ? ((R & ~31) + perm32(R & 31)) : R;
        voffA[i] = (unsigned)(R * g.lda + C) * 2u; voffB[i] = (unsigned)(Rb * K + C) * 2u; }
    const size_t kstep = (size_t)(BK * 2);
    const size_t hstepB = (size_t)HALF * K * 2, hstepA = (size_t)HALF * g.lda * 2;
    const size_t tstepA = 2 * hstepA, tstepB = 2 * hstepB;
    const unsigned ldsw = (unsigned)wid * 1024u;
    const int aoff = lds_byte(wr * 64 + fr, fq * 8), boff = lds_byte(wc * 32 + fr, fq * 8);
#define PG8_SA(b, h) (((b) * 2 + (h)) * HTB)
#define PG8_SB(b, h) ((4 + (b) * 2 + (h)) * HTB)
#define PG8_STAGE(bufoff, gbase, voff) do { _Pragma("unroll") for (int _i = 0; _i < 2; ++_i) \
        __builtin_amdgcn_global_load_lds((const unsigned*)((const char*)(gbase) + (voff)[_i]), (PG8_LAS unsigned*)(lds + (bufoff) + ldsw + _i * 8192), 16, 0, 0); } while (0)
#define PG8_LDA(dst, b, h) do { _Pragma("unroll") for (int m = 0; m < 4; ++m) _Pragma("unroll") for (int k = 0; k < 2; ++k) dst[m][k] = *(const PG8_LAS bf16x8*)(lds + PG8_SA(b, h) + aoff + m * 2048 + k * 1024); } while (0)
#define PG8_LDB(dst, b, h) do { _Pragma("unroll") for (int n = 0; n < 2; ++n) _Pragma("unroll") for (int k = 0; k < 2; ++k) dst[n][k] = *(const PG8_LAS bf16x8*)(lds + PG8_SB(b, h) + boff + n * 2048 + k * 1024); } while (0)
#define PG8_MMA(ai, bj, At, Bt) do { __builtin_amdgcn_s_setprio(1); _Pragma("unroll") for (int m = 0; m < 4; ++m) _Pragma("unroll") for (int n = 0; n < 2; ++n) _Pragma("unroll") for (int k = 0; k < 2; ++k) \
        acc[ai][bj][m][n] = __builtin_amdgcn_mfma_f32_16x16x32_bf16(Bt[n][k], At[m][k], acc[ai][bj][m][n], 0, 0, 0); __builtin_amdgcn_s_setprio(0); } while (0)
#define PG8_WAIT_V(n) asm volatile("s_waitcnt vmcnt(" #n ")" ::: "memory")
#define PG8_WAIT_L(n) asm volatile("s_waitcnt lgkmcnt(" #n ")" ::: "memory")
#define PG8_BAR __builtin_amdgcn_s_barrier()
#define PG8_SCHED __builtin_amdgcn_sched_barrier(0)
    Unit cur, nxt; int ui = 0;
    if (!S.next(0, cur)) return;
    f32x4 acc[2][2][4][2];
#pragma unroll
    for (int a = 0; a < 2; ++a)
#pragma unroll
        for (int b = 0; b < 2; ++b)
#pragma unroll
            for (int m = 0; m < 4; ++m)
#pragma unroll
                for (int n = 0; n < 2; ++n) acc[a][b][m][n] = (f32x4){0.f, 0.f, 0.f, 0.f};
    bf16x8 At[4][2], B0[2][2], B1[2][2];
    const char* cA = (const char*)g.A + (size_t)cur.pm * tstepA; const char* cB = (const char*)g.Bt + (size_t)cur.pn * tstepB;
    S.a_ready(cur);
    if constexpr (SP2) {
        PG8_STAGE(PG8_SB(0, 0), cB, voffB); PG8_STAGE(PG8_SB(0, 1), cB + hstepB, voffB); PG8_STAGE(PG8_SA(0, 0), cA, voffA); PG8_STAGE(PG8_SA(0, 1), cA + hstepA, voffA);
        if (wr == 1) PG8_BAR;
        PG8_WAIT_V(2); PG8_BAR;
        PG8_STAGE(PG8_SB(1, 0), cB + kstep, voffB); PG8_STAGE(PG8_SA(1, 0), cA + kstep, voffA); PG8_STAGE(PG8_SB(1, 1), cB + hstepB + kstep, voffB);
        PG8_WAIT_V(6); PG8_BAR;
    } else {
        PG8_STAGE(PG8_SB(0, 0), cB, voffB); PG8_STAGE(PG8_SA(0, 0), cA, voffA); PG8_STAGE(PG8_SB(0, 1), cB + hstepB, voffB); PG8_STAGE(PG8_SA(0, 1), cA + hstepA, voffA);
        if (wr == 1) PG8_BAR;
        PG8_WAIT_V(4); PG8_BAR;
        PG8_STAGE(PG8_SB(1, 0), cB + kstep, voffB); PG8_STAGE(PG8_SA(1, 0), cA + kstep, voffA); PG8_STAGE(PG8_SB(1, 1), cB + hstepB + kstep, voffB);
        PG8_WAIT_V(6); PG8_BAR;
    }
    for (;;) {
        const bool has_next = S.next(ui + 1, nxt);
        const char* nA = has_next ? (const char*)g.A + (size_t)nxt.pm * tstepA : cA; const char* nB = has_next ? (const char*)g.Bt + (size_t)nxt.pn * tstepB : cB;
        for (int t = 0; t < nt; t += 2) {
            const bool last = (t == nt - 2);
            const char* a1 = cA + (size_t)(t + 1) * kstep;
            const char* a2 = last ? nA : cA + (size_t)(t + 2) * kstep; const char* b2 = last ? nB : cB + (size_t)(t + 2) * kstep;
            const char* a3 = a2 + kstep; const char* b3 = b2 + kstep;
            if (last && has_next) S.a_ready(nxt);
            if constexpr (SP2) {
            PG8_LDB(B0, 0, 0); PG8_LDB(B1, 0, 1); PG8_SCHED; PG8_LDA(At, 0, 0); PG8_STAGE(PG8_SA(1, 1), a1 + hstepA, voffA);
            PG8_WAIT_V(8); PG8_WAIT_L(0); PG8_BAR; PG8_MMA(0, 0, At, B0); PG8_MMA(0, 1, At, B1); PG8_BAR; PG8_SCHED;
            PG8_LDA(At, 0, 1); PG8_STAGE(PG8_SB(0, 0), b2, voffB); PG8_STAGE(PG8_SB(0, 1), b2 + hstepB, voffB); PG8_STAGE(PG8_SA(0, 0), a2, voffA);
            PG8_WAIT_V(8); PG8_WAIT_L(0); PG8_BAR; PG8_MMA(1, 0, At, B0); PG8_MMA(1, 1, At, B1); PG8_BAR; PG8_SCHED;
            PG8_LDB(B0, 1, 0); PG8_LDB(B1, 1, 1); PG8_SCHED; PG8_LDA(At, 1, 0); PG8_STAGE(PG8_SA(0, 1), a2 + hstepA, voffA);
            PG8_WAIT_V(8); PG8_WAIT_L(0); PG8_BAR; PG8_MMA(0, 0, At, B0); PG8_MMA(0, 1, At, B1); PG8_BAR; PG8_SCHED;
            PG8_LDA(At, 1, 1); PG8_STAGE(PG8_SB(1, 0), b3, voffB); PG8_STAGE(PG8_SB(1, 1), b3 + hstepB, voffB); PG8_STAGE(PG8_SA(1, 0), a3, voffA);
            PG8_WAIT_V(8); PG8_WAIT_L(0); PG8_BAR; PG8_MMA(1, 0, At, B0); PG8_MMA(1, 1, At, B1); PG8_BAR; PG8_SCHED;
            } else {
            PG8_LDB(B0, 0, 0); PG8_SCHED; PG8_LDA(At, 0, 0); PG8_STAGE(PG8_SA(1, 1), a1 + hstepA, voffA);
            PG8_WAIT_L(8); PG8_BAR; PG8_WAIT_L(0); PG8_MMA(0, 0, At, B0); PG8_BAR; PG8_SCHED;
            PG8_LDB(B1, 0, 1); PG8_STAGE(PG8_SB(0, 0), b2, voffB);
            PG8_BAR; PG8_WAIT_L(0); PG8_MMA(0, 1, At, B1); PG8_BAR;
            PG8_LDA(At, 0, 1); PG8_STAGE(PG8_SA(0, 0), a2, voffA);
            PG8_BAR; PG8_WAIT_L(0); PG8_MMA(1, 0, At, B0); PG8_BAR; PG8_SCHED;
            PG8_STAGE(PG8_SB(0, 1), b2 + hstepB, voffB);
            PG8_WAIT_V(6); PG8_BAR; PG8_MMA(1, 1, At, B1); PG8_BAR;
            PG8_LDB(B0, 1, 0); PG8_SCHED; PG8_LDA(At, 1, 0); PG8_STAGE(PG8_SA(0, 1), a2 + hstepA, voffA);
            PG8_WAIT_L(8); PG8_BAR; PG8_WAIT_L(0); PG8_MMA(0, 0, At, B0); PG8_BAR; PG8_SCHED;
            PG8_LDB(B1, 1, 1); PG8_STAGE(PG8_SB(1, 0), b3, voffB);
            PG8_BAR; PG8_WAIT_L(0); PG8_MMA(0, 1, At, B1); PG8_BAR;
            PG8_LDA(At, 1, 1); PG8_STAGE(PG8_SA(1, 0), a3, voffA);
            PG8_BAR; PG8_WAIT_L(0); PG8_MMA(1, 0, At, B0); PG8_BAR; PG8_SCHED;
            PG8_STAGE(PG8_SB(1, 1), b3 + hstepB, voffB);
            PG8_WAIT_V(6); PG8_BAR; PG8_MMA(1, 1, At, B1); PG8_BAR;
            }
        }
        if constexpr (ALIGN_EPI) { if (wr == 0) PG8_BAR; }
        if constexpr (!Epi::AFTER_DRAIN) { E(acc, cur, wr, wc, fr, fq, lds); S.done(cur); }
        if (!has_next) break;
#pragma unroll
        for (int a = 0; a < 2; ++a)
#pragma unroll
            for (int b = 0; b < 2; ++b)
#pragma unroll
                for (int m = 0; m < 4; ++m)
#pragma unroll
                    for (int n = 0; n < 2; ++n) acc[a][b][m][n] = (f32x4){0.f, 0.f, 0.f, 0.f};
        cur = nxt; cA = nA; cB = nB; ++ui;
        if constexpr (ALIGN_EPI) { if (wr == 1) PG8_BAR; }
    }
    PG8_WAIT_V(0);
    if constexpr (!ALIGN_EPI) { if (wr == 0) PG8_BAR; }
    PG8_BAR;
    if constexpr (Epi::AFTER_DRAIN) { E.fused(acc, cur, wr, wc, fr, fq, lds, wid, lane); S.done(cur); }
#undef PG8_SA
#undef PG8_SB
#undef PG8_STAGE
#undef PG8_LDA
#undef PG8_LDB
#undef PG8_MMA
#undef PG8_WAIT_V
#undef PG8_WAIT_L
#undef PG8_BAR
#undef PG8_SCHED
}
}
constexpr int BATCH = 8, SEQ = 4096, DM = 1024, MROWS = BATCH * SEQ, DEPTH = 4;
constexpr int NH = 8, HD = 128;
constexpr int FF = 3072, NBLK = 16, MBLK = 256;
constexpr float QSCALE = 0.08838834764831845f;
typedef unsigned short bf16;
typedef float f32x4 __attribute__((ext_vector_type(4)));
typedef unsigned u32x4 __attribute__((ext_vector_type(4)));

constexpr size_t MiB = 1u << 20;
constexpr size_t WS_CTL = 0, CTL_ZERO_BYTES = 1 * MiB;
constexpr size_t WS_WIN = 2 * MiB, WS_WQKV = 18 * MiB, WS_WOH = 30 * MiB, WS_WOM = 34 * MiB, WS_WUP = 38 * MiB, WS_WDN = 86 * MiB;
constexpr size_t WS_SS = 110 * MiB, WS_COS = 112 * MiB, WS_SIN = 113 * MiB, WS_LBV = 114 * MiB, WS_KMEAN = 115 * MiB;
constexpr size_t WS_HGD = 115 * MiB + 512 * 1024, WS_HGE = 116 * MiB;
constexpr size_t WS_TAIL = 132 * MiB, WS_HEADA = 135 * MiB, WS_HEADU = 138 * MiB;
constexpr size_t WS_XB = 144 * MiB, WS_BIG = 208 * MiB, WS_AU = 400 * MiB, WS_END = 464 * MiB;

__device__ __forceinline__ float bf2f(bf16 v) { return __uint_as_float((unsigned)v << 16); }
__device__ __forceinline__ bf16 f2bf(float f) { unsigned u = __float_as_uint(f); return (bf16)((u + 0x7fffu + ((u >> 16) & 1u)) >> 16); }
__device__ __forceinline__ float wave_sum(float v) {
#pragma unroll
    for (int o = 1; o < 64; o <<= 1) v += __shfl_xor(v, o);
    return v;
}
__device__ __forceinline__ float wave_max(float v) {
#pragma unroll
    for (int o = 1; o < 64; o <<= 1) v = fmaxf(v, __shfl_xor(v, o));
    return v;
}

__device__ __forceinline__ void glu_fixup_elem(int pm, int rr, int f, bf16* __restrict__ g, const float* __restrict__ tail, const float* __restrict__ head_a, const float* __restrict__ head_u, const float* __restrict__ cw, const float* __restrict__ cb) {
    const bool first = (pm & 15) == 0;
    const float cur = head_a[((size_t)pm * 2 + rr) * FF + f];
    const float t1 = first ? 0.f : tail[((size_t)(pm - 1) * 2 + 1) * FF + f], t0 = first ? 0.f : tail[((size_t)(pm - 1) * 2 + 0) * FF + f];
    const float prev1 = rr == 0 ? t1 : head_a[((size_t)pm * 2) * FF + f], prev2 = rr == 0 ? t0 : t1;
    const float c = cw[f] * prev2 + cw[FF + f] * prev1 + cw[2 * FF + f] * cur + cb[f];
    g[((size_t)pm * 256 + rr) * FF + f] = f2bf(c / (1.0f + __expf(-c)) * head_u[((size_t)pm * 2 + rr) * FF + f]);
}
#define XB_TMO      128
#define XB_XCNT(j)  (256  + 64 * (j))
#define XB_XSUB(j)  (1280 + 64 * (j))
#define XB_XGEN(j)  (2304 + 64 * (j))
#define XB_TOP      3328
#define XB_TOPGEN   3392
#define XCD_BAR_WORDS 3456
#define XB_SPIN_CAP (1u << 18)
#define LAS __attribute__((address_space(3)))

__device__ __forceinline__ unsigned xb_ld(unsigned* p)              { return __hip_atomic_load(p, __ATOMIC_RELAXED, __HIP_MEMORY_SCOPE_AGENT); }
__device__ __forceinline__ unsigned xb_add(unsigned* p, unsigned v) { return __hip_atomic_fetch_add(p, v, __ATOMIC_RELAXED, __HIP_MEMORY_SCOPE_AGENT); }
__device__ __forceinline__ unsigned xb_xcc_id() { return (unsigned)__builtin_amdgcn_s_getreg((3 << 11) | 20) & 0xFu; }
#define XB_SPIN(cond, bar) do { unsigned _sp = 0; while (cond) { __builtin_amdgcn_s_sleep(1); \
    if ((++_sp & 255u) == 0u) { if (xb_ld(&(bar)[XB_TMO])) break; if (_sp > XB_SPIN_CAP) { atomicAdd(&(bar)[XB_TMO], 1u); break; } } } } while (0)

struct XcdBarrier {
    unsigned* bar; unsigned x;
    volatile LAS unsigned* st;
};

__device__ __forceinline__ XcdBarrier xcd_barrier_post(unsigned* bar, volatile LAS unsigned* st) {
    XcdBarrier b; b.bar = bar; b.x = xb_xcc_id(); b.st = st;
    if (threadIdx.x == 0) (void)xb_add(&bar[XB_XCNT(b.x)], 1u);
    return b;
}
__device__ __forceinline__ void xcd_barrier_complete(unsigned* bar, unsigned x, unsigned& nloc, unsigned& nx) {
    const unsigned G = gridDim.x * gridDim.y * gridDim.z;
    unsigned sum, cnt, mine, sp = 0u;
    for (;;) {
        sum = 0u; cnt = 0u; mine = 0u;
#pragma unroll
        for (unsigned j = 0; j < 16; ++j) { const unsigned c = xb_ld(&bar[XB_XCNT(j)]); sum += c; cnt += (c > 0u) ? 1u : 0u; mine = (j == x) ? c : mine; }
        if (sum == G) break;
        __builtin_amdgcn_s_sleep(1);
        if ((++sp & 255u) == 0u) { if (xb_ld(&bar[XB_TMO])) break; if (sp > XB_SPIN_CAP) { atomicAdd(&bar[XB_TMO], 1u); break; } }
    }
    nloc = mine > 0u ? mine : 1u; nx = cnt > 0u ? cnt : 1u;
}

__device__ __forceinline__ void xcd_barrier(const XcdBarrier& b) {
    asm volatile("s_waitcnt vmcnt(0)" ::: "memory");
    __syncthreads();
    if (threadIdx.x == 0) {
        unsigned* bar = b.bar;
        __builtin_amdgcn_s_waitcnt(0);
        unsigned nloc = b.st[0], nx = b.st[1];
        if (nloc == 0u) { xcd_barrier_complete(bar, b.x, nloc, nx); b.st[0] = nloc; b.st[1] = nx; }
        const unsigned old = xb_add(&bar[XB_XSUB(b.x)], 1u);
        const unsigned gen = old / nloc;
        if (old + 1u == (gen + 1u) * nloc) {
            __builtin_amdgcn_fence(__ATOMIC_RELEASE, "agent");
            asm volatile("s_waitcnt vmcnt(0)" ::: "memory");
            const unsigned og = xb_add(&bar[XB_TOP], 1u);
            const unsigned tg = og / nx;
            if (og + 1u == (tg + 1u) * nx) xb_add(&bar[XB_TOPGEN], 1u);
            else XB_SPIN(xb_ld(&bar[XB_TOPGEN]) == tg, bar);
            __builtin_amdgcn_fence(__ATOMIC_ACQUIRE, "agent");
            xb_add(&bar[XB_XGEN(b.x)], 1u);
            asm volatile("s_waitcnt vmcnt(0)" ::: "memory");
        } else {
            XB_SPIN(xb_ld(&bar[XB_XGEN(b.x)]) == gen, bar);
            __builtin_amdgcn_fence(__ATOMIC_ACQUIRE, "agent");
            asm volatile("s_waitcnt vmcnt(0)" ::: "memory");
        }
    }
    __syncthreads();
}
namespace mb {
typedef short bf16x8 __attribute__((ext_vector_type(8)));
typedef short s16x4 __attribute__((ext_vector_type(4)));
typedef float f32x16 __attribute__((ext_vector_type(16)));
constexpr int D = 128, LDR = 3072, NW = 8, QBLK = 32, KVBLK = 64, QB = NW * QBLK;
constexpr int SHM_V = KVBLK * D * 2, SHM_K = KVBLK * D * 2;
constexpr int OFF_WS = 2 * SHM_V + 2 * SHM_K, OFF_KM = OFF_WS + NW * 64 * 4, ATT_LDS_BYTES = OFF_KM + 16 * 128 * 4;
constexpr float THR = 8.f;
#define KSWZ(row, colB) ((row) * 256 + ((colB) ^ (((row) & 7) << 4)))
#define SBAR() __builtin_amdgcn_sched_barrier(0)
__device__ __forceinline__ int v_st(int k, int c) { const int kk = (k & ~0xC) | ((k & 4) << 1) | ((k & 8) >> 1); return ((kk >> 3) * 4 + (c >> 5)) * 512 + ((kk & 7) * 32 + (c & 31)) * 2; }
__device__ __forceinline__ int v_rd_base(int lane) { return ((lane & 3) << 3) | (((lane >> 2) & 3) << 6) | (((lane >> 4) & 1) << 5) | (((lane >> 5) & 1) << 8); }
constexpr int v_rd_off(int d0, int ks, int half) { return d0 * 512 + ks * 4096 + half * 2048; }
__device__ __forceinline__ int crow(int r, int hi) { return (r & 3) + 8 * (r >> 2) + 4 * hi; }
__device__ __forceinline__ unsigned cvtpk(float lo, float hi) { unsigned r; asm volatile("v_cvt_pk_bf16_f32 %0, %1, %2" : "=v"(r) : "v"(lo), "v"(hi)); return r; }
__device__ __forceinline__ bf16x8 load8(const bf16* p) { return *reinterpret_cast<const bf16x8*>(p); }
__device__ __forceinline__ void mask_causal(f32x16& p0, f32x16& p1, int dq) {
    const float NEG = -__builtin_inff();
#pragma unroll
    for (int r = 0; r < 16; ++r) { const int c = (r & 3) + 8 * (r >> 2); if (dq - c < 0) p0[r] = NEG; if (dq - c - 32 < 0) p1[r] = NEG; }
}
__device__ __forceinline__ void mask_all(f32x16& p0, f32x16& p1, bool keep) {
    const float NEG = -__builtin_inff();
#pragma unroll
    for (int r = 0; r < 16; ++r) { p0[r] = keep ? p0[r] : NEG; p1[r] = keep ? p1[r] : NEG; }
}
__device__ __forceinline__ void partialSM(f32x16& p0, f32x16& p1, float& m_reg, float& mn, float& alpha) {
    float pmax = p0[0]; for (int r = 1; r < 16; ++r) pmax = fmaxf(pmax, p0[r]); for (int r = 0; r < 16; ++r) pmax = fmaxf(pmax, p1[r]);
    { auto rr = __builtin_amdgcn_permlane32_swap(__float_as_uint(pmax), __float_as_uint(pmax), false, false);
      pmax = fmaxf(__uint_as_float(rr[0]), __uint_as_float(rr[1])); }
    constexpr float C2 = 1.4426950408889634f;
    if (__builtin_expect(__all((pmax - m_reg) <= THR), 1)) { mn = m_reg; alpha = 1.f; }
    else { mn = fmaxf(m_reg, pmax); alpha = __builtin_amdgcn_exp2f((m_reg - mn) * C2); m_reg = mn; }
    const float mnL = -mn * C2;
    for (int r = 0; r < 16; ++r) p0[r] = fmaf(p0[r], C2, mnL); for (int r = 0; r < 16; ++r) p1[r] = fmaf(p1[r], C2, mnL);
    for (int r = 0; r < 16; ++r) p0[r] = __builtin_amdgcn_exp2f(p0[r]);
}
__device__ __forceinline__ void finishSM(f32x16& p0, f32x16& p1, float alpha, float& l_reg, bf16x8& pa0, bf16x8& pa1, bf16x8& pa2, bf16x8& pa3) {
    for (int r = 0; r < 16; ++r) p1[r] = __builtin_amdgcn_exp2f(p1[r]);
    float ps = 0; for (int r = 0; r < 16; ++r) ps += p0[r]; for (int r = 0; r < 16; ++r) ps += p1[r];
    { auto rr = __builtin_amdgcn_permlane32_swap(__float_as_uint(ps), __float_as_uint(ps), false, false);
      ps = __uint_as_float(rr[0]) + __uint_as_float(rr[1]); }
    l_reg = l_reg * alpha + ps;
#define PK4(P, B_, OUT) do { unsigned a0 = cvtpk(P[B_+0], P[B_+1]), a1 = cvtpk(P[B_+2], P[B_+3]);                          \
        unsigned b0 = cvtpk(P[B_+4], P[B_+5]), b1 = cvtpk(P[B_+6], P[B_+7]);                                             \
        auto r0 = __builtin_amdgcn_permlane32_swap(a0, b0, false, false); auto r1 = __builtin_amdgcn_permlane32_swap(a1, b1, false, false); \
        u32x4 w = {r0[0], r1[0], r0[1], r1[1]}; OUT = *reinterpret_cast<bf16x8*>(&w); } while (0)
    PK4(p0, 0, pa0); PK4(p0, 8, pa1); PK4(p1, 0, pa2); PK4(p1, 8, pa3);
#undef PK4
}
template <int KB>
__device__ __forceinline__ void qkt(f32x16& p0, f32x16& p1, const char* K_lds, int r32, int hi, const bf16x8* qr) {
    p0 = f32x16{}; p1 = f32x16{};
    const char* kb[4];
#pragma unroll
    for (int dd = 0; dd < 4; ++dd) kb[dd] = K_lds + KB * SHM_K + KSWZ(r32, (dd * 16 + hi * 8) * 2);
#pragma unroll
    for (int d0 = 0; d0 < 8; ++d0) { const char* a = kb[d0 & 3] + (d0 >> 2) * 128;
        bf16x8 b0 = *reinterpret_cast<const bf16x8*>(a);
        bf16x8 b1 = *reinterpret_cast<const bf16x8*>(a + 32 * 256);
        p0 = __builtin_amdgcn_mfma_f32_32x32x16_bf16(b0, qr[d0], p0, 0, 0, 0);
        p1 = __builtin_amdgcn_mfma_f32_32x32x16_bf16(b1, qr[d0], p1, 0, 0, 0); }
}
template <int VB>
__device__ __forceinline__ void pv_tile(f32x16* o, int vb0, bf16x8 pa0, bf16x8 pa1, bf16x8 pa2, bf16x8 pa3) {
#define TRRD(dst, off) asm volatile("ds_read_b64_tr_b16 %0, %1 offset:%2" : "=&v"(dst) : "v"(vb0), "i"(off) : "memory")
#define PV_D0(d0) do { s16x4 l0, l1, l2, l3, h0, h1, h2, h3; constexpr int b_ = VB * SHM_V + v_rd_off(d0, 0, 0);   \
        TRRD(l0, b_); TRRD(h0, b_ + 2048); TRRD(l1, b_ + 4096); TRRD(h1, b_ + 6144); TRRD(l2, b_ + 8192); TRRD(h2, b_ + 10240); TRRD(l3, b_ + 12288); TRRD(h3, b_ + 14336); \
        asm volatile("s_waitcnt lgkmcnt(0)" ::: "memory"); SBAR();   \
        o[d0] = __builtin_amdgcn_mfma_f32_32x32x16_bf16(pa0, (bf16x8){l0[0], l0[1], l0[2], l0[3], h0[0], h0[1], h0[2], h0[3]}, o[d0], 0, 0, 0);   \
        o[d0] = __builtin_amdgcn_mfma_f32_32x32x16_bf16(pa1, (bf16x8){l1[0], l1[1], l1[2], l1[3], h1[0], h1[1], h1[2], h1[3]}, o[d0], 0, 0, 0);   \
        o[d0] = __builtin_amdgcn_mfma_f32_32x32x16_bf16(pa2, (bf16x8){l2[0], l2[1], l2[2], l2[3], h2[0], h2[1], h2[2], h2[3]}, o[d0], 0, 0, 0);   \
        o[d0] = __builtin_amdgcn_mfma_f32_32x32x16_bf16(pa3, (bf16x8){l3[0], l3[1], l3[2], l3[3], h3[0], h3[1], h3[2], h3[3]}, o[d0], 0, 0, 0); } while (0)
    PV_D0(0); PV_D0(1); PV_D0(2); PV_D0(3);
#undef PV_D0
#undef TRRD
}

struct BlockRef { const bf16* Q; const bf16* K; const bf16* V; bf16* O; const float* KM; int iblk; };
struct Seam { bf16x8 qr[8]; bf16x8 st_v0, st_v1, st_k0, st_k1; };
#define ROW(p, k0, rr) ((p) + (size_t)((k0) + (rr)) * LDR + sc)
#define VMW() asm volatile("s_waitcnt vmcnt(0)" ::: "memory")
#define VMWN(n) asm volatile("s_waitcnt vmcnt(%0)" :: "i"(n) : "memory")
#define SLOAD_H(Kp, Vp, k0) do { const bf16* k_ = (Kp) + (size_t)(k0) * LDR; const bf16* v_ = (Vp) + (size_t)(k0) * LDR;                     \
                         S.st_v0 = load8(v_ + (size_t)soff); S.st_v1 = load8(v_ + (size_t)32 * LDR + (size_t)soff);                       \
                         S.st_k0 = load8(k_ + (size_t)soff); S.st_k1 = load8(k_ + (size_t)32 * LDR + (size_t)soff); } while (0)
#define SWRITE_HK(bf) do { *(bf16x8*)(K_lds + (bf) * SHM_K + kws) = S.st_k0; *(bf16x8*)(K_lds + (bf) * SHM_K + kws + 32 * 256) = S.st_k1; } while (0)
#define SWRITE_HV(bf) do { *(bf16x8*)(V_lds + (bf) * SHM_V + vst0) = S.st_v0; *(bf16x8*)(V_lds + (bf) * SHM_V + vst1) = S.st_v1; } while (0)
#define SWRITE_H(bf) do { SWRITE_HV(bf); SWRITE_HK(bf); } while (0)
__device__ __forceinline__ void moba_prime(const BlockRef& cur, char* lds, Seam& S, int tid) {
    const int wid = __builtin_amdgcn_readfirstlane(tid >> 6), lane = tid & 63, r32 = lane & 31, hi = lane >> 5;
    const int sr = tid >> 4, sc = (tid & 15) * 8, kws = KSWZ(sr, sc * 2); char* K_lds = lds + 2 * SHM_V;
    const unsigned soff = (unsigned)(sr * LDR + sc), qoff = (unsigned)(r32 * LDR + hi * 8);
    { const bf16* qb = cur.Q + (size_t)(wid * QBLK) * LDR;
#pragma unroll
      for (int d0 = 0; d0 < 8; ++d0) S.qr[d0] = load8(qb + (size_t)qoff + d0 * 16); }
    SLOAD_H(cur.K, cur.V, 0); VMW(); SWRITE_HK(0);
    __syncthreads();
}
__device__ __forceinline__ void moba_block(const BlockRef& cur, const BlockRef& nxt, char* lds, Seam& S, int tid) {
    const int wid = __builtin_amdgcn_readfirstlane(tid >> 6), lane = tid & 63, r32 = lane & 31, hi = lane >> 5;
    const int iblk = cur.iblk, NT = 4 * (iblk + 1), P0 = iblk * QB;
    const int qlo = P0 + wid * QBLK, qm = qlo + r32 - 4 * hi;
    unsigned sel = 0u; float* KMs = (float*)(lds + OFF_KM);
    if (iblk > 0) {
        int t4 = tid; asm volatile("" : "+v"(t4));
        *(f32x4*)(KMs + t4 * 4) = *(const f32x4*)(cur.KM + t4 * 4);
        __syncthreads();
        float v1 = -__builtin_inff(), v2 = v1, v3 = v1; int i1 = -1, i2 = -1, i3 = -1;
        for (int j = 0; j < iblk; ++j) {
            const float* km = KMs + j * 128 + 8 * hi; float a = 0.f;
#pragma unroll
            for (int d0 = 0; d0 < 8; ++d0) { const f32x4 k0 = *(const f32x4*)(km + 16 * d0), k1 = *(const f32x4*)(km + 16 * d0 + 4); const bf16x8 q = S.qr[d0];
#pragma unroll
                for (int e = 0; e < 4; ++e) { a = fmaf(__uint_as_float((unsigned)(unsigned short)q[e] << 16), k0[e], a); a = fmaf(__uint_as_float((unsigned)(unsigned short)q[e + 4] << 16), k1[e], a); } }
            a += __shfl_xor(a, 32);
            if (a > v1) { v3 = v2; i3 = i2; v2 = v1; i2 = i1; v1 = a; i1 = j; }
            else if (a > v2) { v3 = v2; i3 = i2; v2 = a; i2 = j; }
            else if (a > v3) { v3 = a; i3 = j; }
        }
        sel = (i1 >= 0 ? 1u << i1 : 0u) | (i2 >= 0 ? 1u << i2 : 0u) | (i3 >= 0 ? 1u << i3 : 0u);
    }
    char* V_lds = lds; char* K_lds = lds + 2 * SHM_V;
    float* ws = (float*)(lds + OFF_WS) + wid * 64; float* li_l = ws, * al_l = ws + 32;
    float m_reg = -1e30f, l_reg = 0; f32x16 o[4] = {};
    const int sr = tid >> 4, sc = (tid & 15) * 8, vst0 = v_st(sr, sc), vst1 = v_st(32 + sr, sc), kws = KSWZ(sr, sc * 2);
    const unsigned soff = (unsigned)(sr * LDR + sc), qoff = (unsigned)(r32 * LDR + hi * 8);
    const int vb0 = (int)(uintptr_t)V_lds + v_rd_base(lane);
    const bf16* Kh = cur.K; const bf16* Vh = cur.V;
#define RESC(a) do { if (__any((a) < 1.f)) { if (hi == 0) al_l[r32] = (a); asm volatile("s_waitcnt lgkmcnt(0)" ::: "memory");              \
                     for (int d_ = 0; d_ < 4; ++d_) for (int r = 0; r < 16; ++r) o[d_][r] *= al_l[crow(r, hi)]; } } while (0)
#define KBASE(t) ((t) * KVBLK)
#define MASKT(P0_, P1_, t) do { const int kb_ = KBASE(t); const int bj_ = (t) >> 2; \
        if (bj_ == iblk) { if (kb_ + KVBLK - 1 > qlo) mask_causal(P0_, P1_, qm - kb_); } else mask_all(P0_, P1_, ((sel >> bj_) & 1u) != 0u); } while (0)
    constexpr int NQL = 8;
#define SEAM_K0() do { VMWN(NQL); SWRITE_HK(0); SBAR(); } while (0)
    f32x16 pA0, pA1, pB0, pB1; float mnA, mnB, alA, alB; bf16x8 pa0, pa1, pa2, pa3;
    SWRITE_HV(0); SBAR();
    if (NT > 1) SLOAD_H(Kh, Vh, KBASE(1));
    SBAR(); qkt<0>(pA0, pA1, K_lds, r32, hi, S.qr);
    MASKT(pA0, pA1, 0); partialSM(pA0, pA1, m_reg, mnA, alA);
    if (NT > 1) { VMW(); SWRITE_H(1); }
    __syncthreads();
#define HALF_STEP(PX0, PX1, mnX, alX, PY0, PY1, alY, t, KB, VB, SB) do {                                                      \
        SBAR(); qkt<KB>(PX0, PX1, K_lds, r32, hi, S.qr);                                                                      \
        finishSM(PY0, PY1, alY, l_reg, pa0, pa1, pa2, pa3); SBAR();                                                           \
        if ((t) + 1 < NT) { SLOAD_H(Kh, Vh, KBASE((t) + 1)); SBAR(); }                                                        \
        pv_tile<VB>(o, vb0, pa0, pa1, pa2, pa3); MASKT(PX0, PX1, (t)); partialSM(PX0, PX1, m_reg, mnX, alX);                  \
        __syncthreads();                                                                                                      \
        if ((t) + 1 < NT) { VMW(); SWRITE_H(SB); }                                                                            \
        RESC(alX); __syncthreads(); } while (0)
    for (int t = 1; t + 1 < NT; t += 2) {
        HALF_STEP(pB0, pB1, mnB, alB, pA0, pA1, alA, t, 1, 0, 0);
        HALF_STEP(pA0, pA1, mnA, alA, pB0, pB1, alB, t + 1, 0, 1, 1);
    }
    SBAR(); qkt<1>(pB0, pB1, K_lds, r32, hi, S.qr); SBAR();
    SLOAD_H(nxt.K, nxt.V, 0); SBAR();
    { const bf16* qb = nxt.Q + (size_t)(wid * QBLK) * LDR;
#pragma unroll
      for (int d0 = 0; d0 < 8; ++d0) S.qr[d0] = load8(qb + (size_t)qoff + d0 * 16); }
    SBAR();
    finishSM(pA0, pA1, alA, l_reg, pa0, pa1, pa2, pa3); SBAR();
    pv_tile<0>(o, vb0, pa0, pa1, pa2, pa3);
    MASKT(pB0, pB1, NT - 1); partialSM(pB0, pB1, m_reg, mnB, alB); __syncthreads(); RESC(alB);
    finishSM(pB0, pB1, alB, l_reg, pa0, pa1, pa2, pa3); SBAR(); pv_tile<1>(o, vb0, pa0, pa1, pa2, pa3);
    SBAR(); SEAM_K0();
    if (hi == 0) li_l[r32] = l_reg; asm volatile("s_waitcnt lgkmcnt(0)" ::: "memory");
    float rli[16];
#pragma unroll
    for (int r = 0; r < 16; ++r) rli[r] = __builtin_amdgcn_rcpf(li_l[crow(r, hi)]);
    bf16* Ow = cur.O + (size_t)(wid * QBLK) * LDR;
    int hi_e = hi; asm volatile("" : "+v"(hi_e));
    const unsigned ooff = (unsigned)(4 * hi_e * LDR + r32);
#pragma unroll
    for (int r = 0; r < 16; ++r) { bf16* orow = Ow + (size_t)((r & 3) + 8 * (r >> 2)) * LDR;
#pragma unroll
        for (int d0 = 0; d0 < 4; ++d0) { const float v = o[d0][r] * rli[r];
            const float vn = __shfl_xor(v, 1);
            if ((r32 & 1) == 0) *(unsigned*)(orow + (size_t)ooff + d0 * 32) = cvtpk(v, vn); } }
    __syncthreads();
#undef RESC
#undef KBASE
#undef MASKT
#undef SEAM_K0
#undef HALF_STEP
}
#undef ROW
#undef VMW
#undef VMWN
#undef SLOAD_H
#undef SWRITE_HK
#undef SWRITE_HV
#undef SWRITE_H
#undef KSWZ
#undef SBAR

__device__ __forceinline__ void item_decode(int L, int G, int k, int bx, int& bh, int& x) {
    if (G == 256) { const int xcd = bx & 7, q = bx >> 3; bh = ((k * 8 + xcd) << 2) + (q >> 3); x = q & 7; }
    else { bh = L >> 3; x = L & 7; }
}
__device__ __forceinline__ BlockRef make_ref(bf16* qkv, const float* kmean, int bh, int iblk) {
    const int b = bh >> 3, h = bh & 7; BlockRef r; bf16* base = qkv + (size_t)b * SEQ * LDR + h * 128;
    r.Q = base + (size_t)iblk * QB * LDR; r.O = base + (size_t)iblk * QB * LDR; r.K = base + 1024; r.V = base + 2048; r.KM = kmean + (size_t)bh * 16 * 128; r.iblk = iblk; return r;
}
__device__ __forceinline__ void attn_phase(bf16* qkv, const float* kmean, char* lds, int tid) {
    const int G = gridDim.x, bx = blockIdx.x, total = BATCH * NH * 8;
    int L = bx, k = 0; if (L >= total) return;
    int bh, x; item_decode(L, G, k, bx, bh, x); int pass = 0;
    BlockRef cur = make_ref(qkv, kmean, bh, x);
    Seam S;
    moba_prime(cur, lds, S, tid);
    for (;;) {
        const bool more_pass = pass == 0, more_item = L + G < total, last = !more_pass && !more_item;
        int bhn = bh, xn = x, passn = pass + 1, Ln = L, kn = k;
        if (!more_pass) { passn = 0; if (more_item) { Ln = L + G; kn = k + 1; } item_decode(Ln, G, kn, bx, bhn, xn); }
        const BlockRef nxt = last ? cur : make_ref(qkv, kmean, bhn, passn ? 15 - xn : xn);
        moba_block(cur, nxt, lds, S, tid);
        if (last) break;
        cur = nxt; bh = bhn; x = xn; pass = passn; L = Ln; k = kn;
    }
}
}
namespace hg {
typedef short bf16x8 __attribute__((ext_vector_type(8)));
typedef short s16x4 __attribute__((ext_vector_type(4)));
typedef float f32x16 __attribute__((ext_vector_type(16)));
constexpr int LDB = 4096, CH = 64, NCH_SEG = 16, NSEG = 4;
constexpr int RS = 272, TS = 144, OST_RS = 528;
constexpr int OFF_QR = 0, OFF_KR = 17408, OFF_QI = 34816, OFF_KT = 52224, OFF_VT = 70656, OFF_DEC = 89088, OFF_OST = 89600, HG_LDS_BYTES = OFF_OST + 64 * OST_RS;
static_assert(HG_LDS_BYTES <= 131072, "HGRN LDS map");
__device__ __forceinline__ unsigned pk(float lo, float hi) { unsigned r; asm volatile("v_cvt_pk_bf16_f32 %0, %1, %2" : "=v"(r) : "v"(lo), "v"(hi)); return r; }
__device__ __forceinline__ bf16x8 join8(s16x4 a, s16x4 b) { return (bf16x8){a[0], a[1], a[2], a[3], b[0], b[1], b[2], b[3]}; }
__device__ __forceinline__ bf16x8 acc_frag(const f32x16& x, int s) {
    u32x4 w; w.x = pk(x[8 * s + 0], x[8 * s + 1]); w.y = pk(x[8 * s + 2], x[8 * s + 3]); w.z = pk(x[8 * s + 4], x[8 * s + 5]); w.w = pk(x[8 * s + 6], x[8 * s + 7]);
    return __builtin_bit_cast(bf16x8, w);
}
template <bool FULL>
__device__ __forceinline__ float prep_chunk(const bf16* __restrict__ base, float lb, LAS unsigned char* lds, int lane, int wave) {
    const int c = (lane & 15) + 16 * wave, qq = lane >> 4;
    const bf16* p = base + (size_t)(16 * qq) * LDB + c;
    float z[16], vv[16], qv[16];
#pragma unroll
    for (int i = 0; i < 16; ++i) { z[i] = bf2f(p[(size_t)i * LDB + 1024]); vv[i] = bf2f(p[(size_t)i * LDB + 2048]); if (FULL) qv[i] = bf2f(p[(size_t)i * LDB]) * QSCALE; }
    float G[16], kk[16]; float run = 0.f; const float omlb = 1.0f - lb;
#pragma unroll
    for (int i = 0; i < 16; ++i) { const float e = __expf(-z[i]); const float sg = __builtin_amdgcn_rcpf(1.0f + e); kk[i] = omlb * (e * sg); run += __logf(lb + omlb * sg); G[i] = run; }
    const float T0 = __shfl(run, lane & 15), T1 = __shfl(run, 16 + (lane & 15)), T2 = __shfl(run, 32 + (lane & 15)), T3 = __shfl(run, 48 + (lane & 15));
    const float gmid = T0 + T1, glast = gmid + (T2 + T3);
    const float off = qq == 0 ? 0.f : qq == 1 ? T0 : qq == 2 ? gmid : gmid + T2;
    const float Egm = __expf(gmid), Elm = __expf(glast - gmid);
    u32x4 kt0, kt1, vt0, vt1; unsigned ktw[8], vtw[8];
#pragma unroll
    for (int i = 0; i < 16; i += 2) {
        float ks[2];
#pragma unroll
        for (int e = 0; e < 2; ++e) { const int t = 16 * qq + i + e; const float E1 = __expf(G[i + e] + off - gmid), R1 = __builtin_amdgcn_rcpf(E1);
            ks[e] = kk[i + e] * R1 * Elm;
            if (FULL) { const float qe = qv[i + e] * E1;
                *(LAS bf16*)(lds + OFF_QR + t * RS + 2 * c) = (bf16)(pk(qe, 0.f) & 0xffffu);
                *(LAS bf16*)(lds + OFF_KR + t * RS + 2 * c) = (bf16)(pk(kk[i + e] * R1, 0.f) & 0xffffu);
                *(LAS bf16*)(lds + OFF_QI + t * RS + 2 * c) = (bf16)(pk(qe * Egm, 0.f) & 0xffffu); } }
        ktw[i >> 1] = pk(ks[0], ks[1]); vtw[i >> 1] = pk(vv[i], vv[i + 1]); }
    kt0 = (u32x4){ktw[0], ktw[1], ktw[2], ktw[3]}; kt1 = (u32x4){ktw[4], ktw[5], ktw[6], ktw[7]};
    vt0 = (u32x4){vtw[0], vtw[1], vtw[2], vtw[3]}; vt1 = (u32x4){vtw[4], vtw[5], vtw[6], vtw[7]};
    *(LAS u32x4*)(lds + OFF_KT + c * TS + 32 * qq) = kt0; *(LAS u32x4*)(lds + OFF_KT + c * TS + 32 * qq + 16) = kt1;
    *(LAS u32x4*)(lds + OFF_VT + c * TS + 32 * qq) = vt0; *(LAS u32x4*)(lds + OFF_VT + c * TS + 32 * qq + 16) = vt1;
    if (qq == 0) *(LAS float*)(lds + OFF_DEC + 4 * c) = __expf(glast);
    return glast;
}
__device__ __forceinline__ void state_update(f32x16 (&S)[4], LAS unsigned char* lds, int j, int c, int h) {
#pragma unroll
    for (int i = 0; i < 4; ++i) {
#pragma unroll
        for (int g4 = 0; g4 < 4; ++g4) { const f32x4 dc = *(const LAS f32x4*)(lds + OFF_DEC + 4 * (32 * i + 8 * g4 + 4 * h));
#pragma unroll
            for (int e = 0; e < 4; ++e) S[i][4 * g4 + e] *= dc[e]; }
#pragma unroll
        for (int ks = 0; ks < 4; ++ks) {
            const bf16x8 a = *(const LAS bf16x8*)(lds + OFF_KT + (32 * i + c) * TS + (16 * ks + 8 * h) * 2);
            const bf16x8 b = *(const LAS bf16x8*)(lds + OFF_VT + (32 * j + c) * TS + (16 * ks + 8 * h) * 2);
            S[i] = __builtin_amdgcn_mfma_f32_32x32x16_bf16(a, b, S[i], 0, 0, 0); }
    }
}
__device__ __forceinline__ int crow(int r, int h) { return (r & 3) + 8 * (r >> 2) + 4 * h; }

__device__ __forceinline__ void pass_a(const bf16* __restrict__ big, const float* __restrict__ lbv, float* __restrict__ Eg, float* __restrict__ Dg, LAS unsigned char* lds, int lane, int wave) {
    const int j = wave & 3, th = wave >> 2, c = lane & 31, h = lane >> 5;
    for (int u = blockIdx.x; u < BATCH * NH * NSEG; u += gridDim.x) {
        const int seg = u & 3, hh = (u >> 2) & 7, b = u >> 5;
        if (seg == NSEG - 1) continue;
        const float lb = lbv[hh * 128 + (lane & 15) + 16 * wave];
        f32x16 S[4];
#pragma unroll
        for (int i = 0; i < 4; ++i) S[i] = f32x16{};
        float dsum = 0.f;
        for (int ch = 0; ch < NCH_SEG; ++ch) {
            const bf16* base = big + (size_t)(b * SEQ + (seg * NCH_SEG + ch) * CH) * LDB + hh * 128;
            dsum += prep_chunk<false>(base, lb, lds, lane, wave);
            __syncthreads();
            state_update(S, lds, j, c, h);
            __syncthreads();
        }
        if ((lane >> 4) == 0) Dg[(size_t)u * 128 + (lane & 15) + 16 * wave] = dsum;
        if (th == 0) {
            float* E = Eg + (size_t)u * 16384;
#pragma unroll
            for (int i = 0; i < 4; ++i)
#pragma unroll
                for (int r = 0; r < 16; ++r) E[(size_t)(32 * i + crow(r, h)) * 128 + 32 * j + c] = S[i][r];
        }
    }
}
__device__ __forceinline__ void pass_b(bf16* __restrict__ big, const float* __restrict__ lbv, const float* __restrict__ og, const float* __restrict__ Eg, const float* __restrict__ Dg, LAS unsigned char* lds, int lane, int wave) {
    const int j = wave & 3, th = wave >> 2, c = lane & 31, h = lane >> 5, tid = wave * 64 + lane;
    for (int u = blockIdx.x; u < BATCH * NH * NSEG; u += gridDim.x) {
        const int seg = u & 3, hh = (u >> 2) & 7, b = u >> 5;
        const float lb = lbv[hh * 128 + (lane & 15) + 16 * wave];
        f32x16 S[4];
#pragma unroll
        for (int i = 0; i < 4; ++i) S[i] = f32x16{};
        for (int sp = 0; sp < seg; ++sp) {
            const float* E = Eg + (size_t)(u - seg + sp) * 16384; const float* Dp = Dg + (size_t)(u - seg + sp) * 128;
#pragma unroll
            for (int i = 0; i < 4; ++i)
#pragma unroll
                for (int r = 0; r < 16; ++r) { const int d = 32 * i + crow(r, h); S[i][r] = __expf(Dp[d]) * S[i][r] + E[(size_t)d * 128 + 32 * j + c]; }
        }
        for (int ch = 0; ch < NCH_SEG; ++ch) {
            const size_t row0 = (size_t)b * SEQ + (size_t)(seg * NCH_SEG + ch) * CH;
            (void)prep_chunk<true>(big + row0 * LDB + hh * 128, lb, lds, lane, wave);
            __syncthreads();
            bf16x8 P[2][2];
#pragma unroll
            for (int sh = 0; sh < 2; ++sh) {
                if (sh <= th) {
                    f32x16 X = f32x16{};
#pragma unroll
                    for (int ks = 0; ks < 8; ++ks) {
                        const bf16x8 a = *(const LAS bf16x8*)(lds + OFF_KR + (32 * sh + c) * RS + (16 * ks + 8 * h) * 2);
                        const bf16x8 bq = *(const LAS bf16x8*)(lds + OFF_QR + (32 * th + c) * RS + (16 * ks + 8 * h) * 2);
                        X = __builtin_amdgcn_mfma_f32_32x32x16_bf16(a, bq, X, 0, 0, 0); }
                    if (sh == th) {
#pragma unroll
                        for (int r = 0; r < 16; ++r) X[r] = crow(r, h) <= c ? X[r] : 0.f; }
                    P[sh][0] = acc_frag(X, 0); P[sh][1] = acc_frag(X, 1);
                } else { P[sh][0] = bf16x8{}; P[sh][1] = bf16x8{}; }
            }
            f32x16 o = f32x16{};
#pragma unroll
            for (int i = 0; i < 4; ++i)
#pragma unroll
                for (int s = 0; s < 2; ++s) {
                    const LAS unsigned char* qa = lds + OFF_QI + (32 * th + c) * RS + (32 * i + 16 * s + 4 * h) * 2;
                    const bf16x8 a = join8(*(const LAS s16x4*)qa, *(const LAS s16x4*)(qa + 16));
                    o = __builtin_amdgcn_mfma_f32_32x32x16_bf16(a, acc_frag(S[i], s), o, 0, 0, 0); }
#pragma unroll
            for (int sh = 0; sh < 2; ++sh) {
                if (sh <= th) {
#pragma unroll
                    for (int s = 0; s < 2; ++s) {
                        const LAS unsigned char* va = lds + OFF_VT + (32 * j + c) * TS + (32 * sh + 16 * s + 4 * h) * 2;
                        const bf16x8 bv = join8(*(const LAS s16x4*)va, *(const LAS s16x4*)(va + 16));
                        o = __builtin_amdgcn_mfma_f32_32x32x16_bf16(P[sh][s], bv, o, 0, 0, 0); } }
            }
            state_update(S, lds, j, c, h);
#pragma unroll
            for (int r = 0; r < 16; ++r) *(LAS float*)(lds + OFF_OST + (32 * th + crow(r, h)) * OST_RS + (32 * j + c) * 4) = o[r];
            __syncthreads();
            {
                const int t = tid >> 3, part = tid & 7;
                const LAS f32x4* op = (const LAS f32x4*)(lds + OFF_OST + t * OST_RS + part * 64);
                const f32x4 o0 = op[0], o1 = op[1], o2 = op[2], o3 = op[3];
                float ss = (o0[0] * o0[0] + o0[1] * o0[1]) + (o0[2] * o0[2] + o0[3] * o0[3]) + (o1[0] * o1[0] + o1[1] * o1[1]) + (o1[2] * o1[2] + o1[3] * o1[3])
                         + (o2[0] * o2[0] + o2[1] * o2[1]) + (o2[2] * o2[2] + o2[3] * o2[3]) + (o3[0] * o3[0] + o3[1] * o3[1]) + (o3[2] * o3[2] + o3[3] * o3[3]);
                ss += __shfl_xor(ss, 1); ss += __shfl_xor(ss, 2); ss += __shfl_xor(ss, 4);
                const float rstd = __builtin_amdgcn_rsqf(ss * (1.0f / 128.0f) + 1e-6f);
                bf16* gp = big + (row0 + t) * LDB + 3072 + hh * 128 + part * 16;
                const u32x4 g0 = *(const u32x4*)gp, g1 = *(const u32x4*)(gp + 8);
                const f32x4 w0 = *(const f32x4*)(og + part * 16), w1 = *(const f32x4*)(og + part * 16 + 4), w2 = *(const f32x4*)(og + part * 16 + 8), w3 = *(const f32x4*)(og + part * 16 + 12);
                const unsigned gw[8] = {g0.x, g0.y, g0.z, g0.w, g1.x, g1.y, g1.z, g1.w};
                const float ov[16] = {o0[0], o0[1], o0[2], o0[3], o1[0], o1[1], o1[2], o1[3], o2[0], o2[1], o2[2], o2[3], o3[0], o3[1], o3[2], o3[3]};
                const float wv[16] = {w0[0], w0[1], w0[2], w0[3], w1[0], w1[1], w1[2], w1[3], w2[0], w2[1], w2[2], w2[3], w3[0], w3[1], w3[2], w3[3]};
                unsigned ow[8];
#pragma unroll
                for (int e = 0; e < 8; ++e) { const float ga = __uint_as_float(gw[e] << 16), gb = __uint_as_float(gw[e] & 0xffff0000u);
                    const float ya = ov[2 * e] * rstd * wv[2 * e] * (ga * __builtin_amdgcn_rcpf(1.0f + __expf(-ga)));
                    const float yb = ov[2 * e + 1] * rstd * wv[2 * e + 1] * (gb * __builtin_amdgcn_rcpf(1.0f + __expf(-gb)));
                    ow[e] = pk(ya, yb); }
                *(u32x4*)gp = (u32x4){ow[0], ow[1], ow[2], ow[3]}; *(u32x4*)(gp + 8) = (u32x4){ow[4], ow[5], ow[6], ow[7]};
            }
        }
        __syncthreads();
    }
}
}
#define GAS __attribute__((address_space(1)))
constexpr int NWAVES = 8;
constexpr int RING_OFF = 0, RING_BYTES = 131072;
constexpr int XCH_OFF = 131072;
constexpr int MISC_OFF = 135168;
constexpr int LDS_BYTES = 147456;
constexpr int CW_BAR = 4096;
constexpr int N_PHASES = 25;
static_assert(pg8::STAGE_BYTES == RING_BYTES && XCH_OFF == RING_BYTES, "LDS map");

struct Params { const float* in[15]; float* out; unsigned char* ws; int ph_lo, ph_hi, bar_region, pad; };

#define LDS_WAIT() asm volatile("s_waitcnt lgkmcnt(0)" ::: "memory")
#define VM_WAIT() asm volatile("s_waitcnt vmcnt(0)" ::: "memory")

__device__ __forceinline__ void p0_conv_item(const float* __restrict__ W, const float* __restrict__ gain, int K, int N, bf16* __restrict__ WT, int upperm, LAS float* scr, int item, int lane) {
    const int nblk = N / 32, kb = item / nblk, nb = item % nblk, k0 = 64 * kb, n0 = 32 * nb;
    int src0 = n0;
    if (upperm) { const int pn = n0 >> 8, r = n0 & 255, bj = r >> 7, c = r & 127; src0 = bj * 3072 + 128 * pn + c; }
#pragma unroll 8
    for (int i = 0; i < 32; ++i) { const int kk = 2 * i + (lane >> 5); scr[kk * 33 + (lane & 31)] = W[(size_t)(k0 + kk) * N + src0 + (lane & 31)] * (gain ? gain[k0 + kk] : 1.0f); }
    LDS_WAIT(); asm volatile("" ::: "memory");
    const int c = lane & 7;
#pragma unroll
    for (int j = 0; j < 4; ++j) { const int n = (lane >> 3) + 8 * j; const LAS float* s = scr + (8 * c) * 33 + n;
        u32x4 o; o.x = f2bf(s[0 * 33]) | ((unsigned)f2bf(s[1 * 33]) << 16); o.y = f2bf(s[2 * 33]) | ((unsigned)f2bf(s[3 * 33]) << 16);
        o.z = f2bf(s[4 * 33]) | ((unsigned)f2bf(s[5 * 33]) << 16); o.w = f2bf(s[6 * 33]) | ((unsigned)f2bf(s[7 * 33]) << 16);
        *(u32x4*)(WT + (size_t)(n0 + n) * K + k0 + 8 * c) = o; }
    LDS_WAIT(); asm volatile("" ::: "memory");
}
__device__ __forceinline__ void p0_prologue(const Params& p, LAS unsigned char* lds, int gw, int NGW, int lane, int wave) {
    unsigned char* ws = p.ws;
    LAS float* scr = (LAS float*)(lds + RING_OFF + wave * 16384);
    const float* attn_norm = p.in[1]; const float* ffn_norm = p.in[2];
    constexpr int I_IN = 16 * 128, I_QKV = 16 * 96, I_O = 16 * 32, I_UP = 16 * 192, I_DN = 48 * 32;
    constexpr int NITEMS = 2 * I_IN + 2 * I_QKV + 4 * I_O + 4 * I_UP + 4 * I_DN;
    for (int it = gw; it < NITEMS; it += NGW) {
        int r = it;
        if (r < 2 * I_IN) { const int s = r / I_IN; p0_conv_item(p.in[3] + (size_t)s * 1024 * 4096, attn_norm + (2 * s) * 1024, 1024, 4096, (bf16*)(ws + WS_WIN) + (size_t)s * 4096 * 1024, 0, scr, r % I_IN, lane); continue; } r -= 2 * I_IN;
        if (r < 2 * I_QKV) { const int s = r / I_QKV; p0_conv_item(p.in[7] + (size_t)s * 1024 * 3072, attn_norm + (2 * s + 1) * 1024, 1024, 3072, (bf16*)(ws + WS_WQKV) + (size_t)s * 3072 * 1024, 0, scr, r % I_QKV, lane); continue; } r -= 2 * I_QKV;
        if (r < 2 * I_O) { const int s = r / I_O; p0_conv_item(p.in[6] + (size_t)s * 1024 * 1024, nullptr, 1024, 1024, (bf16*)(ws + WS_WOH) + (size_t)s * 1024 * 1024, 0, scr, r % I_O, lane); continue; } r -= 2 * I_O;
        if (r < 2 * I_O) { const int s = r / I_O; p0_conv_item(p.in[10] + (size_t)s * 1024 * 1024, nullptr, 1024, 1024, (bf16*)(ws + WS_WOM) + (size_t)s * 1024 * 1024, 0, scr, r % I_O, lane); continue; } r -= 2 * I_O;
        if (r < 4 * I_UP) { const int l = r / I_UP; p0_conv_item(p.in[11] + (size_t)l * 1024 * 6144, ffn_norm + l * 1024, 1024, 6144, (bf16*)(ws + WS_WUP) + (size_t)l * 6144 * 1024, 1, scr, r % I_UP, lane); continue; } r -= 4 * I_UP;
        { const int l = r / I_DN; p0_conv_item(p.in[14] + (size_t)l * 3072 * 1024, nullptr, 3072, 1024, (bf16*)(ws + WS_WDN) + (size_t)l * 1024 * 3072, 0, scr, r % I_DN, lane); }
    }
    const float* x = p.in[0]; bf16* xb = (bf16*)(ws + WS_XB); float* ss = (float*)(ws + WS_SS);
    for (int row = gw; row < MROWS; row += NGW) {
        const f32x4* xr = (const f32x4*)(x + (size_t)row * DM); float s = 0.f;
#pragma unroll
        for (int j = 0; j < 4; ++j) { const f32x4 v = xr[lane + 64 * j]; s += (v[0] * v[0] + v[1] * v[1]) + (v[2] * v[2] + v[3] * v[3]);
            unsigned long long w = (unsigned long long)(f2bf(v[0]) | ((unsigned)f2bf(v[1]) << 16)) | ((unsigned long long)(f2bf(v[2]) | ((unsigned)f2bf(v[3]) << 16)) << 32);
            *(unsigned long long*)(xb + (size_t)row * DM + 4 * (lane + 64 * j)) = w; }
        s = wave_sum(s);
        if (lane < 16) ss[(size_t)row * 16 + lane] = lane == 0 ? s : 0.f;
    }
    float* cs = (float*)(ws + WS_COS); float* sn = (float*)(ws + WS_SIN); float* lbv = (float*)(ws + WS_LBV); const float* hgrn_lb = p.in[4];
    for (int idx = gw * 64 + lane; idx < SEQ * 64; idx += NGW * 64) { const int s = idx >> 6, i = idx & 63; const float inv = 1.0f / powf(10000.0f, (float)(2 * i) / 128.0f); const float ang = (float)s * inv; cs[idx] = cosf(ang); sn[idx] = sinf(ang); }
    for (int idx = gw * 64 + lane; idx < 1024; idx += NGW * 64) { const float l0 = hgrn_lb[idx], l1 = hgrn_lb[1024 + idx]; const float mx = fmaxf(l0, l1), e0 = expf(l0 - mx), e1 = expf(l1 - mx); lbv[idx] = 0.f; lbv[1024 + idx] = e1 / (e0 + e1); }
}

__device__ __forceinline__ void kprep_phase(bf16* __restrict__ qkv, const float* __restrict__ qg, const float* __restrict__ kg, const float* __restrict__ cs, const float* __restrict__ sn, float* __restrict__ kmean,
                                            LAS unsigned char* lds, int lane, int wave) {
    const int tidk = wave * 64 + lane;
    LAS float* red = (LAS float*)(lds + RING_OFF);
    for (int u = blockIdx.x; u < 2 * BATCH * NH * NBLK; u += gridDim.x) {
        const int which = u & 1, j = (u >> 1) & 15, h = (u >> 5) & 7, b = u >> 8;
        const float* g = which ? kg : qg; const float g1 = g[lane], g2 = g[lane + 64];
        float a1 = 0.f, a2 = 0.f;
        for (int rr = 0; rr < 32; ++rr) {
            const int pos = j * MBLK + wave * 32 + rr;
            bf16* pp = qkv + (size_t)(b * SEQ + pos) * 3072 + which * 1024 + h * 128;
            const float x1 = bf2f(pp[lane]), x2 = bf2f(pp[lane + 64]);
            const float r = rsqrtf(wave_sum(x1 * x1 + x2 * x2) * (1.0f / 128.0f) + 1e-6f);
            const float y1 = x1 * r * g1, y2 = x2 * r * g2;
            const float c = cs[pos * 64 + lane], s = sn[pos * 64 + lane];
            float o1 = y1 * c - y2 * s, o2 = y2 * c + y1 * s;
            if (!which) { o1 *= QSCALE; o2 *= QSCALE; }
            a1 += o1; a2 += o2;
            pp[lane] = f2bf(o1); pp[lane + 64] = f2bf(o2);
        }
        if (which) {
            red[wave * 128 + lane] = a1; red[wave * 128 + 64 + lane] = a2;
            __syncthreads();
            if (tidk < 128) { float s = 0.f;
#pragma unroll
                for (int w = 0; w < 8; ++w) s += red[w * 128 + tidk];
                kmean[((size_t)(b * 8 + h) * 16 + j) * 128 + tidk] = s * (1.0f / 256.0f); }
            __syncthreads();
        }
    }
}

__device__ __forceinline__ void hg_naive_phase(bf16* __restrict__ big, const float* __restrict__ lbv, const float* __restrict__ og, LAS unsigned char* lds, const int tid) {
    LAS float* sq = (LAS float*)(lds + RING_OFF); LAS float* sf = sq + 128; LAS float* sk = sq + 256; LAS float* red = sq + 384;
    for (int u = blockIdx.x; u < BATCH * NH; u += gridDim.x) {
        const int b = u >> 3, h = u & 7;
        float S[128];
#pragma unroll
        for (int d = 0; d < 128; ++d) S[d] = 0.f;
        const float lb = tid < 128 ? lbv[h * 128 + tid] : 0.f, gain = tid < 128 ? og[tid] : 0.f;
        for (int t = 0; t < SEQ; ++t) {
            bf16* r = big + (size_t)(b * SEQ + t) * 4096 + h * 128 + (tid & 127);
            float q = 0.f, vv = 0.f, gg = 0.f;
            if (tid < 128) { q = bf2f(r[0]) * QSCALE; const float z = bf2f(r[1024]); vv = bf2f(r[2048]); gg = bf2f(r[3072]);
                const float sg = 1.0f / (1.0f + expf(-z)); const float f = lb + (1.0f - lb) * sg; const float k = (1.0f - lb) * (1.0f - sg);
                sq[tid] = q; sf[tid] = f; sk[tid] = k; }
            __syncthreads();
            float o = 0.f;
            if (tid < 128) {
#pragma unroll
                for (int d = 0; d < 128; ++d) { S[d] = sf[d] * S[d] + sk[d] * vv; o += sq[d] * S[d]; }
                const float w = wave_sum(o * o);
                if ((tid & 63) == 0) red[tid >> 6] = w; }
            __syncthreads();
            if (tid < 128) { const float tot = red[0] + red[1];
                const float on = o * rsqrtf(tot * (1.0f / 128.0f) + 1e-6f) * gain;
                r[3072] = f2bf(on * (gg / (1.0f + expf(-gg)))); }
        }
    }
}
__device__ __forceinline__ void attn_naive_phase(bf16* __restrict__ qkv, const float* __restrict__ kmean, LAS unsigned char* lds, int lane, int wave) {
    LAS float* sq = (LAS float*)(lds + RING_OFF) + wave * 128;
    LAS float* sp = (LAS float*)(lds + RING_OFF + 4096) + wave * 1024;
    for (long it0 = (long)blockIdx.x * 8; it0 < (long)MROWS * 8; it0 += (long)gridDim.x * 8) {
        const long item = it0 + wave; const int h = (int)(item & 7); const long row = item >> 3; const int b = (int)(row >> 12), s = (int)(row & (SEQ - 1)), i = s >> 8;
        bf16* qp = qkv + row * 3072 + h * 128;
        __syncthreads();
        sq[lane] = bf2f(qp[lane]); sq[lane + 64] = bf2f(qp[lane + 64]);
        __syncthreads();
        float gv = -INFINITY;
        if (lane < i) { const float* km = kmean + ((size_t)(b * 8 + h) * 16 + lane) * 128; float a = 0.f; for (int d = 0; d < 128; ++d) a += km[d] * sq[d]; gv = a; }
        const int nsel = i < 3 ? i : 3; int s0 = i, s1 = i, s2 = i;
#pragma unroll
        for (int n = 0; n < 3; ++n) {
            if (n < nsel) { const float m = wave_max(gv); const unsigned long long bal = __ballot(gv == m); const int idx = __ffsll((long long)bal) - 1; if (n == 0) s0 = idx; else if (n == 1) s1 = idx; else s2 = idx; if (lane == idx) gv = -INFINITY; } }
#define PICKB(bi) ((bi) == 0 ? s0 : (bi) == 1 ? s1 : (bi) == 2 ? s2 : i)
        float mx = -INFINITY;
        for (int bi = 0; bi <= nsel; ++bi) { const int kb = PICKB(bi) * MBLK;
            for (int c = 0; c < 4; ++c) { const int key = kb + c * 64 + lane;
                const bf16* kp = qkv + (size_t)(b * SEQ + key) * 3072 + 1024 + h * 128; float a = 0.f;
                for (int d8 = 0; d8 < 16; ++d8) { const u32x4 w = *(const u32x4*)(kp + d8 * 8);
                    const unsigned ww[4] = {w.x, w.y, w.z, w.w};
#pragma unroll
                    for (int e = 0; e < 4; ++e) { a += __uint_as_float(ww[e] << 16) * sq[d8 * 8 + 2 * e]; a += __uint_as_float(ww[e] & 0xffff0000u) * sq[d8 * 8 + 2 * e + 1]; } }
                if (bi == nsel && key > s) a = -INFINITY;
                sp[bi * 256 + c * 64 + lane] = a; mx = fmaxf(mx, a); } }
        mx = wave_max(mx);
        float l = 0.f;
        for (int e = lane; e < (nsel + 1) * 256; e += 64) { const float pr = __expf(sp[e] - mx); sp[e] = pr; l += pr; }
        l = wave_sum(l);
        __syncthreads();
        float o0 = 0.f, o1 = 0.f;
        for (int bi = 0; bi <= nsel; ++bi) { const bf16* vp = qkv + (size_t)(b * SEQ + PICKB(bi) * MBLK) * 3072 + 2048 + h * 128 + lane;
            for (int kk = 0; kk < 256; ++kk) { const float pr = sp[bi * 256 + kk]; o0 += pr * bf2f(vp[(size_t)kk * 3072]); o1 += pr * bf2f(vp[(size_t)kk * 3072 + 64]); } }
#undef PICKB
        const float il = 1.0f / l;
        qp[lane] = f2bf(o0 * il); qp[lane + 64] = f2bf(o1 * il);
    }
}

__global__ void __launch_bounds__(NWAVES * 64, 2) mega_fwd(Params p) {
    extern __shared__ __attribute__((aligned(16))) unsigned char lds_raw[];
    LAS unsigned char* lds = (LAS unsigned char*)lds_raw;
    const int G = gridDim.x;
    unsigned char* ws = p.ws;
    for (int u = threadIdx.x; u < (LDS_BYTES - MISC_OFF) / 4; u += NWAVES * 64) ((LAS unsigned*)(lds + MISC_OFF))[u] = 0u;
    __syncthreads();
#define PHASE_IDS() int tid = threadIdx.x; asm volatile("" : "+v"(tid)); const int lane = tid & 63, wave = __builtin_amdgcn_readfirstlane(tid >> 6); (void)lane; (void)wave
    const int lo = p.ph_lo, hi = p.ph_hi;
    XcdBarrier bar; bar.bar = (unsigned*)(ws + WS_CTL) + CW_BAR + p.bar_region * XCD_BAR_WORDS; bar.x = 0; bar.st = nullptr;
    if (hi - lo > 1) bar = xcd_barrier_post((unsigned*)(ws + WS_CTL) + CW_BAR + p.bar_region * XCD_BAR_WORDS, (volatile LAS unsigned*)(lds + MISC_OFF));
#define IN(k) (lo <= (k) && (k) < hi)
#define SEAM(k) do { if (IN(k) && IN((k) + 1)) xcd_barrier(bar); } while (0)
#define PHASE_ENV() PHASE_IDS(); const __attribute__((address_space(4))) Params* pp = (const __attribute__((address_space(4))) Params*)__builtin_amdgcn_kernarg_segment_ptr(); asm volatile("" : "+s"(pp)); \
    unsigned char* ws = pp->ws; float* out = pp->out; bf16* XB = (bf16*)(ws + WS_XB); bf16* BIG = (bf16*)(ws + WS_BIG); float* SS = (float*)(ws + WS_SS); \
    const float* COS = (const float*)(ws + WS_COS); const float* SIN = (const float*)(ws + WS_SIN); const float* LBV = (const float*)(ws + WS_LBV); float* KMEAN = (float*)(ws + WS_KMEAN); \
    float* TAIL = (float*)(ws + WS_TAIL); float* HEADA = (float*)(ws + WS_HEADA); float* HEADU = (float*)(ws + WS_HEADU); \
    (void)out; (void)XB; (void)BIG; (void)SS; (void)COS; (void)SIN; (void)LBV; (void)KMEAN; (void)TAIL; (void)HEADA; (void)HEADU

    if (IN(0)) { PHASE_IDS(); p0_prologue(p, lds, blockIdx.x * NWAVES + wave, G * NWAVES, lane, wave); }
    SEAM(0);
    for (int l = 0; l < DEPTH; ++l) {
        const int pb = 1 + 6 * l, slot = l >> 1; const bool moba = (l & 1) != 0;
        if (IN(pb)) { PHASE_ENV();
            const int N = moba ? 3072 : 4096;
            const bf16* Bt = moba ? (const bf16*)(ws + WS_WQKV) + (size_t)slot * 3072 * 1024 : (const bf16*)(ws + WS_WIN) + (size_t)slot * 4096 * 1024;
            pg8::Gemm g{XB, Bt, MROWS, N, 1024, 1024}; pg8::StaticOrder S; S.init(MROWS, N, G, (int)blockIdx.x);
            pg8::EpiRowScale E{BIG, SS, N, 0};
            pg8::gemm_phase<pg8::EpiRowScale, pg8::StaticOrder, true, true>(lds + RING_OFF, g, S, E);
        }
        SEAM(pb);
        if (moba) {
            if (IN(pb + 1)) { PHASE_ENV(); kprep_phase(BIG, pp->in[8] + slot * 128, pp->in[9] + slot * 128, COS, SIN, KMEAN, lds, lane, wave); }
            SEAM(pb + 1);
#if defined(NAIVE_ATTN)
            if (IN(pb + 2)) { PHASE_ENV(); attn_naive_phase(BIG, KMEAN, lds, lane, wave); }
#elif !defined(NO_ATTN)
            if (IN(pb + 2)) { PHASE_ENV(); mb::attn_phase(BIG, KMEAN, (char*)lds_raw, tid); }
#endif
            SEAM(pb + 2);
        } else {
#if defined(NAIVE_HG)
            SEAM(pb + 1);
            if (IN(pb + 2)) { PHASE_ENV(); hg_naive_phase(BIG, LBV + slot * 1024, pp->in[5] + slot * 128, lds, tid); }
#elif !defined(NO_HG)
            if (IN(pb + 1)) { PHASE_ENV(); hg::pass_a(BIG, LBV + slot * 1024, (float*)(ws + WS_HGE), (float*)(ws + WS_HGD), lds, lane, wave); }
            SEAM(pb + 1);
            if (IN(pb + 2)) { PHASE_ENV(); hg::pass_b(BIG, LBV + slot * 1024, pp->in[5] + slot * 128, (const float*)(ws + WS_HGE), (const float*)(ws + WS_HGD), lds, lane, wave); }
#endif
            SEAM(pb + 2);
        }
        if (IN(pb + 3)) { PHASE_ENV();
            const bf16* A = moba ? BIG : BIG + 3072; const int lda = moba ? 3072 : 4096;
            const bf16* Bt = moba ? (const bf16*)(ws + WS_WOM) + (size_t)slot * 1024 * 1024 : (const bf16*)(ws + WS_WOH) + (size_t)slot * 1024 * 1024;
            pg8::Gemm g{A, Bt, MROWS, 1024, 1024, lda}; pg8::StaticOrder S; S.init(MROWS, 1024, G, (int)blockIdx.x);
            pg8::EpiResid E{l == 0 ? pp->in[0] : out, out, XB, SS};
            pg8::gemm_phase<pg8::EpiResid, pg8::StaticOrder, true, true>(lds + RING_OFF, g, S, E);
        }
        SEAM(pb + 3);
#ifndef NO_GLU
        if (IN(pb + 4)) { PHASE_ENV();
            const float* cw = pp->in[12] + (size_t)l * 3 * FF; const float* cb = pp->in[13] + (size_t)l * FF;
            pg8::Gemm g{XB, (const bf16*)(ws + WS_WUP) + (size_t)l * 6144 * 1024, MROWS, 6144, 1024, 1024}; pg8::StaticOrder S; S.init(MROWS, 6144, G, (int)blockIdx.x);
            pg8::EpiGLU E{BIG, SS, cw, cb, TAIL, HEADA, HEADU};
            pg8::gemm_phase<pg8::EpiGLU, pg8::StaticOrder, true, true>(lds + RING_OFF, g, S, E);
        }
#endif
        SEAM(pb + 4);
        if (IN(pb + 5)) { PHASE_ENV();
            const float* cw = pp->in[12] + (size_t)l * 3 * FF; const float* cb = pp->in[13] + (size_t)l * FF;
            pg8::Gemm g{BIG, (const bf16*)(ws + WS_WDN) + (size_t)l * 1024 * 3072, MROWS, 1024, 3072, 3072}; pg8::StaticOrder S; S.init(MROWS, 1024, G, (int)blockIdx.x);
            pg8::Unit u;
            for (int i = 0; S.next(i, u); ++i)
                for (int e = tid; e < 2 * FF; e += NWAVES * 64) glu_fixup_elem(u.pm, e / FF, e % FF, BIG, TAIL, HEADA, HEADU, cw, cb);
            VM_WAIT(); __syncthreads();
            pg8::EpiResid E{out, out, XB, SS};
            pg8::gemm_phase<pg8::EpiResid, pg8::StaticOrder, true, true>(lds + RING_OFF, g, S, E);
        }
        if (l < DEPTH - 1) SEAM(pb + 5);
    }
#undef IN
#undef SEAM
}

#ifndef MK_PER_PHASE
#define MK_PER_PHASE 0
#endif
extern "C" void kernel_launch(void* const* d_in, const int* in_sizes, int n_in, void* d_out, int out_size, void* d_ws, size_t ws_size, hipStream_t stream) {
    static int grid = 0;
    if (grid == 0) {
        if (n_in != 15 || in_sizes[0] != MROWS * DM || out_size != MROWS * DM || ws_size < WS_END) {
            fprintf(stderr, "kernel_launch: unexpected shapes (n_in %d, in0 %d, out %d, ws %zu < %zu); nothing launched\n", n_in, n_in > 0 ? in_sizes[0] : -1, out_size, ws_size, (size_t)WS_END); grid = -1; return; }
        int dev = 0, cus = 0, per_cu = 0;
        if (hipGetDevice(&dev) != hipSuccess || hipDeviceGetAttribute(&cus, hipDeviceAttributeMultiprocessorCount, dev) != hipSuccess || cus <= 0) { fprintf(stderr, "kernel_launch: no device attributes\n"); grid = -1; return; }
        if (hipFuncSetAttribute((const void*)mega_fwd, hipFuncAttributeMaxDynamicSharedMemorySize, LDS_BYTES) != hipSuccess) { fprintf(stderr, "kernel_launch: hipFuncSetAttribute failed\n"); grid = -1; return; }
        if (hipOccupancyMaxActiveBlocksPerMultiprocessor(&per_cu, (const void*)mega_fwd, NWAVES * 64, LDS_BYTES) != hipSuccess || per_cu < 1)
            fprintf(stderr, "kernel_launch: note: occupancy query reports %d workgroups per CU; launching one per CU (144 KiB LDS each admits exactly one)\n", per_cu);
        (void)hipGetLastError();
        grid = cus;
    }
    if (grid < 0) return;
    (void)hipMemsetAsync((char*)d_ws + WS_CTL, 0, CTL_ZERO_BYTES, stream);
    Params p{};
    for (int i = 0; i < 15; ++i) p.in[i] = (const float*)d_in[i];
    p.out = (float*)d_out; p.ws = (unsigned char*)d_ws;
#if MK_PER_PHASE
    for (int k = 0; k < N_PHASES; ++k) { p.ph_lo = k; p.ph_hi = k + 1; p.bar_region = 0; hipLaunchKernelGGL(mega_fwd, dim3(grid), dim3(NWAVES * 64), LDS_BYTES, stream, p); }
#else
    p.ph_lo = 0; p.ph_hi = N_PHASES; p.bar_region = 0;
    hipLaunchKernelGGL(mega_fwd, dim3(grid), dim3(NWAVES * 64), LDS_BYTES, stream, p);
#endif
}
```

```cpp
#include <hip/hip_runtime.h>
#include <cstdio>
#include <cstdint>
#include <cmath>
namespace pg8 {
#define PG8_LAS __attribute__((address_space(3)))
typedef unsigned short bf16_t;
typedef short bf16x8 __attribute__((ext_vector_type(8)));
typedef float f32x4 __attribute__((ext_vector_type(4)));
typedef unsigned u32x4 __attribute__((ext_vector_type(4)));
constexpr int BM = 256, BK = 64, HALF = 128, HTB = HALF * BK * 2  , STAGE_BYTES = 8 * HTB, NXCD = 8, WGM = 8;

__host__ __device__ __forceinline__ int lds_byte(int r, int c) { const int st = (r >> 4) * 2 + (c >> 5), rr = r & 15, cc = c & 31, ob = rr * 64 + cc * 2; return st * 1024 + (ob ^ (((ob >> 9) & 1) << 5)); }
__host__ __device__ __forceinline__ void stage_rc(int b, int& R, int& C) { const int st = b / 1024, sb = b % 1024, swz = sb ^ (((sb >> 9) & 1) << 5); R = (st >> 1) * 16 + swz / 64; C = (st & 1) * 32 + (swz % 64) / 2; }
__host__ __device__ __forceinline__ int perm32(int rho) { const int n = rho >> 4, i = rho & 15; return 8 * (i >> 2) + 4 * n + (i & 3); }

struct Unit { int pm, pn; };
struct Gemm { const bf16_t* A; const bf16_t* Bt; int M, N, K, lda; };

struct StaticOrder {
    int nM, nN, nwg, G, c;
    __host__ __device__ void init(int M, int N, int G_, int c_) { nM = M / BM; nN = N / BM; nwg = nM * nN; G = G_; c = c_; }
    __host__ __device__ bool next(int i, Unit& u) const {
        const long L = (long)i * G + c; if (L >= nwg) return false;
        int wgid = (int)L; { const int q = nwg / NXCD, r = nwg % NXCD, xcd = wgid % NXCD, off = wgid / NXCD; wgid = (xcd < r ? xcd * (q + 1) : r * (q + 1) + (xcd - r) * q) + off; }
        const int nig = WGM * nN, gid = wgid / nig, fm = gid * WGM, gsz = (nM - fm) < WGM ? (nM - fm) : WGM;
        u.pm = fm + ((wgid % nig) % gsz); u.pn = (wgid % nig) / gsz; return true;
    }
    __device__ __forceinline__ void a_ready(const Unit&) const {}
    __device__ __forceinline__ void done(const Unit&) const {}
};

__device__ __forceinline__ unsigned cvt_pk_bf16(float lo, float hi) { unsigned r; asm volatile("v_cvt_pk_bf16_f32 %0, %1, %2" : "=v"(r) : "v"(lo), "v"(hi)); return r; }
typedef float f32x2 __attribute__((ext_vector_type(2)));
__device__ __forceinline__ float row_rstd(const float* ss, int row, int fq) {
    const f32x4 a = *(const f32x4*)(ss + (size_t)row * 16 + 4 * fq);
    float s = (a[0] + a[1]) + (a[2] + a[3]);
    s += __shfl_xor(s, 16); s += __shfl_xor(s, 32);
    return __builtin_amdgcn_rsqf(s * (1.0f / 1024.0f) + 1e-6f);
}
struct EpiRowScale {
    static constexpr bool PERM = true, AFTER_DRAIN = false;
    bf16_t* O; const float* ss; int ldc, pad;
    __device__ __forceinline__ void operator()(f32x4 (&acc)[2][2][4][2], const Unit& u, int wr, int wc, int fr, int fq, PG8_LAS unsigned char* lds) const {
        const int row0 = u.pm * BM + wr * 64 + fr; const int col0 = u.pn * BM + wc * 32 + 8 * fq;
#pragma unroll
        for (int ai = 0; ai < 2; ++ai)
#pragma unroll
            for (int m = 0; m < 4; ++m) { const int row = row0 + ai * HALF + m * 16; const float rs = row_rstd(ss, row, fq);
                bf16_t* rowp = O + (size_t)row * ldc + col0;
#pragma unroll
                for (int bj = 0; bj < 2; ++bj) { const f32x4 v0 = acc[ai][bj][m][0] * rs, v1 = acc[ai][bj][m][1] * rs;
                    u32x4 w; w.x = cvt_pk_bf16(v0[0], v0[1]); w.y = cvt_pk_bf16(v0[2], v0[3]); w.z = cvt_pk_bf16(v1[0], v1[1]); w.w = cvt_pk_bf16(v1[2], v1[3]);
                    *(u32x4*)(rowp + bj * HALF) = w; } }
    }
};
typedef unsigned u32x2 __attribute__((ext_vector_type(2)));
struct EpiResid {
    static constexpr bool PERM = false, AFTER_DRAIN = false;
    const float* base32; float* out; bf16_t* xb; float* ss;
    __device__ __forceinline__ void operator()(f32x4 (&acc)[2][2][4][2], const Unit& u, int wr, int wc, int fr, int fq, PG8_LAS unsigned char* lds) const {
        const int col0 = u.pn * BM + wc * 32 + 4 * fq;
#pragma unroll
        for (int ai = 0; ai < 2; ++ai)
#pragma unroll
            for (int m = 0; m < 4; ++m) { const int row = u.pm * BM + ai * HALF + wr * 64 + m * 16 + fr; const size_t off = (size_t)row * 1024 + col0; float s = 0.f;
#pragma unroll
                for (int bj = 0; bj < 2; ++bj)
#pragma unroll
                    for (int n = 0; n < 2; ++n) { f32x4 b;
                        if (base32) b = *(const f32x4*)(base32 + off + bj * HALF + n * 16);
                        else { const u32x2 r = *(const u32x2*)(xb + off + bj * HALF + n * 16); b = (f32x4){__uint_as_float(r.x << 16), __uint_as_float(r.x & 0xffff0000u), __uint_as_float(r.y << 16), __uint_as_float(r.y & 0xffff0000u)}; }
                        const f32x4 o = b + acc[ai][bj][m][n];
                        if (out) *(f32x4*)(out + off + bj * HALF + n * 16) = o;
                        s += (o[0] * o[0] + o[1] * o[1]) + (o[2] * o[2] + o[3] * o[3]);
                        u32x2 w; w.x = cvt_pk_bf16(o[0], o[1]); w.y = cvt_pk_bf16(o[2], o[3]); *(u32x2*)(xb + off + bj * HALF + n * 16) = w; }
                s += __shfl_xor(s, 16); s += __shfl_xor(s, 32);
                if (fq == 0) ss[(size_t)row * 16 + u.pn * 4 + wc] = s; }
    }
};
template <int CTRL> __device__ __forceinline__ float dpp_mov(float old, float src) {
    return __builtin_bit_cast(float, __builtin_amdgcn_update_dpp(__builtin_bit_cast(int, old), __builtin_bit_cast(int, src), CTRL, 0xf, 0xf, false)); }
__device__ __forceinline__ float silu_f(float c) { return c * __builtin_amdgcn_rcpf(1.0f + __expf(-c)); }
struct EpiGLU {
    static constexpr bool PERM = true, AFTER_DRAIN = false;
    bf16_t* G; const float* ss; const float* cw; const float* cb; float* tail; float* head_a; float* head_u;
    __device__ __forceinline__ void operator()(f32x4 (&acc)[2][2][4][2], const Unit& u, int wr, int wc, int fr, int fq, PG8_LAS unsigned char* lds) const {
        const int f0 = u.pn * 128 + wc * 32 + 8 * fq;
        PG8_LAS float* X = (PG8_LAS float*)(lds + STAGE_BYTES);
#pragma unroll
        for (int ai = 0; ai < 2; ++ai)
#pragma unroll
            for (int m = 0; m < 4; ++m) { const float rs = row_rstd(ss, u.pm * BM + ai * HALF + wr * 64 + m * 16 + fr, fq);
#pragma unroll
                for (int bj = 0; bj < 2; ++bj)
#pragma unroll
                    for (int n = 0; n < 2; ++n) acc[ai][bj][m][n] = acc[ai][bj][m][n] * rs;
                if (m & 1) asm volatile("" ::: "memory"); }
        if (fr >= 14) {
#pragma unroll
            for (int ai = 0; ai < 2; ++ai)
#pragma unroll
                for (int n = 0; n < 2; ++n) *(PG8_LAS f32x4*)(X + ((((ai * 2 + wr) * 4 + wc) * 2 + (fr - 14)) * 32 + 8 * fq + 4 * n)) = acc[ai][0][3][n];
            if (wr == 1) {
#pragma unroll
                for (int n = 0; n < 2; ++n) *(f32x4*)(tail + ((size_t)u.pm * 2 + (fr - 14)) * 3072 + f0 + 4 * n) = acc[1][0][3][n]; }
        }
        if (wr == 0 && fr < 2) {
#pragma unroll
            for (int n = 0; n < 2; ++n) { *(f32x4*)(head_a + ((size_t)u.pm * 2 + fr) * 3072 + f0 + 4 * n) = acc[0][0][0][n]; *(f32x4*)(head_u + ((size_t)u.pm * 2 + fr) * 3072 + f0 + 4 * n) = acc[0][1][0][n]; } }
        asm volatile("s_waitcnt lgkmcnt(0)" ::: "memory"); __builtin_amdgcn_s_barrier(); asm volatile("" ::: "memory");
#pragma unroll
        for (int n = 0; n < 2; ++n) {
            const f32x4 w0 = *(const f32x4*)(cw + f0 + 4 * n), w1 = *(const f32x4*)(cw + 3072 + f0 + 4 * n), w2 = *(const f32x4*)(cw + 6144 + f0 + 4 * n), bb = *(const f32x4*)(cb + f0 + 4 * n);
#pragma unroll
            for (int ai = 0; ai < 2; ++ai) {
                const int blk = ai * 2 + wr;
                f32x4 P1 = (f32x4){0.f, 0.f, 0.f, 0.f}, P2 = P1;
                if (blk > 0) { P2 = *(const PG8_LAS f32x4*)(X + (((blk - 1) * 4 + wc) * 2 + 0) * 32 + 8 * fq + 4 * n); P1 = *(const PG8_LAS f32x4*)(X + (((blk - 1) * 4 + wc) * 2 + 1) * 32 + 8 * fq + 4 * n); }
#pragma unroll
                for (int m = 0; m < 4; ++m) {
                    f32x4 gv;
#pragma unroll
                    for (int j = 0; j < 4; ++j) {
                        const float cur = acc[ai][0][m][n][j]; float o1, o2;
                        if (m == 0) { o1 = P1[j]; o2 = fr == 0 ? P2[j] : P1[j]; }
                        else { const float pv = acc[ai][0][m > 0 ? m - 1 : 0][n][j]; o1 = dpp_mov<0x121>(pv, pv); o2 = dpp_mov<0x122>(pv, pv); }
                        const float x1 = dpp_mov<0x111>(o1, cur), x2 = dpp_mov<0x112>(o2, cur);
                        const float c = w0[j] * x2 + w1[j] * x1 + w2[j] * cur + bb[j];
                        gv[j] = silu_f(c) * acc[ai][1][m][n][j]; }
                    if (!(blk == 0 && m == 0 && fr < 2)) {
                        u32x2 w; w.x = cvt_pk_bf16(gv[0], gv[1]); w.y = cvt_pk_bf16(gv[2], gv[3]);
                        *(u32x2*)(G + (size_t)(u.pm * BM + ai * HALF + wr * 64 + m * 16 + fr) * 3072 + f0 + 4 * n) = w; }
                    asm volatile("" ::: "memory");
                }
            }
        }
    }
};
template <class Epi, class Sched, bool ALIGN_EPI = false, bool SP2 = false>
__device__ __forceinline__ void gemm_phase(PG8_LAS unsigned char* lds, const Gemm g, const Sched& S, const Epi& E) {
    int tid_ = threadIdx.x; asm volatile("" : "+v"(tid_));
    const int tid = tid_, wid = __builtin_amdgcn_readfirstlane(tid >> 6), lane = tid & 63, wr = wid >> 2, wc = wid & 3, fr = lane & 15, fq = lane >> 4;
    const int K = g.K, nt = K / BK;
    unsigned voffA[2], voffB[2];
#pragma unroll
    for (int i = 0; i < 2; ++i) { int R, C; stage_rc(tid * 16 + i * 8192, R, C); const int Rb = Epi::PERM ? ((R & ~31) + perm32(R & 31)) : R;
        voffA[i] = (unsigned)(R * g.lda + C) * 2u; voffB[i] = (unsigned)(Rb * K + C) * 2u; }
    const size_t kstep = (size_t)(BK * 2);
    const size_t hstepB = (size_t)HALF * K * 2, hstepA = (size_t)HALF * g.lda * 2;
    const size_t tstepA = 2 * hstepA, tstepB = 2 * hstepB;
    const unsigned ldsw = (unsigned)wid * 1024u;
    const int aoff = lds_byte(wr * 64 + fr, fq * 8), boff = lds_byte(wc * 32 + fr, fq * 8);
#define PG8_SA(b, h) (((b) * 2 + (h)) * HTB)
#define PG8_SB(b, h) ((4 + (b) * 2 + (h)) * HTB)
#define PG8_STAGE(bufoff, gbase, voff) do { _Pragma("unroll") for (int _i = 0; _i < 2; ++_i) \
        __builtin_amdgcn_global_load_lds((const unsigned*)((const char*)(gbase) + (voff)[_i]), (PG8_LAS unsigned*)(lds + (bufoff) + ldsw + _i * 8192), 16, 0, 0); } while (0)
#define PG8_LDA(dst, b, h) do { _Pragma("unroll") for (int m = 0; m < 4; ++m) _Pragma("unroll") for (int k = 0; k < 2; ++k) dst[m][k] = *(const PG8_LAS bf16x8*)(lds + PG8_SA(b, h) + aoff + m * 2048 + k * 1024); } while (0)
#define PG8_LDB(dst, b, h) do { _Pragma("unroll") for (int n = 0; n < 2; ++n) _Pragma("unroll") for (int k = 0; k < 2; ++k) dst[n][k] = *(const PG8_LAS bf16x8*)(lds + PG8_SB(b, h) + boff + n * 2048 + k * 1024); } while (0)
#define PG8_MMA(ai, bj, At, Bt) do { __builtin_amdgcn_s_setprio(1); _Pragma("unroll") for (int m = 0; m < 4; ++m) _Pragma("unroll") for (int n = 0; n < 2; ++n) _Pragma("unroll") for (int k = 0; k < 2; ++k) \
        acc[ai][bj][m][n] = __builtin_amdgcn_mfma_f32_16x16x32_bf16(Bt[n][k], At[m][k], acc[ai][bj][m][n], 0, 0, 0); __builtin_amdgcn_s_setprio(0); } while (0)
#define PG8_WAIT_V(n) asm volatile("s_waitcnt vmcnt(" #n ")" ::: "memory")
#define PG8_WAIT_L(n) asm volatile("s_waitcnt lgkmcnt(" #n ")" ::: "memory")
#define PG8_BAR __builtin_amdgcn_s_barrier()
#define PG8_SCHED __builtin_amdgcn_sched_barrier(0)
    Unit cur, nxt; int ui = 0;
    if (!S.next(0, cur)) return;
    f32x4 acc[2][2][4][2];
#pragma unroll
    for (int a = 0; a < 2; ++a)
#pragma unroll
        for (int b = 0; b < 2; ++b)
#pragma unroll
            for (int m = 0; m < 4; ++m)
#pragma unroll
                for (int n = 0; n < 2; ++n) acc[a][b][m][n] = (f32x4){0.f, 0.f, 0.f, 0.f};
    bf16x8 At[4][2], B0[2][2], B1[2][2];
    const char* cA = (const char*)g.A + (size_t)cur.pm * tstepA; const char* cB = (const char*)g.Bt + (size_t)cur.pn * tstepB;
    S.a_ready(cur);
    if constexpr (SP2) {
        PG8_STAGE(PG8_SB(0, 0), cB, voffB); PG8_STAGE(PG8_SB(0, 1), cB + hstepB, voffB); PG8_STAGE(PG8_SA(0, 0), cA, voffA); PG8_STAGE(PG8_SA(0, 1), cA + hstepA, voffA);
        if (wr == 1) PG8_BAR;
        PG8_WAIT_V(2); PG8_BAR;
        PG8_STAGE(PG8_SB(1, 0), cB + kstep, voffB); PG8_STAGE(PG8_SA(1, 0), cA + kstep, voffA); PG8_STAGE(PG8_SB(1, 1), cB + hstepB + kstep, voffB);
        PG8_WAIT_V(6); PG8_BAR;
    } else {
        PG8_STAGE(PG8_SB(0, 0), cB, voffB); PG8_STAGE(PG8_SA(0, 0), cA, voffA); PG8_STAGE(PG8_SB(0, 1), cB + hstepB, voffB); PG8_STAGE(PG8_SA(0, 1), cA + hstepA, voffA);
        if (wr == 1) PG8_BAR;
        PG8_WAIT_V(4); PG8_BAR;
        PG8_STAGE(PG8_SB(1, 0), cB + kstep, voffB); PG8_STAGE(PG8_SA(1, 0), cA + kstep, voffA); PG8_STAGE(PG8_SB(1, 1), cB + hstepB + kstep, voffB);
        PG8_WAIT_V(6); PG8_BAR;
    }
    for (;;) {
        const bool has_next = S.next(ui + 1, nxt);
        const char* nA = has_next ? (const char*)g.A + (size_t)nxt.pm * tstepA : cA; const char* nB = has_next ? (const char*)g.Bt + (size_t)nxt.pn * tstepB : cB;
        for (int t = 0; t < nt; t += 2) {
            const bool last = (t == nt - 2);
            const char* a1 = cA + (size_t)(t + 1) * kstep;
            const char* a2 = last ? nA : cA + (size_t)(t + 2) * kstep; const char* b2 = last ? nB : cB + (size_t)(t + 2) * kstep;
            const char* a3 = a2 + kstep; const char* b3 = b2 + kstep;
            if (last && has_next) S.a_ready(nxt);
            if constexpr (SP2) {
            PG8_LDB(B0, 0, 0); PG8_LDB(B1, 0, 1); PG8_SCHED; PG8_LDA(At, 0, 0); PG8_STAGE(PG8_SA(1, 1), a1 + hstepA, voffA);
            PG8_WAIT_V(8); PG8_WAIT_L(0); PG8_BAR; PG8_MMA(0, 0, At, B0); PG8_MMA(0, 1, At, B1); PG8_BAR; PG8_SCHED;
            PG8_LDA(At, 0, 1); PG8_STAGE(PG8_SB(0, 0), b2, voffB); PG8_STAGE(PG8_SB(0, 1), b2 + hstepB, voffB); PG8_STAGE(PG8_SA(0, 0), a2, voffA);
            PG8_WAIT_V(8); PG8_WAIT_L(0); PG8_BAR; PG8_MMA(1, 0, At, B0); PG8_MMA(1, 1, At, B1); PG8_BAR; PG8_SCHED;
            PG8_LDB(B0, 1, 0); PG8_LDB(B1, 1, 1); PG8_SCHED; PG8_LDA(At, 1, 0); PG8_STAGE(PG8_SA(0, 1), a2 + hstepA, voffA);
            PG8_WAIT_V(8); PG8_WAIT_L(0); PG8_BAR; PG8_MMA(0, 0, At, B0); PG8_MMA(0, 1, At, B1); PG8_BAR; PG8_SCHED;
            PG8_LDA(At, 1, 1); PG8_STAGE(PG8_SB(1, 0), b3, voffB); PG8_STAGE(PG8_SB(1, 1), b3 + hstepB, voffB); PG8_STAGE(PG8_SA(1, 0), a3, voffA);
            PG8_WAIT_V(8); PG8_WAIT_L(0); PG8_BAR; PG8_MMA(1, 0, At, B0); PG8_MMA(1, 1, At, B1); PG8_BAR; PG8_SCHED;
            } else {
            PG8_LDB(B0, 0, 0); PG8_SCHED; PG8_LDA(At, 0, 0); PG8_STAGE(PG8_SA(1, 1), a1 + hstepA, voffA);
            PG8_WAIT_L(8); PG8_BAR; PG8_WAIT_L(0); PG8_MMA(0, 0, At, B0); PG8_BAR; PG8_SCHED;
            PG8_LDB(B1, 0, 1); PG8_STAGE(PG8_SB(0, 0), b2, voffB);
            PG8_BAR; PG8_WAIT_L(0); PG8_MMA(0, 1, At, B1); PG8_BAR;
            PG8_LDA(At, 0, 1); PG8_STAGE(PG8_SA(0, 0), a2, voffA);
            PG8_BAR; PG8_WAIT_L(0); PG8_MMA(1, 0, At, B0); PG8_BAR; PG8_SCHED;
            PG8_STAGE(PG8_SB(0, 1), b2 + hstepB, voffB);
            PG8_WAIT_V(6); PG8_BAR; PG8_MMA(1, 1, At, B1); PG8_BAR;
            PG8_LDB(B0, 1, 0); PG8_SCHED; PG8_LDA(At, 1, 0); PG8_STAGE(PG8_SA(0, 1), a2 + hstepA, voffA);
            PG8_WAIT_L(8); PG8_BAR; PG8_WAIT_L(0); PG8_MMA(0, 0, At, B0); PG8_BAR; PG8_SCHED;
            PG8_LDB(B1, 1, 1); PG8_STAGE(PG8_SB(1, 0), b3, voffB);
            PG8_BAR; PG8_WAIT_L(0); PG8_MMA(0, 1, At, B1); PG8_BAR;
            PG8_LDA(At, 1, 1); PG8_STAGE(PG8_SA(1, 0), a3, voffA);
            PG8_BAR; PG8_WAIT_L(0); PG8_MMA(1, 0, At, B0); PG8_BAR; PG8_SCHED;
            PG8_STAGE(PG8_SB(1, 1), b3 + hstepB, voffB);
            PG8_WAIT_V(6); PG8_BAR; PG8_MMA(1, 1, At, B1); PG8_BAR;
            }
        }
        if constexpr (ALIGN_EPI) { if (wr == 0) PG8_BAR; }
        if constexpr (!Epi::AFTER_DRAIN) { E(acc, cur, wr, wc, fr, fq, lds); S.done(cur); }
        if (!has_next) break;
#pragma unroll
        for (int a = 0; a < 2; ++a)
#pragma unroll
            for (int b = 0; b < 2; ++b)
#pragma unroll
                for (int m = 0; m < 4; ++m)
#pragma unroll
                    for (int n = 0; n < 2; ++n) acc[a][b][m][n] = (f32x4){0.f, 0.f, 0.f, 0.f};
        cur = nxt; cA = nA; cB = nB; ++ui;
        if constexpr (ALIGN_EPI) { if (wr == 1) PG8_BAR; }
    }
    PG8_WAIT_V(0);
    if constexpr (!ALIGN_EPI) { if (wr == 0) PG8_BAR; }
    PG8_BAR;
    if constexpr (Epi::AFTER_DRAIN) { E.fused(acc, cur, wr, wc, fr, fq, lds, wid, lane); S.done(cur); }
#undef PG8_SA
#undef PG8_SB
#undef PG8_STAGE
#undef PG8_LDA
#undef PG8_LDB
#undef PG8_MMA
#undef PG8_WAIT_V
#undef PG8_WAIT_L
#undef PG8_BAR
#undef PG8_SCHED
}
}
#ifndef PROBE_DUP
#define PROBE_DUP 0
#endif
constexpr int BATCH = 8, SEQ = 4096, DM = 1024, MROWS = BATCH * SEQ, DEPTH = 4;
constexpr int NH = 8, HD = 128;
constexpr int FF = 3072, NBLK = 16, MBLK = 256;
constexpr float QSCALE = 0.08838834764831845f;
typedef unsigned short bf16;
typedef float f32x4 __attribute__((ext_vector_type(4)));
typedef unsigned u32x4 __attribute__((ext_vector_type(4)));

constexpr size_t MiB = 1u << 20;
constexpr size_t WS_CTL = 0, CTL_ZERO_BYTES = 1 * MiB;
constexpr size_t WS_WIN = 2 * MiB, WS_WQKV = 18 * MiB, WS_WOH = 30 * MiB, WS_WOM = 34 * MiB, WS_WUP = 38 * MiB, WS_WDN = 86 * MiB;
constexpr size_t WS_SS = 110 * MiB, WS_COS = 112 * MiB, WS_SIN = 113 * MiB, WS_LBV = 114 * MiB, WS_KMEAN = 115 * MiB;
constexpr size_t WS_HGD = 115 * MiB + 512 * 1024, WS_HGE = 116 * MiB;
constexpr size_t WS_TAIL = 132 * MiB, WS_HEADA = 135 * MiB, WS_HEADU = 138 * MiB;
constexpr size_t WS_XB = 144 * MiB, WS_BIG = 208 * MiB, WS_AU = 400 * MiB, WS_END = 464 * MiB;

__device__ __forceinline__ float bf2f(bf16 v) { return __uint_as_float((unsigned)v << 16); }
__device__ __forceinline__ bf16 f2bf(float f) { unsigned u = __float_as_uint(f); return (bf16)((u + 0x7fffu + ((u >> 16) & 1u)) >> 16); }
__device__ __forceinline__ float wave_sum(float v) {
#pragma unroll
    for (int o = 1; o < 64; o <<= 1) v += __shfl_xor(v, o);
    return v;
}
__device__ __forceinline__ float wave_max(float v) {
#pragma unroll
    for (int o = 1; o < 64; o <<= 1) v = fmaxf(v, __shfl_xor(v, o));
    return v;
}

__device__ __forceinline__ void glu_fixup_elem(int pm, int rr, int f, bf16* __restrict__ g, const float* __restrict__ tail, const float* __restrict__ head_a, const float* __restrict__ head_u, const float* __restrict__ cw, const float* __restrict__ cb) {
    const bool first = (pm & 15) == 0;
    const float cur = head_a[((size_t)pm * 2 + rr) * FF + f];
    const float t1 = first ? 0.f : tail[((size_t)(pm - 1) * 2 + 1) * FF + f], t0 = first ? 0.f : tail[((size_t)(pm - 1) * 2 + 0) * FF + f];
    const float prev1 = rr == 0 ? t1 : head_a[((size_t)pm * 2) * FF + f], prev2 = rr == 0 ? t0 : t1;
    const float c = cw[f] * prev2 + cw[FF + f] * prev1 + cw[2 * FF + f] * cur + cb[f];
    g[((size_t)pm * 256 + rr) * FF + f] = f2bf(c / (1.0f + __expf(-c)) * head_u[((size_t)pm * 2 + rr) * FF + f]);
}
#define XB_TMO      128
#define XB_XCNT(j)  (256  + 64 * (j))
#define XB_XSUB(j)  (1280 + 64 * (j))
#define XB_XGEN(j)  (2304 + 64 * (j))
#define XB_TOP      3328
#define XB_TOPGEN   3392
#define XCD_BAR_WORDS 3456
#define XB_SPIN_CAP (1u << 18)
#define LAS __attribute__((address_space(3)))

__device__ __forceinline__ unsigned xb_ld(unsigned* p)              { return __hip_atomic_load(p, __ATOMIC_RELAXED, __HIP_MEMORY_SCOPE_AGENT); }
__device__ __forceinline__ unsigned xb_add(unsigned* p, unsigned v) { return __hip_atomic_fetch_add(p, v, __ATOMIC_RELAXED, __HIP_MEMORY_SCOPE_AGENT); }
__device__ __forceinline__ unsigned xb_xcc_id() { return (unsigned)__builtin_amdgcn_s_getreg((3 << 11) | 20) & 0xFu; }
#define XB_SPIN(cond, bar) do { unsigned _sp = 0; while (cond) { __builtin_amdgcn_s_sleep(1); \
    if ((++_sp & 255u) == 0u) { if (xb_ld(&(bar)[XB_TMO])) break; if (_sp > XB_SPIN_CAP) { atomicAdd(&(bar)[XB_TMO], 1u); break; } } } } while (0)

struct XcdBarrier {
    unsigned* bar; unsigned x;
    volatile LAS unsigned* st;
};

__device__ __forceinline__ XcdBarrier xcd_barrier_post(unsigned* bar, volatile LAS unsigned* st) {
    XcdBarrier b; b.bar = bar; b.x = xb_xcc_id(); b.st = st;
    if (threadIdx.x == 0) (void)xb_add(&bar[XB_XCNT(b.x)], 1u);
    return b;
}
__device__ __forceinline__ void xcd_barrier_complete(unsigned* bar, unsigned x, unsigned& nloc, unsigned& nx) {
    const unsigned G = gridDim.x * gridDim.y * gridDim.z;
    unsigned sum, cnt, mine, sp = 0u;
    for (;;) {
        sum = 0u; cnt = 0u; mine = 0u;
#pragma unroll
        for (unsigned j = 0; j < 16; ++j) { const unsigned c = xb_ld(&bar[XB_XCNT(j)]); sum += c; cnt += (c > 0u) ? 1u : 0u; mine = (j == x) ? c : mine; }
        if (sum == G) break;
        __builtin_amdgcn_s_sleep(1);
        if ((++sp & 255u) == 0u) { if (xb_ld(&bar[XB_TMO])) break; if (sp > XB_SPIN_CAP) { atomicAdd(&bar[XB_TMO], 1u); break; } }
    }
    nloc = mine > 0u ? mine : 1u; nx = cnt > 0u ? cnt : 1u;
}

__device__ __forceinline__ void xcd_barrier(const XcdBarrier& b) {
    asm volatile("s_waitcnt vmcnt(0)" ::: "memory");
    __syncthreads();
    if (threadIdx.x == 0) {
        unsigned* bar = b.bar;
        __builtin_amdgcn_s_waitcnt(0);
        unsigned nloc = b.st[0], nx = b.st[1];
        if (nloc == 0u) { xcd_barrier_complete(bar, b.x, nloc, nx); b.st[0] = nloc; b.st[1] = nx; }
        const unsigned old = xb_add(&bar[XB_XSUB(b.x)], 1u);
        const unsigned gen = old / nloc;
        if (old + 1u == (gen + 1u) * nloc) {
            __builtin_amdgcn_fence(__ATOMIC_RELEASE, "agent");
            asm volatile("s_waitcnt vmcnt(0)" ::: "memory");
            const unsigned og = xb_add(&bar[XB_TOP], 1u);
            const unsigned tg = og / nx;
            if (og + 1u == (tg + 1u) * nx) xb_add(&bar[XB_TOPGEN], 1u);
            else XB_SPIN(xb_ld(&bar[XB_TOPGEN]) == tg, bar);
            __builtin_amdgcn_fence(__ATOMIC_ACQUIRE, "agent");
            xb_add(&bar[XB_XGEN(b.x)], 1u);
            asm volatile("s_waitcnt vmcnt(0)" ::: "memory");
        } else {
            XB_SPIN(xb_ld(&bar[XB_XGEN(b.x)]) == gen, bar);
            __builtin_amdgcn_fence(__ATOMIC_ACQUIRE, "agent");
            asm volatile("s_waitcnt vmcnt(0)" ::: "memory");
        }
    }
    __syncthreads();
}
namespace mb {
typedef short bf16x8 __attribute__((ext_vector_type(8)));
typedef short s16x4 __attribute__((ext_vector_type(4)));
typedef float f32x16 __attribute__((ext_vector_type(16)));
constexpr int D = 128, LDR = 3072, NW = 8, QBLK = 32, KVBLK = 64, QB = NW * QBLK;
constexpr int SHM_V = KVBLK * D * 2, SHM_K = KVBLK * D * 2;
constexpr int OFF_WS = 2 * SHM_V + 2 * SHM_K, OFF_KM = OFF_WS + NW * 64 * 4, ATT_LDS_BYTES = OFF_KM + 16 * 128 * 4;
constexpr float THR = 8.f;
#define KSWZ(row, colB) ((row) * 256 + ((colB) ^ (((row) & 7) << 4)))
#define SBAR() __builtin_amdgcn_sched_barrier(0)
__device__ __forceinline__ int v_st(int k, int c) { const int kk = (k & ~0xC) | ((k & 4) << 1) | ((k & 8) >> 1); return ((kk >> 3) * 4 + (c >> 5)) * 512 + ((kk & 7) * 32 + (c & 31)) * 2; }
__device__ __forceinline__ int v_rd_base(int lane) { return ((lane & 3) << 3) | (((lane >> 2) & 3) << 6) | (((lane >> 4) & 1) << 5) | (((lane >> 5) & 1) << 8); }
constexpr int v_rd_off(int d0, int ks, int half) { return d0 * 512 + ks * 4096 + half * 2048; }
__device__ __forceinline__ int crow(int r, int hi) { return (r & 3) + 8 * (r >> 2) + 4 * hi; }
__device__ __forceinline__ unsigned cvtpk(float lo, float hi) { unsigned r; asm volatile("v_cvt_pk_bf16_f32 %0, %1, %2" : "=v"(r) : "v"(lo), "v"(hi)); return r; }
__device__ __forceinline__ bf16x8 load8(const bf16* p) { return *reinterpret_cast<const bf16x8*>(p); }
__device__ __forceinline__ void mask_causal(f32x16& p0, f32x16& p1, int dq) {
    const float NEG = -__builtin_inff();
#pragma unroll
    for (int r = 0; r < 16; ++r) { const int c = (r & 3) + 8 * (r >> 2); if (dq - c < 0) p0[r] = NEG; if (dq - c - 32 < 0) p1[r] = NEG; }
}
__device__ __forceinline__ void mask_all(f32x16& p0, f32x16& p1, bool keep) {
    const float NEG = -__builtin_inff();
#pragma unroll
    for (int r = 0; r < 16; ++r) { p0[r] = keep ? p0[r] : NEG; p1[r] = keep ? p1[r] : NEG; }
}
__device__ __forceinline__ void partialSM(f32x16& p0, f32x16& p1, float& m_reg, float& mn, float& alpha) {
    float pmax = p0[0]; for (int r = 1; r < 16; ++r) pmax = fmaxf(pmax, p0[r]); for (int r = 0; r < 16; ++r) pmax = fmaxf(pmax, p1[r]);
    { auto rr = __builtin_amdgcn_permlane32_swap(__float_as_uint(pmax), __float_as_uint(pmax), false, false);
      pmax = fmaxf(__uint_as_float(rr[0]), __uint_as_float(rr[1])); }
    constexpr float C2 = 1.4426950408889634f;
    if (__builtin_expect(__all((pmax - m_reg) <= THR), 1)) { mn = m_reg; alpha = 1.f; }
    else { mn = fmaxf(m_reg, pmax); alpha = __builtin_amdgcn_exp2f((m_reg - mn) * C2); m_reg = mn; }
    const float mnL = -mn * C2;
    for (int r = 0; r < 16; ++r) p0[r] = fmaf(p0[r], C2, mnL); for (int r = 0; r < 16; ++r) p1[r] = fmaf(p1[r], C2, mnL);
    for (int r = 0; r < 16; ++r) p0[r] = __builtin_amdgcn_exp2f(p0[r]);
}
__device__ __forceinline__ void finishSM(f32x16& p0, f32x16& p1, float alpha, float& l_reg, bf16x8& pa0, bf16x8& pa1, bf16x8& pa2, bf16x8& pa3) {
    for (int r = 0; r < 16; ++r) p1[r] = __builtin_amdgcn_exp2f(p1[r]);
    float ps = 0; for (int r = 0; r < 16; ++r) ps += p0[r]; for (int r = 0; r < 16; ++r) ps += p1[r];
    { auto rr = __builtin_amdgcn_permlane32_swap(__float_as_uint(ps), __float_as_uint(ps), false, false);
      ps = __uint_as_float(rr[0]) + __uint_as_float(rr[1]); }
    l_reg = l_reg * alpha + ps;
#define PK4(P, B_, OUT) do { unsigned a0 = cvtpk(P[B_+0], P[B_+1]), a1 = cvtpk(P[B_+2], P[B_+3]);                          \
        unsigned b0 = cvtpk(P[B_+4], P[B_+5]), b1 = cvtpk(P[B_+6], P[B_+7]);                                             \
        auto r0 = __builtin_amdgcn_permlane32_swap(a0, b0, false, false); auto r1 = __builtin_amdgcn_permlane32_swap(a1, b1, false, false); \
        u32x4 w = {r0[0], r1[0], r0[1], r1[1]}; OUT = *reinterpret_cast<bf16x8*>(&w); } while (0)
    PK4(p0, 0, pa0); PK4(p0, 8, pa1); PK4(p1, 0, pa2); PK4(p1, 8, pa3);
#undef PK4
}
template <int KB>
__device__ __forceinline__ void qkt(f32x16& p0, f32x16& p1, const char* K_lds, int r32, int hi, const bf16x8* qr) {
    p0 = f32x16{}; p1 = f32x16{};
    const char* kb[4];
#pragma unroll
    for (int dd = 0; dd < 4; ++dd) kb[dd] = K_lds + KB * SHM_K + KSWZ(r32, (dd * 16 + hi * 8) * 2);
#pragma unroll
    for (int d0 = 0; d0 < 8; ++d0) { const char* a = kb[d0 & 3] + (d0 >> 2) * 128;
        bf16x8 b0 = *reinterpret_cast<const bf16x8*>(a);
        bf16x8 b1 = *reinterpret_cast<const bf16x8*>(a + 32 * 256);
        p0 = __builtin_amdgcn_mfma_f32_32x32x16_bf16(b0, qr[d0], p0, 0, 0, 0);
        p1 = __builtin_amdgcn_mfma_f32_32x32x16_bf16(b1, qr[d0], p1, 0, 0, 0); }
}
template <int VB>
__device__ __forceinline__ void pv_tile(f32x16* o, int vb0, bf16x8 pa0, bf16x8 pa1, bf16x8 pa2, bf16x8 pa3) {
#define TRRD(dst, off) asm volatile("ds_read_b64_tr_b16 %0, %1 offset:%2" : "=&v"(dst) : "v"(vb0), "i"(off) : "memory")
#define PV_D0(d0) do { s16x4 l0, l1, l2, l3, h0, h1, h2, h3; constexpr int b_ = VB * SHM_V + v_rd_off(d0, 0, 0);   \
        TRRD(l0, b_); TRRD(h0, b_ + 2048); TRRD(l1, b_ + 4096); TRRD(h1, b_ + 6144); TRRD(l2, b_ + 8192); TRRD(h2, b_ + 10240); TRRD(l3, b_ + 12288); TRRD(h3, b_ + 14336); \
        asm volatile("s_waitcnt lgkmcnt(0)" ::: "memory"); SBAR();   \
        o[d0] = __builtin_amdgcn_mfma_f32_32x32x16_bf16(pa0, (bf16x8){l0[0], l0[1], l0[2], l0[3], h0[0], h0[1], h0[2], h0[3]}, o[d0], 0, 0, 0);   \
        o[d0] = __builtin_amdgcn_mfma_f32_32x32x16_bf16(pa1, (bf16x8){l1[0], l1[1], l1[2], l1[3], h1[0], h1[1], h1[2], h1[3]}, o[d0], 0, 0, 0);   \
        o[d0] = __builtin_amdgcn_mfma_f32_32x32x16_bf16(pa2, (bf16x8){l2[0], l2[1], l2[2], l2[3], h2[0], h2[1], h2[2], h2[3]}, o[d0], 0, 0, 0);   \
        o[d0] = __builtin_amdgcn_mfma_f32_32x32x16_bf16(pa3, (bf16x8){l3[0], l3[1], l3[2], l3[3], h3[0], h3[1], h3[2], h3[3]}, o[d0], 0, 0, 0); } while (0)
    PV_D0(0); PV_D0(1); PV_D0(2); PV_D0(3);
#undef PV_D0
#undef TRRD
}

struct BlockRef { const bf16* Q; const bf16* K; const bf16* V; bf16* O; const float* KM; int iblk, ldo, store; };
struct Seam { bf16x8 qr[8]; bf16x8 st_v0, st_v1, st_k0, st_k1; };
#define ROW(p, k0, rr) ((p) + (size_t)((k0) + (rr)) * LDR + sc)
#define VMW() asm volatile("s_waitcnt vmcnt(0)" ::: "memory")
#define VMWN(n) asm volatile("s_waitcnt vmcnt(%0)" :: "i"(n) : "memory")
#define SLOAD_H(Kp, Vp, k0) do { const bf16* k_ = (Kp) + (size_t)(k0) * LDR; const bf16* v_ = (Vp) + (size_t)(k0) * LDR;                     \
                         S.st_v0 = load8(v_ + (size_t)soff); S.st_v1 = load8(v_ + (size_t)32 * LDR + (size_t)soff);                       \
                         S.st_k0 = load8(k_ + (size_t)soff); S.st_k1 = load8(k_ + (size_t)32 * LDR + (size_t)soff); } while (0)
#define SWRITE_HK(bf) do { *(bf16x8*)(K_lds + (bf) * SHM_K + kws) = S.st_k0; *(bf16x8*)(K_lds + (bf) * SHM_K + kws + 32 * 256) = S.st_k1; } while (0)
#define SWRITE_HV(bf) do { *(bf16x8*)(V_lds + (bf) * SHM_V + vst0) = S.st_v0; *(bf16x8*)(V_lds + (bf) * SHM_V + vst1) = S.st_v1; } while (0)
#define SWRITE_H(bf) do { SWRITE_HV(bf); SWRITE_HK(bf); } while (0)
__device__ __forceinline__ void moba_prime(const BlockRef& cur, char* lds, Seam& S, int tid) {
    const int wid = __builtin_amdgcn_readfirstlane(tid >> 6), lane = tid & 63, r32 = lane & 31, hi = lane >> 5;
    const int sr = tid >> 4, sc = (tid & 15) * 8, kws = KSWZ(sr, sc * 2); char* K_lds = lds + 2 * SHM_V;
    const unsigned soff = (unsigned)(sr * LDR + sc), qoff = (unsigned)(r32 * LDR + hi * 8);
    { const bf16* qb = cur.Q + (size_t)(wid * QBLK) * LDR;
#pragma unroll
      for (int d0 = 0; d0 < 8; ++d0) S.qr[d0] = load8(qb + (size_t)qoff + d0 * 16); }
    SLOAD_H(cur.K, cur.V, 0); VMW(); SWRITE_HK(0);
    __syncthreads();
}
__device__ __forceinline__ void moba_block(const BlockRef& cur, const BlockRef& nxt, char* lds, Seam& S, int tid) {
    const int wid = __builtin_amdgcn_readfirstlane(tid >> 6), lane = tid & 63, r32 = lane & 31, hi = lane >> 5;
    const int iblk = cur.iblk, NT = 4 * (iblk + 1), P0 = iblk * QB;
    const int qlo = P0 + wid * QBLK, qm = qlo + r32 - 4 * hi;
    unsigned sel = 0u; float* KMs = (float*)(lds + OFF_KM);
    if (iblk > 0) {
        int t4 = tid; asm volatile("" : "+v"(t4));
        *(f32x4*)(KMs + t4 * 4) = *(const f32x4*)(cur.KM + t4 * 4);
        __syncthreads();
        float v1 = -__builtin_inff(), v2 = v1, v3 = v1; int i1 = -1, i2 = -1, i3 = -1;
        for (int j = 0; j < iblk; ++j) {
            const float* km = KMs + j * 128 + 8 * hi; float a = 0.f;
#pragma unroll
            for (int d0 = 0; d0 < 8; ++d0) { const f32x4 k0 = *(const f32x4*)(km + 16 * d0), k1 = *(const f32x4*)(km + 16 * d0 + 4); const bf16x8 q = S.qr[d0];
#pragma unroll
                for (int e = 0; e < 4; ++e) { a = fmaf(__uint_as_float((unsigned)(unsigned short)q[e] << 16), k0[e], a); a = fmaf(__uint_as_float((unsigned)(unsigned short)q[e + 4] << 16), k1[e], a); } }
            a += __shfl_xor(a, 32);
            if (a > v1) { v3 = v2; i3 = i2; v2 = v1; i2 = i1; v1 = a; i1 = j; }
            else if (a > v2) { v3 = v2; i3 = i2; v2 = a; i2 = j; }
            else if (a > v3) { v3 = a; i3 = j; }
        }
        sel = (i1 >= 0 ? 1u << i1 : 0u) | (i2 >= 0 ? 1u << i2 : 0u) | (i3 >= 0 ? 1u << i3 : 0u);
    }
    char* V_lds = lds; char* K_lds = lds + 2 * SHM_V;
    float* ws = (float*)(lds + OFF_WS) + wid * 64; float* li_l = ws, * al_l = ws + 32;
    float m_reg = -1e30f, l_reg = 0; f32x16 o[4] = {};
    const int sr = tid >> 4, sc = (tid & 15) * 8, vst0 = v_st(sr, sc), vst1 = v_st(32 + sr, sc), kws = KSWZ(sr, sc * 2);
    const unsigned soff = (unsigned)(sr * LDR + sc), qoff = (unsigned)(r32 * LDR + hi * 8);
    const int vb0 = (int)(uintptr_t)V_lds + v_rd_base(lane);
    const bf16* Kh = cur.K; const bf16* Vh = cur.V;
#define RESC(a) do { if (__any((a) < 1.f)) { if (hi == 0) al_l[r32] = (a); asm volatile("s_waitcnt lgkmcnt(0)" ::: "memory");              \
                     for (int d_ = 0; d_ < 4; ++d_) for (int r = 0; r < 16; ++r) o[d_][r] *= al_l[crow(r, hi)]; } } while (0)
#define KBASE(t) ((t) * KVBLK)
#define MASKT(P0_, P1_, t) do { const int kb_ = KBASE(t); const int bj_ = (t) >> 2; \
        if (bj_ == iblk) { if (kb_ + KVBLK - 1 > qlo) mask_causal(P0_, P1_, qm - kb_); } else mask_all(P0_, P1_, ((sel >> bj_) & 1u) != 0u); } while (0)
    constexpr int NQL = 8;
#define SEAM_K0() do { VMWN(NQL); SWRITE_HK(0); SBAR(); } while (0)
    f32x16 pA0, pA1, pB0, pB1; float mnA, mnB, alA, alB; bf16x8 pa0, pa1, pa2, pa3;
    SWRITE_HV(0); SBAR();
    if (NT > 1) SLOAD_H(Kh, Vh, KBASE(1));
    SBAR(); qkt<0>(pA0, pA1, K_lds, r32, hi, S.qr);
    MASKT(pA0, pA1, 0); partialSM(pA0, pA1, m_reg, mnA, alA);
    if (NT > 1) { VMW(); SWRITE_H(1); }
    __syncthreads();
#define HALF_STEP(PX0, PX1, mnX, alX, PY0, PY1, alY, t, KB, VB, SB) do {                                                      \
        SBAR(); qkt<KB>(PX0, PX1, K_lds, r32, hi, S.qr);                                                                      \
        finishSM(PY0, PY1, alY, l_reg, pa0, pa1, pa2, pa3); SBAR();                                                           \
        if ((t) + 1 < NT) { SLOAD_H(Kh, Vh, KBASE((t) + 1)); SBAR(); }                                                        \
        pv_tile<VB>(o, vb0, pa0, pa1, pa2, pa3); MASKT(PX0, PX1, (t)); partialSM(PX0, PX1, m_reg, mnX, alX);                  \
        __syncthreads();                                                                                                      \
        if ((t) + 1 < NT) { VMW(); SWRITE_H(SB); }                                                                            \
        RESC(alX); __syncthreads(); } while (0)
    for (int t = 1; t + 1 < NT; t += 2) {
        HALF_STEP(pB0, pB1, mnB, alB, pA0, pA1, alA, t, 1, 0, 0);
        HALF_STEP(pA0, pA1, mnA, alA, pB0, pB1, alB, t + 1, 0, 1, 1);
    }
    SBAR(); qkt<1>(pB0, pB1, K_lds, r32, hi, S.qr); SBAR();
    SLOAD_H(nxt.K, nxt.V, 0); SBAR();
    { const bf16* qb = nxt.Q + (size_t)(wid * QBLK) * LDR;
#pragma unroll
      for (int d0 = 0; d0 < 8; ++d0) S.qr[d0] = load8(qb + (size_t)qoff + d0 * 16); }
    SBAR();
    finishSM(pA0, pA1, alA, l_reg, pa0, pa1, pa2, pa3); SBAR();
    pv_tile<0>(o, vb0, pa0, pa1, pa2, pa3);
    MASKT(pB0, pB1, NT - 1); partialSM(pB0, pB1, m_reg, mnB, alB); __syncthreads(); RESC(alB);
    finishSM(pB0, pB1, alB, l_reg, pa0, pa1, pa2, pa3); SBAR(); pv_tile<1>(o, vb0, pa0, pa1, pa2, pa3);
    SBAR(); SEAM_K0();
    if (hi == 0) li_l[r32] = l_reg; asm volatile("s_waitcnt lgkmcnt(0)" ::: "memory");
    float rli[16];
#pragma unroll
    for (int r = 0; r < 16; ++r) rli[r] = __builtin_amdgcn_rcpf(li_l[crow(r, hi)]);
    const int ldo = cur.ldo; bf16* Ow = cur.O + (size_t)(wid * QBLK) * ldo;
    int hi_e = hi; asm volatile("" : "+v"(hi_e));
    const unsigned ooff = (unsigned)(4 * hi_e * ldo + r32);
#pragma unroll
    for (int r = 0; r < 16; ++r) { bf16* orow = Ow + (size_t)((r & 3) + 8 * (r >> 2)) * ldo;
#pragma unroll
        for (int d0 = 0; d0 < 4; ++d0) { const float v = o[d0][r] * rli[r];
            const float vn = __shfl_xor(v, 1);
            if ((r32 & 1) == 0 && cur.store) *(unsigned*)(orow + (size_t)ooff + d0 * 32) = cvtpk(v, vn); } }
    __syncthreads();
#undef RESC
#undef KBASE
#undef MASKT
#undef SEAM_K0
#undef HALF_STEP
}
#undef ROW
#undef VMW
#undef VMWN
#undef SLOAD_H
#undef SWRITE_HK
#undef SWRITE_HV
#undef SWRITE_H
#undef KSWZ
#undef SBAR

__device__ __forceinline__ void item_decode(int L, int G, int k, int bx, int& bh, int& x) {
    if (G == 256) { const int xcd = bx & 7, q = bx >> 3; bh = ((k * 8 + xcd) << 2) + (q >> 3); x = q & 7; }
    else { bh = L >> 3; x = L & 7; }
}
__device__ __forceinline__ BlockRef make_ref(bf16* qkv, const float* kmean, bf16* ob, int ldo, int bh, int iblk) {
    const int b = bh >> 3, h = bh & 7; BlockRef r; bf16* base = qkv + (size_t)b * SEQ * LDR + h * 128;
    r.Q = base + (size_t)iblk * QB * LDR; r.O = ob + ((size_t)b * SEQ + (size_t)iblk * QB) * ldo + h * 128; r.K = base + 1024; r.V = base + 2048; r.KM = kmean + (size_t)bh * 16 * 128; r.iblk = iblk; r.ldo = ldo; r.store = 1; return r;
}
__device__ __forceinline__ void attn_phase(bf16* qkv, const float* kmean, bf16* ob, int ldo, char* lds, int tid) {
    const int G = gridDim.x, bx = blockIdx.x, real = BATCH * NH * 8, total = (PROBE_DUP & 16) ? 2 * real : real;
    int L = bx, k = 0; if (L >= total) return;
    int bh, x; item_decode(L % real, G, k & 1, bx, bh, x); int pass = 0;
    BlockRef cur = make_ref(qkv, kmean, ob, ldo, bh, x); cur.store = ((PROBE_DUP & 16) == 0) || L >= real;
    Seam S;
    moba_prime(cur, lds, S, tid);
    for (;;) {
        const bool more_pass = pass == 0, more_item = L + G < total, last = !more_pass && !more_item;
        int bhn = bh, xn = x, passn = pass + 1, Ln = L, kn = k;
        if (!more_pass) { passn = 0; if (more_item) { Ln = L + G; kn = k + 1; } item_decode(Ln % real, G, kn & 1, bx, bhn, xn); }
        BlockRef nxt = last ? cur : make_ref(qkv, kmean, ob, ldo, bhn, passn ? 15 - xn : xn); nxt.store = ((PROBE_DUP & 16) == 0) || Ln >= real;
        moba_block(cur, nxt, lds, S, tid);
        if (last) break;
        cur = nxt; bh = bhn; x = xn; pass = passn; L = Ln; k = kn;
    }
}
}
namespace hg {
typedef short bf16x8 __attribute__((ext_vector_type(8)));
typedef short s16x4 __attribute__((ext_vector_type(4)));
typedef float f32x16 __attribute__((ext_vector_type(16)));
constexpr int LDB = 4096, CH = 64, NCH_SEG = 16, NSEG = 4;
constexpr int RS = 272, TS = 144, OST_RS = 528;
constexpr int OFF_QR = 0, OFF_KR = 17408, OFF_QI = 34816, OFF_KT = 52224, OFF_VT = 70656, OFF_DEC = 89088, OFF_OST = 89600, HG_LDS_BYTES = OFF_OST + 64 * OST_RS;
static_assert(HG_LDS_BYTES <= 131072, "HGRN LDS map");
__device__ __forceinline__ unsigned pk(float lo, float hi) { unsigned r; asm volatile("v_cvt_pk_bf16_f32 %0, %1, %2" : "=v"(r) : "v"(lo), "v"(hi)); return r; }
__device__ __forceinline__ bf16x8 join8(s16x4 a, s16x4 b) { return (bf16x8){a[0], a[1], a[2], a[3], b[0], b[1], b[2], b[3]}; }
__device__ __forceinline__ bf16x8 acc_frag(const f32x16& x, int s) {
    u32x4 w; w.x = pk(x[8 * s + 0], x[8 * s + 1]); w.y = pk(x[8 * s + 2], x[8 * s + 3]); w.z = pk(x[8 * s + 4], x[8 * s + 5]); w.w = pk(x[8 * s + 6], x[8 * s + 7]);
    return __builtin_bit_cast(bf16x8, w);
}
template <bool FULL> struct Raw { bf16 z[16], v[16], q[FULL ? 16 : 1]; };
template <bool FULL>
__device__ __forceinline__ void load_chunk(Raw<FULL>& R, const bf16* __restrict__ base, int lane, int wave) {
    const int c = (lane & 15) + 16 * wave, qq = lane >> 4;
    const bf16* p = base + (size_t)(16 * qq) * LDB + c;
#pragma unroll
    for (int i = 0; i < 16; ++i) { R.z[i] = p[(size_t)i * LDB + 1024]; R.v[i] = p[(size_t)i * LDB + 2048]; if (FULL) R.q[i] = p[(size_t)i * LDB]; }
}
template <bool FULL>
__device__ __forceinline__ float build_chunk(const Raw<FULL>& R, float lb, LAS unsigned char* lds, int lane, int wave) {
    const int c = (lane & 15) + 16 * wave, qq = lane >> 4;
    float G[16], kk[16]; float run = 0.f; const float omlb = 1.0f - lb;
#pragma unroll
    for (int i = 0; i < 16; ++i) { const float e = __expf(-bf2f(R.z[i])); const float sg = __builtin_amdgcn_rcpf(1.0f + e); kk[i] = omlb * (e * sg); run += __logf(lb + omlb * sg); G[i] = run; }
    const float T0 = __shfl(run, lane & 15), T1 = __shfl(run, 16 + (lane & 15)), T2 = __shfl(run, 32 + (lane & 15)), T3 = __shfl(run, 48 + (lane & 15));
    const float gmid = T0 + T1, glast = gmid + (T2 + T3);
    const float off = qq == 0 ? 0.f : qq == 1 ? T0 : qq == 2 ? gmid : gmid + T2;
    const float Egm = __expf(gmid), Elm = __expf(glast - gmid);
    unsigned ktw[8], vtw[8];
#pragma unroll
    for (int i = 0; i < 16; i += 2) {
        float ks[2];
#pragma unroll
        for (int e = 0; e < 2; ++e) { const int t = 16 * qq + i + e; const float E1 = __expf(G[i + e] + off - gmid), R1 = __builtin_amdgcn_rcpf(E1);
            ks[e] = kk[i + e] * R1 * Elm;
            if (FULL) { const float qe = bf2f(R.q[FULL ? i + e : 0]) * QSCALE * E1;
                *(LAS bf16*)(lds + OFF_QR + t * RS + 2 * c) = (bf16)(pk(qe, 0.f) & 0xffffu);
                *(LAS bf16*)(lds + OFF_KR + t * RS + 2 * c) = (bf16)(pk(kk[i + e] * R1, 0.f) & 0xffffu);
                *(LAS bf16*)(lds + OFF_QI + t * RS + 2 * c) = (bf16)(pk(qe * Egm, 0.f) & 0xffffu); } }
        ktw[i >> 1] = pk(ks[0], ks[1]); vtw[i >> 1] = (unsigned)R.v[i] | ((unsigned)R.v[i + 1] << 16); }
    *(LAS u32x4*)(lds + OFF_KT + c * TS + 32 * qq) = (u32x4){ktw[0], ktw[1], ktw[2], ktw[3]}; *(LAS u32x4*)(lds + OFF_KT + c * TS + 32 * qq + 16) = (u32x4){ktw[4], ktw[5], ktw[6], ktw[7]};
    *(LAS u32x4*)(lds + OFF_VT + c * TS + 32 * qq) = (u32x4){vtw[0], vtw[1], vtw[2], vtw[3]}; *(LAS u32x4*)(lds + OFF_VT + c * TS + 32 * qq + 16) = (u32x4){vtw[4], vtw[5], vtw[6], vtw[7]};
    if (qq == 0) *(LAS float*)(lds + OFF_DEC + 4 * c) = __expf(glast);
    return glast;
}
__device__ __forceinline__ void state_update(f32x16 (&S)[4], LAS unsigned char* lds, int j, int c, int h) {
#pragma unroll
    for (int i = 0; i < 4; ++i) {
#pragma unroll
        for (int g4 = 0; g4 < 4; ++g4) { const f32x4 dc = *(const LAS f32x4*)(lds + OFF_DEC + 4 * (32 * i + 8 * g4 + 4 * h));
#pragma unroll
            for (int e = 0; e < 4; ++e) S[i][4 * g4 + e] *= dc[e]; }
#pragma unroll
        for (int ks = 0; ks < 4; ++ks) {
            const bf16x8 a = *(const LAS bf16x8*)(lds + OFF_KT + (32 * i + c) * TS + (16 * ks + 8 * h) * 2);
            const bf16x8 b = *(const LAS bf16x8*)(lds + OFF_VT + (32 * j + c) * TS + (16 * ks + 8 * h) * 2);
            S[i] = __builtin_amdgcn_mfma_f32_32x32x16_bf16(a, b, S[i], 0, 0, 0); }
    }
}
__device__ __forceinline__ int crow(int r, int h) { return (r & 3) + 8 * (r >> 2) + 4 * h; }

__device__ __forceinline__ void pass_a(const bf16* __restrict__ big, const float* __restrict__ lbv, float* __restrict__ Eg, float* __restrict__ Dg, LAS unsigned char* lds, int lane, int wave) {
    const int j = wave & 3, th = wave >> 2, c = lane & 31, h = lane >> 5;
    for (int u = blockIdx.x; u < BATCH * NH * NSEG; u += gridDim.x) {
        const int seg = u & 3, hh = (u >> 2) & 7, b = u >> 5;
        if (seg == NSEG - 1) continue;
        const float lb = lbv[hh * 128 + (lane & 15) + 16 * wave];
        f32x16 S[4];
#pragma unroll
        for (int i = 0; i < 4; ++i) S[i] = f32x16{};
        float dsum = 0.f;
        const bf16* base = big + (size_t)(b * SEQ + seg * NCH_SEG * CH) * LDB + hh * 128;
        Raw<false> R; load_chunk<false>(R, base, lane, wave);
        for (int ch = 0; ch < NCH_SEG; ++ch) {
            dsum += build_chunk<false>(R, lb, lds, lane, wave);
            __syncthreads();
            if (ch + 1 < NCH_SEG) load_chunk<false>(R, base + (size_t)(ch + 1) * CH * LDB, lane, wave);
            state_update(S, lds, j, c, h);
            __syncthreads();
        }
        if ((lane >> 4) == 0) Dg[(size_t)u * 128 + (lane & 15) + 16 * wave] = dsum;
        if (th == 0) {
            float* E = Eg + (size_t)u * 16384;
#pragma unroll
            for (int i = 0; i < 4; ++i)
#pragma unroll
                for (int r = 0; r < 16; ++r) E[(size_t)(32 * i + crow(r, h)) * 128 + 32 * j + c] = S[i][r];
        }
    }
}
__device__ __forceinline__ void pass_b(bf16* big, bf16* outp, int ldo, const float* __restrict__ lbv, const float* __restrict__ og, const float* __restrict__ Eg, const float* __restrict__ Dg, LAS unsigned char* lds, int lane, int wave) {
    const int j = wave & 3, th = wave >> 2, c = lane & 31, h = lane >> 5, tid = wave * 64 + lane;
    for (int u = blockIdx.x; u < BATCH * NH * NSEG; u += gridDim.x) {
        const int seg = u & 3, hh = (u >> 2) & 7, b = u >> 5;
        const float lb = lbv[hh * 128 + (lane & 15) + 16 * wave];
        f32x16 S[4];
#pragma unroll
        for (int i = 0; i < 4; ++i) S[i] = f32x16{};
        for (int sp = 0; sp < seg; ++sp) {
            const float* E = Eg + (size_t)(u - seg + sp) * 16384; const float* Dp = Dg + (size_t)(u - seg + sp) * 128;
#pragma unroll
            for (int i = 0; i < 4; ++i)
#pragma unroll
                for (int r = 0; r < 16; ++r) { const int d = 32 * i + crow(r, h); S[i][r] = __expf(Dp[d]) * S[i][r] + E[(size_t)d * 128 + 32 * j + c]; }
        }
        const bf16* base = big + ((size_t)b * SEQ + (size_t)seg * NCH_SEG * CH) * LDB + hh * 128;
        Raw<true> R; load_chunk<true>(R, base, lane, wave);
        const int ot = tid >> 3, opart = tid & 7;
        u32x4 gn0, gn1;
        { const bf16* gp = base + (size_t)ot * LDB + 3072 + opart * 16; gn0 = *(const u32x4*)gp; gn1 = *(const u32x4*)(gp + 8); }
        for (int ch = 0; ch < NCH_SEG; ++ch) {
            const size_t row0 = (size_t)b * SEQ + (size_t)(seg * NCH_SEG + ch) * CH;
            (void)build_chunk<true>(R, lb, lds, lane, wave);
            const u32x4 g0 = gn0, g1 = gn1;
            __syncthreads();
            if (ch + 1 < NCH_SEG) { const bf16* nb = base + (size_t)(ch + 1) * CH * LDB; load_chunk<true>(R, nb, lane, wave);
                const bf16* gp = nb + (size_t)ot * LDB + 3072 + opart * 16; gn0 = *(const u32x4*)gp; gn1 = *(const u32x4*)(gp + 8); }
            bf16x8 P[2][2];
#pragma unroll
            for (int sh = 0; sh < 2; ++sh) {
                if (sh <= th) {
                    f32x16 X = f32x16{};
#pragma unroll
                    for (int ks = 0; ks < 8; ++ks) {
                        const bf16x8 a = *(const LAS bf16x8*)(lds + OFF_KR + (32 * sh + c) * RS + (16 * ks + 8 * h) * 2);
                        const bf16x8 bq = *(const LAS bf16x8*)(lds + OFF_QR + (32 * th + c) * RS + (16 * ks + 8 * h) * 2);
                        X = __builtin_amdgcn_mfma_f32_32x32x16_bf16(a, bq, X, 0, 0, 0); }
                    if (sh == th) {
#pragma unroll
                        for (int r = 0; r < 16; ++r) X[r] = crow(r, h) <= c ? X[r] : 0.f; }
                    P[sh][0] = acc_frag(X, 0); P[sh][1] = acc_frag(X, 1);
                } else { P[sh][0] = bf16x8{}; P[sh][1] = bf16x8{}; }
            }
            f32x16 o = f32x16{};
#pragma unroll
            for (int i = 0; i < 4; ++i)
#pragma unroll
                for (int s = 0; s < 2; ++s) {
                    const LAS unsigned char* qa = lds + OFF_QI + (32 * th + c) * RS + (32 * i + 16 * s + 4 * h) * 2;
                    const bf16x8 a = join8(*(const LAS s16x4*)qa, *(const LAS s16x4*)(qa + 16));
                    o = __builtin_amdgcn_mfma_f32_32x32x16_bf16(a, acc_frag(S[i], s), o, 0, 0, 0); }
#pragma unroll
            for (int sh = 0; sh < 2; ++sh) {
                if (sh <= th) {
#pragma unroll
                    for (int s = 0; s < 2; ++s) {
                        const LAS unsigned char* va = lds + OFF_VT + (32 * j + c) * TS + (32 * sh + 16 * s + 4 * h) * 2;
                        const bf16x8 bv = join8(*(const LAS s16x4*)va, *(const LAS s16x4*)(va + 16));
                        o = __builtin_amdgcn_mfma_f32_32x32x16_bf16(P[sh][s], bv, o, 0, 0, 0); } }
            }
            state_update(S, lds, j, c, h);
#pragma unroll
            for (int r = 0; r < 16; ++r) *(LAS float*)(lds + OFF_OST + (32 * th + crow(r, h)) * OST_RS + (32 * j + c) * 4) = o[r];
            __syncthreads();
            {
                const int t = ot, part = opart;
                const LAS f32x4* op = (const LAS f32x4*)(lds + OFF_OST + t * OST_RS + part * 64);
                const f32x4 o0 = op[0], o1 = op[1], o2 = op[2], o3 = op[3];
                float ss = (o0[0] * o0[0] + o0[1] * o0[1]) + (o0[2] * o0[2] + o0[3] * o0[3]) + (o1[0] * o1[0] + o1[1] * o1[1]) + (o1[2] * o1[2] + o1[3] * o1[3])
                         + (o2[0] * o2[0] + o2[1] * o2[1]) + (o2[2] * o2[2] + o2[3] * o2[3]) + (o3[0] * o3[0] + o3[1] * o3[1]) + (o3[2] * o3[2] + o3[3] * o3[3]);
                ss += __shfl_xor(ss, 1); ss += __shfl_xor(ss, 2); ss += __shfl_xor(ss, 4);
                const float rstd = __builtin_amdgcn_rsqf(ss * (1.0f / 128.0f) + 1e-6f);
                bf16* yp = outp + (row0 + t) * ldo + hh * 128 + part * 16;
                const f32x4 w0 = *(const f32x4*)(og + part * 16), w1 = *(const f32x4*)(og + part * 16 + 4), w2 = *(const f32x4*)(og + part * 16 + 8), w3 = *(const f32x4*)(og + part * 16 + 12);
                const unsigned gw[8] = {g0.x, g0.y, g0.z, g0.w, g1.x, g1.y, g1.z, g1.w};
                const float ov[16] = {o0[0], o0[1], o0[2], o0[3], o1[0], o1[1], o1[2], o1[3], o2[0], o2[1], o2[2], o2[3], o3[0], o3[1], o3[2], o3[3]};
                const float wv[16] = {w0[0], w0[1], w0[2], w0[3], w1[0], w1[1], w1[2], w1[3], w2[0], w2[1], w2[2], w2[3], w3[0], w3[1], w3[2], w3[3]};
                unsigned ow[8];
#pragma unroll
                for (int e = 0; e < 8; ++e) { const float ga = __uint_as_float(gw[e] << 16), gb = __uint_as_float(gw[e] & 0xffff0000u);
                    const float ya = ov[2 * e] * rstd * wv[2 * e] * (ga * __builtin_amdgcn_rcpf(1.0f + __expf(-ga)));
                    const float yb = ov[2 * e + 1] * rstd * wv[2 * e + 1] * (gb * __builtin_amdgcn_rcpf(1.0f + __expf(-gb)));
                    ow[e] = pk(ya, yb); }
                *(u32x4*)yp = (u32x4){ow[0], ow[1], ow[2], ow[3]}; *(u32x4*)(yp + 8) = (u32x4){ow[4], ow[5], ow[6], ow[7]};
            }
        }
        __syncthreads();
    }
}
}
#define GAS __attribute__((address_space(1)))
constexpr int NWAVES = 8;
constexpr int RING_OFF = 0, RING_BYTES = 131072;
constexpr int XCH_OFF = 131072;
constexpr int MISC_OFF = 135168;
constexpr int LDS_BYTES = 147456;
constexpr int CW_BAR = 4096;
constexpr int N_PHASES = 25;
static_assert(pg8::STAGE_BYTES == RING_BYTES && XCH_OFF == RING_BYTES, "LDS map");

struct Params { const float* in[15]; float* out; unsigned char* ws; int ph_lo, ph_hi, bar_region, pad; };

#define LDS_WAIT() asm volatile("s_waitcnt lgkmcnt(0)" ::: "memory")
#define VM_WAIT() asm volatile("s_waitcnt vmcnt(0)" ::: "memory")

__device__ __forceinline__ void p0_conv_item(const float* __restrict__ W, const float* __restrict__ gain, int K, int N, bf16* __restrict__ WT, int upperm, LAS float* scr, int item, int lane) {
    const int nblk = N / 32, kb = item / nblk, nb = item % nblk, k0 = 64 * kb, n0 = 32 * nb;
    int src0 = n0;
    if (upperm) { const int pn = n0 >> 8, r = n0 & 255, bj = r >> 7, c = r & 127; src0 = bj * 3072 + 128 * pn + c; }
#pragma unroll 8
    for (int i = 0; i < 32; ++i) { const int kk = 2 * i + (lane >> 5); scr[kk * 33 + (lane & 31)] = W[(size_t)(k0 + kk) * N + src0 + (lane & 31)] * (gain ? gain[k0 + kk] : 1.0f); }
    LDS_WAIT(); asm volatile("" ::: "memory");
    const int c = lane & 7;
#pragma unroll
    for (int j = 0; j < 4; ++j) { const int n = (lane >> 3) + 8 * j; const LAS float* s = scr + (8 * c) * 33 + n;
        u32x4 o; o.x = f2bf(s[0 * 33]) | ((unsigned)f2bf(s[1 * 33]) << 16); o.y = f2bf(s[2 * 33]) | ((unsigned)f2bf(s[3 * 33]) << 16);
        o.z = f2bf(s[4 * 33]) | ((unsigned)f2bf(s[5 * 33]) << 16); o.w = f2bf(s[6 * 33]) | ((unsigned)f2bf(s[7 * 33]) << 16);
        *(u32x4*)(WT + (size_t)(n0 + n) * K + k0 + 8 * c) = o; }
    LDS_WAIT(); asm volatile("" ::: "memory");
}
__device__ __forceinline__ void p0_prologue(const Params& p, LAS unsigned char* lds, int gw, int NGW, int lane, int wave) {
    unsigned char* ws = p.ws;
    LAS float* scr = (LAS float*)(lds + RING_OFF + wave * 16384);
    const float* attn_norm = p.in[1]; const float* ffn_norm = p.in[2];
    constexpr int I_IN = 16 * 128, I_QKV = 16 * 96, I_O = 16 * 32, I_UP = 16 * 192, I_DN = 48 * 32;
    constexpr int NITEMS = 2 * I_IN + 2 * I_QKV + 4 * I_O + 4 * I_UP + 4 * I_DN;
    for (int it = gw; it < NITEMS; it += NGW) {
        int r = it;
        if (r < 2 * I_IN) { const int s = r / I_IN; p0_conv_item(p.in[3] + (size_t)s * 1024 * 4096, attn_norm + (2 * s) * 1024, 1024, 4096, (bf16*)(ws + WS_WIN) + (size_t)s * 4096 * 1024, 0, scr, r % I_IN, lane); continue; } r -= 2 * I_IN;
        if (r < 2 * I_QKV) { const int s = r / I_QKV; p0_conv_item(p.in[7] + (size_t)s * 1024 * 3072, attn_norm + (2 * s + 1) * 1024, 1024, 3072, (bf16*)(ws + WS_WQKV) + (size_t)s * 3072 * 1024, 0, scr, r % I_QKV, lane); continue; } r -= 2 * I_QKV;
        if (r < 2 * I_O) { const int s = r / I_O; p0_conv_item(p.in[6] + (size_t)s * 1024 * 1024, nullptr, 1024, 1024, (bf16*)(ws + WS_WOH) + (size_t)s * 1024 * 1024, 0, scr, r % I_O, lane); continue; } r -= 2 * I_O;
        if (r < 2 * I_O) { const int s = r / I_O; p0_conv_item(p.in[10] + (size_t)s * 1024 * 1024, nullptr, 1024, 1024, (bf16*)(ws + WS_WOM) + (size_t)s * 1024 * 1024, 0, scr, r % I_O, lane); continue; } r -= 2 * I_O;
        if (r < 4 * I_UP) { const int l = r / I_UP; p0_conv_item(p.in[11] + (size_t)l * 1024 * 6144, ffn_norm + l * 1024, 1024, 6144, (bf16*)(ws + WS_WUP) + (size_t)l * 6144 * 1024, 1, scr, r % I_UP, lane); continue; } r -= 4 * I_UP;
        { const int l = r / I_DN; p0_conv_item(p.in[14] + (size_t)l * 3072 * 1024, nullptr, 3072, 1024, (bf16*)(ws + WS_WDN) + (size_t)l * 1024 * 3072, 0, scr, r % I_DN, lane); }
    }
    const float* x = p.in[0]; bf16* xb = (bf16*)(ws + WS_XB); float* ss = (float*)(ws + WS_SS);
    for (int row = gw; row < MROWS; row += NGW) {
        const f32x4* xr = (const f32x4*)(x + (size_t)row * DM); float s = 0.f;
#pragma unroll
        for (int j = 0; j < 4; ++j) { const f32x4 v = xr[lane + 64 * j]; s += (v[0] * v[0] + v[1] * v[1]) + (v[2] * v[2] + v[3] * v[3]);
            unsigned long long w = (unsigned long long)(f2bf(v[0]) | ((unsigned)f2bf(v[1]) << 16)) | ((unsigned long long)(f2bf(v[2]) | ((unsigned)f2bf(v[3]) << 16)) << 32);
            *(unsigned long long*)(xb + (size_t)row * DM + 4 * (lane + 64 * j)) = w; }
        s = wave_sum(s);
        if (lane < 16) ss[(size_t)row * 16 + lane] = lane == 0 ? s : 0.f;
    }
    float* cs = (float*)(ws + WS_COS); float* sn = (float*)(ws + WS_SIN); float* lbv = (float*)(ws + WS_LBV); const float* hgrn_lb = p.in[4];
    for (int idx = gw * 64 + lane; idx < SEQ * 64; idx += NGW * 64) { const int s = idx >> 6, i = idx & 63; const float inv = 1.0f / powf(10000.0f, (float)(2 * i) / 128.0f); const float ang = (float)s * inv; cs[idx] = cosf(ang); sn[idx] = sinf(ang); }
    for (int idx = gw * 64 + lane; idx < 1024; idx += NGW * 64) { const float l0 = hgrn_lb[idx], l1 = hgrn_lb[1024 + idx]; const float mx = fmaxf(l0, l1), e0 = expf(l0 - mx), e1 = expf(l1 - mx); lbv[idx] = 0.f; lbv[1024 + idx] = e1 / (e0 + e1); }
}

__device__ __forceinline__ void kprep_phase(const bf16* qkv, bf16* qdst, bf16* kdst, int ldd, const float* __restrict__ qg, const float* __restrict__ kg, const float* __restrict__ cs, const float* __restrict__ sn, float* __restrict__ kmean,
                                            LAS unsigned char* lds, int lane, int wave) {
    const int tidk = wave * 64 + lane;
    LAS float* red = (LAS float*)(lds + RING_OFF);
    for (int u = blockIdx.x; u < 2 * BATCH * NH * NBLK; u += gridDim.x) {
        const int which = u & 1, j = (u >> 1) & 15, h = (u >> 5) & 7, b = u >> 8;
        const float* g = which ? kg : qg; const float g1 = g[lane], g2 = g[lane + 64];
        float a1 = 0.f, a2 = 0.f;
        for (int rr = 0; rr < 32; ++rr) {
            const int pos = j * MBLK + wave * 32 + rr;
            const bf16* pp = qkv + (size_t)(b * SEQ + pos) * 3072 + which * 1024 + h * 128; bf16* dp = (which ? kdst : qdst) + (size_t)(b * SEQ + pos) * ldd + h * 128;
            const float x1 = bf2f(pp[lane]), x2 = bf2f(pp[lane + 64]);
            const float r = rsqrtf(wave_sum(x1 * x1 + x2 * x2) * (1.0f / 128.0f) + 1e-6f);
            const float y1 = x1 * r * g1, y2 = x2 * r * g2;
            const float c = cs[pos * 64 + lane], s = sn[pos * 64 + lane];
            float o1 = y1 * c - y2 * s, o2 = y2 * c + y1 * s;
            if (!which) { o1 *= QSCALE; o2 *= QSCALE; }
            a1 += o1; a2 += o2;
            dp[lane] = f2bf(o1); dp[lane + 64] = f2bf(o2);
        }
        if (which) {
            red[wave * 128 + lane] = a1; red[wave * 128 + 64 + lane] = a2;
            __syncthreads();
            if (tidk < 128) { float s = 0.f;
#pragma unroll
                for (int w = 0; w < 8; ++w) s += red[w * 128 + tidk];
                kmean[((size_t)(b * 8 + h) * 16 + j) * 128 + tidk] = s * (1.0f / 256.0f); }
            __syncthreads();
        }
    }
}

__device__ __forceinline__ void hg_naive_phase(bf16* __restrict__ big, const float* __restrict__ lbv, const float* __restrict__ og, LAS unsigned char* lds, const int tid) {
    LAS float* sq = (LAS float*)(lds + RING_OFF); LAS float* sf = sq + 128; LAS float* sk = sq + 256; LAS float* red = sq + 384;
    for (int u = blockIdx.x; u < BATCH * NH; u += gridDim.x) {
        const int b = u >> 3, h = u & 7;
        float S[128];
#pragma unroll
        for (int d = 0; d < 128; ++d) S[d] = 0.f;
        const float lb = tid < 128 ? lbv[h * 128 + tid] : 0.f, gain = tid < 128 ? og[tid] : 0.f;
        for (int t = 0; t < SEQ; ++t) {
            bf16* r = big + (size_t)(b * SEQ + t) * 4096 + h * 128 + (tid & 127);
            float q = 0.f, vv = 0.f, gg = 0.f;
            if (tid < 128) { q = bf2f(r[0]) * QSCALE; const float z = bf2f(r[1024]); vv = bf2f(r[2048]); gg = bf2f(r[3072]);
                const float sg = 1.0f / (1.0f + expf(-z)); const float f = lb + (1.0f - lb) * sg; const float k = (1.0f - lb) * (1.0f - sg);
                sq[tid] = q; sf[tid] = f; sk[tid] = k; }
            __syncthreads();
            float o = 0.f;
            if (tid < 128) {
#pragma unroll
                for (int d = 0; d < 128; ++d) { S[d] = sf[d] * S[d] + sk[d] * vv; o += sq[d] * S[d]; }
                const float w = wave_sum(o * o);
                if ((tid & 63) == 0) red[tid >> 6] = w; }
            __syncthreads();
            if (tid < 128) { const float tot = red[0] + red[1];
                const float on = o * rsqrtf(tot * (1.0f / 128.0f) + 1e-6f) * gain;
                r[3072] = f2bf(on * (gg / (1.0f + expf(-gg)))); }
        }
    }
}
__device__ __forceinline__ void attn_naive_phase(bf16* __restrict__ qkv, const float* __restrict__ kmean, LAS unsigned char* lds, int lane, int wave) {
    LAS float* sq = (LAS float*)(lds + RING_OFF) + wave * 128;
    LAS float* sp = (LAS float*)(lds + RING_OFF + 4096) + wave * 1024;
    for (long it0 = (long)blockIdx.x * 8; it0 < (long)MROWS * 8; it0 += (long)gridDim.x * 8) {
        const long item = it0 + wave; const int h = (int)(item & 7); const long row = item >> 3; const int b = (int)(row >> 12), s = (int)(row & (SEQ - 1)), i = s >> 8;
        bf16* qp = qkv + row * 3072 + h * 128;
        __syncthreads();
        sq[lane] = bf2f(qp[lane]); sq[lane + 64] = bf2f(qp[lane + 64]);
        __syncthreads();
        float gv = -INFINITY;
        if (lane < i) { const float* km = kmean + ((size_t)(b * 8 + h) * 16 + lane) * 128; float a = 0.f; for (int d = 0; d < 128; ++d) a += km[d] * sq[d]; gv = a; }
        const int nsel = i < 3 ? i : 3; int s0 = i, s1 = i, s2 = i;
#pragma unroll
        for (int n = 0; n < 3; ++n) {
            if (n < nsel) { const float m = wave_max(gv); const unsigned long long bal = __ballot(gv == m); const int idx = __ffsll((long long)bal) - 1; if (n == 0) s0 = idx; else if (n == 1) s1 = idx; else s2 = idx; if (lane == idx) gv = -INFINITY; } }
#define PICKB(bi) ((bi) == 0 ? s0 : (bi) == 1 ? s1 : (bi) == 2 ? s2 : i)
        float mx = -INFINITY;
        for (int bi = 0; bi <= nsel; ++bi) { const int kb = PICKB(bi) * MBLK;
            for (int c = 0; c < 4; ++c) { const int key = kb + c * 64 + lane;
                const bf16* kp = qkv + (size_t)(b * SEQ + key) * 3072 + 1024 + h * 128; float a = 0.f;
                for (int d8 = 0; d8 < 16; ++d8) { const u32x4 w = *(const u32x4*)(kp + d8 * 8);
                    const unsigned ww[4] = {w.x, w.y, w.z, w.w};
#pragma unroll
                    for (int e = 0; e < 4; ++e) { a += __uint_as_float(ww[e] << 16) * sq[d8 * 8 + 2 * e]; a += __uint_as_float(ww[e] & 0xffff0000u) * sq[d8 * 8 + 2 * e + 1]; } }
                if (bi == nsel && key > s) a = -INFINITY;
                sp[bi * 256 + c * 64 + lane] = a; mx = fmaxf(mx, a); } }
        mx = wave_max(mx);
        float l = 0.f;
        for (int e = lane; e < (nsel + 1) * 256; e += 64) { const float pr = __expf(sp[e] - mx); sp[e] = pr; l += pr; }
        l = wave_sum(l);
        __syncthreads();
        float o0 = 0.f, o1 = 0.f;
        for (int bi = 0; bi <= nsel; ++bi) { const bf16* vp = qkv + (size_t)(b * SEQ + PICKB(bi) * MBLK) * 3072 + 2048 + h * 128 + lane;
            for (int kk = 0; kk < 256; ++kk) { const float pr = sp[bi * 256 + kk]; o0 += pr * bf2f(vp[(size_t)kk * 3072]); o1 += pr * bf2f(vp[(size_t)kk * 3072 + 64]); } }
#undef PICKB
        const float il = 1.0f / l;
        qp[lane] = f2bf(o0 * il); qp[lane + 64] = f2bf(o1 * il);
    }
}

__global__ void __launch_bounds__(NWAVES * 64, 2) mega_fwd(Params p) {
    extern __shared__ __attribute__((aligned(16))) unsigned char lds_raw[];
    LAS unsigned char* lds = (LAS unsigned char*)lds_raw;
    const int G = gridDim.x;
    unsigned char* ws = p.ws;
    for (int u = threadIdx.x; u < (LDS_BYTES - MISC_OFF) / 4; u += NWAVES * 64) ((LAS unsigned*)(lds + MISC_OFF))[u] = 0u;
    __syncthreads();
#define PHASE_IDS() int tid = threadIdx.x; asm volatile("" : "+v"(tid)); const int lane = tid & 63, wave = __builtin_amdgcn_readfirstlane(tid >> 6); (void)lane; (void)wave
    const int lo = p.ph_lo, hi = p.ph_hi;
    XcdBarrier bar; bar.bar = (unsigned*)(ws + WS_CTL) + CW_BAR + p.bar_region * XCD_BAR_WORDS; bar.x = 0; bar.st = nullptr;
    if (hi - lo > 1) bar = xcd_barrier_post((unsigned*)(ws + WS_CTL) + CW_BAR + p.bar_region * XCD_BAR_WORDS, (volatile LAS unsigned*)(lds + MISC_OFF));
#define IN(k) (lo <= (k) && (k) < hi)
#define SEAM(k) do { if (IN(k) && IN((k) + 1)) xcd_barrier(bar); } while (0)
#define PHASE_ENV() PHASE_IDS(); const __attribute__((address_space(4))) Params* pp = (const __attribute__((address_space(4))) Params*)__builtin_amdgcn_kernarg_segment_ptr(); asm volatile("" : "+s"(pp)); \
    unsigned char* ws = pp->ws; float* out = pp->out; bf16* XB = (bf16*)(ws + WS_XB); bf16* BIG = (bf16*)(ws + WS_BIG); float* SS = (float*)(ws + WS_SS); \
    const float* COS = (const float*)(ws + WS_COS); const float* SIN = (const float*)(ws + WS_SIN); const float* LBV = (const float*)(ws + WS_LBV); float* KMEAN = (float*)(ws + WS_KMEAN); \
    float* TAIL = (float*)(ws + WS_TAIL); float* HEADA = (float*)(ws + WS_HEADA); float* HEADU = (float*)(ws + WS_HEADU); \
    (void)out; (void)XB; (void)BIG; (void)SS; (void)COS; (void)SIN; (void)LBV; (void)KMEAN; (void)TAIL; (void)HEADA; (void)HEADU

    if (IN(0)) { PHASE_IDS(); p0_prologue(p, lds, blockIdx.x * NWAVES + wave, G * NWAVES, lane, wave);
#if PROBE_DUP & 8
        __syncthreads(); p0_prologue(p, lds, blockIdx.x * NWAVES + wave, G * NWAVES, lane, wave);
#endif
    }
    SEAM(0);
    for (int l = 0; l < DEPTH; ++l) {
        const int pb = 1 + 6 * l, slot = l >> 1; const bool moba = (l & 1) != 0;
        if (IN(pb)) { PHASE_ENV();
            const int N = moba ? 3072 : 4096;
            const bf16* Bt = moba ? (const bf16*)(ws + WS_WQKV) + (size_t)slot * 3072 * 1024 : (const bf16*)(ws + WS_WIN) + (size_t)slot * 4096 * 1024;
            pg8::Gemm g{XB, Bt, MROWS, N, 1024, 1024}; pg8::StaticOrder S; S.init(MROWS, N, G, (int)blockIdx.x);
            pg8::EpiRowScale E{BIG, SS, N, 0};
            pg8::gemm_phase<pg8::EpiRowScale, pg8::StaticOrder, true, true>(lds + RING_OFF, g, S, E);
#if PROBE_DUP & 1
            __syncthreads(); pg8::gemm_phase<pg8::EpiRowScale, pg8::StaticOrder, true, true>(lds + RING_OFF, g, S, E);
#endif
        }
        SEAM(pb);
        if (moba) {
            if (IN(pb + 1)) { PHASE_ENV();
#if PROBE_DUP & 64
                kprep_phase(BIG, XB, (bf16*)(ws + WS_AU), 1024, pp->in[8] + slot * 128, pp->in[9] + slot * 128, COS, SIN, KMEAN, lds, lane, wave);
#endif
                kprep_phase(BIG, BIG, BIG + 1024, 3072, pp->in[8] + slot * 128, pp->in[9] + slot * 128, COS, SIN, KMEAN, lds, lane, wave); }
            SEAM(pb + 1);
#if defined(NAIVE_ATTN)
            if (IN(pb + 2)) { PHASE_ENV(); attn_naive_phase(BIG, KMEAN, lds, lane, wave); }
#elif !defined(NO_ATTN)
            if (IN(pb + 2)) { PHASE_ENV();
                mb::attn_phase(BIG, KMEAN, BIG, 3072, (char*)lds_raw, tid); }
#endif
            SEAM(pb + 2);
        } else {
#if defined(NAIVE_HG)
            SEAM(pb + 1);
            if (IN(pb + 2)) { PHASE_ENV(); hg_naive_phase(BIG, LBV + slot * 1024, pp->in[5] + slot * 128, lds, tid); }
#elif !defined(NO_HG)
            if (IN(pb + 1)) { PHASE_ENV();
#if PROBE_DUP & 4
                hg::pass_a(BIG, LBV + slot * 1024, (float*)(ws + WS_HGE), (float*)(ws + WS_HGD), lds, lane, wave);
#endif
                hg::pass_a(BIG, LBV + slot * 1024, (float*)(ws + WS_HGE), (float*)(ws + WS_HGD), lds, lane, wave); }
            SEAM(pb + 1);
            if (IN(pb + 2)) { PHASE_ENV();
#if PROBE_DUP & 32
                hg::pass_b(BIG, XB, 1024, LBV + slot * 1024, pp->in[5] + slot * 128, (const float*)(ws + WS_HGE), (const float*)(ws + WS_HGD), lds, lane, wave);
#endif
                hg::pass_b(BIG, BIG + 3072, 4096, LBV + slot * 1024, pp->in[5] + slot * 128, (const float*)(ws + WS_HGE), (const float*)(ws + WS_HGD), lds, lane, wave); }
#endif
            SEAM(pb + 2);
        }
        if (IN(pb + 3)) { PHASE_ENV();
            const bf16* A = moba ? BIG : BIG + 3072; const int lda = moba ? 3072 : 4096;
            const bf16* Bt = moba ? (const bf16*)(ws + WS_WOM) + (size_t)slot * 1024 * 1024 : (const bf16*)(ws + WS_WOH) + (size_t)slot * 1024 * 1024;
            pg8::Gemm g{A, Bt, MROWS, 1024, 1024, lda}; pg8::StaticOrder S; S.init(MROWS, 1024, G, (int)blockIdx.x);
            pg8::EpiResid E{l == 0 ? pp->in[0] : nullptr, nullptr, XB, SS};
            pg8::gemm_phase<pg8::EpiResid, pg8::StaticOrder, true, true>(lds + RING_OFF, g, S, E);
        }
        SEAM(pb + 3);
#ifndef NO_GLU
        if (IN(pb + 4)) { PHASE_ENV();
            const float* cw = pp->in[12] + (size_t)l * 3 * FF; const float* cb = pp->in[13] + (size_t)l * FF;
            pg8::Gemm g{XB, (const bf16*)(ws + WS_WUP) + (size_t)l * 6144 * 1024, MROWS, 6144, 1024, 1024}; pg8::StaticOrder S; S.init(MROWS, 6144, G, (int)blockIdx.x);
            pg8::EpiGLU E{BIG, SS, cw, cb, TAIL, HEADA, HEADU};
            pg8::gemm_phase<pg8::EpiGLU, pg8::StaticOrder, true, true>(lds + RING_OFF, g, S, E);
#if PROBE_DUP & 2
            __syncthreads(); pg8::gemm_phase<pg8::EpiGLU, pg8::StaticOrder, true, true>(lds + RING_OFF, g, S, E);
#endif
        }
#endif
        SEAM(pb + 4);
        if (IN(pb + 5)) { PHASE_ENV();
            const float* cw = pp->in[12] + (size_t)l * 3 * FF; const float* cb = pp->in[13] + (size_t)l * FF;
            pg8::Gemm g{BIG, (const bf16*)(ws + WS_WDN) + (size_t)l * 1024 * 3072, MROWS, 1024, 3072, 3072}; pg8::StaticOrder S; S.init(MROWS, 1024, G, (int)blockIdx.x);
            pg8::Unit u;
            for (int i = 0; S.next(i, u); ++i)
                for (int e = tid; e < 2 * FF; e += NWAVES * 64) glu_fixup_elem(u.pm, e / FF, e % FF, BIG, TAIL, HEADA, HEADU, cw, cb);
            VM_WAIT(); __syncthreads();
            pg8::EpiResid E{nullptr, l == DEPTH - 1 ? out : nullptr, XB, SS};
            pg8::gemm_phase<pg8::EpiResid, pg8::StaticOrder, true, true>(lds + RING_OFF, g, S, E);
        }
        if (l < DEPTH - 1) SEAM(pb + 5);
    }
#undef IN
#undef SEAM
}

#ifndef MK_PER_PHASE
#define MK_PER_PHASE 0
#endif
extern "C" void kernel_launch(void* const* d_in, const int* in_sizes, int n_in, void* d_out, int out_size, void* d_ws, size_t ws_size, hipStream_t stream) {
    static int grid = 0;
    if (grid == 0) {
        if (n_in != 15 || in_sizes[0] != MROWS * DM || out_size != MROWS * DM || ws_size < WS_END) {
            fprintf(stderr, "kernel_launch: unexpected shapes (n_in %d, in0 %d, out %d, ws %zu < %zu); nothing launched\n", n_in, n_in > 0 ? in_sizes[0] : -1, out_size, ws_size, (size_t)WS_END); grid = -1; return; }
        int dev = 0, cus = 0, per_cu = 0;
        if (hipGetDevice(&dev) != hipSuccess || hipDeviceGetAttribute(&cus, hipDeviceAttributeMultiprocessorCount, dev) != hipSuccess || cus <= 0) { fprintf(stderr, "kernel_launch: no device attributes\n"); grid = -1; return; }
        if (hipFuncSetAttribute((const void*)mega_fwd, hipFuncAttributeMaxDynamicSharedMemorySize, LDS_BYTES) != hipSuccess) { fprintf(stderr, "kernel_launch: hipFuncSetAttribute failed\n"); grid = -1; return; }
        if (hipOccupancyMaxActiveBlocksPerMultiprocessor(&per_cu, (const void*)mega_fwd, NWAVES * 64, LDS_BYTES) != hipSuccess || per_cu < 1)
            fprintf(stderr, "kernel_launch: note: occupancy query reports %d workgroups per CU; launching one per CU (144 KiB LDS each admits exactly one)\n", per_cu);
        (void)hipGetLastError();
        grid = cus;
    }
    if (grid < 0) return;
    (void)hipMemsetAsync((char*)d_ws + WS_CTL, 0, CTL_ZERO_BYTES, stream);
    Params p{};
    for (int i = 0; i < 15; ++i) p.in[i] = (const float*)d_in[i];
    p.out = (float*)d_out; p.ws = (unsigned char*)d_ws;
#if MK_PER_PHASE
    for (int k = 0; k < N_PHASES; ++k) { p.ph_lo = k; p.ph_hi = k + 1; p.bar_region = 0; hipLaunchKernelGGL(mega_fwd, dim3(grid), dim3(NWAVES * 64), LDS_BYTES, stream, p); }
#else
    p.ph_lo = 0; p.ph_hi = N_PHASES; p.bar_region = 0;
    hipLaunchKernelGGL(mega_fwd, dim3(grid), dim3(NWAVES * 64), LDS_BYTES, stream, p);
#endif
}
```

```cpp
#define PG8_PRE 1
#define PG8_RESID_PF 0
#define PG8_PF_DIST 4
#include <hip/hip_runtime.h>
#include <cstdio>
#include <cstdint>
#include <cmath>
namespace pg8 {
#define PG8_LAS __attribute__((address_space(3)))
typedef unsigned short bf16_t;
typedef short bf16x8 __attribute__((ext_vector_type(8)));
typedef float f32x4 __attribute__((ext_vector_type(4)));
typedef unsigned u32x4 __attribute__((ext_vector_type(4)));
constexpr int BM = 256, BK = 64, HALF = 128, HTB = HALF * BK * 2  , STAGE_BYTES = 8 * HTB, NXCD = 8, WGM = 8;

__host__ __device__ __forceinline__ int lds_byte(int r, int c) { const int st = (r >> 4) * 2 + (c >> 5), rr = r & 15, cc = c & 31, ob = rr * 64 + cc * 2; return st * 1024 + (ob ^ (((ob >> 9) & 1) << 5)); }
__host__ __device__ __forceinline__ void stage_rc(int b, int& R, int& C) { const int st = b / 1024, sb = b % 1024, swz = sb ^ (((sb >> 9) & 1) << 5); R = (st >> 1) * 16 + swz / 64; C = (st & 1) * 32 + (swz % 64) / 2; }
__host__ __device__ __forceinline__ int perm32(int rho) { const int n = rho >> 4, i = rho & 15; return 8 * (i >> 2) + 4 * n + (i & 3); }

struct Unit { int pm, pn; };
struct Gemm { const bf16_t* A; const bf16_t* Bt; int M, N, K, lda; };

struct StaticOrder {
    int nM, nN, nwg, G, c;
    __host__ __device__ __forceinline__ void init(int M, int N, int G_, int c_) { nM = M / BM; nN = N / BM; nwg = nM * nN; G = G_; c = c_; }
    __host__ __device__ __forceinline__ bool next(int i, Unit& u) const {
        const long L = (long)i * G + c; if (L >= nwg) return false;
        int wgid = (int)L; { const int q = nwg / NXCD, r = nwg % NXCD, xcd = wgid % NXCD, off = wgid / NXCD; wgid = (xcd < r ? xcd * (q + 1) : r * (q + 1) + (xcd - r) * q) + off; }
        const int nig = WGM * nN, gid = wgid / nig, fm = gid * WGM, gsz = (nM - fm) < WGM ? (nM - fm) : WGM;
        u.pm = fm + ((wgid % nig) % gsz); u.pn = (wgid % nig) / gsz; return true;
    }
    __device__ __forceinline__ void a_ready(const Unit&) const {}
    __device__ __forceinline__ void done(const Unit&) const {}
};

__device__ __forceinline__ unsigned cvt_pk_bf16(float lo, float hi) { unsigned r; asm volatile("v_cvt_pk_bf16_f32 %0, %1, %2" : "=v"(r) : "v"(lo), "v"(hi)); return r; }
typedef float f32x2 __attribute__((ext_vector_type(2)));
constexpr int SS_M = 32768;
struct RstdTab { int p0, p1, ok; };
constexpr int RSTD_TAB_OFF = STAGE_BYTES + 6144;
template <class Sched>
__device__ __forceinline__ RstdTab rstd_tab_build(PG8_LAS unsigned char* lds, const Sched& S, const float* ss, int tid) {
    RstdTab T; T.p0 = -1; T.p1 = -1; T.ok = 1; Unit u;
    for (int i = 0; S.next(i, u); ++i) { if (T.p0 < 0) T.p0 = u.pm; else if (u.pm != T.p0) { if (T.p1 < 0) T.p1 = u.pm; else if (u.pm != T.p1) T.ok = 0; } }
    if (T.ok) { const int slot = tid >> 8, row = tid & 255, pm = slot ? T.p1 : T.p0;
        if (pm >= 0) { const float* sp = ss + (size_t)pm * BM + row; float a[4], b[4], c[4], d[4];
#pragma unroll
            for (int k = 0; k < 4; ++k) { a[k] = sp[(size_t)k * SS_M]; b[k] = sp[(size_t)(4 + k) * SS_M]; c[k] = sp[(size_t)(8 + k) * SS_M]; d[k] = sp[(size_t)(12 + k) * SS_M]; }
            const float s = (((a[0] + a[1]) + (a[2] + a[3])) + ((b[0] + b[1]) + (b[2] + b[3]))) + (((c[0] + c[1]) + (c[2] + c[3])) + ((d[0] + d[1]) + (d[2] + d[3])));
            ((PG8_LAS float*)(lds + RSTD_TAB_OFF))[slot * BM + row] = __builtin_amdgcn_rsqf(s * (1.0f / 1024.0f) + 1e-6f); } }
    asm volatile("s_waitcnt lgkmcnt(0)" ::: "memory"); __builtin_amdgcn_s_barrier(); asm volatile("" ::: "memory");
    return T;
}
template <bool APERM = false> __device__ __forceinline__ void row_rstd8_tab(float (&rs)[2][4], PG8_LAS unsigned char* lds, const RstdTab& tab, int pm, int rt0, int fr4) {
    const PG8_LAS float* T = (const PG8_LAS float*)(lds + RSTD_TAB_OFF) + (pm == tab.p0 ? 0 : BM);
#pragma unroll
    for (int ai = 0; ai < 2; ++ai)
#pragma unroll
        for (int m = 0; m < 4; ++m) rs[ai][m] = T[rt0 + ai * HALF + (APERM ? fr4 + m : m * 16)];
}
template <bool APERM = false> __device__ __forceinline__ void row_rstd8(float (&rs)[2][4], const float* ss, int row0, int fq, int fr4 = 0) {
    f32x4 a[2][4];
#pragma unroll
    for (int ai = 0; ai < 2; ++ai)
#pragma unroll
        for (int m = 0; m < 4; ++m)
#pragma unroll
            for (int k = 0; k < 4; ++k) a[ai][m][k] = ss[(size_t)(4 * fq + k) * SS_M + (row0 + ai * HALF + (APERM ? fr4 + m : m * 16))];
#pragma unroll
    for (int ai = 0; ai < 2; ++ai)
#pragma unroll
        for (int m = 0; m < 4; ++m) { float s = (a[ai][m][0] + a[ai][m][1]) + (a[ai][m][2] + a[ai][m][3]);
            s += __shfl_xor(s, 16); s += __shfl_xor(s, 32);
            rs[ai][m] = __builtin_amdgcn_rsqf(s * (1.0f / 1024.0f) + 1e-6f); }
}
constexpr int MROWS_HM = 32768;
struct EpiRowScale {
    static constexpr bool PERM = true, AFTER_DRAIN = false, APERM = false; static constexpr int NST = 16; static constexpr bool PF = false;
    bf16_t* O; const float* ss; int ldc, pad; RstdTab tab;
    __device__ __forceinline__ void operator()(f32x4 (&acc)[2][2][4][2], const Unit& u, int wr, int wc, int fr, int fq, PG8_LAS unsigned char* lds) const {
        if (pad) asm volatile("s_waitcnt vmcnt(0)" ::: "memory");
        if (pad == 1) return;
        asm volatile("" : "+v"(fr), "+v"(fq));
        const int row0 = u.pm * BM + wr * 64 + fr; const int col0 = u.pn * BM + wc * 32 + 8 * fq;
        float rs8[2][4]; if (tab.ok) row_rstd8_tab(rs8, lds, tab, u.pm, wr * 64 + fr, 0); else row_rstd8(rs8, ss, row0, fq);
#pragma unroll
        for (int ai = 0; ai < 2; ++ai)
#pragma unroll
            for (int m = 0; m < 4; ++m) { const int row = row0 + ai * HALF + m * 16; const float rs = rs8[ai][m];
                bf16_t* rowp = ldc ? O + (size_t)row * ldc + col0
                                   : (u.pn < 12 ? O + ((((size_t)(row >> 12) * 8 + 2 * (u.pn & 3)) * 3 + (u.pn >> 2)) * 4096 + (row & 4095)) * 128 + wc * 32 + 8 * fq
                                                : O + (size_t)3 * MROWS_HM * 1024 + (size_t)row * 1024 + (u.pn - 12) * BM + wc * 32 + 8 * fq);
                const size_t bjstep = ldc ? (size_t)HALF : (u.pn < 12 ? (size_t)3 * 4096 * 128 : (size_t)HALF);
#pragma unroll
                for (int bj = 0; bj < 2; ++bj) { const f32x4 v0 = acc[ai][bj][m][0] * rs, v1 = acc[ai][bj][m][1] * rs;
                    u32x4 w; w.x = cvt_pk_bf16(v0[0], v0[1]); w.y = cvt_pk_bf16(v0[2], v0[3]); w.z = cvt_pk_bf16(v1[0], v1[1]); w.w = cvt_pk_bf16(v1[2], v1[3]);
                    if (pad != 2) *(u32x4*)(rowp + bj * bjstep) = w; } }
    }
};
typedef unsigned u32x2 __attribute__((ext_vector_type(2)));
template <int SITE  > struct EpiResid {
    static constexpr bool PERM = true, AFTER_DRAIN = false, APERM = false; static constexpr int NST = 16; static constexpr bool PF = PG8_RESID_PF;
    const float* base32; float* out; bf16_t* xb; float* ss; bf16_t* xbw; float* ssw; int dry, pad;
    template <bool F32IN, bool F32OUT>
    __device__ __forceinline__ void run(f32x4 (&acc)[2][2][4][2], const Unit& u, int wr, int wc, int fr, int fq) const {
        asm volatile("" : "+v"(fr), "+v"(fq));
        const int col0 = u.pn * BM + wc * 32 + 8 * fq;
#pragma unroll
        for (int ai = 0; ai < 2; ++ai) {
            const size_t off0 = (size_t)(u.pm * BM + ai * HALF + wr * 64 + fr) * 1024 + col0;
            f32x4 bf[F32IN ? 4 : 1][2][2]; u32x4 bh[F32IN ? 1 : 4][2];
#pragma unroll
            for (int m = 0; m < 4; ++m)
#pragma unroll
                for (int bj = 0; bj < 2; ++bj) { const size_t off = off0 + (size_t)m * 16 * 1024 + bj * HALF;
                    if (F32IN) { bf[F32IN ? m : 0][bj][0] = *(const f32x4*)(base32 + off); bf[F32IN ? m : 0][bj][1] = *(const f32x4*)(base32 + off + 4); }
                    else bh[F32IN ? 0 : m][bj] = dry == 2 ? (u32x4){0u, 0u, 0u, 0u} : *(const u32x4*)(xb + off); }
#pragma unroll
            for (int m = 0; m < 4; ++m) { float s = 0.f;
#pragma unroll
                for (int bj = 0; bj < 2; ++bj) { const size_t off = off0 + (size_t)m * 16 * 1024 + bj * HALF; f32x4 b0, b1;
                    if (F32IN) { b0 = bf[F32IN ? m : 0][bj][0]; b1 = bf[F32IN ? m : 0][bj][1]; }
                    else { const u32x4 r = bh[F32IN ? 0 : m][bj];
                        b0 = (f32x4){__uint_as_float(r.x << 16), __uint_as_float(r.x & 0xffff0000u), __uint_as_float(r.y << 16), __uint_as_float(r.y & 0xffff0000u)};
                        b1 = (f32x4){__uint_as_float(r.z << 16), __uint_as_float(r.z & 0xffff0000u), __uint_as_float(r.w << 16), __uint_as_float(r.w & 0xffff0000u)}; }
                    const f32x4 o0 = b0 + acc[ai][bj][m][0], o1 = b1 + acc[ai][bj][m][1];
                    if (F32OUT) { *(f32x4*)(out + off) = o0; *(f32x4*)(out + off + 4) = o1; }
                    s += ((o0[0] * o0[0] + o0[1] * o0[1]) + (o0[2] * o0[2] + o0[3] * o0[3])) + ((o1[0] * o1[0] + o1[1] * o1[1]) + (o1[2] * o1[2] + o1[3] * o1[3]));
                    u32x4 w; w.x = cvt_pk_bf16(o0[0], o0[1]); w.y = cvt_pk_bf16(o0[2], o0[3]); w.z = cvt_pk_bf16(o1[0], o1[1]); w.w = cvt_pk_bf16(o1[2], o1[3]); if (dry != 4 && dry != 6) *(u32x4*)(xbw + off) = w; }
                s += __shfl_xor(s, 16); s += __shfl_xor(s, 32);
                if (fq == 0 && dry != 3 && dry != 7) ssw[(size_t)(u.pn * 4 + wc) * SS_M + (u.pm * BM + ai * HALF + wr * 64 + m * 16 + fr)] = s; }
        }
    }
    __device__ __forceinline__ void prefetch(const Unit& u, int tid, int wid, PG8_LAS unsigned char* lds) const {
        if (base32 != nullptr || dry == 1 || dry == 2) return;
#pragma unroll
        for (int i = 0; i < 2; ++i) { const int L = tid + i * 512;
            __builtin_amdgcn_global_load_lds((const unsigned*)(xb + (size_t)(u.pm * BM + (L >> 2)) * 1024 + u.pn * BM + (L & 3) * 64), (PG8_LAS unsigned*)(lds + STAGE_BYTES + wid * 256), 4, 0, 0); }
    }
    __device__ __forceinline__ void operator()(f32x4 (&acc)[2][2][4][2], const Unit& u, int wr, int wc, int fr, int fq, PG8_LAS unsigned char* lds) const {
        if (dry) asm volatile("s_waitcnt vmcnt(0)" ::: "memory");
        if (dry == 1) return;
        if (dry >= 5) {
#pragma unroll
            for (int a = 0; a < 2; ++a)
#pragma unroll
                for (int b = 0; b < 2; ++b)
#pragma unroll
                    for (int m = 0; m < 4; ++m)
#pragma unroll
                        for (int n = 0; n < 2; ++n) acc[a][b][m][n] = (f32x4){0.f, 0.f, 0.f, 0.f}; }
        if (SITE == 0) { if (base32) run<true, false>(acc, u, wr, wc, fr, fq); else run<false, false>(acc, u, wr, wc, fr, fq); }
        else { if (out) run<false, true>(acc, u, wr, wc, fr, fq); else run<false, false>(acc, u, wr, wc, fr, fq); }
    }
};
template <int CTRL> __device__ __forceinline__ float dpp_mov(float old, float src) {
    return __builtin_bit_cast(float, __builtin_amdgcn_update_dpp(__builtin_bit_cast(int, old), __builtin_bit_cast(int, src), CTRL, 0xf, 0xf, false)); }
__device__ __forceinline__ float silu_f(float c) { return c * __builtin_amdgcn_rcpf(1.0f + __expf(-c)); }
struct EpiGLU {
    static constexpr bool PERM = true, AFTER_DRAIN = false, APERM = true; static constexpr int NST = 20; static constexpr bool PF = false;
    bf16_t* G; const float* ss; const float* cw; const float* cb; float* tail; float* head_a; float* head_u; int dry, pad; RstdTab tab;
    __device__ __forceinline__ void operator()(f32x4 (&acc)[2][2][4][2], const Unit& u, int wr, int wc, int fr, int fq, PG8_LAS unsigned char* lds) const {
        if (dry) asm volatile("s_waitcnt vmcnt(0)" ::: "memory");
        if (dry == 1) { __builtin_amdgcn_s_barrier(); return; }
        asm volatile("" : "+v"(fr), "+v"(fq));
        const int f0 = u.pn * 128 + wc * 32 + 8 * fq;
        PG8_LAS float* X = (PG8_LAS float*)(lds + STAGE_BYTES);
        f32x4 w0 = *(const f32x4*)(cw + f0), w1 = *(const f32x4*)(cw + 3072 + f0), w2 = *(const f32x4*)(cw + 6144 + f0), bb = *(const f32x4*)(cb + f0);
        const f32x4 v0 = *(const f32x4*)(cw + f0 + 4), v1 = *(const f32x4*)(cw + 3072 + f0 + 4), v2 = *(const f32x4*)(cw + 6144 + f0 + 4), vb = *(const f32x4*)(cb + f0 + 4);
        { float rs8[2][4]; if (tab.ok) row_rstd8_tab<true>(rs8, lds, tab, u.pm, wr * 64, 4 * fr); else row_rstd8<true>(rs8, ss, u.pm * BM + wr * 64, fq, 4 * fr);
#pragma unroll
          for (int ai = 0; ai < 2; ++ai)
#pragma unroll
            for (int m = 0; m < 4; ++m) {
#pragma unroll
                for (int bj = 0; bj < 2; ++bj)
#pragma unroll
                    for (int n = 0; n < 2; ++n) acc[ai][bj][m][n] = acc[ai][bj][m][n] * rs8[ai][m]; } }
        if (fr == 15) {
#pragma unroll
            for (int ai = 0; ai < 2; ++ai)
#pragma unroll
                for (int n = 0; n < 2; ++n) { *(PG8_LAS f32x4*)(X + ((((ai * 2 + wr) * 4 + wc) * 2 + 0) * 32 + 8 * fq + 4 * n)) = acc[ai][0][2][n]; *(PG8_LAS f32x4*)(X + ((((ai * 2 + wr) * 4 + wc) * 2 + 1) * 32 + 8 * fq + 4 * n)) = acc[ai][0][3][n]; }
        }
        asm volatile("s_waitcnt lgkmcnt(0)" ::: "memory"); __builtin_amdgcn_s_barrier(); asm volatile("" ::: "memory");
#pragma unroll
        for (int ai = 0; ai < 2; ++ai) {
            const int blk = ai * 2 + wr;
            unsigned pk[2][4][2];
#pragma unroll
            for (int n = 0; n < 2; ++n) {
                const f32x4 c_w0 = n ? v0 : w0, c_w1 = n ? v1 : w1, c_w2 = n ? v2 : w2, c_bb = n ? vb : bb;
                f32x4 P1 = (f32x4){0.f, 0.f, 0.f, 0.f}, P2 = P1;
                if (blk > 0) { P2 = *(const PG8_LAS f32x4*)(X + (((blk - 1) * 4 + wc) * 2 + 0) * 32 + 8 * fq + 4 * n); P1 = *(const PG8_LAS f32x4*)(X + (((blk - 1) * 4 + wc) * 2 + 1) * 32 + 8 * fq + 4 * n); }
                f32x4 gv[4];
#pragma unroll
                for (int j = 0; j < 4; ++j) {
                    const float a0 = acc[ai][0][0][n][j], a1 = acc[ai][0][1][n][j], a2 = acc[ai][0][2][n][j], a3 = acc[ai][0][3][n][j];
                    const float L3 = dpp_mov<0x111>(P1[j], a3), L2 = dpp_mov<0x111>(P2[j], a2);
                    const float c0 = fmaf(c_w0[j], L2, fmaf(c_w1[j], L3, fmaf(c_w2[j], a0, c_bb[j])));
                    const float c1 = fmaf(c_w0[j], L3, fmaf(c_w1[j], a0, fmaf(c_w2[j], a1, c_bb[j])));
                    const float c2 = fmaf(c_w0[j], a0, fmaf(c_w1[j], a1, fmaf(c_w2[j], a2, c_bb[j])));
                    const float c3 = fmaf(c_w0[j], a1, fmaf(c_w1[j], a2, fmaf(c_w2[j], a3, c_bb[j])));
                    if (dry == 3) { gv[0][j] = a0 * acc[ai][1][0][n][j]; gv[1][j] = a1 * acc[ai][1][1][n][j]; gv[2][j] = a2 * acc[ai][1][2][n][j]; gv[3][j] = a3 * acc[ai][1][3][n][j]; } else {
                    gv[0][j] = silu_f(c0) * acc[ai][1][0][n][j]; gv[1][j] = silu_f(c1) * acc[ai][1][1][n][j]; gv[2][j] = silu_f(c2) * acc[ai][1][2][n][j]; gv[3][j] = silu_f(c3) * acc[ai][1][3][n][j]; } }
#pragma unroll
                for (int m = 0; m < 4; ++m) { pk[n][m][0] = cvt_pk_bf16(gv[m][0], gv[m][1]); pk[n][m][1] = cvt_pk_bf16(gv[m][2], gv[m][3]); }
            }
#pragma unroll
            for (int m = 0; m < 4; ++m) {
                const u32x4 w = (u32x4){pk[0][m][0], pk[0][m][1], pk[1][m][0], pk[1][m][1]};
                if (dry == 5) { const int li = fr + 16 * fq; *(u32x4*)(G + (size_t)(u.pm * BM + (wr * 4 + wc) * 32 + (ai * 4 + m) * 4 + (li >> 4)) * 3072 + u.pn * 128 + (li & 15) * 8) = w; }
                else if (dry == 4) *(u32x4*)(G + (size_t)((u.pm & 1) * BM + ai * HALF + wr * 64 + 4 * fr + m) * 3072 + f0) = w;
                else if (dry != 2) *(u32x4*)(G + (size_t)(u.pm * BM + ai * HALF + wr * 64 + 4 * fr + m) * 3072 + f0) = w; }
            asm volatile("" ::: "memory");
        }
        if (fr == 15 && wr == 1) {
#pragma unroll
            for (int n = 0; n < 2; ++n) { *(f32x4*)(tail + ((size_t)u.pm * 2 + 0) * 3072 + f0 + 4 * n) = acc[1][0][2][n]; *(f32x4*)(tail + ((size_t)u.pm * 2 + 1) * 3072 + f0 + 4 * n) = acc[1][0][3][n]; } }
        if (wr == 0 && fr == 0) {
#pragma unroll
            for (int n = 0; n < 2; ++n)
#pragma unroll
                for (int m = 0; m < 2; ++m) { *(f32x4*)(head_a + ((size_t)u.pm * 2 + m) * 3072 + f0 + 4 * n) = acc[0][0][m][n]; *(f32x4*)(head_u + ((size_t)u.pm * 2 + m) * 3072 + f0 + 4 * n) = acc[0][1][m][n]; } }
    }
};
struct EpiQKV {
    static constexpr bool PERM = true, AFTER_DRAIN = false, APERM = false; static constexpr int NST = 16; static constexpr bool PF = false;
    bf16_t* O; const float* ss; const float* qg; const float* kg; const float* invf; float* kmean; int dry, pad; RstdTab tab;
    __device__ __forceinline__ void operator()(f32x4 (&acc)[2][2][4][2], const Unit& u, int wr, int wc, int fr, int fq, PG8_LAS unsigned char* lds) const {
        if (dry) asm volatile("s_waitcnt vmcnt(0)" ::: "memory");
        asm volatile("" : "+v"(fr), "+v"(fq));
        const int type = u.pn >> 2, wv = wr * 4 + wc;
        const int dlo_ = 32 * (wc & 1) + 8 * fq; const float* g_ = type == 1 ? kg : qg;
        const f32x4 glo_a = *(const f32x4*)(g_ + dlo_), ghi_a = *(const f32x4*)(g_ + 64 + dlo_), if_a = *(const f32x4*)(invf + dlo_), glo_b = *(const f32x4*)(g_ + dlo_ + 4), ghi_b = *(const f32x4*)(g_ + 64 + dlo_ + 4), if_b = *(const f32x4*)(invf + dlo_ + 4);
        PG8_LAS float* X = (PG8_LAS float*)(lds + STAGE_BYTES);
        PG8_LAS float* KS = X + 1024;
        { float rs8[2][4]; if (tab.ok) row_rstd8_tab(rs8, lds, tab, u.pm, wr * 64 + fr, 0); else row_rstd8(rs8, ss, u.pm * BM + wr * 64 + fr, fq);
#pragma unroll
          for (int ai = 0; ai < 2; ++ai)
#pragma unroll
            for (int m = 0; m < 4; ++m)
#pragma unroll
                for (int bj = 0; bj < 2; ++bj)
#pragma unroll
                    for (int n = 0; n < 2; ++n) acc[ai][bj][m][n] = acc[ai][bj][m][n] * rs8[ai][m]; }
        if (type == 2) {
#pragma unroll
            for (int ai = 0; ai < 2; ++ai)
#pragma unroll
                for (int m = 0; m < 4; ++m) { const int row = u.pm * BM + ai * HALF + wr * 64 + m * 16 + fr;
                    bf16_t* rowp = O + ((((size_t)(row >> 12) * 8 + 2 * (u.pn & 3)) * 3 + 2) * 4096 + (row & 4095)) * 128 + wc * 32 + 8 * fq;
#pragma unroll
                    for (int bj = 0; bj < 2; ++bj) { const f32x4 v0 = acc[ai][bj][m][0], v1 = acc[ai][bj][m][1];
                        u32x4 w; w.x = cvt_pk_bf16(v0[0], v0[1]); w.y = cvt_pk_bf16(v0[2], v0[3]); w.z = cvt_pk_bf16(v1[0], v1[1]); w.w = cvt_pk_bf16(v1[2], v1[3]);
                        *(u32x4*)(rowp + (size_t)bj * 3 * 4096 * 128) = w; } }
        } else {
#pragma unroll
            for (int ai = 0; ai < 2; ++ai)
#pragma unroll
                for (int m = 0; m < 4; ++m) { float s = 0.f;
#pragma unroll
                    for (int bj = 0; bj < 2; ++bj)
#pragma unroll
                        for (int n = 0; n < 2; ++n) { const f32x4 v = acc[ai][bj][m][n]; s += (v[0] * v[0] + v[1] * v[1]) + (v[2] * v[2] + v[3] * v[3]); }
                    s += __shfl_xor(s, 16); s += __shfl_xor(s, 32);
                    if (fq == 0) X[wv * 128 + ai * 64 + m * 16 + fr] = s; }
        }
        asm volatile("s_waitcnt lgkmcnt(0)" ::: "memory"); __builtin_amdgcn_s_barrier(); asm volatile("" ::: "memory");
        if (type < 2 && dry != 1) {
            const int head = 2 * (u.pn & 3) + (wc >> 1), dlo = 32 * (wc & 1) + 8 * fq;
            const float* g = type ? kg : qg; const float qs = type ? 1.0f : 0.08838834764831845f;
            f32x4 clo[2], chi[2];
#pragma unroll
            for (int n = 0; n < 2; ++n) { clo[n] = (f32x4){0.f, 0.f, 0.f, 0.f}; chi[n] = clo[n]; }
#pragma unroll
            for (int ai = 0; ai < 2; ++ai)
#pragma unroll
                for (int m = 0; m < 4; ++m) {
                    const int r = ai * 64 + m * 16 + fr, row = u.pm * BM + ai * HALF + wr * 64 + m * 16 + fr; const float pos = (float)(row & 4095);
                    const float tot = X[(wv & ~1) * 128 + r] + X[(wv | 1) * 128 + r];
                    const float rh = __builtin_amdgcn_rsqf(tot * (1.0f / 128.0f) + 1e-6f);
                    u32x4 wlo, whi; unsigned pl[4], ph[4];
#pragma unroll
                    for (int n = 0; n < 2; ++n) {
                        const f32x4 glo = n ? glo_b : glo_a, ghi = n ? ghi_b : ghi_a, ifq = n ? if_b : if_a;
                        f32x4 olo, ohi;
#pragma unroll
                        for (int j = 0; j < 4; ++j) {
                            const float ylo = acc[ai][0][m][n][j] * rh * glo[j], yhi = acc[ai][1][m][n][j] * rh * ghi[j];
                            const float ang = pos * ifq[j];
                            const float rev = __builtin_amdgcn_fractf(ang * 0.15915494309189535f);
                            const float c = __builtin_amdgcn_cosf(rev), sn = __builtin_amdgcn_sinf(rev);
                            olo[j] = (ylo * c - yhi * sn) * qs; ohi[j] = (yhi * c + ylo * sn) * qs; }
                        clo[n] = clo[n] + olo; chi[n] = chi[n] + ohi;
                        pl[2 * n] = cvt_pk_bf16(olo[0], olo[1]); pl[2 * n + 1] = cvt_pk_bf16(olo[2], olo[3]); ph[2 * n] = cvt_pk_bf16(ohi[0], ohi[1]); ph[2 * n + 1] = cvt_pk_bf16(ohi[2], ohi[3]); }
                    wlo = (u32x4){pl[0], pl[1], pl[2], pl[3]}; whi = (u32x4){ph[0], ph[1], ph[2], ph[3]};
                    bf16_t* op = O + ((((size_t)(row >> 12) * 8 + head) * 3 + type) * 4096 + (row & 4095)) * 128 + dlo;
                    if (dry != 2) { *(u32x4*)op = wlo; *(u32x4*)(op + 64) = whi; }
                }
            if (type == 1) {
#pragma unroll
                for (int n = 0; n < 2; ++n)
#pragma unroll
                    for (int j = 0; j < 4; ++j) {
                        float a = clo[n][j], bsum = chi[n][j];
                        a += __shfl_xor(a, 1); a += __shfl_xor(a, 2); a += __shfl_xor(a, 4); a += __shfl_xor(a, 8);
                        bsum += __shfl_xor(bsum, 1); bsum += __shfl_xor(bsum, 2); bsum += __shfl_xor(bsum, 4); bsum += __shfl_xor(bsum, 8);
                        if (fr == 0) { KS[wv * 64 + 8 * fq + 4 * n + j] = a; KS[wv * 64 + 32 + 8 * fq + 4 * n + j] = bsum; } }
            }
        }
        asm volatile("s_waitcnt lgkmcnt(0)" ::: "memory"); __builtin_amdgcn_s_barrier(); asm volatile("" ::: "memory");
        if (type == 1 && wr == 0) {
            const int lane = fr + 16 * fq, head = 2 * (u.pn & 3) + (wc >> 1), d = 64 * (lane >> 5) + 32 * (wc & 1) + (lane & 31);
            const float s = KS[wv * 64 + lane] + KS[(wv + 4) * 64 + lane];
            kmean[((size_t)((u.pm >> 4) * 8 + head) * 16 + (u.pm & 15)) * 128 + d] = s * (1.0f / 256.0f);
        }
    }
};
template <class Epi, class Sched, bool ALIGN_EPI = false, bool SP2 = false>
__device__ __forceinline__ void gemm_phase(PG8_LAS unsigned char* lds, const Gemm g, const Sched& S, const Epi& E) {
    int tid_ = threadIdx.x; asm volatile("" : "+v"(tid_));
    const int tid = tid_, wid = __builtin_amdgcn_readfirstlane(tid >> 6), lane = tid & 63, wr = wid >> 2, wc = wid & 3, fr = lane & 15, fq = lane >> 4;
    const int K = g.K, nt = K / BK;
    unsigned voffA[2], voffB[2];
#pragma unroll
    for (int i = 0; i < 2; ++i) { int R, C; stage_rc(tid * 16 + i * 8192, R, C); const int Rb = Epi::PERM ? ((R & ~31) + perm32(R & 31)) : R;
        const int Ra = Epi::APERM ? ((R & ~63) + 4 * (R & 15) + ((R >> 4) & 3)) : R;
        voffA[i] = (unsigned)(Ra * g.lda + C) * 2u; voffB[i] = (unsigned)(Rb * K + C) * 2u; }
    const size_t kstep = (size_t)(BK * 2);
    const size_t hstepB = (size_t)HALF * K * 2, hstepA = (size_t)HALF * g.lda * 2;
    const size_t tstepA = 2 * hstepA, tstepB = 2 * hstepB;
    const unsigned ldsw = (unsigned)wid * 1024u;
    const int aoff = lds_byte(wr * 64 + fr, fq * 8), boff = lds_byte(wc * 32 + fr, fq * 8);
#define PG8_SA(b, h) (((b) * 2 + (h)) * HTB)
#define PG8_SB(b, h) ((4 + (b) * 2 + (h)) * HTB)
#define PG8_STAGE(bufoff, gbase, voff) do { _Pragma("unroll") for (int _i = 0; _i < 2; ++_i) \
        __builtin_amdgcn_global_load_lds((const unsigned*)((const char*)(gbase) + (voff)[_i]), (PG8_LAS unsigned*)(lds + (bufoff) + ldsw + _i * 8192), 16, 0, 0); } while (0)
#define PG8_LDA(dst, b, h) do { _Pragma("unroll") for (int m = 0; m < 4; ++m) _Pragma("unroll") for (int k = 0; k < 2; ++k) dst[m][k] = *(const PG8_LAS bf16x8*)(lds + PG8_SA(b, h) + aoff + m * 2048 + k * 1024); } while (0)
#define PG8_LDB(dst, b, h) do { _Pragma("unroll") for (int n = 0; n < 2; ++n) _Pragma("unroll") for (int k = 0; k < 2; ++k) dst[n][k] = *(const PG8_LAS bf16x8*)(lds + PG8_SB(b, h) + boff + n * 2048 + k * 1024); } while (0)
#define PG8_MMA(ai, bj, At, Bt) do { __builtin_amdgcn_s_setprio(1); _Pragma("unroll") for (int m = 0; m < 4; ++m) _Pragma("unroll") for (int n = 0; n < 2; ++n) _Pragma("unroll") for (int k = 0; k < 2; ++k) \
        acc[ai][bj][m][n] = __builtin_amdgcn_mfma_f32_16x16x32_bf16(Bt[n][k], At[m][k], acc[ai][bj][m][n], 0, 0, 0); __builtin_amdgcn_s_setprio(0); } while (0)
#define PG8_WAIT_V(n) asm volatile("s_waitcnt vmcnt(" #n ")" ::: "memory")
#define PG8_WAIT_L(n) asm volatile("s_waitcnt lgkmcnt(" #n ")" ::: "memory")
#define PG8_BAR __builtin_amdgcn_s_barrier()
#define PG8_SCHED __builtin_amdgcn_sched_barrier(0)
    Unit cur, nxt; int ui = 0;
    if (!S.next(0, cur)) return;
    f32x4 acc[2][2][4][2];
#pragma unroll
    for (int a = 0; a < 2; ++a)
#pragma unroll
        for (int b = 0; b < 2; ++b)
#pragma unroll
            for (int m = 0; m < 4; ++m)
#pragma unroll
                for (int n = 0; n < 2; ++n) acc[a][b][m][n] = (f32x4){0.f, 0.f, 0.f, 0.f};
    bf16x8 At[4][2], B0[2][2], B1[2][2];
    const char* cA = (const char*)g.A + (size_t)cur.pm * tstepA; const char* cB = (const char*)g.Bt + (size_t)cur.pn * tstepB;
    S.a_ready(cur);
    if constexpr (SP2) {
        PG8_STAGE(PG8_SB(0, 0), cB, voffB); PG8_STAGE(PG8_SB(0, 1), cB + hstepB, voffB); PG8_STAGE(PG8_SA(0, 0), cA, voffA); PG8_STAGE(PG8_SA(0, 1), cA + hstepA, voffA);
        if (wr == 1) PG8_BAR;
        PG8_WAIT_V(2); PG8_BAR;
        PG8_STAGE(PG8_SB(1, 0), cB + kstep, voffB); PG8_STAGE(PG8_SA(1, 0), cA + kstep, voffA); PG8_STAGE(PG8_SB(1, 1), cB + hstepB + kstep, voffB);
        PG8_WAIT_V(6); PG8_BAR;
    } else {
        PG8_STAGE(PG8_SB(0, 0), cB, voffB); PG8_STAGE(PG8_SA(0, 0), cA, voffA); PG8_STAGE(PG8_SB(0, 1), cB + hstepB, voffB); PG8_STAGE(PG8_SA(0, 1), cA + hstepA, voffA);
        if (wr == 1) PG8_BAR;
        PG8_WAIT_V(4); PG8_BAR;
        PG8_STAGE(PG8_SB(1, 0), cB + kstep, voffB); PG8_STAGE(PG8_SA(1, 0), cA + kstep, voffA); PG8_STAGE(PG8_SB(1, 1), cB + hstepB + kstep, voffB);
        PG8_WAIT_V(6); PG8_BAR;
    }
    constexpr bool PRE = PG8_PRE && SP2 && ALIGN_EPI;
    for (;;) {
        const bool has_next = S.next(ui + 1, nxt);
        const char* nA = has_next ? (const char*)g.A + (size_t)nxt.pm * tstepA : cA; const char* nB = has_next ? (const char*)g.Bt + (size_t)nxt.pn * tstepB : cB;
        for (int t = 0; t < nt; t += 2) {
            const bool last = (t == nt - 2);
            const char* a1 = cA + (size_t)(t + 1) * kstep;
            const char* a2 = last ? nA : cA + (size_t)(t + 2) * kstep; const char* b2 = last ? nB : cB + (size_t)(t + 2) * kstep;
            const char* a3 = a2 + kstep; const char* b3 = b2 + kstep;
            int pre_s = __builtin_amdgcn_readfirstlane(t | (ui == 0)); asm volatile("" : "+s"(pre_s)); const bool pre = PRE && pre_s == 0;
            if (last && has_next) S.a_ready(nxt);
            if constexpr (SP2) {
            PG8_LDB(B0, 0, 0); PG8_LDB(B1, 0, 1); PG8_SCHED; PG8_LDA(At, 0, 0); if (!(PRE && pre)) PG8_STAGE(PG8_SA(1, 1), a1 + hstepA, voffA);
            if (PRE && pre) asm volatile("s_waitcnt vmcnt(%0)" :: "n"(Epi::NST) : "memory"); else PG8_WAIT_V(8);
            if constexpr (Epi::PF) { int pf_s = __builtin_amdgcn_readfirstlane(t - (nt - PG8_PF_DIST)); asm volatile("" : "+s"(pf_s)); if (pf_s == 0) E.prefetch(cur, tid, wid, lds); }
            PG8_WAIT_L(0); PG8_BAR; PG8_MMA(0, 0, At, B0); PG8_MMA(0, 1, At, B1); PG8_BAR; PG8_SCHED;
            PG8_LDA(At, 0, 1); PG8_STAGE(PG8_SB(0, 0), b2, voffB); PG8_STAGE(PG8_SB(0, 1), b2 + hstepB, voffB); PG8_STAGE(PG8_SA(0, 0), a2, voffA);
            if (!(PRE && pre)) PG8_WAIT_V(8);
            PG8_WAIT_L(0); PG8_BAR; PG8_MMA(1, 0, At, B0); PG8_MMA(1, 1, At, B1); PG8_BAR; PG8_SCHED;
            PG8_LDB(B0, 1, 0); PG8_LDB(B1, 1, 1); PG8_SCHED; PG8_LDA(At, 1, 0); PG8_STAGE(PG8_SA(0, 1), a2 + hstepA, voffA);
            if (!(PRE && pre)) PG8_WAIT_V(8);
            PG8_WAIT_L(0); PG8_BAR; PG8_MMA(0, 0, At, B0); PG8_MMA(0, 1, At, B1); PG8_BAR; PG8_SCHED;
            PG8_LDA(At, 1, 1); PG8_STAGE(PG8_SB(1, 0), b3, voffB); PG8_STAGE(PG8_SB(1, 1), b3 + hstepB, voffB); PG8_STAGE(PG8_SA(1, 0), a3, voffA);
            PG8_WAIT_V(8); PG8_WAIT_L(0); PG8_BAR; PG8_MMA(1, 0, At, B0); PG8_MMA(1, 1, At, B1); PG8_BAR; PG8_SCHED;
            } else {
            PG8_LDB(B0, 0, 0); PG8_SCHED; PG8_LDA(At, 0, 0); PG8_STAGE(PG8_SA(1, 1), a1 + hstepA, voffA);
            PG8_WAIT_L(8); PG8_BAR; PG8_WAIT_L(0); PG8_MMA(0, 0, At, B0); PG8_BAR; PG8_SCHED;
            PG8_LDB(B1, 0, 1); PG8_STAGE(PG8_SB(0, 0), b2, voffB);
            PG8_BAR; PG8_WAIT_L(0); PG8_MMA(0, 1, At, B1); PG8_BAR;
            PG8_LDA(At, 0, 1); PG8_STAGE(PG8_SA(0, 0), a2, voffA);
            PG8_BAR; PG8_WAIT_L(0); PG8_MMA(1, 0, At, B0); PG8_BAR; PG8_SCHED;
            PG8_STAGE(PG8_SB(0, 1), b2 + hstepB, voffB);
            PG8_WAIT_V(6); PG8_BAR; PG8_MMA(1, 1, At, B1); PG8_BAR;
            PG8_LDB(B0, 1, 0); PG8_SCHED; PG8_LDA(At, 1, 0); PG8_STAGE(PG8_SA(0, 1), a2 + hstepA, voffA);
            PG8_WAIT_L(8); PG8_BAR; PG8_WAIT_L(0); PG8_MMA(0, 0, At, B0); PG8_BAR; PG8_SCHED;
            PG8_LDB(B1, 1, 1); PG8_STAGE(PG8_SB(1, 0), b3, voffB);
            PG8_BAR; PG8_WAIT_L(0); PG8_MMA(0, 1, At, B1); PG8_BAR;
            PG8_LDA(At, 1, 1); PG8_STAGE(PG8_SA(1, 0), a3, voffA);
            PG8_BAR; PG8_WAIT_L(0); PG8_MMA(1, 0, At, B0); PG8_BAR; PG8_SCHED;
            PG8_STAGE(PG8_SB(1, 1), b3 + hstepB, voffB);
            PG8_WAIT_V(6); PG8_BAR; PG8_MMA(1, 1, At, B1); PG8_BAR;
            }
        }
        if constexpr (ALIGN_EPI) { if (wr == 0) PG8_BAR; }
        if constexpr (PRE) { if (has_next) { PG8_STAGE(PG8_SA(1, 1), nA + kstep + hstepA, voffA); } }
        if constexpr (!Epi::AFTER_DRAIN) { E(acc, cur, wr, wc, fr, fq, lds); S.done(cur); }
        if (!has_next) break;
#pragma unroll
        for (int a = 0; a < 2; ++a)
#pragma unroll
            for (int b = 0; b < 2; ++b)
#pragma unroll
                for (int m = 0; m < 4; ++m)
#pragma unroll
                    for (int n = 0; n < 2; ++n) acc[a][b][m][n] = (f32x4){0.f, 0.f, 0.f, 0.f};
        cur = nxt; cA = nA; cB = nB; ++ui;
        if constexpr (ALIGN_EPI) { if (wr == 1) PG8_BAR; }
    }
    PG8_WAIT_V(0);
    if constexpr (!ALIGN_EPI) { if (wr == 0) PG8_BAR; }
    PG8_BAR;
    if constexpr (Epi::AFTER_DRAIN) { E.fused(acc, cur, wr, wc, fr, fq, lds, wid, lane); S.done(cur); }
#undef PG8_SA
#undef PG8_SB
#undef PG8_STAGE
#undef PG8_LDA
#undef PG8_LDB
#undef PG8_MMA
#undef PG8_WAIT_V
#undef PG8_WAIT_L
#undef PG8_BAR
#undef PG8_SCHED
}
}
#ifndef PROBE_DUP
#define PROBE_DUP 0
#endif
constexpr int BATCH = 8, SEQ = 4096, DM = 1024, MROWS = BATCH * SEQ, DEPTH = 4;
constexpr int NH = 8, HD = 128;
constexpr int FF = 3072, NBLK = 16, MBLK = 256;
constexpr float QSCALE = 0.08838834764831845f;
typedef unsigned short bf16;
typedef float f32x4 __attribute__((ext_vector_type(4)));
typedef unsigned u32x4 __attribute__((ext_vector_type(4)));

constexpr size_t MiB = 1u << 20;
constexpr size_t WS_CTL = 0, CTL_ZERO_BYTES = 64 * 1024;
constexpr size_t WS_WIN = 2 * MiB, WS_WQKV = 18 * MiB, WS_WOH = 30 * MiB, WS_WOM = 34 * MiB, WS_WUP = 38 * MiB, WS_WDN = 86 * MiB;
constexpr size_t WS_SS = 110 * MiB, WS_COS = 112 * MiB, WS_SIN = 113 * MiB, WS_LBV = 114 * MiB, WS_KMEAN = 115 * MiB;
constexpr size_t WS_INVF = 114 * MiB + 16384;
constexpr size_t WS_HGD = 115 * MiB + 512 * 1024, WS_HGE = 116 * MiB;
constexpr size_t WS_TAIL = 132 * MiB, WS_HEADA = 135 * MiB, WS_HEADU = 138 * MiB;
constexpr size_t WS_XB = 144 * MiB, WS_BIG = 208 * MiB, WS_AU = 400 * MiB, WS_ML = 464 * MiB, WS_END = 472 * MiB;

__device__ __forceinline__ float bf2f(bf16 v) { return __uint_as_float((unsigned)v << 16); }
__device__ __forceinline__ bf16 f2bf(float f) { unsigned u = __float_as_uint(f); return (bf16)((u + 0x7fffu + ((u >> 16) & 1u)) >> 16); }
__device__ __forceinline__ float wave_sum(float v) {
#pragma unroll
    for (int o = 1; o < 64; o <<= 1) v += __shfl_xor(v, o);
    return v;
}
__device__ __forceinline__ float wave_max(float v) {
#pragma unroll
    for (int o = 1; o < 64; o <<= 1) v = fmaxf(v, __shfl_xor(v, o));
    return v;
}

__device__ __forceinline__ void glu_fixup_elem(int pm, int rr, int f, bf16* __restrict__ g, const float* __restrict__ tail, const float* __restrict__ head_a, const float* __restrict__ head_u, const float* __restrict__ cw, const float* __restrict__ cb) {
    const bool first = (pm & 15) == 0;
    const float cur = head_a[((size_t)pm * 2 + rr) * FF + f];
    const float t1 = first ? 0.f : tail[((size_t)(pm - 1) * 2 + 1) * FF + f], t0 = first ? 0.f : tail[((size_t)(pm - 1) * 2 + 0) * FF + f];
    const float prev1 = rr == 0 ? t1 : head_a[((size_t)pm * 2) * FF + f], prev2 = rr == 0 ? t0 : t1;
    const float c = cw[f] * prev2 + cw[FF + f] * prev1 + cw[2 * FF + f] * cur + cb[f];
    g[((size_t)pm * 256 + rr) * FF + f] = f2bf(c / (1.0f + __expf(-c)) * head_u[((size_t)pm * 2 + rr) * FF + f]);
}
#define XB_TMO      128
#define XB_XCNT(j)  (256  + 64 * (j))
#define XB_XSUB(j)  (1280 + 64 * (j))
#define XB_XGEN(j)  (2304 + 64 * (j))
#define XB_TOP      3328
#define XB_TOPGEN   3392
#define XCD_BAR_WORDS 3456
#define XB_SPIN_CAP (1u << 18)
#define LAS __attribute__((address_space(3)))

__device__ __forceinline__ unsigned xb_ld(unsigned* p)              { return __hip_atomic_load(p, __ATOMIC_RELAXED, __HIP_MEMORY_SCOPE_AGENT); }
__device__ __forceinline__ unsigned xb_add(unsigned* p, unsigned v) { return __hip_atomic_fetch_add(p, v, __ATOMIC_RELAXED, __HIP_MEMORY_SCOPE_AGENT); }
__device__ __forceinline__ unsigned xb_xcc_id() { return (unsigned)__builtin_amdgcn_s_getreg((3 << 11) | 20) & 0xFu; }
#define XB_SPIN(cond, bar) do { unsigned _sp = 0; while (cond) { __builtin_amdgcn_s_sleep(1); \
    if ((++_sp & 255u) == 0u) { if (xb_ld(&(bar)[XB_TMO])) break; if (_sp > XB_SPIN_CAP) { atomicAdd(&(bar)[XB_TMO], 1u); break; } } } } while (0)

struct XcdBarrier {
    unsigned* bar; unsigned x;
    volatile LAS unsigned* st;
};

__device__ __forceinline__ XcdBarrier xcd_barrier_post(unsigned* bar, volatile LAS unsigned* st) {
    XcdBarrier b; b.bar = bar; b.x = xb_xcc_id(); b.st = st;
    if (threadIdx.x == 0) (void)xb_add(&bar[XB_XCNT(b.x)], 1u);
    return b;
}
__device__ __forceinline__ void xcd_barrier_complete(unsigned* bar, unsigned x, unsigned& nloc, unsigned& nx) {
    const unsigned G = gridDim.x * gridDim.y * gridDim.z;
    unsigned sum, cnt, mine, sp = 0u;
    for (;;) {
        sum = 0u; cnt = 0u; mine = 0u;
#pragma unroll
        for (unsigned j = 0; j < 16; ++j) { const unsigned c = xb_ld(&bar[XB_XCNT(j)]); sum += c; cnt += (c > 0u) ? 1u : 0u; mine = (j == x) ? c : mine; }
        if (sum == G) break;
        __builtin_amdgcn_s_sleep(1);
        if ((++sp & 255u) == 0u) { if (xb_ld(&bar[XB_TMO])) break; if (sp > XB_SPIN_CAP) { atomicAdd(&bar[XB_TMO], 1u); break; } }
    }
    nloc = mine > 0u ? mine : 1u; nx = cnt > 0u ? cnt : 1u;
}

__device__ __forceinline__ void xcd_barrier(const XcdBarrier& b) {
    asm volatile("s_waitcnt vmcnt(0)" ::: "memory");
    __syncthreads();
    if (threadIdx.x == 0) {
        unsigned* bar = b.bar;
        __builtin_amdgcn_s_waitcnt(0);
        unsigned nloc = b.st[0], nx = b.st[1];
        if (nloc == 0u) { xcd_barrier_complete(bar, b.x, nloc, nx); b.st[0] = nloc; b.st[1] = nx; }
        const unsigned old = xb_add(&bar[XB_XSUB(b.x)], 1u);
        const unsigned gen = old / nloc;
        if (old + 1u == (gen + 1u) * nloc) {
            __builtin_amdgcn_fence(__ATOMIC_RELEASE, "agent");
            asm volatile("s_waitcnt vmcnt(0)" ::: "memory");
            const unsigned og = xb_add(&bar[XB_TOP], 1u);
            const unsigned tg = og / nx;
            if (og + 1u == (tg + 1u) * nx) xb_add(&bar[XB_TOPGEN], 1u);
            else XB_SPIN(xb_ld(&bar[XB_TOPGEN]) == tg, bar);
            __builtin_amdgcn_fence(__ATOMIC_ACQUIRE, "agent");
            xb_add(&bar[XB_XGEN(b.x)], 1u);
            asm volatile("s_waitcnt vmcnt(0)" ::: "memory");
        } else {
            XB_SPIN(xb_ld(&bar[XB_XGEN(b.x)]) == gen, bar);
            __builtin_amdgcn_fence(__ATOMIC_ACQUIRE, "agent");
            asm volatile("s_waitcnt vmcnt(0)" ::: "memory");
        }
    }
    __syncthreads();
}
namespace mb {
typedef short bf16x8 __attribute__((ext_vector_type(8)));
typedef short s16x4 __attribute__((ext_vector_type(4)));
typedef float f32x16 __attribute__((ext_vector_type(16)));
typedef float f32x2 __attribute__((ext_vector_type(2)));
#ifndef MOBA_SPARSE
#define MOBA_SPARSE 0
#endif
constexpr int D = 128, LDR = 128, ARR = 4096 * 128, NW = 8, QBLK = 32, KVBLK = 64, QB = NW * QBLK;
static_assert(!MOBA_SPARSE, "the sparse sub-phases below still address the token-major q|k|v layout");
constexpr int SHM_V = KVBLK * D * 2, SHM_K = KVBLK * D * 2;
constexpr int OFF_WS = 2 * SHM_V + 2 * SHM_K, OFF_KM = OFF_WS + NW * 64 * 4, ATT_LDS_BYTES = OFF_KM + 16 * 128 * 4;
constexpr float THR = 8.f;
#define KSWZ(row, colB) ((row) * 256 + ((colB) ^ (((row) & 7) << 4)))
#define SBAR() __builtin_amdgcn_sched_barrier(0)
__device__ __forceinline__ int v_st(int k, int c) { const int kk = (k & ~0xC) | ((k & 4) << 1) | ((k & 8) >> 1); return ((kk >> 3) * 4 + (c >> 5)) * 512 + ((kk & 7) * 32 + (c & 31)) * 2; }
__device__ __forceinline__ int v_rd_base(int lane) { return ((lane & 3) << 3) | (((lane >> 2) & 3) << 6) | (((lane >> 4) & 1) << 5) | (((lane >> 5) & 1) << 8); }
constexpr int v_rd_off(int d0, int ks, int half) { return d0 * 512 + ks * 4096 + half * 2048; }
__device__ __forceinline__ int crow(int r, int hi) { return (r & 3) + 8 * (r >> 2) + 4 * hi; }
__device__ __forceinline__ unsigned cvtpk(float lo, float hi) { unsigned r; asm volatile("v_cvt_pk_bf16_f32 %0, %1, %2" : "=v"(r) : "v"(lo), "v"(hi)); return r; }
__device__ __forceinline__ bf16x8 load8(const bf16* p) { return *reinterpret_cast<const bf16x8*>(p); }
__device__ __forceinline__ void mask_causal(f32x16& p0, f32x16& p1, int dq) {
    const float NEG = -__builtin_inff();
#pragma unroll
    for (int r = 0; r < 16; ++r) { const int c = (r & 3) + 8 * (r >> 2); if (dq - c < 0) p0[r] = NEG; if (dq - c - 32 < 0) p1[r] = NEG; }
}
__device__ __forceinline__ void mask_all(f32x16& p0, f32x16& p1, bool keep) {
    const float NEG = -__builtin_inff();
#pragma unroll
    for (int r = 0; r < 16; ++r) { p0[r] = keep ? p0[r] : NEG; p1[r] = keep ? p1[r] : NEG; }
}
__device__ __forceinline__ void partialSM(f32x16& p0, f32x16& p1, float& m_reg, float& mn, float& alpha, bool keep = true) {
    float pmax = p0[0]; for (int r = 1; r < 16; ++r) pmax = fmaxf(pmax, p0[r]); for (int r = 0; r < 16; ++r) pmax = fmaxf(pmax, p1[r]);
    pmax = keep ? pmax : -__builtin_inff();
    { auto rr = __builtin_amdgcn_permlane32_swap(__float_as_uint(pmax), __float_as_uint(pmax), false, false);
      pmax = fmaxf(__uint_as_float(rr[0]), __uint_as_float(rr[1])); }
    constexpr float C2 = 1.4426950408889634f;
    if (__builtin_expect(__all((pmax - m_reg) <= THR), 1)) { mn = m_reg; alpha = 1.f; }
    else { mn = fmaxf(m_reg, pmax); alpha = __builtin_amdgcn_exp2f((m_reg - mn) * C2); m_reg = mn; }
    const float mnL = keep ? -mn * C2 : -__builtin_inff();
    { f32x16 c2v, mlv;
#pragma unroll
      for (int r = 0; r < 16; ++r) { c2v[r] = C2; mlv[r] = mnL; }
      p0 = __builtin_elementwise_fma(p0, c2v, mlv); p1 = __builtin_elementwise_fma(p1, c2v, mlv); }
    for (int r = 0; r < 16; ++r) p0[r] = __builtin_amdgcn_exp2f(p0[r]);
}
__device__ __forceinline__ void finishSM(f32x16& p0, f32x16& p1, float alpha, float& l_reg, bf16x8& pa0, bf16x8& pa1, bf16x8& pa2, bf16x8& pa3) {
    for (int r = 0; r < 16; ++r) p1[r] = __builtin_amdgcn_exp2f(p1[r]);
    float ps;
    { const f32x16 s16 = p0 + p1;
      typedef float f32x8_t __attribute__((ext_vector_type(8))); typedef float f32x4_t __attribute__((ext_vector_type(4))); typedef float f32x2_t __attribute__((ext_vector_type(2)));
      const f32x8_t s8 = __builtin_shufflevector(s16, s16, 0, 1, 2, 3, 4, 5, 6, 7) + __builtin_shufflevector(s16, s16, 8, 9, 10, 11, 12, 13, 14, 15);
      const f32x4_t s4 = __builtin_shufflevector(s8, s8, 0, 1, 2, 3) + __builtin_shufflevector(s8, s8, 4, 5, 6, 7);
      const f32x2_t s2 = __builtin_shufflevector(s4, s4, 0, 1) + __builtin_shufflevector(s4, s4, 2, 3);
      ps = s2[0] + s2[1]; }
    { auto rr = __builtin_amdgcn_permlane32_swap(__float_as_uint(ps), __float_as_uint(ps), false, false);
      ps = __uint_as_float(rr[0]) + __uint_as_float(rr[1]); }
    l_reg = l_reg * alpha + ps;
#define PK4(P, B_, OUT) do { unsigned a0 = cvtpk(P[B_+0], P[B_+1]), a1 = cvtpk(P[B_+2], P[B_+3]);                          \
        unsigned b0 = cvtpk(P[B_+4], P[B_+5]), b1 = cvtpk(P[B_+6], P[B_+7]);                                             \
        auto r0 = __builtin_amdgcn_permlane32_swap(a0, b0, false, false); auto r1 = __builtin_amdgcn_permlane32_swap(a1, b1, false, false); \
        u32x4 w = {r0[0], r1[0], r0[1], r1[1]}; OUT = *reinterpret_cast<bf16x8*>(&w); } while (0)
    PK4(p0, 0, pa0); PK4(p0, 8, pa1); PK4(p1, 0, pa2); PK4(p1, 8, pa3);
#undef PK4
}
template <int KB>
__device__ __forceinline__ void qkt(f32x16& p0, f32x16& p1, const char* K_lds, int r32, int hi, const bf16x8* qr) {
    p0 = f32x16{}; p1 = f32x16{};
    const char* kb[4];
#pragma unroll
    for (int dd = 0; dd < 4; ++dd) kb[dd] = K_lds + KB * SHM_K + KSWZ(r32, (dd * 16 + hi * 8) * 2);
#pragma unroll
    for (int d0 = 0; d0 < 8; ++d0) { const char* a = kb[d0 & 3] + (d0 >> 2) * 128;
        bf16x8 b0 = *reinterpret_cast<const bf16x8*>(a);
        bf16x8 b1 = *reinterpret_cast<const bf16x8*>(a + 32 * 256);
        p0 = __builtin_amdgcn_mfma_f32_32x32x16_bf16(b0, qr[d0], p0, 0, 0, 0);
        p1 = __builtin_amdgcn_mfma_f32_32x32x16_bf16(b1, qr[d0], p1, 0, 0, 0); }
}
template <int VB>
__device__ __forceinline__ void pv_tile(f32x16* o, int vb0, bf16x8 pa0, bf16x8 pa1, bf16x8 pa2, bf16x8 pa3) {
#define TRRD(dst, off) asm volatile("ds_read_b64_tr_b16 %0, %1 offset:%2" : "=&v"(dst) : "v"(vb0), "i"(off) : "memory")
#define PV_D0(d0) do { s16x4 l0, l1, l2, l3, h0, h1, h2, h3; constexpr int b_ = VB * SHM_V + v_rd_off(d0, 0, 0);   \
        TRRD(l0, b_); TRRD(h0, b_ + 2048); TRRD(l1, b_ + 4096); TRRD(h1, b_ + 6144); TRRD(l2, b_ + 8192); TRRD(h2, b_ + 10240); TRRD(l3, b_ + 12288); TRRD(h3, b_ + 14336); \
        asm volatile("s_waitcnt lgkmcnt(0)" ::: "memory"); SBAR();   \
        o[d0] = __builtin_amdgcn_mfma_f32_32x32x16_bf16(pa0, (bf16x8){l0[0], l0[1], l0[2], l0[3], h0[0], h0[1], h0[2], h0[3]}, o[d0], 0, 0, 0);   \
        o[d0] = __builtin_amdgcn_mfma_f32_32x32x16_bf16(pa1, (bf16x8){l1[0], l1[1], l1[2], l1[3], h1[0], h1[1], h1[2], h1[3]}, o[d0], 0, 0, 0);   \
        o[d0] = __builtin_amdgcn_mfma_f32_32x32x16_bf16(pa2, (bf16x8){l2[0], l2[1], l2[2], l2[3], h2[0], h2[1], h2[2], h2[3]}, o[d0], 0, 0, 0);   \
        o[d0] = __builtin_amdgcn_mfma_f32_32x32x16_bf16(pa3, (bf16x8){l3[0], l3[1], l3[2], l3[3], h3[0], h3[1], h3[2], h3[3]}, o[d0], 0, 0, 0); } while (0)
    PV_D0(0); PV_D0(1); PV_D0(2); PV_D0(3);
#undef PV_D0
#undef TRRD
}

struct BlockRef { const bf16* Q; const bf16* K; const bf16* V; bf16* O; const float* KM; int iblk, ldo, store, bh; };
struct Partials { bf16* P[3]; float* ML; };
struct Seam { bf16x8 qr[8]; bf16x8 st_v0, st_v1, st_k0, st_k1; };
#define ROW(p, k0, rr) ((p) + (size_t)((k0) + (rr)) * LDR + sc)
#define VMW() asm volatile("s_waitcnt vmcnt(0)" ::: "memory")
#define VMWN(n) asm volatile("s_waitcnt vmcnt(%0)" :: "i"(n) : "memory")
#define SLOAD_H(Kp, Vp, k0) do { const bf16* k_ = (Kp) + (size_t)(k0) * LDR; const bf16* v_ = (Vp) + (size_t)(k0) * LDR;                     \
                         S.st_v0 = load8(v_ + (size_t)soff); S.st_v1 = load8(v_ + (size_t)32 * LDR + (size_t)soff);                       \
                         S.st_k0 = load8(k_ + (size_t)soff); S.st_k1 = load8(k_ + (size_t)32 * LDR + (size_t)soff); } while (0)
#define SWRITE_HK(bf) do { *(bf16x8*)(K_lds + (bf) * SHM_K + kws) = S.st_k0; *(bf16x8*)(K_lds + (bf) * SHM_K + kws + 32 * 256) = S.st_k1; } while (0)
#define SWRITE_HV(bf) do { *(bf16x8*)(V_lds + (bf) * SHM_V + vst0) = S.st_v0; *(bf16x8*)(V_lds + (bf) * SHM_V + vst1) = S.st_v1; } while (0)
#define SWRITE_H(bf) do { SWRITE_HV(bf); SWRITE_HK(bf); } while (0)
__device__ __forceinline__ void moba_prime(const BlockRef& cur, char* lds, Seam& S, int tid) {
    const int t0c = MOBA_SPARSE ? 4 * cur.iblk : 0;
    const int wid = __builtin_amdgcn_readfirstlane(tid >> 6), lane = tid & 63, r32 = lane & 31, hi = lane >> 5;
    const int sr = tid >> 4, sc = (tid & 15) * 8, kws = KSWZ(sr, sc * 2); char* K_lds = lds + 2 * SHM_V;
    const unsigned soff = (unsigned)(sr * LDR + sc), qoff = (unsigned)(r32 * LDR + hi * 8);
    { const bf16* qb = cur.Q + (size_t)(wid * QBLK) * LDR;
#pragma unroll
      for (int d0 = 0; d0 < 8; ++d0) S.qr[d0] = load8(qb + (size_t)qoff + d0 * 16); }
    SLOAD_H(cur.K, cur.V, t0c * KVBLK); VMW(); SWRITE_HK(0);
    __syncthreads();
}
__device__ __forceinline__ void moba_block(const BlockRef& cur, const BlockRef& nxt, const Partials& PP, char* lds, Seam& S, int tid) {
    const int wid = __builtin_amdgcn_readfirstlane(tid >> 6), lane = tid & 63, r32 = lane & 31, hi = lane >> 5;
    const int iblk = cur.iblk, t0 = MOBA_SPARSE ? 4 * iblk : 0, NT = MOBA_SPARSE ? 4 : 4 * (iblk + 1), P0 = iblk * QB;
    const int qlo = P0 + wid * QBLK, qm = qlo + r32 - 4 * hi;
    unsigned sel = 0u; float* KMs = (float*)(lds + OFF_KM);
    if (!MOBA_SPARSE && iblk > 0) {
        int t4 = tid; asm volatile("" : "+v"(t4));
        *(f32x4*)(KMs + t4 * 4) = *(const f32x4*)(cur.KM + t4 * 4);
        __syncthreads();
        float v1 = -__builtin_inff(), v2 = v1, v3 = v1; int i1 = -1, i2 = -1, i3 = -1;
        for (int j = 0; j < iblk; ++j) {
            const float* km = KMs + j * 128 + 8 * hi; float a = 0.f;
#pragma unroll
            for (int d0 = 0; d0 < 8; ++d0) { const f32x4 k0 = *(const f32x4*)(km + 16 * d0), k1 = *(const f32x4*)(km + 16 * d0 + 4); const bf16x8 q = S.qr[d0];
#pragma unroll
                for (int e = 0; e < 4; ++e) { a = fmaf(__uint_as_float((unsigned)(unsigned short)q[e] << 16), k0[e], a); a = fmaf(__uint_as_float((unsigned)(unsigned short)q[e + 4] << 16), k1[e], a); } }
            a += __shfl_xor(a, 32);
            if (a > v1) { v3 = v2; i3 = i2; v2 = v1; i2 = i1; v1 = a; i1 = j; }
            else if (a > v2) { v3 = v2; i3 = i2; v2 = a; i2 = j; }
            else if (a > v3) { v3 = a; i3 = j; }
        }
        sel = (i1 >= 0 ? 1u << i1 : 0u) | (i2 >= 0 ? 1u << i2 : 0u) | (i3 >= 0 ? 1u << i3 : 0u);
    }
    char* V_lds = lds; char* K_lds = lds + 2 * SHM_V;
    float* ws = (float*)(lds + OFF_WS) + wid * 64; float* li_l = ws, * al_l = ws + 32;
    float m_reg = -1e30f, l_reg = 0; f32x16 o[4] = {};
    const int sr = tid >> 4, sc = (tid & 15) * 8, vst0 = v_st(sr, sc), vst1 = v_st(32 + sr, sc), kws = KSWZ(sr, sc * 2);
    const unsigned soff = (unsigned)(sr * LDR + sc), qoff = (unsigned)(r32 * LDR + hi * 8);
    const int vb0 = (int)(uintptr_t)V_lds + v_rd_base(lane);
    const bf16* Kh = cur.K; const bf16* Vh = cur.V;
#define RESC(a) do { if (__any((a) < 1.f)) { if (hi == 0) al_l[r32] = (a); asm volatile("s_waitcnt lgkmcnt(0)" ::: "memory");              \
                     for (int d_ = 0; d_ < 4; ++d_) for (int r = 0; r < 16; ++r) o[d_][r] *= al_l[crow(r, hi)]; } } while (0)
#define KBASE(t) ((t0 + (t)) * KVBLK)
#define MASKT(P0_, P1_, t, KEEP_) do { const int kb_ = KBASE(t); const int bj_ = (t0 + (t)) >> 2; KEEP_ = true; \
        if (bj_ == iblk) { if (kb_ + KVBLK - 1 > qlo) mask_causal(P0_, P1_, qm - kb_); } else KEEP_ = ((sel >> bj_) & 1u) != 0u; } while (0)
    constexpr int NQL = 8;
#define SEAM_K0() do { VMWN(NQL); SWRITE_HK(0); SBAR(); } while (0)
    f32x16 pA0, pA1, pB0, pB1; float mnA, mnB, alA, alB; bf16x8 pa0, pa1, pa2, pa3;
    SWRITE_HV(0); SBAR();
    if (NT > 1) SLOAD_H(Kh, Vh, KBASE(1));
    SBAR(); qkt<0>(pA0, pA1, K_lds, r32, hi, S.qr);
    { bool kp_; MASKT(pA0, pA1, 0, kp_); partialSM(pA0, pA1, m_reg, mnA, alA, kp_); }
    if (NT > 1) { VMW(); SWRITE_H(1); }
    __syncthreads();
#define HALF_STEP(PX0, PX1, mnX, alX, PY0, PY1, alY, t, KB, VB, SB) do {                                                      \
        SBAR(); qkt<KB>(PX0, PX1, K_lds, r32, hi, S.qr);                                                                      \
        finishSM(PY0, PY1, alY, l_reg, pa0, pa1, pa2, pa3); SBAR();                                                           \
        if ((t) + 1 < NT) { SLOAD_H(Kh, Vh, KBASE((t) + 1)); SBAR(); }                                                        \
        pv_tile<VB>(o, vb0, pa0, pa1, pa2, pa3); { bool kp_; MASKT(PX0, PX1, (t), kp_); partialSM(PX0, PX1, m_reg, mnX, alX, kp_); } \
        __syncthreads();                                                                                                      \
        if ((t) + 1 < NT) { VMW(); SWRITE_H(SB); }                                                                            \
        RESC(alX); __syncthreads(); } while (0)
    for (int t = 1; t + 1 < NT; t += 2) {
        HALF_STEP(pB0, pB1, mnB, alB, pA0, pA1, alA, t, 1, 0, 0);
        HALF_STEP(pA0, pA1, mnA, alA, pB0, pB1, alB, t + 1, 0, 1, 1);
    }
    SBAR(); qkt<1>(pB0, pB1, K_lds, r32, hi, S.qr); SBAR();
    SLOAD_H(nxt.K, nxt.V, (MOBA_SPARSE ? 4 * nxt.iblk : 0) * KVBLK); SBAR();
    { const bf16* qb = nxt.Q + (size_t)(wid * QBLK) * LDR;
#pragma unroll
      for (int d0 = 0; d0 < 8; ++d0) S.qr[d0] = load8(qb + (size_t)qoff + d0 * 16); }
    SBAR();
    finishSM(pA0, pA1, alA, l_reg, pa0, pa1, pa2, pa3); SBAR();
    pv_tile<0>(o, vb0, pa0, pa1, pa2, pa3);
    { bool kp_; MASKT(pB0, pB1, NT - 1, kp_); partialSM(pB0, pB1, m_reg, mnB, alB, kp_); } __syncthreads(); RESC(alB);
    finishSM(pB0, pB1, alB, l_reg, pa0, pa1, pa2, pa3); SBAR(); pv_tile<1>(o, vb0, pa0, pa1, pa2, pa3);
    SBAR(); SEAM_K0();
    int hi_e = hi; asm volatile("" : "+v"(hi_e));
    const int ldo = cur.ldo; bf16* Ow = cur.O + (size_t)(wid * QBLK) * ldo;
    const unsigned ooff = (unsigned)(4 * hi_e * ldo + r32);
    if (!MOBA_SPARSE) {
        if (hi == 0) li_l[r32] = l_reg; asm volatile("s_waitcnt lgkmcnt(0)" ::: "memory");
        float rli[16];
#pragma unroll
        for (int r = 0; r < 16; ++r) rli[r] = __builtin_amdgcn_rcpf(li_l[crow(r, hi_e)]);
#pragma unroll
        for (int r = 0; r < 16; ++r) { bf16* orow = Ow + (size_t)((r & 3) + 8 * (r >> 2)) * ldo;
#pragma unroll
            for (int d0 = 0; d0 < 4; ++d0) { const float v = o[d0][r] * rli[r];
                const float vn = __shfl_xor(v, 1);
                if ((r32 & 1) == 0 && cur.store) *(unsigned*)(orow + (size_t)ooff + d0 * 32) = cvtpk(v, vn); } }
    } else {
        const int np = iblk < 3 ? iblk : 3; constexpr float L2E = 1.4426950408889634f;
        float* mt = (float*)(lds + OFF_KM) + wid * 128;
        const size_t rowg = (size_t)cur.bh * SEQ + (size_t)iblk * QB + wid * QBLK;
        float ms[3], ls[3];
#pragma unroll
        for (int sidx = 0; sidx < 3; ++sidx) { ms[sidx] = -1e30f; ls[sidx] = 0.f;
            if (sidx < np) { const f32x2 v = *(const f32x2*)(PP.ML + ((size_t)sidx * BATCH * NH * SEQ + rowg + r32) * 2); ms[sidx] = v[0]; ls[sidx] = v[1]; } }
        const float M = fmaxf(fmaxf(m_reg, ms[0]), fmaxf(ms[1], ms[2]));
        const float e0 = __builtin_amdgcn_exp2f((m_reg - M) * L2E), e1 = ls[0] * __builtin_amdgcn_exp2f((ms[0] - M) * L2E), e2 = ls[1] * __builtin_amdgcn_exp2f((ms[1] - M) * L2E), e3 = ls[2] * __builtin_amdgcn_exp2f((ms[2] - M) * L2E);
        const float iw = __builtin_amdgcn_rcpf(l_reg * e0 + (e1 + e2 + e3));
        if (hi == 0) *(f32x4*)(mt + 4 * r32) = (f32x4){e0 * iw, e1 * iw, e2 * iw, e3 * iw};
        asm volatile("s_waitcnt lgkmcnt(0)" ::: "memory");
#pragma unroll
        for (int r = 0; r < 16; ++r) { const float w0 = mt[4 * ((r & 3) + 8 * (r >> 2) + 4 * hi_e)];
#pragma unroll
            for (int d0 = 0; d0 < 4; ++d0) o[d0][r] *= w0; }
        const unsigned lofs0 = (unsigned)(4 * hi_e * 128 + r32);
#pragma unroll
        for (int sidx = 0; sidx < 3; ++sidx) {
            if (sidx < np) {
                const bf16* pbase = PP.P[sidx] + rowg * 128; bf16 pv[16][4];
#pragma unroll
                for (int r = 0; r < 16; ++r)
#pragma unroll
                    for (int d0 = 0; d0 < 4; ++d0) pv[r][d0] = pbase[(size_t)((r & 3) + 8 * (r >> 2)) * 128 + lofs0 + d0 * 32];
#pragma unroll
                for (int r = 0; r < 16; ++r) { const float wsl = mt[4 * ((r & 3) + 8 * (r >> 2) + 4 * hi_e) + 1 + sidx];
#pragma unroll
                    for (int d0 = 0; d0 < 4; ++d0) o[d0][r] += wsl * bf2f(pv[r][d0]); }
            }
        }
#pragma unroll
        for (int r = 0; r < 16; ++r) { bf16* orow = Ow + (size_t)((r & 3) + 8 * (r >> 2)) * ldo;
#pragma unroll
            for (int d0 = 0; d0 < 4; ++d0) { const float v = o[d0][r]; const float vn = __shfl_xor(v, 1);
                if ((r32 & 1) == 0 && cur.store) *(unsigned*)(orow + (size_t)ooff + d0 * 32) = cvtpk(v, vn); } }
    }
    __syncthreads();
#undef RESC
#undef KBASE
#undef MASKT
#undef SEAM_K0
#undef HALF_STEP
}

__device__ __forceinline__ void sel_phase(const bf16* qkv, const float* kmean, unsigned short* LIST, unsigned* CNT, char* lds, int tid) {
    const int wid = __builtin_amdgcn_readfirstlane(tid >> 6), lane = tid & 63, r32 = lane & 31, hi = lane >> 5;
    float* KMs = (float*)(lds + OFF_KM); unsigned* cw = (unsigned*)(lds + OFF_WS);
    for (int u = blockIdx.x; u < BATCH * NH * 15; u += gridDim.x) {
        const int bh = u / 15, i = 1 + u % 15, b = bh >> 3, h = bh & 7;
        __syncthreads();
        *(f32x4*)(KMs + tid * 4) = *(const f32x4*)(kmean + (size_t)bh * 2048 + tid * 4);
        bf16x8 qr[8];
        { const bf16* qb = qkv + ((size_t)b * SEQ + (size_t)i * QB + wid * QBLK + r32) * LDR + h * 128 + hi * 8;
#pragma unroll
          for (int d0 = 0; d0 < 8; ++d0) qr[d0] = load8(qb + d0 * 16); }
        __syncthreads();
        float v1 = -__builtin_inff(), v2 = v1, v3 = v1; int i1 = -1, i2 = -1, i3 = -1;
        for (int j = 0; j < i; ++j) {
            const float* km = KMs + j * 128 + 8 * hi; float a = 0.f;
#pragma unroll
            for (int d0 = 0; d0 < 8; ++d0) { const f32x4 k0 = *(const f32x4*)(km + 16 * d0), k1 = *(const f32x4*)(km + 16 * d0 + 4); const bf16x8 q = qr[d0];
#pragma unroll
                for (int e = 0; e < 4; ++e) { a = fmaf(__uint_as_float((unsigned)(unsigned short)q[e] << 16), k0[e], a); a = fmaf(__uint_as_float((unsigned)(unsigned short)q[e + 4] << 16), k1[e], a); } }
            a += __shfl_xor(a, 32);
            if (a > v1) { v3 = v2; i3 = i2; v2 = v1; i2 = i1; v1 = a; i1 = j; }
            else if (a > v2) { v3 = v2; i3 = i2; v2 = a; i2 = j; }
            else if (a > v3) { v3 = a; i3 = j; }
        }
        const unsigned sel = (i1 >= 0 ? 1u << i1 : 0u) | (i2 >= 0 ? 1u << i2 : 0u) | (i3 >= 0 ? 1u << i3 : 0u);
        for (int j = 0; j < i; ++j) {
            const unsigned long long bal = __ballot(((sel >> j) & 1u) != 0u && hi == 0);
            if (lane == 0) cw[j * 8 + wid] = (unsigned)__popcll(bal); }
        __syncthreads();
        for (int j = 0; j < i; ++j) {
            const bool on = ((sel >> j) & 1u) != 0u && hi == 0;
            const unsigned long long bal = __ballot(on);
            unsigned off = 0, tot = 0;
#pragma unroll
            for (int w = 0; w < 8; ++w) { const unsigned c = cw[j * 8 + w]; off += w < wid ? c : 0u; tot += c; }
            if (on) { const unsigned rank = (unsigned)__popcll(bal & ((1ull << lane) - 1ull)), slot = (unsigned)__popc(sel & ((1u << j) - 1u));
                LIST[((size_t)(bh * 16 + i) * 16 + j) * 256 + off + rank] = (unsigned short)((wid * 32 + r32) | (slot << 8)); }
            if (tid == 0) CNT[(bh * 16 + i) * 16 + j] = tot;
        }
    }
}
__device__ __forceinline__ void past_phase(const bf16* qkv, const unsigned short* LIST, const unsigned* CNT, const Partials& PP, unsigned* head, char* lds, int tid) {
    const int wid = __builtin_amdgcn_readfirstlane(tid >> 6), lane = tid & 63, r32 = lane & 31, hi = lane >> 5;
    char* V_lds = lds; char* K_lds = lds + 4 * SHM_V;
    constexpr int OFF_X = 8 * SHM_V;
    float* ws = (float*)(lds + OFF_X) + wid * 96; float* al_l = ws; unsigned* rt = (unsigned*)(ws + 32);
    float* li_l = ws + 64;
    unsigned* gt = (unsigned*)(lds + OFF_X + 8 * 96 * 4);
    const int sr = tid >> 4, sc = (tid & 15) * 8, vst0 = v_st(sr, sc), vst1 = v_st(32 + sr, sc), kws = KSWZ(sr, sc * 2);
    const unsigned soff = (unsigned)(sr * LDR + sc);
    const int vb0 = (int)(uintptr_t)V_lds + v_rd_base(lane);
    for (;;) {
        __syncthreads();
        if (tid == 0) gt[32] = __hip_atomic_fetch_add(head, 1u, __ATOMIC_RELAXED, __HIP_MEMORY_SCOPE_AGENT);
        __syncthreads();
        const int item = (int)gt[32]; if (item >= BATCH * NH * 15) break;
        const int j = item >> 6, bh = item & 63, b = bh >> 3, h = bh & 7;
        { const bf16* kp = qkv + ((size_t)b * SEQ + (size_t)j * QB) * LDR + 1024 + h * 128; const bf16* vp = kp + 1024;
          bf16x8 kk[4][2], vv[4][2];
#pragma unroll
          for (int t = 0; t < 4; ++t) { kk[t][0] = load8(kp + (size_t)(64 * t) * LDR + soff); kk[t][1] = load8(kp + (size_t)(64 * t + 32) * LDR + soff);
                                        vv[t][0] = load8(vp + (size_t)(64 * t) * LDR + soff); vv[t][1] = load8(vp + (size_t)(64 * t + 32) * LDR + soff); }
          if (tid < 16) { const unsigned c = tid > j ? CNT[(bh * 16 + tid) * 16 + j] : 0u; gt[16 + tid] = c; gt[tid] = (c + 31u) >> 5; }
#pragma unroll
          for (int t = 0; t < 4; ++t) { *(bf16x8*)(K_lds + t * SHM_K + kws) = kk[t][0]; *(bf16x8*)(K_lds + t * SHM_K + kws + 32 * 256) = kk[t][1];
                                        *(bf16x8*)(V_lds + t * SHM_V + vst0) = vv[t][0]; *(bf16x8*)(V_lds + t * SHM_V + vst1) = vv[t][1]; } }
        __syncthreads();
        int gtot = 0;
        for (int i = j + 1; i < 16; ++i) gtot += (int)gt[i];
        for (int g = wid; g < gtot; g += 8) {
            int i = j + 1, gl = g;
            while (gl >= (int)gt[i]) { gl -= (int)gt[i]; ++i; }
            const int cnt = (int)gt[16 + i], e = gl * 32 + r32; const bool valid = e < cnt;
            const unsigned ent = LIST[((size_t)(bh * 16 + i) * 16 + j) * 256 + (valid ? e : 0)];
            const int rowl = (int)(ent & 255u);
            if (hi == 0) rt[r32] = ent | (valid ? 0x10000u : 0u);
            bf16x8 qr[8];
            { const bf16* qb = qkv + ((size_t)b * SEQ + (size_t)i * QB + rowl) * LDR + h * 128 + hi * 8;
#pragma unroll
              for (int d0 = 0; d0 < 8; ++d0) qr[d0] = load8(qb + d0 * 16); }
            float m_reg = -1e30f, l_reg = 0.f; f32x16 o[4] = {};
            f32x16 pA0, pA1, pB0, pB1; float mnA, mnB, alA, alB; bf16x8 pa0, pa1, pa2, pa3;
#define RESC2(a) do { if (__any((a) < 1.f)) { if (hi == 0) al_l[r32] = (a); asm volatile("s_waitcnt lgkmcnt(0)" ::: "memory");              \
                     for (int d_ = 0; d_ < 4; ++d_) for (int r = 0; r < 16; ++r) o[d_][r] *= al_l[crow(r, hi)]; } } while (0)
            SBAR(); qkt<0>(pA0, pA1, K_lds, r32, hi, qr); partialSM(pA0, pA1, m_reg, mnA, alA);
            SBAR(); qkt<1>(pB0, pB1, K_lds, r32, hi, qr); finishSM(pA0, pA1, alA, l_reg, pa0, pa1, pa2, pa3); SBAR(); pv_tile<0>(o, vb0, pa0, pa1, pa2, pa3); partialSM(pB0, pB1, m_reg, mnB, alB); RESC2(alB);
            SBAR(); qkt<2>(pA0, pA1, K_lds, r32, hi, qr); finishSM(pB0, pB1, alB, l_reg, pa0, pa1, pa2, pa3); SBAR(); pv_tile<1>(o, vb0, pa0, pa1, pa2, pa3); partialSM(pA0, pA1, m_reg, mnA, alA); RESC2(alA);
            SBAR(); qkt<3>(pB0, pB1, K_lds, r32, hi, qr); finishSM(pA0, pA1, alA, l_reg, pa0, pa1, pa2, pa3); SBAR(); pv_tile<2>(o, vb0, pa0, pa1, pa2, pa3); partialSM(pB0, pB1, m_reg, mnB, alB); RESC2(alB);
            SBAR(); finishSM(pB0, pB1, alB, l_reg, pa0, pa1, pa2, pa3); SBAR(); pv_tile<3>(o, vb0, pa0, pa1, pa2, pa3);
#undef RESC2
            const size_t rowb = (size_t)bh * SEQ + (size_t)i * QB;
            if (hi == 0) { li_l[r32] = __builtin_amdgcn_rcpf(l_reg);
                if (valid) *(f32x2*)(PP.ML + ((size_t)(ent >> 8) * BATCH * NH * SEQ + rowb + rowl) * 2) = (f32x2){m_reg, l_reg}; }
            asm volatile("s_waitcnt lgkmcnt(0)" ::: "memory");
#pragma unroll
            for (int r = 0; r < 16; ++r) { const int rr = crow(r, hi); const unsigned en = rt[rr]; const float il = li_l[rr];
                bf16* pb = ((en >> 8) & 3u) == 0u ? PP.P[0] : ((en >> 8) & 3u) == 1u ? PP.P[1] : PP.P[2];
                bf16* prow = pb + (rowb + (en & 255u)) * 128 + r32;
#pragma unroll
                for (int d0 = 0; d0 < 4; ++d0) { const float v = o[d0][r] * il; const float vn = __shfl_xor(v, 1);
                    if ((r32 & 1) == 0 && (en & 0x10000u)) *(unsigned*)(prow + d0 * 32) = cvtpk(v, vn); } }
        }
    }
}
#ifndef MOBA_PP
#define MOBA_PP 0
#endif
constexpr int PP_OFF_WS = 4 * SHM_V + 4 * SHM_K, PP_OFF_KM = 139264 + 64, PP_LDS_BYTES = PP_OFF_KM + 15 * 128 * 4;
static_assert(PP_OFF_WS + NW * 64 * 4 <= 139264 && PP_LDS_BYTES <= 147456, "LDS map");
#define PPBAR() do { asm volatile("s_waitcnt lgkmcnt(0)" ::: "memory"); __builtin_amdgcn_s_barrier(); asm volatile("" ::: "memory"); } while (0)
__device__ __forceinline__ void moba_block_pp(const BlockRef& cur, char* lds, int tid_) {
    int tid = tid_; asm volatile("" : "+v"(tid));
    const int wid = __builtin_amdgcn_readfirstlane(tid >> 6), lane = tid & 63, r32 = lane & 31, hi = lane >> 5, half = wid >> 2;
    const int iblk = cur.iblk, NT = 4 * (iblk + 1), P0 = iblk * QB;
    const int qlo = P0 + wid * QBLK, qm = qlo + r32 - 4 * hi;
    char* V_lds = lds; char* K_lds = lds + 4 * SHM_V;
    float* KMs = (float*)(lds + PP_OFF_KM);
    float* ws = (float*)(lds + PP_OFF_WS) + wid * 64; float* li_l = ws, * al_l = ws + 32;
    const int sr = tid >> 4, sc = (tid & 15) * 8, vst0 = v_st(sr, sc), vst1 = v_st(32 + sr, sc), kws = KSWZ(sr, sc * 2);
    const unsigned soff = (unsigned)(sr * LDR + sc), qoff = (unsigned)(r32 * LDR + hi * 8);
    const int vb0 = (int)(uintptr_t)V_lds + v_rd_base(lane);
    const bf16* Kh = cur.K; const bf16* Vh = cur.V;
    Seam S;
    { const bf16* qb = cur.Q + (size_t)(wid * QBLK) * LDR;
#pragma unroll
      for (int d0 = 0; d0 < 8; ++d0) S.qr[d0] = load8(qb + (size_t)qoff + d0 * 16); }
    { int t4 = tid; asm volatile("" : "+v"(t4));
      const f32x4 kmv = *(const f32x4*)(cur.KM + t4 * 4);
      SLOAD_H(Kh, Vh, 0); VMW();
      if (t4 < 15 * 32) *(f32x4*)(KMs + t4 * 4) = kmv; SWRITE_H(0); }
    SLOAD_H(Kh, Vh, KVBLK);
    __syncthreads();
    unsigned sel = 0u;
    if (iblk > 0) {
        float v1 = -__builtin_inff(), v2 = v1, v3 = v1; int i1 = -1, i2 = -1, i3 = -1;
        for (int j = 0; j < iblk; ++j) {
            const float* km = KMs + j * 128 + 8 * hi; float a = 0.f;
#pragma unroll
            for (int d0 = 0; d0 < 8; ++d0) { const f32x4 k0 = *(const f32x4*)(km + 16 * d0), k1 = *(const f32x4*)(km + 16 * d0 + 4); const bf16x8 q = S.qr[d0];
#pragma unroll
                for (int e = 0; e < 4; ++e) { a = fmaf(__uint_as_float((unsigned)(unsigned short)q[e] << 16), k0[e], a); a = fmaf(__uint_as_float((unsigned)(unsigned short)q[e + 4] << 16), k1[e], a); } }
            a += __shfl_xor(a, 32);
            if (a > v1) { v3 = v2; i3 = i2; v2 = v1; i2 = i1; v1 = a; i1 = j; }
            else if (a > v2) { v3 = v2; i3 = i2; v2 = a; i2 = j; }
            else if (a > v3) { v3 = a; i3 = j; }
        }
        sel = (i1 >= 0 ? 1u << i1 : 0u) | (i2 >= 0 ? 1u << i2 : 0u) | (i3 >= 0 ? 1u << i3 : 0u);
    }
    VMW(); SWRITE_H(1); SLOAD_H(Kh, Vh, 2 * KVBLK);
    __syncthreads();
    float m_reg = -1e30f, l_reg = 0; f32x16 o[4] = {};
    f32x16 pA0, pA1, pB0 = {}, pB1 = {}; float mnA, mnB, alA = 1.f, alB = 1.f; bf16x8 pa0, pa1, pa2, pa3;
#define RESC(a) do { if (__any((a) < 1.f)) { if (hi == 0) al_l[r32] = (a); asm volatile("s_waitcnt lgkmcnt(0)" ::: "memory");              \
                     for (int d_ = 0; d_ < 4; ++d_) for (int r = 0; r < 16; ++r) o[d_][r] *= al_l[crow(r, hi)]; } } while (0)
#define MASKT(P0_, P1_, t) do { const int kb_ = (t) * KVBLK; const int bj_ = (t) >> 2; \
        if (bj_ == iblk) { if (kb_ + KVBLK - 1 > qlo) mask_causal(P0_, P1_, qm - kb_); } else mask_all(P0_, P1_, ((sel >> bj_) & 1u) != 0u); } while (0)
#define PP_STEP(t, SL, PX0, PX1, mnX, alX, PY0, PY1, alY, HASPREV) do {                                                              \
        __builtin_amdgcn_s_setprio(1); qkt<SL>(PX0, PX1, K_lds, r32, hi, S.qr); __builtin_amdgcn_s_setprio(0); PPBAR();                 \
        if (HASPREV) finishSM(PY0, PY1, alY, l_reg, pa0, pa1, pa2, pa3); PPBAR();                                                       \
        if (HASPREV) { __builtin_amdgcn_s_setprio(1); pv_tile<((SL) + 3) & 3>(o, vb0, pa0, pa1, pa2, pa3); __builtin_amdgcn_s_setprio(0); } PPBAR(); \
        MASKT(PX0, PX1, (t)); partialSM(PX0, PX1, m_reg, mnX, alX); RESC(alX);                                                          \
        if ((t) + 2 < NT) { VMW(); SWRITE_H(((SL) + 2) & 3); if ((t) + 3 < NT) SLOAD_H(Kh, Vh, ((t) + 3) * KVBLK); }                    \
        PPBAR(); } while (0)
    if (half == 1) PPBAR();
    for (int t = 0; t < NT; t += 4) {
        PP_STEP(t,     0, pA0, pA1, mnA, alA, pB0, pB1, alB, t > 0);
        PP_STEP(t + 1, 1, pB0, pB1, mnB, alB, pA0, pA1, alA, true);
        PP_STEP(t + 2, 2, pA0, pA1, mnA, alA, pB0, pB1, alB, true);
        PP_STEP(t + 3, 3, pB0, pB1, mnB, alB, pA0, pA1, alA, true);
    }
    if (half == 0) PPBAR();
    finishSM(pB0, pB1, alB, l_reg, pa0, pa1, pa2, pa3); SBAR(); pv_tile<3>(o, vb0, pa0, pa1, pa2, pa3);
    { int hi_e = hi; asm volatile("" : "+v"(hi_e));
      const int ldo = cur.ldo; bf16* Ow = cur.O + (size_t)(wid * QBLK) * ldo;
      const unsigned ooff = (unsigned)(4 * hi_e * ldo + r32);
      if (hi == 0) li_l[r32] = l_reg; asm volatile("s_waitcnt lgkmcnt(0)" ::: "memory");
      float rli[16];
#pragma unroll
      for (int r = 0; r < 16; ++r) rli[r] = __builtin_amdgcn_rcpf(li_l[crow(r, hi_e)]);
#pragma unroll
      for (int r = 0; r < 16; ++r) { bf16* orow = Ow + (size_t)((r & 3) + 8 * (r >> 2)) * ldo;
#pragma unroll
          for (int d0 = 0; d0 < 4; ++d0) { const float v = o[d0][r] * rli[r];
              const float vn = __shfl_xor(v, 1);
              if ((r32 & 1) == 0 && cur.store) *(unsigned*)(orow + (size_t)ooff + d0 * 32) = cvtpk(v, vn); } } }
    __syncthreads();
#undef PP_STEP
#undef MASKT
#undef RESC
}
#undef ROW
#undef VMW
#undef VMWN
#undef SLOAD_H
#undef SWRITE_HK
#undef SWRITE_HV
#undef SWRITE_H
#undef KSWZ
#undef SBAR

__device__ __forceinline__ void item_decode(int L, int G, int k, int bx, int& bh, int& x) {
    if (G == 256) { const int xcd = bx & 7, q = bx >> 3; bh = ((k * 8 + xcd) << 2) + (q >> 3); x = q & 7; }
    else { bh = L >> 3; x = L & 7; }
}
__device__ __forceinline__ BlockRef make_ref(bf16* qkv, const float* kmean, bf16* ob, int ldo, int bh, int iblk) {
    const int b = bh >> 3, h = bh & 7; BlockRef r; bf16* base = qkv + (size_t)bh * 3 * ARR;
    r.Q = base + (size_t)iblk * QB * LDR; r.O = ob + ((size_t)b * SEQ + (size_t)iblk * QB) * ldo + h * 128; r.K = base + ARR; r.V = base + 2 * ARR; r.KM = kmean + (size_t)bh * 16 * 128; r.iblk = iblk; r.ldo = ldo; r.store = 1; r.bh = bh; return r;
}
__device__ __forceinline__ void attn_phase(bf16* qkv, const float* kmean, bf16* ob, int ldo, const Partials& PP, char* lds, int tid) {
    const int G = gridDim.x, bx = blockIdx.x, real = BATCH * NH * 8, total = (PROBE_DUP & 16) ? 2 * real : real;
    int L = bx, k = 0; if (L >= total) return;
    int bh, x; item_decode(L % real, G, k & 1, bx, bh, x); int pass = 0;
    BlockRef cur = make_ref(qkv, kmean, ob, ldo, bh, x); cur.store = ((PROBE_DUP & 16) == 0) || L >= real;
    Seam S;
    moba_prime(cur, lds, S, tid);
    for (;;) {
        const bool more_pass = pass == 0, more_item = L + G < total, last = !more_pass && !more_item;
        int bhn = bh, xn = x, passn = pass + 1, Ln = L, kn = k;
        if (!more_pass) { passn = 0; if (more_item) { Ln = L + G; kn = k + 1; } item_decode(Ln % real, G, kn & 1, bx, bhn, xn); }
        BlockRef nxt = last ? cur : make_ref(qkv, kmean, ob, ldo, bhn, passn ? 15 - xn : xn); nxt.store = ((PROBE_DUP & 16) == 0) || Ln >= real;
        moba_block(cur, nxt, PP, lds, S, tid);
        if (last) break;
        cur = nxt; bh = bhn; x = xn; pass = passn; L = Ln; k = kn;
    }
}
__device__ __forceinline__ void attn_phase_pp(bf16* qkv, const float* kmean, bf16* ob, int ldo, char* lds, int tid) {
    const int G = gridDim.x, bx = blockIdx.x, real = BATCH * NH * 8, total = (PROBE_DUP & 16) ? 2 * real : real;
    int k = 0;
    for (int L = bx; L < total; L += G, ++k) {
        int bh, x; item_decode(L % real, G, k & 1, bx, bh, x);
#pragma unroll 1
        for (int pass = 0; pass < 2; ++pass) {
            BlockRef cur = make_ref(qkv, kmean, ob, ldo, bh, pass ? 15 - x : x); cur.store = ((PROBE_DUP & 16) == 0) || L >= real;
            moba_block_pp(cur, lds, tid);
        }
    }
}
}
namespace hg {
typedef short bf16x8 __attribute__((ext_vector_type(8)));
typedef short s16x4 __attribute__((ext_vector_type(4)));
typedef float f32x16 __attribute__((ext_vector_type(16)));
constexpr int LDB = 4096, CH = 64, NCH_SEG = 16, NSEG = 4;
constexpr int RS = 272, TS = 144, OST_RS = 528;
constexpr int OFF_QR = 0, OFF_KR = 17408, OFF_QI = 34816, OFF_KT = 52224, OFF_VT = 70656, OFF_DEC = 89088, OFF_OST = 89600, HG_LDS_BYTES = OFF_OST + 64 * OST_RS;
static_assert(HG_LDS_BYTES <= 131072, "HGRN LDS map");
__device__ __forceinline__ unsigned pk(float lo, float hi) { unsigned r; asm volatile("v_cvt_pk_bf16_f32 %0, %1, %2" : "=v"(r) : "v"(lo), "v"(hi)); return r; }
__device__ __forceinline__ bf16x8 join8(s16x4 a, s16x4 b) { return (bf16x8){a[0], a[1], a[2], a[3], b[0], b[1], b[2], b[3]}; }
__device__ __forceinline__ bf16x8 acc_frag(const f32x16& x, int s) {
    u32x4 w; w.x = pk(x[8 * s + 0], x[8 * s + 1]); w.y = pk(x[8 * s + 2], x[8 * s + 3]); w.z = pk(x[8 * s + 4], x[8 * s + 5]); w.w = pk(x[8 * s + 6], x[8 * s + 7]);
    return __builtin_bit_cast(bf16x8, w);
}
template <bool FULL> struct Raw { bf16 z[16], v[16], q[FULL ? 16 : 1]; };
struct Scan { float kk[16], G[16]; };
constexpr int OFF_TQ = 131072;
template <bool FULL>
__device__ __forceinline__ void load_z(Raw<FULL>& R, const bf16* __restrict__ base, int lane, int wave) {
    const bf16* p = base + (size_t)(16 * (wave >> 1)) * LDB + 64 * (wave & 1) + lane + 1024;
#pragma unroll
    for (int i = 0; i < 16; ++i) R.z[i] = p[(size_t)i * LDB];
}
template <bool FULL>
__device__ __forceinline__ void load_qv(Raw<FULL>& R, const bf16* __restrict__ base, int lane, int wave) {
    const bf16* p = base + (size_t)(16 * (wave >> 1)) * LDB + 64 * (wave & 1) + lane;
#pragma unroll
    for (int i = 0; i < 16; ++i) { R.v[i] = p[(size_t)i * LDB + 2048]; if (FULL) R.q[i] = p[(size_t)i * LDB]; }
}
template <bool FULL>
__device__ __forceinline__ void build_scan(Scan& C, const Raw<FULL>& R, float lb, LAS unsigned char* lds, int lane, int wave) {
    const int c = 64 * (wave & 1) + lane, qq = wave >> 1;
    float run = 0.f; const float omlb = 1.0f - lb;
#pragma unroll
    for (int i = 0; i < 16; ++i) { const float e = __expf(-bf2f(R.z[i])); const float sg = __builtin_amdgcn_rcpf(1.0f + e); C.kk[i] = omlb * (e * sg); run += __logf(lb + omlb * sg); C.G[i] = run; }
    *(LAS float*)(lds + OFF_TQ + 4 * (qq * 128 + c)) = run;
}
template <bool FULL>
__device__ __forceinline__ float build_ops(const Scan& C, const Raw<FULL>& R, LAS unsigned char* lds, int lane, int wave) {
    const int c = 64 * (wave & 1) + lane, qq = wave >> 1;
    const float T0 = *(const LAS float*)(lds + OFF_TQ + 4 * c), T1 = *(const LAS float*)(lds + OFF_TQ + 4 * (128 + c)), T2 = *(const LAS float*)(lds + OFF_TQ + 4 * (256 + c)), T3 = *(const LAS float*)(lds + OFF_TQ + 4 * (384 + c));
    const float gmid = T0 + T1, glast = gmid + (T2 + T3);
    const float off = qq == 0 ? 0.f : qq == 1 ? T0 : qq == 2 ? gmid : gmid + T2;
    const float Egm = __expf(gmid), Elm = __expf(glast - gmid);
    unsigned ktw[8], vtw[8];
#pragma unroll
    for (int i = 0; i < 16; i += 2) {
        float ks[2];
#pragma unroll
        for (int e = 0; e < 2; ++e) { const int t = 16 * qq + i + e; const float E1 = __expf(C.G[i + e] + off - gmid), R1 = __builtin_amdgcn_rcpf(E1);
            ks[e] = C.kk[i + e] * R1 * Elm;
            if (FULL) { const float qe = bf2f(R.q[FULL ? i + e : 0]) * QSCALE * E1;
                *(LAS bf16*)(lds + OFF_QR + t * RS + 2 * c) = (bf16)(pk(qe, 0.f) & 0xffffu);
                *(LAS bf16*)(lds + OFF_KR + t * RS + 2 * c) = (bf16)(pk(C.kk[i + e] * R1, 0.f) & 0xffffu);
                *(LAS bf16*)(lds + OFF_QI + t * RS + 2 * c) = (bf16)(pk(qe * Egm, 0.f) & 0xffffu); } }
        ktw[i >> 1] = pk(ks[0], ks[1]); vtw[i >> 1] = (unsigned)R.v[i] | ((unsigned)R.v[i + 1] << 16); }
    *(LAS u32x4*)(lds + OFF_KT + c * TS + 32 * qq) = (u32x4){ktw[0], ktw[1], ktw[2], ktw[3]}; *(LAS u32x4*)(lds + OFF_KT + c * TS + 32 * qq + 16) = (u32x4){ktw[4], ktw[5], ktw[6], ktw[7]};
    *(LAS u32x4*)(lds + OFF_VT + c * TS + 32 * qq) = (u32x4){vtw[0], vtw[1], vtw[2], vtw[3]}; *(LAS u32x4*)(lds + OFF_VT + c * TS + 32 * qq + 16) = (u32x4){vtw[4], vtw[5], vtw[6], vtw[7]};
    if (qq == 0) *(LAS float*)(lds + OFF_DEC + 4 * c) = __expf(glast);
    return glast;
}
__device__ __forceinline__ void state_update(f32x16 (&S)[4], LAS unsigned char* lds, int j, int c, int h) {
#pragma unroll
    for (int i = 0; i < 4; ++i) {
#pragma unroll
        for (int g4 = 0; g4 < 4; ++g4) { const f32x4 dc = *(const LAS f32x4*)(lds + OFF_DEC + 4 * (32 * i + 8 * g4 + 4 * h));
#pragma unroll
            for (int e = 0; e < 4; ++e) S[i][4 * g4 + e] *= dc[e]; }
#pragma unroll
        for (int ks = 0; ks < 4; ++ks) {
            const bf16x8 a = *(const LAS bf16x8*)(lds + OFF_KT + (32 * i + c) * TS + (16 * ks + 8 * h) * 2);
            const bf16x8 b = *(const LAS bf16x8*)(lds + OFF_VT + (32 * j + c) * TS + (16 * ks + 8 * h) * 2);
            S[i] = __builtin_amdgcn_mfma_f32_32x32x16_bf16(a, b, S[i], 0, 0, 0); }
    }
}
__device__ __forceinline__ int crow(int r, int h) { return (r & 3) + 8 * (r >> 2) + 4 * h; }

__device__ __forceinline__ void pass_a(const bf16* __restrict__ big, const float* __restrict__ lbv, float* __restrict__ Eg, float* __restrict__ Dg, LAS unsigned char* lds, int lane, int wave) {
    const int j = wave & 3, th = wave >> 2, c = lane & 31, h = lane >> 5;
    for (int u = blockIdx.x; u < BATCH * NH * NSEG; u += gridDim.x) {
        const int seg = u & 3, hh = (u >> 2) & 7, b = u >> 5;
        if (seg == NSEG - 1) continue;
        const int cch = 64 * (wave & 1) + lane;
        const float lb = lbv[hh * 128 + cch];
        f32x16 S[4];
#pragma unroll
        for (int i = 0; i < 4; ++i) S[i] = f32x16{};
        float dsum = 0.f;
        const bf16* base = big + (size_t)(b * SEQ + seg * NCH_SEG * CH) * LDB + hh * 128;
        Raw<false> R; load_z<false>(R, base, lane, wave); load_qv<false>(R, base, lane, wave);
        Scan C; build_scan<false>(C, R, lb, lds, lane, wave);
        load_z<false>(R, base + (size_t)CH * LDB, lane, wave);
        __syncthreads();
        for (int ch = 0; ch < NCH_SEG; ++ch) {
            dsum += build_ops<false>(C, R, lds, lane, wave);
            __syncthreads();
            if (ch + 1 < NCH_SEG) load_qv<false>(R, base + (size_t)(ch + 1) * CH * LDB, lane, wave);
            state_update(S, lds, j, c, h);
            if (ch + 1 < NCH_SEG) { build_scan<false>(C, R, lb, lds, lane, wave); if (ch + 2 < NCH_SEG) load_z<false>(R, base + (size_t)(ch + 2) * CH * LDB, lane, wave); }
            __syncthreads();
        }
        if ((wave >> 1) == 0) Dg[(size_t)u * 128 + cch] = dsum;
        if (th == 0) {
            float* E = Eg + (size_t)u * 16384;
#pragma unroll
            for (int i = 0; i < 4; ++i)
#pragma unroll
                for (int r = 0; r < 16; ++r) E[(size_t)(32 * i + crow(r, h)) * 128 + 32 * j + c] = S[i][r];
        }
    }
}
__device__ __forceinline__ void pass_b(bf16* big, bf16* outp, int ldo, int store, const float* __restrict__ lbv, const float* __restrict__ og, const float* __restrict__ Eg, const float* __restrict__ Dg, LAS unsigned char* lds, int lane, int wave) {
    const int j = wave & 3, th = wave >> 2, c = lane & 31, h = lane >> 5, tid = wave * 64 + lane;
    for (int u = blockIdx.x; u < BATCH * NH * NSEG; u += gridDim.x) {
        const int seg = u & 3, hh = (u >> 2) & 7, b = u >> 5;
        const float lb = lbv[hh * 128 + 64 * (wave & 1) + lane];
        f32x16 S[4];
#pragma unroll
        for (int i = 0; i < 4; ++i) S[i] = f32x16{};
        for (int sp = 0; sp < seg; ++sp) {
            const float* E = Eg + (size_t)(u - seg + sp) * 16384; const float* Dp = Dg + (size_t)(u - seg + sp) * 128;
#pragma unroll
            for (int i = 0; i < 4; ++i)
#pragma unroll
                for (int r = 0; r < 16; ++r) { const int d = 32 * i + crow(r, h); S[i][r] = __expf(Dp[d]) * S[i][r] + E[(size_t)d * 128 + 32 * j + c]; }
        }
        const bf16* base = big + ((size_t)b * SEQ + (size_t)seg * NCH_SEG * CH) * LDB + hh * 128;
        Raw<true> R; load_z<true>(R, base, lane, wave); load_qv<true>(R, base, lane, wave);
        Scan C; build_scan<true>(C, R, lb, lds, lane, wave);
        load_z<true>(R, base + (size_t)CH * LDB, lane, wave);
        __syncthreads();
        const int ot = tid >> 3, opart = tid & 7;
        u32x4 gn0, gn1;
        { const bf16* gp = base + (size_t)ot * LDB + 3072 + opart * 16; gn0 = *(const u32x4*)gp; gn1 = *(const u32x4*)(gp + 8); }
        for (int ch = 0; ch < NCH_SEG; ++ch) {
            const size_t row0 = (size_t)b * SEQ + (size_t)(seg * NCH_SEG + ch) * CH;
            if (store != 3) (void)build_ops<true>(C, R, lds, lane, wave);
            const u32x4 g0 = gn0, g1 = gn1;
            __syncthreads();
            if (ch + 1 < NCH_SEG) { const bf16* nb = base + (size_t)(ch + 1) * CH * LDB; load_qv<true>(R, nb, lane, wave);
                const bf16* gp = nb + (size_t)ot * LDB + 3072 + opart * 16; gn0 = *(const u32x4*)gp; gn1 = *(const u32x4*)(gp + 8); }
            if (store == 2) { __syncthreads(); continue; }
            bf16x8 P[2][2];
#pragma unroll
            for (int sh = 0; sh < 2; ++sh) {
                if (sh <= th) {
                    f32x16 X = f32x16{};
#pragma unroll
                    for (int ks = 0; ks < 8; ++ks) {
                        const bf16x8 a = *(const LAS bf16x8*)(lds + OFF_KR + (32 * sh + c) * RS + (16 * ks + 8 * h) * 2);
                        const bf16x8 bq = *(const LAS bf16x8*)(lds + OFF_QR + (32 * th + c) * RS + (16 * ks + 8 * h) * 2);
                        X = __builtin_amdgcn_mfma_f32_32x32x16_bf16(a, bq, X, 0, 0, 0); }
                    if (sh == th) {
#pragma unroll
                        for (int r = 0; r < 16; ++r) X[r] = crow(r, h) <= c ? X[r] : 0.f; }
                    P[sh][0] = acc_frag(X, 0); P[sh][1] = acc_frag(X, 1);
                } else { P[sh][0] = bf16x8{}; P[sh][1] = bf16x8{}; }
            }
            f32x16 o = f32x16{};
#pragma unroll
            for (int i = 0; i < 4; ++i)
#pragma unroll
                for (int s = 0; s < 2; ++s) {
                    const LAS unsigned char* qa = lds + OFF_QI + (32 * th + c) * RS + (32 * i + 16 * s + 4 * h) * 2;
                    const bf16x8 a = join8(*(const LAS s16x4*)qa, *(const LAS s16x4*)(qa + 16));
                    o = __builtin_amdgcn_mfma_f32_32x32x16_bf16(a, acc_frag(S[i], s), o, 0, 0, 0); }
#pragma unroll
            for (int sh = 0; sh < 2; ++sh) {
                if (sh <= th) {
#pragma unroll
                    for (int s = 0; s < 2; ++s) {
                        const LAS unsigned char* va = lds + OFF_VT + (32 * j + c) * TS + (32 * sh + 16 * s + 4 * h) * 2;
                        const bf16x8 bv = join8(*(const LAS s16x4*)va, *(const LAS s16x4*)(va + 16));
                        o = __builtin_amdgcn_mfma_f32_32x32x16_bf16(P[sh][s], bv, o, 0, 0, 0); } }
            }
            state_update(S, lds, j, c, h);
            if (ch + 1 < NCH_SEG) { build_scan<true>(C, R, lb, lds, lane, wave); if (ch + 2 < NCH_SEG) load_z<true>(R, base + (size_t)(ch + 2) * CH * LDB, lane, wave); }
#pragma unroll
            for (int r = 0; r < 16; ++r) *(LAS float*)(lds + OFF_OST + (32 * th + crow(r, h)) * OST_RS + (32 * j + c) * 4) = o[r];
            __syncthreads();
            {
                const int t = ot, part = opart;
                const LAS f32x4* op = (const LAS f32x4*)(lds + OFF_OST + t * OST_RS + part * 64);
                const f32x4 o0 = op[0], o1 = op[1], o2 = op[2], o3 = op[3];
                float ss = (o0[0] * o0[0] + o0[1] * o0[1]) + (o0[2] * o0[2] + o0[3] * o0[3]) + (o1[0] * o1[0] + o1[1] * o1[1]) + (o1[2] * o1[2] + o1[3] * o1[3])
                         + (o2[0] * o2[0] + o2[1] * o2[1]) + (o2[2] * o2[2] + o2[3] * o2[3]) + (o3[0] * o3[0] + o3[1] * o3[1]) + (o3[2] * o3[2] + o3[3] * o3[3]);
                ss += __shfl_xor(ss, 1); ss += __shfl_xor(ss, 2); ss += __shfl_xor(ss, 4);
                const float rstd = __builtin_amdgcn_rsqf(ss * (1.0f / 128.0f) + 1e-6f);
                bf16* yp = outp + (row0 + t) * ldo + hh * 128 + part * 16;
                const f32x4 w0 = *(const f32x4*)(og + part * 16), w1 = *(const f32x4*)(og + part * 16 + 4), w2 = *(const f32x4*)(og + part * 16 + 8), w3 = *(const f32x4*)(og + part * 16 + 12);
                const unsigned gw[8] = {g0.x, g0.y, g0.z, g0.w, g1.x, g1.y, g1.z, g1.w};
                const float ov[16] = {o0[0], o0[1], o0[2], o0[3], o1[0], o1[1], o1[2], o1[3], o2[0], o2[1], o2[2], o2[3], o3[0], o3[1], o3[2], o3[3]};
                const float wv[16] = {w0[0], w0[1], w0[2], w0[3], w1[0], w1[1], w1[2], w1[3], w2[0], w2[1], w2[2], w2[3], w3[0], w3[1], w3[2], w3[3]};
                unsigned ow[8];
#pragma unroll
                for (int e = 0; e < 8; ++e) { const float ga = __uint_as_float(gw[e] << 16), gb = __uint_as_float(gw[e] & 0xffff0000u);
                    const float ya = ov[2 * e] * rstd * wv[2 * e] * (ga * __builtin_amdgcn_rcpf(1.0f + __expf(-ga)));
                    const float yb = ov[2 * e + 1] * rstd * wv[2 * e + 1] * (gb * __builtin_amdgcn_rcpf(1.0f + __expf(-gb)));
                    ow[e] = pk(ya, yb); }
                if (store == 1) { *(u32x4*)yp = (u32x4){ow[0], ow[1], ow[2], ow[3]}; *(u32x4*)(yp + 8) = (u32x4){ow[4], ow[5], ow[6], ow[7]}; }
            }
        }
        __syncthreads();
    }
}
}
namespace hg2 {
#define HG2_BAR() do { asm volatile("s_waitcnt lgkmcnt(0)" ::: "memory"); __builtin_amdgcn_s_barrier(); asm volatile("" ::: "memory"); } while (0)
typedef short bf16x8 __attribute__((ext_vector_type(8)));
typedef short s16x4 __attribute__((ext_vector_type(4)));
typedef float f32x16 __attribute__((ext_vector_type(16)));
constexpr int LDB = 128, ARR = 4096 * 128, LDG = 1024, CH = 32, NCH_SEG = 32, NSEG = 4;
constexpr int RS = 272, TS = 80, OST_RS = 528;
constexpr int B_QR = 0, B_KR = 8704, B_KT = 17408, B_VT = 27648, B_DEC = 37888, B_EGM = 38400, BUF_BYTES = 38912;
constexpr int OFF_OST = 2 * BUF_BYTES, OST_BYTES = 32 * OST_RS, OFF_SCR = OFF_OST + 2 * OST_BYTES, HG2_LDS_BYTES = OFF_SCR + 4 * 2560;
static_assert(HG2_LDS_BYTES <= 131072, "HGRN LDS map");
__device__ __forceinline__ unsigned pk(float lo, float hi) { unsigned r; asm volatile("v_cvt_pk_bf16_f32 %0, %1, %2" : "=v"(r) : "v"(lo), "v"(hi)); return r; }
__device__ __forceinline__ bf16x8 join8(s16x4 a, s16x4 b) { return (bf16x8){a[0], a[1], a[2], a[3], b[0], b[1], b[2], b[3]}; }
__device__ __forceinline__ int crow(int r, int h) { return (r & 3) + 8 * (r >> 2) + 4 * h; }
__device__ __forceinline__ bf16x8 acc_frag_scaled(const f32x16& x, int s, const f32x4& e0, const f32x4& e1) {
    u32x4 w; w.x = pk(x[8 * s + 0] * e0[0], x[8 * s + 1] * e0[1]); w.y = pk(x[8 * s + 2] * e0[2], x[8 * s + 3] * e0[3]); w.z = pk(x[8 * s + 4] * e1[0], x[8 * s + 5] * e1[1]); w.w = pk(x[8 * s + 6] * e1[2], x[8 * s + 7] * e1[3]);
    return __builtin_bit_cast(bf16x8, w);
}
__device__ __forceinline__ bf16x8 acc_frag(const f32x16& x, int s) {
    u32x4 w; w.x = pk(x[8 * s + 0], x[8 * s + 1]); w.y = pk(x[8 * s + 2], x[8 * s + 3]); w.z = pk(x[8 * s + 4], x[8 * s + 5]); w.w = pk(x[8 * s + 6], x[8 * s + 7]);
    return __builtin_bit_cast(bf16x8, w);
}
template <bool FULL> struct Raw { u32x4 z[2], v[2], q[FULL ? 2 : 1]; };
constexpr int SCR_RS = 80, SCR_BYTES = 32 * SCR_RS;
template <bool FULL>
__device__ __forceinline__ void load_raw(Raw<FULL>& R, const bf16* __restrict__ base, int lane, int bw) {
    const bf16* p = base + (size_t)(lane >> 2) * LDB + 32 * bw + 8 * (lane & 3);
#pragma unroll
    for (int e = 0; e < 2; ++e) { R.z[e] = *(const u32x4*)(p + (size_t)(16 * e) * LDB + ARR); R.v[e] = *(const u32x4*)(p + (size_t)(16 * e) * LDB + 2 * ARR); if (FULL) R.q[e] = *(const u32x4*)(p + (size_t)(16 * e) * LDB); }
}
__device__ __forceinline__ void transpose16(float (&out)[16], const u32x4 (&src)[2], LAS unsigned char* scr, int lane) {
    *(LAS u32x4*)(scr + (lane >> 2) * SCR_RS + 16 * (lane & 3)) = src[0]; *(LAS u32x4*)(scr + ((lane >> 2) + 16) * SCR_RS + 16 * (lane & 3)) = src[1];
    asm volatile("s_waitcnt lgkmcnt(0)" ::: "memory");
#pragma unroll
    for (int i = 0; i < 16; ++i) out[i] = bf2f(*(const LAS bf16*)(scr + (16 * (lane >> 5) + i) * SCR_RS + 2 * (lane & 31)));
    asm volatile("s_waitcnt lgkmcnt(0)" ::: "memory");
}
template <bool FULL>
__device__ __forceinline__ float build_chunk(const Raw<FULL>& R, float lb, LAS unsigned char* buf, LAS unsigned char* scr, int lane, int bw) {
    const int c = 32 * bw + (lane & 31), half = lane >> 5;
    float Pr[16], kk[16]; float run = 1.f; const float omlb = 1.0f - lb;
    { float z[16]; transpose16(z, R.z, scr, lane);
#pragma unroll
      for (int i = 0; i < 16; ++i) { const float e = __expf(-z[i]); const float sg = __builtin_amdgcn_rcpf(1.0f + e); kk[i] = omlb * (e * sg); run *= lb + omlb * sg; Pr[i] = run; } }
    const float oth = __shfl_xor(run, 32);
    const float T0 = half ? oth : run, T1 = half ? run : oth;
    const float sc1 = half ? 1.0f : __builtin_amdgcn_rcpf(T0);
    const float Elm = T1;
    float qv[16];
    if constexpr (FULL) transpose16(qv, R.q, scr, lane);
    float vv[16]; transpose16(vv, R.v, scr, lane);
    unsigned ktw[8], vtw[8];
#pragma unroll
    for (int i = 0; i < 16; i += 2) {
        float ks[2];
#pragma unroll
        for (int e = 0; e < 2; ++e) { const int t = 16 * half + i + e; const float E1 = Pr[i + e] * sc1, R1 = __builtin_amdgcn_rcpf(E1);
            ks[e] = kk[i + e] * R1 * Elm;
            if (FULL) { *(LAS bf16*)(buf + B_QR + t * RS + 2 * c) = (bf16)(pk(qv[FULL ? i + e : 0] * QSCALE * E1, 0.f) & 0xffffu);
                        *(LAS bf16*)(buf + B_KR + t * RS + 2 * c) = (bf16)(pk(kk[i + e] * R1, 0.f) & 0xffffu); } }
        ktw[i >> 1] = pk(ks[0], ks[1]); vtw[i >> 1] = pk(vv[i], vv[i + 1]); }
    *(LAS u32x4*)(buf + B_KT + c * TS + 32 * half) = (u32x4){ktw[0], ktw[1], ktw[2], ktw[3]}; *(LAS u32x4*)(buf + B_KT + c * TS + 32 * half + 16) = (u32x4){ktw[4], ktw[5], ktw[6], ktw[7]};
    *(LAS u32x4*)(buf + B_VT + c * TS + 32 * half) = (u32x4){vtw[0], vtw[1], vtw[2], vtw[3]}; *(LAS u32x4*)(buf + B_VT + c * TS + 32 * half + 16) = (u32x4){vtw[4], vtw[5], vtw[6], vtw[7]};
    if (half == 0) { *(LAS float*)(buf + B_DEC + 4 * c) = T0 * T1; *(LAS float*)(buf + B_EGM + 4 * c) = T0; }
    return FULL ? 0.f : __logf(T0 * T1);
}
__device__ __forceinline__ void state_update(f32x16 (&S)[4], const LAS unsigned char* buf, int j, int c, int h) {
    bf16x8 a[4][2], bv[2]; f32x4 dc[4][4];
#pragma unroll
    for (int ks = 0; ks < 2; ++ks) bv[ks] = *(const LAS bf16x8*)(buf + B_VT + (32 * j + c) * TS + (16 * ks + 8 * h) * 2);
#pragma unroll
    for (int i = 0; i < 4; ++i) {
#pragma unroll
        for (int ks = 0; ks < 2; ++ks) a[i][ks] = *(const LAS bf16x8*)(buf + B_KT + (32 * i + c) * TS + (16 * ks + 8 * h) * 2);
#pragma unroll
        for (int g4 = 0; g4 < 4; ++g4) dc[i][g4] = *(const LAS f32x4*)(buf + B_DEC + 4 * (32 * i + 8 * g4 + 4 * h)); }
#pragma unroll
    for (int i = 0; i < 4; ++i) {
#pragma unroll
        for (int g4 = 0; g4 < 4; ++g4)
#pragma unroll
            for (int e = 0; e < 4; ++e) S[i][4 * g4 + e] *= dc[i][g4][e];
#pragma unroll
        for (int ks = 0; ks < 2; ++ks) S[i] = __builtin_amdgcn_mfma_f32_32x32x16_bf16(a[i][ks], bv[ks], S[i], 0, 0, 0);
    }
}
__device__ __forceinline__ void pass_a(const bf16* __restrict__ big, const float* __restrict__ lbv, float* __restrict__ Eg, float* __restrict__ Dg, LAS unsigned char* lds, int lane, int wave) {
    const bool builder = wave < 4; const int bw = wave & 3, j = wave & 3, c = lane & 31, h = lane >> 5;
    for (int u = blockIdx.x; u < BATCH * NH * NSEG; u += gridDim.x) {
        const int seg = u & 3, hh = (u >> 2) & 7, b = u >> 5;
        if (seg == NSEG - 1) continue;
        const bf16* base = big + ((size_t)(b * 8 + hh) * 3 * 4096 + (size_t)seg * NCH_SEG * CH) * 128;
        if (builder) {
            const float lb = lbv[hh * 128 + 32 * bw + (lane & 31)];
            float dsum = 0.f; Raw<false> R0, R1;
            load_raw<false>(R0, base, lane, bw); load_raw<false>(R1, base + (size_t)CH * LDB, lane, bw);
#define HG2_A_ITER(kk_, RX) do { const int k_ = (kk_); if (k_ < NCH_SEG) { dsum += build_chunk<false>(RX, lb, lds + (k_ & 1) * BUF_BYTES, lds + OFF_SCR + bw * 2560, lane, bw); \
                if (k_ + 2 < NCH_SEG) load_raw<false>(RX, base + (size_t)(k_ + 2) * CH * LDB, lane, bw); } HG2_BAR(); } while (0)
            for (int k = 0; k < NCH_SEG; k += 2) { HG2_A_ITER(k, R0); HG2_A_ITER(k + 1, R1); }
            HG2_A_ITER(NCH_SEG, R0);
#undef HG2_A_ITER
            if ((lane >> 5) == 0) Dg[(size_t)u * 128 + 32 * bw + (lane & 31)] = dsum;
        } else {
            f32x16 S[4];
#pragma unroll
            for (int i = 0; i < 4; ++i) S[i] = f32x16{};
            for (int k = 0; k <= NCH_SEG; ++k) {
                if (k > 0) state_update(S, lds + ((k - 1) & 1) * BUF_BYTES, j, c, h);
                HG2_BAR();
            }
            float* E = Eg + (size_t)u * 16384;
#pragma unroll
            for (int i = 0; i < 4; ++i)
#pragma unroll
                for (int r = 0; r < 16; ++r) E[(size_t)(32 * i + crow(r, h)) * 128 + 32 * j + c] = S[i][r];
        }
    }
}
__device__ __forceinline__ void pass_b(bf16* big, bf16* outp, int ldo, int store, const float* __restrict__ lbv, const float* __restrict__ og, const float* __restrict__ Eg, const float* __restrict__ Dg, LAS unsigned char* lds, int lane, int wave) {
    const bool builder = wave < 4; const int bw = wave & 3, j = wave & 3, c = lane & 31, h = lane >> 5, btid = (wave & 3) * 64 + lane;
    for (int u = blockIdx.x; u < BATCH * NH * NSEG; u += gridDim.x) {
        const int seg = u & 3, hh = (u >> 2) & 7, b = u >> 5;
        const bf16* base = big + ((size_t)(b * 8 + hh) * 3 * 4096 + (size_t)seg * NCH_SEG * CH) * 128;
        const bf16* gbase = big + (size_t)3 * MROWS * 1024 + ((size_t)b * SEQ + (size_t)seg * NCH_SEG * CH) * LDG + hh * 128;
        if (builder) {
            const float lb = lbv[hh * 128 + 32 * bw + (lane & 31)];
            Raw<true> R0, R1;
            load_raw<true>(R0, base, lane, bw); load_raw<true>(R1, base + (size_t)CH * LDB, lane, bw);
#define HG2_B_ITER(kk_, RX) do { const int k_ = (kk_); \
                if (k_ < NCH_SEG) { if (store != 3) (void)build_chunk<true>(RX, lb, lds + (k_ & 1) * BUF_BYTES, lds + OFF_SCR + bw * 2560, lane, bw); if (k_ + 2 < NCH_SEG) load_raw<true>(RX, base + (size_t)(k_ + 2) * CH * LDB, lane, bw); } \
                HG2_BAR(); } while (0)
            for (int k = 0; k <= NCH_SEG + 1; k += 2) { HG2_B_ITER(k, R0); HG2_B_ITER(k + 1, R1); }
#undef HG2_B_ITER
        } else {
            f32x16 S[4];
#pragma unroll
            for (int i = 0; i < 4; ++i) S[i] = f32x16{};
            for (int sp = 0; sp < seg; ++sp) {
                const float* E = Eg + (size_t)(u - seg + sp) * 16384; const float* Dp = Dg + (size_t)(u - seg + sp) * 128;
#pragma unroll
                for (int i = 0; i < 4; ++i)
#pragma unroll
                    for (int r = 0; r < 16; ++r) { const int d = 32 * i + crow(r, h); S[i][r] = __expf(Dp[d]) * S[i][r] + E[(size_t)d * 128 + 32 * j + c]; }
            }
            u32x4 gn0 = (u32x4){0u, 0u, 0u, 0u}, gn1 = gn0;
            const int ot = btid >> 3, opart = btid & 7;
            for (int k = 0; k <= NCH_SEG + 1; ++k) {
                if (k >= 1 && k <= NCH_SEG && store != 4) {
                const LAS unsigned char* buf = lds + ((k - 1) & 1) * BUF_BYTES;
                f32x16 X = f32x16{};
                { bf16x8 ka[8], qb[8];
#pragma unroll
                  for (int ks = 0; ks < 8; ++ks) { ka[ks] = *(const LAS bf16x8*)(buf + B_KR + c * RS + (16 * ks + 8 * h) * 2); qb[ks] = *(const LAS bf16x8*)(buf + B_QR + c * RS + (16 * ks + 8 * h) * 2); }
#pragma unroll
                  for (int ks = 0; ks < 8; ++ks) X = __builtin_amdgcn_mfma_f32_32x32x16_bf16(ka[ks], qb[ks], X, 0, 0, 0); }
#pragma unroll
                for (int r = 0; r < 16; ++r) X[r] = crow(r, h) <= c ? X[r] : 0.f;
                const bf16x8 P0 = acc_frag(X, 0), P1 = acc_frag(X, 1);
                f32x16 o = f32x16{};
                { bf16x8 qa8[8]; f32x4 eg[8][2];
#pragma unroll
                  for (int i = 0; i < 4; ++i)
#pragma unroll
                    for (int s = 0; s < 2; ++s) { const LAS unsigned char* qa = buf + B_QR + c * RS + (32 * i + 16 * s + 4 * h) * 2; qa8[2 * i + s] = join8(*(const LAS s16x4*)qa, *(const LAS s16x4*)(qa + 16));
                        eg[2 * i + s][0] = *(const LAS f32x4*)(buf + B_EGM + 4 * (32 * i + 16 * s + 4 * h)); eg[2 * i + s][1] = *(const LAS f32x4*)(buf + B_EGM + 4 * (32 * i + 16 * s + 8 + 4 * h)); }
#pragma unroll
                  for (int i = 0; i < 4; ++i)
#pragma unroll
                    for (int s = 0; s < 2; ++s) o = __builtin_amdgcn_mfma_f32_32x32x16_bf16(qa8[2 * i + s], acc_frag_scaled(S[i], s, eg[2 * i + s][0], eg[2 * i + s][1]), o, 0, 0, 0); }
#pragma unroll
                for (int s = 0; s < 2; ++s) {
                    const LAS unsigned char* va = buf + B_VT + (32 * j + c) * TS + (16 * s + 4 * h) * 2;
                    const bf16x8 bv = join8(*(const LAS s16x4*)va, *(const LAS s16x4*)(va + 16));
                    o = __builtin_amdgcn_mfma_f32_32x32x16_bf16(s ? P1 : P0, bv, o, 0, 0, 0); }
                state_update(S, buf, j, c, h);
#pragma unroll
                for (int r = 0; r < 16; ++r) *(LAS float*)(lds + OFF_OST + ((k - 1) & 1) * OST_BYTES + crow(r, h) * OST_RS + (32 * j + c) * 4) = o[r];
                }
                if (k >= 2 && store != 5) {
                    const int kc = k - 2; const u32x4 g0 = gn0, g1 = gn1;
                    const LAS f32x4* op = (const LAS f32x4*)(lds + OFF_OST + (kc & 1) * OST_BYTES + ot * OST_RS + opart * 64);
                    const f32x4 o0 = op[0], o1 = op[1], o2 = op[2], o3 = op[3];
                    float ss = (o0[0] * o0[0] + o0[1] * o0[1]) + (o0[2] * o0[2] + o0[3] * o0[3]) + (o1[0] * o1[0] + o1[1] * o1[1]) + (o1[2] * o1[2] + o1[3] * o1[3])
                             + (o2[0] * o2[0] + o2[1] * o2[1]) + (o2[2] * o2[2] + o2[3] * o2[3]) + (o3[0] * o3[0] + o3[1] * o3[1]) + (o3[2] * o3[2] + o3[3] * o3[3]);
                    ss += __shfl_xor(ss, 1); ss += __shfl_xor(ss, 2); ss += __shfl_xor(ss, 4);
                    const float rstd = __builtin_amdgcn_rsqf(ss * (1.0f / 128.0f) + 1e-6f);
                    const size_t row = (size_t)b * SEQ + (size_t)(seg * NCH_SEG + kc) * CH + ot;
                    bf16* yp = outp + row * ldo + hh * 128 + opart * 16;
                    const f32x4 w0 = *(const f32x4*)(og + opart * 16), w1 = *(const f32x4*)(og + opart * 16 + 4), w2 = *(const f32x4*)(og + opart * 16 + 8), w3 = *(const f32x4*)(og + opart * 16 + 12);
                    const unsigned gw[8] = {g0.x, g0.y, g0.z, g0.w, g1.x, g1.y, g1.z, g1.w};
                    const float ov[16] = {o0[0], o0[1], o0[2], o0[3], o1[0], o1[1], o1[2], o1[3], o2[0], o2[1], o2[2], o2[3], o3[0], o3[1], o3[2], o3[3]};
                    const float wv[16] = {w0[0], w0[1], w0[2], w0[3], w1[0], w1[1], w1[2], w1[3], w2[0], w2[1], w2[2], w2[3], w3[0], w3[1], w3[2], w3[3]};
                    unsigned ow[8];
#pragma unroll
                    for (int e = 0; e < 8; ++e) { const float ga = __uint_as_float(gw[e] << 16), gb = __uint_as_float(gw[e] & 0xffff0000u);
                        const float ya = ov[2 * e] * rstd * wv[2 * e] * (ga * __builtin_amdgcn_rcpf(1.0f + __expf(-ga)));
                        const float yb = ov[2 * e + 1] * rstd * wv[2 * e + 1] * (gb * __builtin_amdgcn_rcpf(1.0f + __expf(-gb)));
                        ow[e] = pk(ya, yb); }
                    if (store == 1) { *(u32x4*)yp = (u32x4){ow[0], ow[1], ow[2], ow[3]}; *(u32x4*)(yp + 8) = (u32x4){ow[4], ow[5], ow[6], ow[7]}; }
                }
                if (k >= 1 && k - 1 < NCH_SEG) { const bf16* gp = gbase + (size_t)((k - 1) * CH + ot) * LDG + opart * 16; gn0 = *(const u32x4*)gp; gn1 = *(const u32x4*)(gp + 8); }
                HG2_BAR();
            }
        }
    }
}
}
#define GAS __attribute__((address_space(1)))
constexpr int NWAVES = 8;
constexpr int RING_OFF = 0, RING_BYTES = 131072;
constexpr int XCH_OFF = 131072;
constexpr int MISC_OFF = 139264;
constexpr int LDS_BYTES = 147456;
constexpr int CW_Q = 2048;
constexpr int CW_BAR = 4096;
constexpr int N_PHASES = 25;
static_assert(pg8::STAGE_BYTES == RING_BYTES && XCH_OFF == RING_BYTES, "LDS map");
static_assert((CW_BAR + 3456) * 4 <= (int)CTL_ZERO_BYTES, "barrier words inside the memset region");

struct Params { const float* in[15]; float* out; unsigned char* ws; int ph_lo, ph_hi, bar_region, pad; };

#define LDS_WAIT() asm volatile("s_waitcnt lgkmcnt(0)" ::: "memory")
#define VM_WAIT() asm volatile("s_waitcnt vmcnt(0)" ::: "memory")

__device__ __forceinline__ void p0_conv_item(const float* __restrict__ W, const float* __restrict__ gain, int K, int N, bf16* __restrict__ WT, int upperm, LAS float* scr, int item, int lane) {
    const int nblk = N / 64, kb = item / nblk, nb = item % nblk, k0 = 64 * kb, n0 = 64 * nb;
    int src0 = n0;
    if (upperm == 1) { const int pn = n0 >> 8, r = n0 & 255, bj = r >> 7, c = r & 127; src0 = bj * 3072 + 128 * pn + c; }
    if (upperm == 2) { const int pn = n0 >> 8, type = pn >> 2; if (type < 2) src0 = type * 1024 + (2 * (pn & 3) + ((n0 >> 6) & 1)) * 128 + 64 * ((n0 >> 7) & 1); }
    const int kr = lane >> 4, n4 = (lane & 15) * 4;
    f32x4 v[16];
#pragma unroll
    for (int i = 0; i < 16; ++i) v[i] = *(const f32x4*)(W + (size_t)(k0 + 4 * i + kr) * N + src0 + n4);
#pragma unroll
    for (int i = 0; i < 16; ++i) { const int k = 4 * i + kr; const float gsc = gain ? gain[k0 + k] : 1.0f;
#pragma unroll
        for (int e = 0; e < 4; ++e) scr[(n4 + e) * 65 + k] = v[i][e] * gsc; }
    LDS_WAIT(); asm volatile("" ::: "memory");
    const int c = lane & 7;
#pragma unroll
    for (int j = 0; j < 8; ++j) { const int n = (lane >> 3) + 8 * j; const LAS float* s = scr + n * 65 + 8 * c;
        u32x4 o; o.x = f2bf(s[0]) | ((unsigned)f2bf(s[1]) << 16); o.y = f2bf(s[2]) | ((unsigned)f2bf(s[3]) << 16);
        o.z = f2bf(s[4]) | ((unsigned)f2bf(s[5]) << 16); o.w = f2bf(s[6]) | ((unsigned)f2bf(s[7]) << 16);
        *(u32x4*)(WT + (size_t)(n0 + n) * K + k0 + 8 * c) = o; }
    LDS_WAIT(); asm volatile("" ::: "memory");
}
__device__ __forceinline__ void p0_prologue(const Params& p, LAS unsigned char* lds, int gw, int NGW, int lane, int wave) {
    unsigned char* ws = p.ws;
    LAS float* scr = (LAS float*)(lds + RING_OFF + wave * 16640);
    const float* attn_norm = p.in[1]; const float* ffn_norm = p.in[2];
    constexpr int I_IN = 16 * 64, I_QKV = 16 * 48, I_O = 16 * 16, I_UP = 16 * 96, I_DN = 48 * 16;
    constexpr int NITEMS = 2 * I_IN + 2 * I_QKV + 4 * I_O + 4 * I_UP + 4 * I_DN;
    for (int it = gw; it < NITEMS; it += NGW) {
        int r = it;
        if (r < 2 * I_IN) { const int s = r / I_IN; p0_conv_item(p.in[3] + (size_t)s * 1024 * 4096, attn_norm + (2 * s) * 1024, 1024, 4096, (bf16*)(ws + WS_WIN) + (size_t)s * 4096 * 1024, 0, scr, r % I_IN, lane); continue; } r -= 2 * I_IN;
        if (r < 2 * I_QKV) { const int s = r / I_QKV; p0_conv_item(p.in[7] + (size_t)s * 1024 * 3072, attn_norm + (2 * s + 1) * 1024, 1024, 3072, (bf16*)(ws + WS_WQKV) + (size_t)s * 3072 * 1024, 2, scr, r % I_QKV, lane); continue; } r -= 2 * I_QKV;
        if (r < 2 * I_O) { const int s = r / I_O; p0_conv_item(p.in[6] + (size_t)s * 1024 * 1024, nullptr, 1024, 1024, (bf16*)(ws + WS_WOH) + (size_t)s * 1024 * 1024, 0, scr, r % I_O, lane); continue; } r -= 2 * I_O;
        if (r < 2 * I_O) { const int s = r / I_O; p0_conv_item(p.in[10] + (size_t)s * 1024 * 1024, nullptr, 1024, 1024, (bf16*)(ws + WS_WOM) + (size_t)s * 1024 * 1024, 0, scr, r % I_O, lane); continue; } r -= 2 * I_O;
        if (r < 4 * I_UP) { const int l = r / I_UP; p0_conv_item(p.in[11] + (size_t)l * 1024 * 6144, ffn_norm + l * 1024, 1024, 6144, (bf16*)(ws + WS_WUP) + (size_t)l * 6144 * 1024, 1, scr, r % I_UP, lane); continue; } r -= 4 * I_UP;
        { const int l = r / I_DN; p0_conv_item(p.in[14] + (size_t)l * 3072 * 1024, nullptr, 3072, 1024, (bf16*)(ws + WS_WDN) + (size_t)l * 1024 * 3072, 0, scr, r % I_DN, lane); }
    }
    const float* x = p.in[0]; bf16* xb = (bf16*)(ws + WS_XB); float* ss = (float*)(ws + WS_SS);
    for (int row0 = gw * 4; row0 < MROWS; row0 += NGW * 4) {
        f32x4 v[4][4];
#pragma unroll
        for (int r = 0; r < 4; ++r)
#pragma unroll
            for (int j = 0; j < 4; ++j) v[r][j] = ((const f32x4*)(x + (size_t)(row0 + r) * DM))[lane + 64 * j];
        float s4[4];
#pragma unroll
        for (int r = 0; r < 4; ++r) { float s = 0.f;
#pragma unroll
            for (int j = 0; j < 4; ++j) { const f32x4 t = v[r][j]; s += (t[0] * t[0] + t[1] * t[1]) + (t[2] * t[2] + t[3] * t[3]);
                unsigned long long w = (unsigned long long)(f2bf(t[0]) | ((unsigned)f2bf(t[1]) << 16)) | ((unsigned long long)(f2bf(t[2]) | ((unsigned)f2bf(t[3]) << 16)) << 32);
                *(unsigned long long*)(xb + (size_t)(row0 + r) * DM + 4 * (lane + 64 * j)) = w; }
            s4[r] = wave_sum(s); }
        { const int slot = lane >> 2, rr = lane & 3; const float sv = rr == 0 ? s4[0] : rr == 1 ? s4[1] : rr == 2 ? s4[2] : s4[3];
          ss[(size_t)slot * MROWS + row0 + rr] = slot == 0 ? sv : 0.f; }
    }
    float* lbv = (float*)(ws + WS_LBV); const float* hgrn_lb = p.in[4];
    if (gw == 0) ((float*)(ws + WS_INVF))[lane] = 1.0f / powf(10000.0f, (float)(2 * lane) / 128.0f);
    for (int idx = gw * 64 + lane; idx < 1024; idx += NGW * 64) { const float l0 = hgrn_lb[idx], l1 = hgrn_lb[1024 + idx]; const float mx = fmaxf(l0, l1), e0 = expf(l0 - mx), e1 = expf(l1 - mx); lbv[idx] = 0.f; lbv[1024 + idx] = e1 / (e0 + e1); }
}

__device__ __forceinline__ void kprep_phase(const bf16* qkv, bf16* qdst, bf16* kdst, int ldd, const float* __restrict__ qg, const float* __restrict__ kg, const float* __restrict__ cs, const float* __restrict__ sn, float* __restrict__ kmean,
                                            LAS unsigned char* lds, int lane, int wave) {
    const int tidk = wave * 64 + lane, rg = lane >> 4, cch = lane & 15;
    LAS float* red = (LAS float*)(lds + RING_OFF);
    for (int u = blockIdx.x; u < 2 * BATCH * NH * NBLK; u += gridDim.x) {
        const int which = u & 1, j = (u >> 1) & 15, h = (u >> 5) & 7, b = u >> 8;
        const float* g = which ? kg : qg; const f32x4 ga = *(const f32x4*)(g + 8 * cch), gb = *(const f32x4*)(g + 8 * cch + 4);
        const float gn[8] = {ga[0], ga[1], ga[2], ga[3], gb[0], gb[1], gb[2], gb[3]};
        const int pos0 = j * MBLK + wave * 32 + rg;
        const bf16* src = qkv + (size_t)(b * SEQ + pos0) * 3072 + which * 1024 + h * 128 + 8 * cch;
        bf16* dst = (which ? kdst : qdst) + (size_t)(b * SEQ + pos0) * ldd + h * 128 + 8 * cch;
        u32x4 raw[8];
#pragma unroll
        for (int it = 0; it < 8; ++it) raw[it] = *(const u32x4*)(src + (size_t)(4 * it) * 3072);
        float acc[8];
#pragma unroll
        for (int e = 0; e < 8; ++e) acc[e] = 0.f;
#pragma unroll
        for (int it = 0; it < 8; ++it) {
            const unsigned w[4] = {raw[it].x, raw[it].y, raw[it].z, raw[it].w};
            float x[8];
#pragma unroll
            for (int e = 0; e < 4; ++e) { x[2 * e] = __uint_as_float(w[e] << 16); x[2 * e + 1] = __uint_as_float(w[e] & 0xffff0000u); }
            float ss = 0.f;
#pragma unroll
            for (int e = 0; e < 8; ++e) ss += x[e] * x[e];
            ss += __shfl_xor(ss, 1); ss += __shfl_xor(ss, 2); ss += __shfl_xor(ss, 4); ss += __shfl_xor(ss, 8);
            const float r = rsqrtf(ss * (1.0f / 128.0f) + 1e-6f);
            const int pos = pos0 + 4 * it;
            const f32x4 c0 = *(const f32x4*)(cs + pos * 64 + 8 * (cch & 7)), c1 = *(const f32x4*)(cs + pos * 64 + 8 * (cch & 7) + 4);
            const f32x4 s0 = *(const f32x4*)(sn + pos * 64 + 8 * (cch & 7)), s1 = *(const f32x4*)(sn + pos * 64 + 8 * (cch & 7) + 4);
            const float cv[8] = {c0[0], c0[1], c0[2], c0[3], c1[0], c1[1], c1[2], c1[3]}, sv[8] = {s0[0], s0[1], s0[2], s0[3], s1[0], s1[1], s1[2], s1[3]};
            float o[8];
#pragma unroll
            for (int e = 0; e < 8; ++e) { const float y = x[e] * r * gn[e]; const float py = __shfl_xor(y, 8);
                float v = cch < 8 ? y * cv[e] - py * sv[e] : y * cv[e] + py * sv[e];
                if (!which) v *= QSCALE;
                o[e] = v; acc[e] += v; }
            u32x4 ow; ow.x = f2bf(o[0]) | ((unsigned)f2bf(o[1]) << 16); ow.y = f2bf(o[2]) | ((unsigned)f2bf(o[3]) << 16); ow.z = f2bf(o[4]) | ((unsigned)f2bf(o[5]) << 16); ow.w = f2bf(o[6]) | ((unsigned)f2bf(o[7]) << 16);
            *(u32x4*)(dst + (size_t)(4 * it) * ldd) = ow;
        }
        if (which) {
#pragma unroll
            for (int e = 0; e < 8; ++e) { acc[e] += __shfl_xor(acc[e], 16); acc[e] += __shfl_xor(acc[e], 32); }
            if (rg == 0) {
#pragma unroll
                for (int e = 0; e < 8; ++e) red[wave * 128 + 8 * cch + e] = acc[e]; }
            __syncthreads();
            if (tidk < 128) { float s = 0.f;
#pragma unroll
                for (int w = 0; w < 8; ++w) s += red[w * 128 + tidk];
                kmean[((size_t)(b * 8 + h) * 16 + j) * 128 + tidk] = s * (1.0f / 256.0f); }
            __syncthreads();
        }
    }
}

__device__ __forceinline__ void hg_naive_phase(bf16* __restrict__ big, const float* __restrict__ lbv, const float* __restrict__ og, LAS unsigned char* lds, const int tid) {
    LAS float* sq = (LAS float*)(lds + RING_OFF); LAS float* sf = sq + 128; LAS float* sk = sq + 256; LAS float* red = sq + 384;
    for (int u = blockIdx.x; u < BATCH * NH; u += gridDim.x) {
        const int b = u >> 3, h = u & 7;
        float S[128];
#pragma unroll
        for (int d = 0; d < 128; ++d) S[d] = 0.f;
        const float lb = tid < 128 ? lbv[h * 128 + tid] : 0.f, gain = tid < 128 ? og[tid] : 0.f;
        for (int t = 0; t < SEQ; ++t) {
            bf16* r = big + (size_t)(b * SEQ + t) * 4096 + h * 128 + (tid & 127);
            float q = 0.f, vv = 0.f, gg = 0.f;
            if (tid < 128) { q = bf2f(r[0]) * QSCALE; const float z = bf2f(r[1024]); vv = bf2f(r[2048]); gg = bf2f(r[3072]);
                const float sg = 1.0f / (1.0f + expf(-z)); const float f = lb + (1.0f - lb) * sg; const float k = (1.0f - lb) * (1.0f - sg);
                sq[tid] = q; sf[tid] = f; sk[tid] = k; }
            __syncthreads();
            float o = 0.f;
            if (tid < 128) {
#pragma unroll
                for (int d = 0; d < 128; ++d) { S[d] = sf[d] * S[d] + sk[d] * vv; o += sq[d] * S[d]; }
                const float w = wave_sum(o * o);
                if ((tid & 63) == 0) red[tid >> 6] = w; }
            __syncthreads();
            if (tid < 128) { const float tot = red[0] + red[1];
                const float on = o * rsqrtf(tot * (1.0f / 128.0f) + 1e-6f) * gain;
                r[3072] = f2bf(on * (gg / (1.0f + expf(-gg)))); }
        }
    }
}
__device__ __forceinline__ void attn_naive_phase(bf16* __restrict__ qkv, const float* __restrict__ kmean, LAS unsigned char* lds, int lane, int wave) {
    LAS float* sq = (LAS float*)(lds + RING_OFF) + wave * 128;
    LAS float* sp = (LAS float*)(lds + RING_OFF + 4096) + wave * 1024;
    for (long it0 = (long)blockIdx.x * 8; it0 < (long)MROWS * 8; it0 += (long)gridDim.x * 8) {
        const long item = it0 + wave; const int h = (int)(item & 7); const long row = item >> 3; const int b = (int)(row >> 12), s = (int)(row & (SEQ - 1)), i = s >> 8;
        bf16* qp = qkv + row * 3072 + h * 128;
        __syncthreads();
        sq[lane] = bf2f(qp[lane]); sq[lane + 64] = bf2f(qp[lane + 64]);
        __syncthreads();
        float gv = -INFINITY;
        if (lane < i) { const float* km = kmean + ((size_t)(b * 8 + h) * 16 + lane) * 128; float a = 0.f; for (int d = 0; d < 128; ++d) a += km[d] * sq[d]; gv = a; }
        const int nsel = i < 3 ? i : 3; int s0 = i, s1 = i, s2 = i;
#pragma unroll
        for (int n = 0; n < 3; ++n) {
            if (n < nsel) { const float m = wave_max(gv); const unsigned long long bal = __ballot(gv == m); const int idx = __ffsll((long long)bal) - 1; if (n == 0) s0 = idx; else if (n == 1) s1 = idx; else s2 = idx; if (lane == idx) gv = -INFINITY; } }
#define PICKB(bi) ((bi) == 0 ? s0 : (bi) == 1 ? s1 : (bi) == 2 ? s2 : i)
        float mx = -INFINITY;
        for (int bi = 0; bi <= nsel; ++bi) { const int kb = PICKB(bi) * MBLK;
            for (int c = 0; c < 4; ++c) { const int key = kb + c * 64 + lane;
                const bf16* kp = qkv + (size_t)(b * SEQ + key) * 3072 + 1024 + h * 128; float a = 0.f;
                for (int d8 = 0; d8 < 16; ++d8) { const u32x4 w = *(const u32x4*)(kp + d8 * 8);
                    const unsigned ww[4] = {w.x, w.y, w.z, w.w};
#pragma unroll
                    for (int e = 0; e < 4; ++e) { a += __uint_as_float(ww[e] << 16) * sq[d8 * 8 + 2 * e]; a += __uint_as_float(ww[e] & 0xffff0000u) * sq[d8 * 8 + 2 * e + 1]; } }
                if (bi == nsel && key > s) a = -INFINITY;
                sp[bi * 256 + c * 64 + lane] = a; mx = fmaxf(mx, a); } }
        mx = wave_max(mx);
        float l = 0.f;
        for (int e = lane; e < (nsel + 1) * 256; e += 64) { const float pr = __expf(sp[e] - mx); sp[e] = pr; l += pr; }
        l = wave_sum(l);
        __syncthreads();
        float o0 = 0.f, o1 = 0.f;
        for (int bi = 0; bi <= nsel; ++bi) { const bf16* vp = qkv + (size_t)(b * SEQ + PICKB(bi) * MBLK) * 3072 + 2048 + h * 128 + lane;
            for (int kk = 0; kk < 256; ++kk) { const float pr = sp[bi * 256 + kk]; o0 += pr * bf2f(vp[(size_t)kk * 3072]); o1 += pr * bf2f(vp[(size_t)kk * 3072 + 64]); } }
#undef PICKB
        const float il = 1.0f / l;
        qp[lane] = f2bf(o0 * il); qp[lane + 64] = f2bf(o1 * il);
    }
}

#ifndef HG_PIPE
#define HG_PIPE 1
#endif
#if HG_PIPE
#define HGNS hg2
#else
#define HGNS hg
#endif
#ifndef PROBE_BMODE
#define PROBE_BMODE 0
#endif
#ifndef STAGGER_TICKS
#define STAGGER_TICKS 0
#endif
__device__ __forceinline__ void phase_stagger() {
    if (STAGGER_TICKS > 0) { const unsigned q = (blockIdx.x >> 3) & 3u; const unsigned long long t0 = __builtin_amdgcn_s_memrealtime();
        while (__builtin_amdgcn_s_memrealtime() - t0 < (unsigned long long)(q * STAGGER_TICKS)) __builtin_amdgcn_s_sleep(8); }
}
__global__ void __launch_bounds__(NWAVES * 64, 2) mega_fwd(Params p) {
    extern __shared__ __attribute__((aligned(16))) unsigned char lds_raw[];
    LAS unsigned char* lds = (LAS unsigned char*)lds_raw;
    const int G = gridDim.x;
    unsigned char* ws = p.ws;
    for (int u = threadIdx.x; u < (LDS_BYTES - MISC_OFF) / 4; u += NWAVES * 64) ((LAS unsigned*)(lds + MISC_OFF))[u] = 0u;
    __syncthreads();
#define PHASE_IDS() int tid = threadIdx.x; asm volatile("" : "+v"(tid)); const int lane = tid & 63, wave = __builtin_amdgcn_readfirstlane(tid >> 6); (void)lane; (void)wave
    const int lo = p.ph_lo, hi = p.ph_hi;
    XcdBarrier bar; bar.bar = (unsigned*)(ws + WS_CTL) + CW_BAR + p.bar_region * XCD_BAR_WORDS; bar.x = 0; bar.st = nullptr;
    if (hi - lo > 1) bar = xcd_barrier_post((unsigned*)(ws + WS_CTL) + CW_BAR + p.bar_region * XCD_BAR_WORDS, (volatile LAS unsigned*)(lds + MISC_OFF));
#define IN(k) (lo <= (k) && (k) < hi)
#define SEAM(k) do { if (IN(k) && IN((k) + 1)) { xcd_barrier(bar); if (PROBE_DUP & 1024) xcd_barrier(bar); } } while (0)
#define PHASE_ENV() PHASE_IDS(); const __attribute__((address_space(4))) Params* pp = (const __attribute__((address_space(4))) Params*)__builtin_amdgcn_kernarg_segment_ptr(); asm volatile("" : "+s"(pp)); \
    unsigned char* ws = pp->ws; float* out = pp->out; bf16* XB = (bf16*)(ws + WS_XB); bf16* BIG = (bf16*)(ws + WS_BIG); float* SS = (float*)(ws + WS_SS); \
    const float* COS = (const float*)(ws + WS_COS); const float* SIN = (const float*)(ws + WS_SIN); const float* LBV = (const float*)(ws + WS_LBV); float* KMEAN = (float*)(ws + WS_KMEAN); \
    float* TAIL = (float*)(ws + WS_TAIL); float* HEADA = (float*)(ws + WS_HEADA); float* HEADU = (float*)(ws + WS_HEADU); \
    (void)out; (void)XB; (void)BIG; (void)SS; (void)COS; (void)SIN; (void)LBV; (void)KMEAN; (void)TAIL; (void)HEADA; (void)HEADU

    if (IN(0)) {
#pragma unroll 1
        for (int rep = (PROBE_DUP & 8) ? 0 : 1; rep < 2; ++rep) { PHASE_IDS(); p0_prologue(p, lds, blockIdx.x * NWAVES + wave, G * NWAVES, lane, wave); __syncthreads(); }
    }
    SEAM(0);
    for (int l = 0; l < DEPTH; ++l) {
        const int pb = 1 + 6 * l, slot = l >> 1; const bool moba = (l & 1) != 0;
        if (IN(pb)) { PHASE_ENV();
            if (moba) {
                pg8::Gemm g{XB, (const bf16*)(ws + WS_WQKV) + (size_t)slot * 3072 * 1024, MROWS, 3072, 1024, 1024}; pg8::StaticOrder S; S.init(MROWS, 3072, G, (int)blockIdx.x);
                pg8::EpiQKV E{BIG, SS, pp->in[8] + slot * 128, pp->in[9] + slot * 128, (const float*)(ws + WS_INVF), KMEAN, 0, 0, pg8::rstd_tab_build(lds + RING_OFF, S, SS, tid)};
#pragma unroll 1
                for (int rep = (PROBE_DUP & 65536) ? 0 : 1; rep < 2; ++rep) { E.dry = rep ? 0 : PROBE_BMODE; pg8::gemm_phase<pg8::EpiQKV, pg8::StaticOrder, true, true>(lds + RING_OFF, g, S, E); __syncthreads(); }
            } else {
                pg8::Gemm g{XB, (const bf16*)(ws + WS_WIN) + (size_t)slot * 4096 * 1024, MROWS, 4096, 1024, 1024}; pg8::StaticOrder S; S.init(MROWS, 4096, G, (int)blockIdx.x);
                pg8::EpiRowScale E{BIG, SS, 0, 0, pg8::rstd_tab_build(lds + RING_OFF, S, SS, tid)};
#pragma unroll 1
                for (int rep = (PROBE_DUP & 1) ? 0 : 1; rep < 2; ++rep) { E.pad = ((PROBE_DUP & 128) && rep == 0) ? (PROBE_BMODE ? PROBE_BMODE : 1) : 0; pg8::gemm_phase<pg8::EpiRowScale, pg8::StaticOrder, true, true>(lds + RING_OFF, g, S, E); __syncthreads(); }
            }
        }
        SEAM(pb);
        if (moba) {
#if MOBA_SPARSE
            if (IN(pb + 1)) { PHASE_ENV();
#pragma unroll 1
                for (int rep = (PROBE_DUP & 16384) ? 0 : 1; rep < 2; ++rep) { mb::sel_phase(BIG, KMEAN, (unsigned short*)(ws + WS_HGE), (unsigned*)(ws + WS_HGE + 8 * MiB), (char*)lds_raw, tid); __syncthreads(); } }
            SEAM(pb + 1);
            if (IN(pb + 2)) { PHASE_ENV();
                mb::Partials PP; PP.P[0] = (bf16*)out; PP.P[1] = (bf16*)out + (size_t)BATCH * NH * SEQ * 128; PP.P[2] = (bf16*)(ws + WS_AU); PP.ML = (float*)(ws + WS_ML);
#pragma unroll 1
                for (int rep = (PROBE_DUP & 32768) ? 0 : 1; rep < 2; ++rep) {
                    mb::past_phase(BIG, (const unsigned short*)(ws + WS_HGE), (const unsigned*)(ws + WS_HGE + 8 * MiB), PP, (unsigned*)(ws + WS_CTL) + CW_Q + 64 * l + 32 * rep, (char*)lds_raw, tid); __syncthreads(); }
                xcd_barrier(bar);
                mb::attn_phase(BIG, KMEAN, BIG, 3072, PP, (char*)lds_raw, tid); }
#else
            if (IN(pb + 2)) { PHASE_ENV(); if (MOBA_PP) mb::attn_phase_pp(BIG, KMEAN, BIG + (size_t)3 * MROWS * 1024, 1024, (char*)lds_raw, tid); else { mb::Partials PP{}; mb::attn_phase(BIG, KMEAN, BIG + (size_t)3 * MROWS * 1024, 1024, PP, (char*)lds_raw, tid); } }
#endif
            SEAM(pb + 2);
        } else {
#if defined(NAIVE_HG)
            SEAM(pb + 1);
            if (IN(pb + 2)) { PHASE_ENV(); hg_naive_phase(BIG, LBV + slot * 1024, pp->in[5] + slot * 128, lds, tid); }
#elif !defined(NO_HG)
            if (IN(pb + 1)) { PHASE_ENV();
#pragma unroll 1
                for (int rep = (PROBE_DUP & 4) ? 0 : 1; rep < 2; ++rep) { HGNS::pass_a(BIG, LBV + slot * 1024, (float*)(ws + WS_HGE), (float*)(ws + WS_HGD), lds, lane, wave); __syncthreads(); } }
            SEAM(pb + 1);
            if (IN(pb + 2)) { PHASE_ENV();
#pragma unroll 1
                for (int rep = (PROBE_DUP & 32) ? 0 : 1; rep < 2; ++rep) {
                    HGNS::pass_b(BIG, BIG + (size_t)3 * MROWS * 1024, 1024, rep ? 1 : PROBE_BMODE, LBV + slot * 1024, pp->in[5] + slot * 128, (const float*)(ws + WS_HGE), (const float*)(ws + WS_HGD), lds, lane, wave); __syncthreads(); } }
#endif
            SEAM(pb + 2);
        }
        if (IN(pb + 3)) { PHASE_ENV();
            const bf16* A = BIG + (size_t)3 * MROWS * 1024; const int lda = 1024;
            const bf16* Bt = moba ? (const bf16*)(ws + WS_WOM) + (size_t)slot * 1024 * 1024 : (const bf16*)(ws + WS_WOH) + (size_t)slot * 1024 * 1024;
            pg8::Gemm g{A, Bt, MROWS, 1024, 1024, lda}; pg8::StaticOrder S; S.init(MROWS, 1024, G, (int)blockIdx.x);
            pg8::EpiResid<0> E{l == 0 ? pp->in[0] : nullptr, nullptr, XB, SS, XB, SS, 0, 0};
#pragma unroll 1
            for (int rep = (PROBE_DUP & (256 | 4096)) ? 0 : 1; rep < 2; ++rep) { E.dry = (rep == 0) && !((PROBE_DUP & 4096) && moba); if ((PROBE_DUP & 4096) && moba) { E.xbw = (rep || PROBE_BMODE >= 5) ? XB : (bf16*)(ws + WS_AU); E.ssw = (rep || PROBE_BMODE >= 5) ? SS : (float*)(ws + WS_END); E.dry = rep ? 0 : PROBE_BMODE; } pg8::gemm_phase<pg8::EpiResid<0>, pg8::StaticOrder, true, true>(lds + RING_OFF, g, S, E); __syncthreads(); }
        }
        SEAM(pb + 3);
#ifndef NO_GLU
        if (IN(pb + 4)) { PHASE_ENV();
            const float* cw = pp->in[12] + (size_t)l * 3 * FF; const float* cb = pp->in[13] + (size_t)l * FF;
            pg8::Gemm g{XB, (const bf16*)(ws + WS_WUP) + (size_t)l * 6144 * 1024, MROWS, 6144, 1024, 1024}; pg8::StaticOrder S; S.init(MROWS, 6144, G, (int)blockIdx.x);
            pg8::EpiGLU E{BIG, SS, cw, cb, TAIL, HEADA, HEADU, 0, 0, pg8::rstd_tab_build(lds + RING_OFF, S, SS, tid)}; phase_stagger();
#pragma unroll 1
            for (int rep = (PROBE_DUP & 2) ? 0 : 1; rep < 2; ++rep) { E.dry = rep ? 0 : PROBE_BMODE; E.G = (rep == 0 && PROBE_BMODE == 4) ? (bf16*)(ws + WS_END) : BIG; pg8::gemm_phase<pg8::EpiGLU, pg8::StaticOrder, true, true>(lds + RING_OFF, g, S, E); __syncthreads(); }
        }
#endif
        SEAM(pb + 4);
        if (IN(pb + 5)) { PHASE_ENV();
            const float* cw = pp->in[12] + (size_t)l * 3 * FF; const float* cb = pp->in[13] + (size_t)l * FF;
            pg8::Gemm g{BIG, (const bf16*)(ws + WS_WDN) + (size_t)l * 1024 * 3072, MROWS, 1024, 3072, 3072}; pg8::StaticOrder S; S.init(MROWS, 1024, G, (int)blockIdx.x);
            pg8::Unit u;
            for (int i = 0; S.next(i, u); ++i) {
#pragma unroll
                for (int e0 = 0; e0 < 2 * FF; e0 += NWAVES * 64) { const int e = e0 + tid; glu_fixup_elem(u.pm, e >= FF, e >= FF ? e - FF : e, BIG, TAIL, HEADA, HEADU, cw, cb); } }
            VM_WAIT(); __syncthreads();
            pg8::EpiResid<1> E{nullptr, l == DEPTH - 1 ? out : nullptr, XB, SS, XB, SS, 0, 0};
#pragma unroll 1
            for (int rep = (PROBE_DUP & (512 | 8192)) ? 0 : 1; rep < 2; ++rep) { E.dry = (rep == 0) && !(PROBE_DUP & 8192); if (PROBE_DUP & 8192) { E.xbw = rep ? XB : (bf16*)(ws + WS_AU); E.ssw = rep ? SS : (float*)(ws + WS_END); E.out = (rep && l == DEPTH - 1) ? out : nullptr; } pg8::gemm_phase<pg8::EpiResid<1>, pg8::StaticOrder, true, true>(lds + RING_OFF, g, S, E); __syncthreads(); }
        }
        if (l < DEPTH - 1) SEAM(pb + 5);
    }
#undef IN
#undef SEAM
}

#ifndef MK_PER_PHASE
#define MK_PER_PHASE 0
#endif
extern "C" void kernel_launch(void* const* d_in, const int* in_sizes, int n_in, void* d_out, int out_size, void* d_ws, size_t ws_size, hipStream_t stream) {
    static int grid = 0;
    if (grid == 0) {
        if (n_in != 15 || in_sizes[0] != MROWS * DM || out_size != MROWS * DM || ws_size < WS_END) {
            fprintf(stderr, "kernel_launch: unexpected shapes (n_in %d, in0 %d, out %d, ws %zu < %zu); nothing launched\n", n_in, n_in > 0 ? in_sizes[0] : -1, out_size, ws_size, (size_t)WS_END); grid = -1; return; }
        int dev = 0, cus = 0, per_cu = 0;
        if (hipGetDevice(&dev) != hipSuccess || hipDeviceGetAttribute(&cus, hipDeviceAttributeMultiprocessorCount, dev) != hipSuccess || cus <= 0) { fprintf(stderr, "kernel_launch: no device attributes\n"); grid = -1; return; }
        if (hipFuncSetAttribute((const void*)mega_fwd, hipFuncAttributeMaxDynamicSharedMemorySize, LDS_BYTES) != hipSuccess) { fprintf(stderr, "kernel_launch: hipFuncSetAttribute failed\n"); grid = -1; return; }
        if (hipOccupancyMaxActiveBlocksPerMultiprocessor(&per_cu, (const void*)mega_fwd, NWAVES * 64, LDS_BYTES) != hipSuccess || per_cu < 1)
            fprintf(stderr, "kernel_launch: note: occupancy query reports %d workgroups per CU; launching one per CU (144 KiB LDS each admits exactly one)\n", per_cu);
        (void)hipGetLastError();
        grid = cus;
    }
    if (grid < 0) return;
    (void)hipMemsetAsync((char*)d_ws + WS_CTL, 0, CTL_ZERO_BYTES, stream);
    Params p{};
    for (int i = 0; i < 15; ++i) p.in[i] = (const float*)d_in[i];
    p.out = (float*)d_out; p.ws = (unsigned char*)d_ws;
#if MK_PER_PHASE
    for (int k = 0; k < N_PHASES; ++k) { p.ph_lo = k; p.ph_hi = k + 1; p.bar_region = 0; hipLaunchKernelGGL(mega_fwd, dim3(grid), dim3(NWAVES * 64), LDS_BYTES, stream, p); }
#else
    p.ph_lo = 0; p.ph_hi = N_PHASES; p.bar_region = 0;
    hipLaunchKernelGGL(mega_fwd, dim3(grid), dim3(NWAVES * 64), LDS_BYTES, stream, p);
#endif
}
```

```cpp
#define PG8_PRE 1
#define PG8_RESID_PF 0
#define PG8_PF_DIST 4
#include <hip/hip_runtime.h>
#include <cstdio>
#include <cstdint>
#include <cmath>
namespace pg8 {
#define PG8_LAS __attribute__((address_space(3)))
typedef unsigned short bf16_t;
typedef short bf16x8 __attribute__((ext_vector_type(8)));
typedef float f32x4 __attribute__((ext_vector_type(4)));
typedef unsigned u32x4 __attribute__((ext_vector_type(4)));
constexpr int BM = 256, BK = 64, HALF = 128, HTB = HALF * BK * 2  , STAGE_BYTES = 8 * HTB, NXCD = 8, WGM = 8;

__host__ __device__ __forceinline__ int lds_byte(int r, int c) { const int st = (r >> 4) * 2 + (c >> 5), rr = r & 15, cc = c & 31, ob = rr * 64 + cc * 2; return st * 1024 + (ob ^ (((ob >> 9) & 1) << 5)); }
__host__ __device__ __forceinline__ void stage_rc(int b, int& R, int& C) { const int st = b / 1024, sb = b % 1024, swz = sb ^ (((sb >> 9) & 1) << 5); R = (st >> 1) * 16 + swz / 64; C = (st & 1) * 32 + (swz % 64) / 2; }
__host__ __device__ __forceinline__ int perm32(int rho) { const int n = rho >> 4, i = rho & 15; return 8 * (i >> 2) + 4 * n + (i & 3); }

struct Unit { int pm, pn; };
struct Gemm { const bf16_t* A; const bf16_t* Bt; int M, N, K, lda; };

struct StaticOrder {
    int nM, nN, nwg, G, c;
    __host__ __device__ __forceinline__ void init(int M, int N, int G_, int c_) { nM = M / BM; nN = N / BM; nwg = nM * nN; G = G_; c = c_; }
    __host__ __device__ __forceinline__ bool next(int i, Unit& u) const {
        const long L = (long)i * G + c; if (L >= nwg) return false;
        int wgid = (int)L; { const int q = nwg / NXCD, r = nwg % NXCD, xcd = wgid % NXCD, off = wgid / NXCD; wgid = (xcd < r ? xcd * (q + 1) : r * (q + 1) + (xcd - r) * q) + off; }
        const int nig = WGM * nN, gid = wgid / nig, fm = gid * WGM, gsz = (nM - fm) < WGM ? (nM - fm) : WGM;
        u.pm = fm + ((wgid % nig) % gsz); u.pn = (wgid % nig) / gsz; return true;
    }
    __device__ __forceinline__ void a_ready(const Unit&) const {}
    __device__ __forceinline__ void done(const Unit&) const {}
};

__device__ __forceinline__ unsigned cvt_pk_bf16(float lo, float hi) { unsigned r; asm volatile("v_cvt_pk_bf16_f32 %0, %1, %2" : "=v"(r) : "v"(lo), "v"(hi)); return r; }
typedef float f32x2 __attribute__((ext_vector_type(2)));
constexpr int SS_M = 32768;
struct RstdTab { int p0, p1, ok; };
constexpr int RSTD_TAB_OFF = STAGE_BYTES + 6144;
template <class Sched>
__device__ __forceinline__ RstdTab rstd_tab_build(PG8_LAS unsigned char* lds, const Sched& S, const float* ss, int tid) {
    RstdTab T; T.p0 = -1; T.p1 = -1; T.ok = 1; Unit u;
    for (int i = 0; S.next(i, u); ++i) { if (T.p0 < 0) T.p0 = u.pm; else if (u.pm != T.p0) { if (T.p1 < 0) T.p1 = u.pm; else if (u.pm != T.p1) T.ok = 0; } }
    if (T.ok) { const int slot = tid >> 8, row = tid & 255, pm = slot ? T.p1 : T.p0;
        if (pm >= 0) { const float* sp = ss + (size_t)pm * BM + row; float a[4], b[4], c[4], d[4];
#pragma unroll
            for (int k = 0; k < 4; ++k) { a[k] = sp[(size_t)k * SS_M]; b[k] = sp[(size_t)(4 + k) * SS_M]; c[k] = sp[(size_t)(8 + k) * SS_M]; d[k] = sp[(size_t)(12 + k) * SS_M]; }
            const float s = (((a[0] + a[1]) + (a[2] + a[3])) + ((b[0] + b[1]) + (b[2] + b[3]))) + (((c[0] + c[1]) + (c[2] + c[3])) + ((d[0] + d[1]) + (d[2] + d[3])));
            ((PG8_LAS float*)(lds + RSTD_TAB_OFF))[slot * BM + row] = __builtin_amdgcn_rsqf(s * (1.0f / 1024.0f) + 1e-6f); } }
    asm volatile("s_waitcnt lgkmcnt(0)" ::: "memory"); __builtin_amdgcn_s_barrier(); asm volatile("" ::: "memory");
    return T;
}
template <bool APERM = false> __device__ __forceinline__ void row_rstd8_tab(float (&rs)[2][4], PG8_LAS unsigned char* lds, const RstdTab& tab, int pm, int rt0, int fr4) {
    const PG8_LAS float* T = (const PG8_LAS float*)(lds + RSTD_TAB_OFF) + (pm == tab.p0 ? 0 : BM);
#pragma unroll
    for (int ai = 0; ai < 2; ++ai)
#pragma unroll
        for (int m = 0; m < 4; ++m) rs[ai][m] = T[rt0 + ai * HALF + (APERM ? fr4 + m : m * 16)];
}
template <bool APERM = false> __device__ __forceinline__ void row_rstd8(float (&rs)[2][4], const float* ss, int row0, int fq, int fr4 = 0) {
    f32x4 a[2][4];
#pragma unroll
    for (int ai = 0; ai < 2; ++ai)
#pragma unroll
        for (int m = 0; m < 4; ++m)
#pragma unroll
            for (int k = 0; k < 4; ++k) a[ai][m][k] = ss[(size_t)(4 * fq + k) * SS_M + (row0 + ai * HALF + (APERM ? fr4 + m : m * 16))];
#pragma unroll
    for (int ai = 0; ai < 2; ++ai)
#pragma unroll
        for (int m = 0; m < 4; ++m) { float s = (a[ai][m][0] + a[ai][m][1]) + (a[ai][m][2] + a[ai][m][3]);
            s += __shfl_xor(s, 16); s += __shfl_xor(s, 32);
            rs[ai][m] = __builtin_amdgcn_rsqf(s * (1.0f / 1024.0f) + 1e-6f); }
}
constexpr int MROWS_HM = 32768;
struct EpiRowScale {
    static constexpr bool PERM = true, AFTER_DRAIN = false, APERM = false; static constexpr int NST = 16; static constexpr bool PF = false;
    bf16_t* O; const float* ss; int ldc, pad; RstdTab tab;
    __device__ __forceinline__ void operator()(f32x4 (&acc)[2][2][4][2], const Unit& u, int wr, int wc, int fr, int fq, PG8_LAS unsigned char* lds) const {
        if (pad) asm volatile("s_waitcnt vmcnt(0)" ::: "memory");
        if (pad == 1) return;
        asm volatile("" : "+v"(fr), "+v"(fq));
        const int row0 = u.pm * BM + wr * 64 + fr; const int col0 = u.pn * BM + wc * 32 + 8 * fq;
        float rs8[2][4]; if (tab.ok) row_rstd8_tab(rs8, lds, tab, u.pm, wr * 64 + fr, 0); else row_rstd8(rs8, ss, row0, fq);
#pragma unroll
        for (int ai = 0; ai < 2; ++ai)
#pragma unroll
            for (int m = 0; m < 4; ++m) { const int row = row0 + ai * HALF + m * 16; const float rs = rs8[ai][m];
                bf16_t* rowp = ldc ? O + (size_t)row * ldc + col0
                                   : (u.pn < 12 ? O + ((((size_t)(row >> 12) * 8 + 2 * (u.pn & 3)) * 3 + (u.pn >> 2)) * 4096 + (row & 4095)) * 128 + wc * 32 + 8 * fq
                                                : O + (size_t)3 * MROWS_HM * 1024 + (size_t)row * 1024 + (u.pn - 12) * BM + wc * 32 + 8 * fq);
                const size_t bjstep = ldc ? (size_t)HALF : (u.pn < 12 ? (size_t)3 * 4096 * 128 : (size_t)HALF);
#pragma unroll
                for (int bj = 0; bj < 2; ++bj) { const f32x4 v0 = acc[ai][bj][m][0] * rs, v1 = acc[ai][bj][m][1] * rs;
                    u32x4 w; w.x = cvt_pk_bf16(v0[0], v0[1]); w.y = cvt_pk_bf16(v0[2], v0[3]); w.z = cvt_pk_bf16(v1[0], v1[1]); w.w = cvt_pk_bf16(v1[2], v1[3]);
                    if (pad != 2) *(u32x4*)(rowp + bj * bjstep) = w; } }
    }
};
typedef unsigned u32x2 __attribute__((ext_vector_type(2)));
template <int SITE  > struct EpiResid {
    static constexpr bool PERM = true, AFTER_DRAIN = false, APERM = false; static constexpr int NST = 16; static constexpr bool PF = PG8_RESID_PF;
    const float* base32; float* out; bf16_t* xb; float* ss; bf16_t* xbw; float* ssw; int dry, pad;
    template <bool F32IN, bool F32OUT>
    __device__ __forceinline__ void run(f32x4 (&acc)[2][2][4][2], const Unit& u, int wr, int wc, int fr, int fq) const {
        asm volatile("" : "+v"(fr), "+v"(fq));
        const int col0 = u.pn * BM + wc * 32 + 8 * fq;
#pragma unroll
        for (int ai = 0; ai < 2; ++ai) {
            const size_t off0 = (size_t)(u.pm * BM + ai * HALF + wr * 64 + fr) * 1024 + col0;
            f32x4 bf[F32IN ? 4 : 1][2][2]; u32x4 bh[F32IN ? 1 : 4][2];
#pragma unroll
            for (int m = 0; m < 4; ++m)
#pragma unroll
                for (int bj = 0; bj < 2; ++bj) { const size_t off = off0 + (size_t)m * 16 * 1024 + bj * HALF;
                    if (F32IN) { bf[F32IN ? m : 0][bj][0] = *(const f32x4*)(base32 + off); bf[F32IN ? m : 0][bj][1] = *(const f32x4*)(base32 + off + 4); }
                    else bh[F32IN ? 0 : m][bj] = dry == 2 ? (u32x4){0u, 0u, 0u, 0u} : *(const u32x4*)(xb + off); }
#pragma unroll
            for (int m = 0; m < 4; ++m) { float s = 0.f;
#pragma unroll
                for (int bj = 0; bj < 2; ++bj) { const size_t off = off0 + (size_t)m * 16 * 1024 + bj * HALF; f32x4 b0, b1;
                    if (F32IN) { b0 = bf[F32IN ? m : 0][bj][0]; b1 = bf[F32IN ? m : 0][bj][1]; }
                    else { const u32x4 r = bh[F32IN ? 0 : m][bj];
                        b0 = (f32x4){__uint_as_float(r.x << 16), __uint_as_float(r.x & 0xffff0000u), __uint_as_float(r.y << 16), __uint_as_float(r.y & 0xffff0000u)};
                        b1 = (f32x4){__uint_as_float(r.z << 16), __uint_as_float(r.z & 0xffff0000u), __uint_as_float(r.w << 16), __uint_as_float(r.w & 0xffff0000u)}; }
                    const f32x4 o0 = b0 + acc[ai][bj][m][0], o1 = b1 + acc[ai][bj][m][1];
                    if (F32OUT) { *(f32x4*)(out + off) = o0; *(f32x4*)(out + off + 4) = o1; }
                    s += ((o0[0] * o0[0] + o0[1] * o0[1]) + (o0[2] * o0[2] + o0[3] * o0[3])) + ((o1[0] * o1[0] + o1[1] * o1[1]) + (o1[2] * o1[2] + o1[3] * o1[3]));
                    u32x4 w; w.x = cvt_pk_bf16(o0[0], o0[1]); w.y = cvt_pk_bf16(o0[2], o0[3]); w.z = cvt_pk_bf16(o1[0], o1[1]); w.w = cvt_pk_bf16(o1[2], o1[3]); if (dry != 4 && dry != 6) *(u32x4*)(xbw + off) = w; }
                s += __shfl_xor(s, 16); s += __shfl_xor(s, 32);
                if (fq == 0 && dry != 3 && dry != 7) ssw[(size_t)(u.pn * 4 + wc) * SS_M + (u.pm * BM + ai * HALF + wr * 64 + m * 16 + fr)] = s; }
        }
    }
    __device__ __forceinline__ void prefetch(const Unit& u, int tid, int wid, PG8_LAS unsigned char* lds) const {
        if (base32 != nullptr || dry == 1 || dry == 2) return;
#pragma unroll
        for (int i = 0; i < 2; ++i) { const int L = tid + i * 512;
            __builtin_amdgcn_global_load_lds((const unsigned*)(xb + (size_t)(u.pm * BM + (L >> 2)) * 1024 + u.pn * BM + (L & 3) * 64), (PG8_LAS unsigned*)(lds + STAGE_BYTES + wid * 256), 4, 0, 0); }
    }
    __device__ __forceinline__ void operator()(f32x4 (&acc)[2][2][4][2], const Unit& u, int wr, int wc, int fr, int fq, PG8_LAS unsigned char* lds) const {
        if (dry) asm volatile("s_waitcnt vmcnt(0)" ::: "memory");
        if (dry == 1) return;
        if (dry >= 5) {
#pragma unroll
            for (int a = 0; a < 2; ++a)
#pragma unroll
                for (int b = 0; b < 2; ++b)
#pragma unroll
                    for (int m = 0; m < 4; ++m)
#pragma unroll
                        for (int n = 0; n < 2; ++n) acc[a][b][m][n] = (f32x4){0.f, 0.f, 0.f, 0.f}; }
        if (SITE == 0) { if (base32) run<true, false>(acc, u, wr, wc, fr, fq); else run<false, false>(acc, u, wr, wc, fr, fq); }
        else { if (out) run<false, true>(acc, u, wr, wc, fr, fq); else run<false, false>(acc, u, wr, wc, fr, fq); }
    }
};
template <int CTRL> __device__ __forceinline__ float dpp_mov(float old, float src) {
    return __builtin_bit_cast(float, __builtin_amdgcn_update_dpp(__builtin_bit_cast(int, old), __builtin_bit_cast(int, src), CTRL, 0xf, 0xf, false)); }
__device__ __forceinline__ float silu_f(float c) { return c * __builtin_amdgcn_rcpf(1.0f + __expf(-c)); }
struct EpiGLU {
    static constexpr bool PERM = true, AFTER_DRAIN = false, APERM = true; static constexpr int NST = 20; static constexpr bool PF = false;
    bf16_t* G; const float* ss; const float* cw; const float* cb; float* tail; float* head_a; float* head_u; int dry, pad; RstdTab tab;
    __device__ __forceinline__ void operator()(f32x4 (&acc)[2][2][4][2], const Unit& u, int wr, int wc, int fr, int fq, PG8_LAS unsigned char* lds) const {
        if (dry) asm volatile("s_waitcnt vmcnt(0)" ::: "memory");
        if (dry == 1) { __builtin_amdgcn_s_barrier(); return; }
        asm volatile("" : "+v"(fr), "+v"(fq));
        const int f0 = u.pn * 128 + wc * 32 + 8 * fq;
        PG8_LAS float* X = (PG8_LAS float*)(lds + STAGE_BYTES);
        f32x4 w0 = *(const f32x4*)(cw + f0), w1 = *(const f32x4*)(cw + 3072 + f0), w2 = *(const f32x4*)(cw + 6144 + f0), bb = *(const f32x4*)(cb + f0);
        const f32x4 v0 = *(const f32x4*)(cw + f0 + 4), v1 = *(const f32x4*)(cw + 3072 + f0 + 4), v2 = *(const f32x4*)(cw + 6144 + f0 + 4), vb = *(const f32x4*)(cb + f0 + 4);
        { float rs8[2][4]; if (tab.ok) row_rstd8_tab<true>(rs8, lds, tab, u.pm, wr * 64, 4 * fr); else row_rstd8<true>(rs8, ss, u.pm * BM + wr * 64, fq, 4 * fr);
#pragma unroll
          for (int ai = 0; ai < 2; ++ai)
#pragma unroll
            for (int m = 0; m < 4; ++m) {
#pragma unroll
                for (int bj = 0; bj < 2; ++bj)
#pragma unroll
                    for (int n = 0; n < 2; ++n) acc[ai][bj][m][n] = acc[ai][bj][m][n] * rs8[ai][m]; } }
        if (fr == 15) {
#pragma unroll
            for (int ai = 0; ai < 2; ++ai)
#pragma unroll
                for (int n = 0; n < 2; ++n) { *(PG8_LAS f32x4*)(X + ((((ai * 2 + wr) * 4 + wc) * 2 + 0) * 32 + 8 * fq + 4 * n)) = acc[ai][0][2][n]; *(PG8_LAS f32x4*)(X + ((((ai * 2 + wr) * 4 + wc) * 2 + 1) * 32 + 8 * fq + 4 * n)) = acc[ai][0][3][n]; }
        }
        asm volatile("s_waitcnt lgkmcnt(0)" ::: "memory"); __builtin_amdgcn_s_barrier(); asm volatile("" ::: "memory");
#pragma unroll
        for (int ai = 0; ai < 2; ++ai) {
            const int blk = ai * 2 + wr;
            unsigned pk[2][4][2];
#pragma unroll
            for (int n = 0; n < 2; ++n) {
                const f32x4 c_w0 = n ? v0 : w0, c_w1 = n ? v1 : w1, c_w2 = n ? v2 : w2, c_bb = n ? vb : bb;
                f32x4 P1 = (f32x4){0.f, 0.f, 0.f, 0.f}, P2 = P1;
                if (blk > 0) { P2 = *(const PG8_LAS f32x4*)(X + (((blk - 1) * 4 + wc) * 2 + 0) * 32 + 8 * fq + 4 * n); P1 = *(const PG8_LAS f32x4*)(X + (((blk - 1) * 4 + wc) * 2 + 1) * 32 + 8 * fq + 4 * n); }
                f32x4 gv[4];
#pragma unroll
                for (int j = 0; j < 4; ++j) {
                    const float a0 = acc[ai][0][0][n][j], a1 = acc[ai][0][1][n][j], a2 = acc[ai][0][2][n][j], a3 = acc[ai][0][3][n][j];
                    const float L3 = dpp_mov<0x111>(P1[j], a3), L2 = dpp_mov<0x111>(P2[j], a2);
                    const float c0 = fmaf(c_w0[j], L2, fmaf(c_w1[j], L3, fmaf(c_w2[j], a0, c_bb[j])));
                    const float c1 = fmaf(c_w0[j], L3, fmaf(c_w1[j], a0, fmaf(c_w2[j], a1, c_bb[j])));
                    const float c2 = fmaf(c_w0[j], a0, fmaf(c_w1[j], a1, fmaf(c_w2[j], a2, c_bb[j])));
                    const float c3 = fmaf(c_w0[j], a1, fmaf(c_w1[j], a2, fmaf(c_w2[j], a3, c_bb[j])));
                    if (dry == 3) { gv[0][j] = a0 * acc[ai][1][0][n][j]; gv[1][j] = a1 * acc[ai][1][1][n][j]; gv[2][j] = a2 * acc[ai][1][2][n][j]; gv[3][j] = a3 * acc[ai][1][3][n][j]; } else {
                    gv[0][j] = silu_f(c0) * acc[ai][1][0][n][j]; gv[1][j] = silu_f(c1) * acc[ai][1][1][n][j]; gv[2][j] = silu_f(c2) * acc[ai][1][2][n][j]; gv[3][j] = silu_f(c3) * acc[ai][1][3][n][j]; } }
#pragma unroll
                for (int m = 0; m < 4; ++m) { pk[n][m][0] = cvt_pk_bf16(gv[m][0], gv[m][1]); pk[n][m][1] = cvt_pk_bf16(gv[m][2], gv[m][3]); }
            }
#pragma unroll
            for (int m = 0; m < 4; ++m) {
                const u32x4 w = (u32x4){pk[0][m][0], pk[0][m][1], pk[1][m][0], pk[1][m][1]};
                if (dry == 5) { const int li = fr + 16 * fq; *(u32x4*)(G + (size_t)(u.pm * BM + (wr * 4 + wc) * 32 + (ai * 4 + m) * 4 + (li >> 4)) * 3072 + u.pn * 128 + (li & 15) * 8) = w; }
                else if (dry == 4) *(u32x4*)(G + (size_t)((u.pm & 1) * BM + ai * HALF + wr * 64 + 4 * fr + m) * 3072 + f0) = w;
                else if (dry != 2) *(u32x4*)(G + (size_t)(u.pm * BM + ai * HALF + wr * 64 + 4 * fr + m) * 3072 + f0) = w; }
            asm volatile("" ::: "memory");
        }
        if (fr == 15 && wr == 1) {
#pragma unroll
            for (int n = 0; n < 2; ++n) { *(f32x4*)(tail + ((size_t)u.pm * 2 + 0) * 3072 + f0 + 4 * n) = acc[1][0][2][n]; *(f32x4*)(tail + ((size_t)u.pm * 2 + 1) * 3072 + f0 + 4 * n) = acc[1][0][3][n]; } }
        if (wr == 0 && fr == 0) {
#pragma unroll
            for (int n = 0; n < 2; ++n)
#pragma unroll
                for (int m = 0; m < 2; ++m) { *(f32x4*)(head_a + ((size_t)u.pm * 2 + m) * 3072 + f0 + 4 * n) = acc[0][0][m][n]; *(f32x4*)(head_u + ((size_t)u.pm * 2 + m) * 3072 + f0 + 4 * n) = acc[0][1][m][n]; } }
    }
};
struct EpiQKV {
    static constexpr bool PERM = true, AFTER_DRAIN = false, APERM = false; static constexpr int NST = 16; static constexpr bool PF = false;
    bf16_t* O; const float* ss; const float* qg; const float* kg; const float* invf; float* kmean; int dry, pad; RstdTab tab;
    __device__ __forceinline__ void operator()(f32x4 (&acc)[2][2][4][2], const Unit& u, int wr, int wc, int fr, int fq, PG8_LAS unsigned char* lds) const {
        if (dry) asm volatile("s_waitcnt vmcnt(0)" ::: "memory");
        asm volatile("" : "+v"(fr), "+v"(fq));
        const int type = u.pn >> 2, wv = wr * 4 + wc;
        const int dlo_ = 32 * (wc & 1) + 8 * fq; const float* g_ = type == 1 ? kg : qg;
        const f32x4 glo_a = *(const f32x4*)(g_ + dlo_), ghi_a = *(const f32x4*)(g_ + 64 + dlo_), if_a = *(const f32x4*)(invf + dlo_), glo_b = *(const f32x4*)(g_ + dlo_ + 4), ghi_b = *(const f32x4*)(g_ + 64 + dlo_ + 4), if_b = *(const f32x4*)(invf + dlo_ + 4);
        PG8_LAS float* X = (PG8_LAS float*)(lds + STAGE_BYTES);
        PG8_LAS float* KS = X + 1024;
        { float rs8[2][4]; if (tab.ok) row_rstd8_tab(rs8, lds, tab, u.pm, wr * 64 + fr, 0); else row_rstd8(rs8, ss, u.pm * BM + wr * 64 + fr, fq);
#pragma unroll
          for (int ai = 0; ai < 2; ++ai)
#pragma unroll
            for (int m = 0; m < 4; ++m)
#pragma unroll
                for (int bj = 0; bj < 2; ++bj)
#pragma unroll
                    for (int n = 0; n < 2; ++n) acc[ai][bj][m][n] = acc[ai][bj][m][n] * rs8[ai][m]; }
        if (type == 2) {
#pragma unroll
            for (int ai = 0; ai < 2; ++ai)
#pragma unroll
                for (int m = 0; m < 4; ++m) { const int row = u.pm * BM + ai * HALF + wr * 64 + m * 16 + fr;
                    bf16_t* rowp = O + ((((size_t)(row >> 12) * 8 + 2 * (u.pn & 3)) * 3 + 2) * 4096 + (row & 4095)) * 128 + wc * 32 + 8 * fq;
#pragma unroll
                    for (int bj = 0; bj < 2; ++bj) { const f32x4 v0 = acc[ai][bj][m][0], v1 = acc[ai][bj][m][1];
                        u32x4 w; w.x = cvt_pk_bf16(v0[0], v0[1]); w.y = cvt_pk_bf16(v0[2], v0[3]); w.z = cvt_pk_bf16(v1[0], v1[1]); w.w = cvt_pk_bf16(v1[2], v1[3]);
                        *(u32x4*)(rowp + (size_t)bj * 3 * 4096 * 128) = w; } }
        } else {
#pragma unroll
            for (int ai = 0; ai < 2; ++ai)
#pragma unroll
                for (int m = 0; m < 4; ++m) { float s = 0.f;
#pragma unroll
                    for (int bj = 0; bj < 2; ++bj)
#pragma unroll
                        for (int n = 0; n < 2; ++n) { const f32x4 v = acc[ai][bj][m][n]; s += (v[0] * v[0] + v[1] * v[1]) + (v[2] * v[2] + v[3] * v[3]); }
                    s += __shfl_xor(s, 16); s += __shfl_xor(s, 32);
                    if (fq == 0) X[wv * 128 + ai * 64 + m * 16 + fr] = s; }
        }
        asm volatile("s_waitcnt lgkmcnt(0)" ::: "memory"); __builtin_amdgcn_s_barrier(); asm volatile("" ::: "memory");
        if (type < 2 && dry != 1) {
            const int head = 2 * (u.pn & 3) + (wc >> 1), dlo = 32 * (wc & 1) + 8 * fq;
            const float* g = type ? kg : qg; const float qs = type ? 1.0f : 0.08838834764831845f;
            f32x4 clo[2], chi[2];
#pragma unroll
            for (int n = 0; n < 2; ++n) { clo[n] = (f32x4){0.f, 0.f, 0.f, 0.f}; chi[n] = clo[n]; }
#pragma unroll
            for (int ai = 0; ai < 2; ++ai)
#pragma unroll
                for (int m = 0; m < 4; ++m) {
                    const int r = ai * 64 + m * 16 + fr, row = u.pm * BM + ai * HALF + wr * 64 + m * 16 + fr; const float pos = (float)(row & 4095);
                    const float tot = X[(wv & ~1) * 128 + r] + X[(wv | 1) * 128 + r];
                    const float rh = __builtin_amdgcn_rsqf(tot * (1.0f / 128.0f) + 1e-6f);
                    u32x4 wlo, whi; unsigned pl[4], ph[4];
#pragma unroll
                    for (int n = 0; n < 2; ++n) {
                        const f32x4 glo = n ? glo_b : glo_a, ghi = n ? ghi_b : ghi_a, ifq = n ? if_b : if_a;
                        f32x4 olo, ohi;
#pragma unroll
                        for (int j = 0; j < 4; ++j) {
                            const float ylo = acc[ai][0][m][n][j] * rh * glo[j], yhi = acc[ai][1][m][n][j] * rh * ghi[j];
                            const float ang = pos * ifq[j];
                            const float rev = __builtin_amdgcn_fractf(ang * 0.15915494309189535f);
                            const float c = __builtin_amdgcn_cosf(rev), sn = __builtin_amdgcn_sinf(rev);
                            olo[j] = (ylo * c - yhi * sn) * qs; ohi[j] = (yhi * c + ylo * sn) * qs; }
                        clo[n] = clo[n] + olo; chi[n] = chi[n] + ohi;
                        pl[2 * n] = cvt_pk_bf16(olo[0], olo[1]); pl[2 * n + 1] = cvt_pk_bf16(olo[2], olo[3]); ph[2 * n] = cvt_pk_bf16(ohi[0], ohi[1]); ph[2 * n + 1] = cvt_pk_bf16(ohi[2], ohi[3]); }
                    wlo = (u32x4){pl[0], pl[1], pl[2], pl[3]}; whi = (u32x4){ph[0], ph[1], ph[2], ph[3]};
                    bf16_t* op = O + ((((size_t)(row >> 12) * 8 + head) * 3 + type) * 4096 + (row & 4095)) * 128 + dlo;
                    if (dry != 2) { *(u32x4*)op = wlo; *(u32x4*)(op + 64) = whi; }
                }
            if (type == 1) {
#pragma unroll
                for (int n = 0; n < 2; ++n)
#pragma unroll
                    for (int j = 0; j < 4; ++j) {
                        float a = clo[n][j], bsum = chi[n][j];
                        a += __shfl_xor(a, 1); a += __shfl_xor(a, 2); a += __shfl_xor(a, 4); a += __shfl_xor(a, 8);
                        bsum += __shfl_xor(bsum, 1); bsum += __shfl_xor(bsum, 2); bsum += __shfl_xor(bsum, 4); bsum += __shfl_xor(bsum, 8);
                        if (fr == 0) { KS[wv * 64 + 8 * fq + 4 * n + j] = a; KS[wv * 64 + 32 + 8 * fq + 4 * n + j] = bsum; } }
            }
        }
        asm volatile("s_waitcnt lgkmcnt(0)" ::: "memory"); __builtin_amdgcn_s_barrier(); asm volatile("" ::: "memory");
        if (type == 1 && wr == 0) {
            const int lane = fr + 16 * fq, head = 2 * (u.pn & 3) + (wc >> 1), d = 64 * (lane >> 5) + 32 * (wc & 1) + (lane & 31);
            const float s = KS[wv * 64 + lane] + KS[(wv + 4) * 64 + lane];
            kmean[((size_t)((u.pm >> 4) * 8 + head) * 16 + (u.pm & 15)) * 128 + d] = s * (1.0f / 256.0f);
        }
    }
};
template <class Epi, class Sched, bool ALIGN_EPI = false, bool SP2 = false>
__device__ __forceinline__ void gemm_phase(PG8_LAS unsigned char* lds, const Gemm g, const Sched& S, const Epi& E) {
    int tid_ = threadIdx.x; asm volatile("" : "+v"(tid_));
    const int tid = tid_, wid = __builtin_amdgcn_readfirstlane(tid >> 6), lane = tid & 63, wr = wid >> 2, wc = wid & 3, fr = lane & 15, fq = lane >> 4;
    const int K = g.K, nt = K / BK;
    unsigned voffA[2], voffB[2];
#pragma unroll
    for (int i = 0; i < 2; ++i) { int R, C; stage_rc(tid * 16 + i * 8192, R, C); const int Rb = Epi::PERM ? ((R & ~31) + perm32(R & 31)) : R;
        const int Ra = Epi::APERM ? ((R & ~63) + 4 * (R & 15) + ((R >> 4) & 3)) : R;
        voffA[i] = (unsigned)(Ra * g.lda + C) * 2u; voffB[i] = (unsigned)(Rb * K + C) * 2u; }
    const size_t kstep = (size_t)(BK * 2);
    const size_t hstepB = (size_t)HALF * K * 2, hstepA = (size_t)HALF * g.lda * 2;
    const size_t tstepA = 2 * hstepA, tstepB = 2 * hstepB;
    const unsigned ldsw = (unsigned)wid * 1024u;
    const int aoff = lds_byte(wr * 64 + fr, fq * 8), boff = lds_byte(wc * 32 + fr, fq * 8);
#define PG8_SA(b, h) (((b) * 2 + (h)) * HTB)
#define PG8_SB(b, h) ((4 + (b) * 2 + (h)) * HTB)
#define PG8_STAGE(bufoff, gbase, voff) do { _Pragma("unroll") for (int _i = 0; _i < 2; ++_i) \
        __builtin_amdgcn_global_load_lds((const unsigned*)((const char*)(gbase) + (voff)[_i]), (PG8_LAS unsigned*)(lds + (bufoff) + ldsw + _i * 8192), 16, 0, 0); } while (0)
#define PG8_LDA(dst, b, h) do { _Pragma("unroll") for (int m = 0; m < 4; ++m) _Pragma("unroll") for (int k = 0; k < 2; ++k) dst[m][k] = *(const PG8_LAS bf16x8*)(lds + PG8_SA(b, h) + aoff + m * 2048 + k * 1024); } while (0)
#define PG8_LDB(dst, b, h) do { _Pragma("unroll") for (int n = 0; n < 2; ++n) _Pragma("unroll") for (int k = 0; k < 2; ++k) dst[n][k] = *(const PG8_LAS bf16x8*)(lds + PG8_SB(b, h) + boff + n * 2048 + k * 1024); } while (0)
#define PG8_MMA(ai, bj, At, Bt) do { __builtin_amdgcn_s_setprio(1); _Pragma("unroll") for (int m = 0; m < 4; ++m) _Pragma("unroll") for (int n = 0; n < 2; ++n) _Pragma("unroll") for (int k = 0; k < 2; ++k) \
        acc[ai][bj][m][n] = __builtin_amdgcn_mfma_f32_16x16x32_bf16(Bt[n][k], At[m][k], acc[ai][bj][m][n], 0, 0, 0); __builtin_amdgcn_s_setprio(0); } while (0)
#define PG8_WAIT_V(n) asm volatile("s_waitcnt vmcnt(" #n ")" ::: "memory")
#define PG8_WAIT_L(n) asm volatile("s_waitcnt lgkmcnt(" #n ")" ::: "memory")
#define PG8_BAR __builtin_amdgcn_s_barrier()
#define PG8_SCHED __builtin_amdgcn_sched_barrier(0)
    Unit cur, nxt; int ui = 0;
    if (!S.next(0, cur)) return;
    f32x4 acc[2][2][4][2];
#pragma unroll
    for (int a = 0; a < 2; ++a)
#pragma unroll
        for (int b = 0; b < 2; ++b)
#pragma unroll
            for (int m = 0; m < 4; ++m)
#pragma unroll
                for (int n = 0; n < 2; ++n) acc[a][b][m][n] = (f32x4){0.f, 0.f, 0.f, 0.f};
    bf16x8 At[4][2], B0[2][2], B1[2][2];
    const char* cA = (const char*)g.A + (size_t)cur.pm * tstepA; const char* cB = (const char*)g.Bt + (size_t)cur.pn * tstepB;
    S.a_ready(cur);
    if constexpr (SP2) {
        PG8_STAGE(PG8_SB(0, 0), cB, voffB); PG8_STAGE(PG8_SB(0, 1), cB + hstepB, voffB); PG8_STAGE(PG8_SA(0, 0), cA, voffA); PG8_STAGE(PG8_SA(0, 1), cA + hstepA, voffA);
        if (wr == 1) PG8_BAR;
        PG8_WAIT_V(2); PG8_BAR;
        PG8_STAGE(PG8_SB(1, 0), cB + kstep, voffB); PG8_STAGE(PG8_SA(1, 0), cA + kstep, voffA); PG8_STAGE(PG8_SB(1, 1), cB + hstepB + kstep, voffB);
        PG8_WAIT_V(6); PG8_BAR;
    } else {
        PG8_STAGE(PG8_SB(0, 0), cB, voffB); PG8_STAGE(PG8_SA(0, 0), cA, voffA); PG8_STAGE(PG8_SB(0, 1), cB + hstepB, voffB); PG8_STAGE(PG8_SA(0, 1), cA + hstepA, voffA);
        if (wr == 1) PG8_BAR;
        PG8_WAIT_V(4); PG8_BAR;
        PG8_STAGE(PG8_SB(1, 0), cB + kstep, voffB); PG8_STAGE(PG8_SA(1, 0), cA + kstep, voffA); PG8_STAGE(PG8_SB(1, 1), cB + hstepB + kstep, voffB);
        PG8_WAIT_V(6); PG8_BAR;
    }
    constexpr bool PRE = PG8_PRE && SP2 && ALIGN_EPI;
    for (;;) {
        const bool has_next = S.next(ui + 1, nxt);
        const char* nA = has_next ? (const char*)g.A + (size_t)nxt.pm * tstepA : cA; const char* nB = has_next ? (const char*)g.Bt + (size_t)nxt.pn * tstepB : cB;
        for (int t = 0; t < nt; t += 2) {
            const bool last = (t == nt - 2);
            const char* a1 = cA + (size_t)(t + 1) * kstep;
            const char* a2 = last ? nA : cA + (size_t)(t + 2) * kstep; const char* b2 = last ? nB : cB + (size_t)(t + 2) * kstep;
            const char* a3 = a2 + kstep; const char* b3 = b2 + kstep;
            int pre_s = __builtin_amdgcn_readfirstlane(t | (ui == 0)); asm volatile("" : "+s"(pre_s)); const bool pre = PRE && pre_s == 0;
            if (last && has_next) S.a_ready(nxt);
            if constexpr (SP2) {
            PG8_LDB(B0, 0, 0); PG8_LDB(B1, 0, 1); PG8_SCHED; PG8_LDA(At, 0, 0); if (!(PRE && pre)) PG8_STAGE(PG8_SA(1, 1), a1 + hstepA, voffA);
            if (PRE && pre) asm volatile("s_waitcnt vmcnt(%0)" :: "n"(Epi::NST) : "memory"); else PG8_WAIT_V(8);
            if constexpr (Epi::PF) { int pf_s = __builtin_amdgcn_readfirstlane(t - (nt - PG8_PF_DIST)); asm volatile("" : "+s"(pf_s)); if (pf_s == 0) E.prefetch(cur, tid, wid, lds); }
            PG8_WAIT_L(0); PG8_BAR; PG8_MMA(0, 0, At, B0); PG8_MMA(0, 1, At, B1); PG8_BAR; PG8_SCHED;
            PG8_LDA(At, 0, 1); PG8_STAGE(PG8_SB(0, 0), b2, voffB); PG8_STAGE(PG8_SB(0, 1), b2 + hstepB, voffB); PG8_STAGE(PG8_SA(0, 0), a2, voffA);
            if (!(PRE && pre)) PG8_WAIT_V(8);
            PG8_WAIT_L(0); PG8_BAR; PG8_MMA(1, 0, At, B0); PG8_MMA(1, 1, At, B1); PG8_BAR; PG8_SCHED;
            PG8_LDB(B0, 1, 0); PG8_LDB(B1, 1, 1); PG8_SCHED; PG8_LDA(At, 1, 0); PG8_STAGE(PG8_SA(0, 1), a2 + hstepA, voffA);
            if (!(PRE && pre)) PG8_WAIT_V(8);
            PG8_WAIT_L(0); PG8_BAR; PG8_MMA(0, 0, At, B0); PG8_MMA(0, 1, At, B1); PG8_BAR; PG8_SCHED;
            PG8_LDA(At, 1, 1); PG8_STAGE(PG8_SB(1, 0), b3, voffB); PG8_STAGE(PG8_SB(1, 1), b3 + hstepB, voffB); PG8_STAGE(PG8_SA(1, 0), a3, voffA);
            PG8_WAIT_V(8); PG8_WAIT_L(0); PG8_BAR; PG8_MMA(1, 0, At, B0); PG8_MMA(1, 1, At, B1); PG8_BAR; PG8_SCHED;
            } else {
            PG8_LDB(B0, 0, 0); PG8_SCHED; PG8_LDA(At, 0, 0); PG8_STAGE(PG8_SA(1, 1), a1 + hstepA, voffA);
            PG8_WAIT_L(8); PG8_BAR; PG8_WAIT_L(0); PG8_MMA(0, 0, At, B0); PG8_BAR; PG8_SCHED;
            PG8_LDB(B1, 0, 1); PG8_STAGE(PG8_SB(0, 0), b2, voffB);
            PG8_BAR; PG8_WAIT_L(0); PG8_MMA(0, 1, At, B1); PG8_BAR;
            PG8_LDA(At, 0, 1); PG8_STAGE(PG8_SA(0, 0), a2, voffA);
            PG8_BAR; PG8_WAIT_L(0); PG8_MMA(1, 0, At, B0); PG8_BAR; PG8_SCHED;
            PG8_STAGE(PG8_SB(0, 1), b2 + hstepB, voffB);
            PG8_WAIT_V(6); PG8_BAR; PG8_MMA(1, 1, At, B1); PG8_BAR;
            PG8_LDB(B0, 1, 0); PG8_SCHED; PG8_LDA(At, 1, 0); PG8_STAGE(PG8_SA(0, 1), a2 + hstepA, voffA);
            PG8_WAIT_L(8); PG8_BAR; PG8_WAIT_L(0); PG8_MMA(0, 0, At, B0); PG8_BAR; PG8_SCHED;
            PG8_LDB(B1, 1, 1); PG8_STAGE(PG8_SB(1, 0), b3, voffB);
            PG8_BAR; PG8_WAIT_L(0); PG8_MMA(0, 1, At, B1); PG8_BAR;
            PG8_LDA(At, 1, 1); PG8_STAGE(PG8_SA(1, 0), a3, voffA);
            PG8_BAR; PG8_WAIT_L(0); PG8_MMA(1, 0, At, B0); PG8_BAR; PG8_SCHED;
            PG8_STAGE(PG8_SB(1, 1), b3 + hstepB, voffB);
            PG8_WAIT_V(6); PG8_BAR; PG8_MMA(1, 1, At, B1); PG8_BAR;
            }
        }
        if constexpr (ALIGN_EPI) { if (wr == 0) PG8_BAR; }
        if constexpr (PRE) { if (has_next) { PG8_STAGE(PG8_SA(1, 1), nA + kstep + hstepA, voffA); } }
        if constexpr (!Epi::AFTER_DRAIN) { E(acc, cur, wr, wc, fr, fq, lds); S.done(cur); }
        if (!has_next) break;
#pragma unroll
        for (int a = 0; a < 2; ++a)
#pragma unroll
            for (int b = 0; b < 2; ++b)
#pragma unroll
                for (int m = 0; m < 4; ++m)
#pragma unroll
                    for (int n = 0; n < 2; ++n) acc[a][b][m][n] = (f32x4){0.f, 0.f, 0.f, 0.f};
        cur = nxt; cA = nA; cB = nB; ++ui;
        if constexpr (ALIGN_EPI) { if (wr == 1) PG8_BAR; }
    }
    PG8_WAIT_V(0);
    if constexpr (!ALIGN_EPI) { if (wr == 0) PG8_BAR; }
    PG8_BAR;
    if constexpr (Epi::AFTER_DRAIN) { E.fused(acc, cur, wr, wc, fr, fq, lds, wid, lane); S.done(cur); }
#undef PG8_SA
#undef PG8_SB
#undef PG8_STAGE
#undef PG8_LDA
#undef PG8_LDB
#undef PG8_MMA
#undef PG8_WAIT_V
#undef PG8_WAIT_L
#undef PG8_BAR
#undef PG8_SCHED
}
}
#ifndef PROBE_DUP
#define PROBE_DUP 0
#endif
constexpr int BATCH = 8, SEQ = 4096, DM = 1024, MROWS = BATCH * SEQ, DEPTH = 4;
constexpr int NH = 8, HD = 128;
constexpr int FF = 3072, NBLK = 16, MBLK = 256;
constexpr float QSCALE = 0.08838834764831845f;
typedef unsigned short bf16;
typedef float f32x4 __attribute__((ext_vector_type(4)));
typedef unsigned u32x4 __attribute__((ext_vector_type(4)));

constexpr size_t MiB = 1u << 20;
constexpr size_t WS_CTL = 0, CTL_ZERO_BYTES = 64 * 1024;
constexpr size_t WS_WIN = 2 * MiB, WS_WQKV = 18 * MiB, WS_WOH = 30 * MiB, WS_WOM = 34 * MiB, WS_WUP = 38 * MiB, WS_WDN = 86 * MiB;
constexpr size_t WS_SS = 110 * MiB, WS_COS = 112 * MiB, WS_SIN = 113 * MiB, WS_LBV = 114 * MiB, WS_KMEAN = 115 * MiB;
constexpr size_t WS_INVF = 114 * MiB + 16384;
constexpr size_t WS_HGD = 115 * MiB + 512 * 1024, WS_HGE = 116 * MiB;
constexpr size_t WS_TAIL = 132 * MiB, WS_HEADA = 135 * MiB, WS_HEADU = 138 * MiB;
constexpr size_t WS_XB = 144 * MiB, WS_BIG = 208 * MiB, WS_AU = 400 * MiB, WS_ML = 464 * MiB, WS_END = 472 * MiB;

__device__ __forceinline__ float bf2f(bf16 v) { return __uint_as_float((unsigned)v << 16); }
__device__ __forceinline__ bf16 f2bf(float f) { unsigned u = __float_as_uint(f); return (bf16)((u + 0x7fffu + ((u >> 16) & 1u)) >> 16); }
__device__ __forceinline__ float wave_sum(float v) {
#pragma unroll
    for (int o = 1; o < 64; o <<= 1) v += __shfl_xor(v, o);
    return v;
}
__device__ __forceinline__ float wave_max(float v) {
#pragma unroll
    for (int o = 1; o < 64; o <<= 1) v = fmaxf(v, __shfl_xor(v, o));
    return v;
}

__device__ __forceinline__ void glu_fixup_elem(int pm, int rr, int f, bf16* __restrict__ g, const float* __restrict__ tail, const float* __restrict__ head_a, const float* __restrict__ head_u, const float* __restrict__ cw, const float* __restrict__ cb) {
    const bool first = (pm & 15) == 0;
    const float cur = head_a[((size_t)pm * 2 + rr) * FF + f];
    const float t1 = first ? 0.f : tail[((size_t)(pm - 1) * 2 + 1) * FF + f], t0 = first ? 0.f : tail[((size_t)(pm - 1) * 2 + 0) * FF + f];
    const float prev1 = rr == 0 ? t1 : head_a[((size_t)pm * 2) * FF + f], prev2 = rr == 0 ? t0 : t1;
    const float c = cw[f] * prev2 + cw[FF + f] * prev1 + cw[2 * FF + f] * cur + cb[f];
    g[((size_t)pm * 256 + rr) * FF + f] = f2bf(c / (1.0f + __expf(-c)) * head_u[((size_t)pm * 2 + rr) * FF + f]);
}
#define XB_TMO      128
#define XB_XCNT(j)  (256  + 64 * (j))
#define XB_XSUB(j)  (1280 + 64 * (j))
#define XB_XGEN(j)  (2304 + 64 * (j))
#define XB_TOP      3328
#define XB_TOPGEN   3392
#define XCD_BAR_WORDS 3456
#define XB_SPIN_CAP (1u << 18)
#define LAS __attribute__((address_space(3)))

__device__ __forceinline__ unsigned xb_ld(unsigned* p)              { return __hip_atomic_load(p, __ATOMIC_RELAXED, __HIP_MEMORY_SCOPE_AGENT); }
__device__ __forceinline__ unsigned xb_add(unsigned* p, unsigned v) { return __hip_atomic_fetch_add(p, v, __ATOMIC_RELAXED, __HIP_MEMORY_SCOPE_AGENT); }
__device__ __forceinline__ unsigned xb_xcc_id() { return (unsigned)__builtin_amdgcn_s_getreg((3 << 11) | 20) & 0xFu; }
#define XB_SPIN(cond, bar) do { unsigned _sp = 0; while (cond) { __builtin_amdgcn_s_sleep(1); \
    if ((++_sp & 255u) == 0u) { if (xb_ld(&(bar)[XB_TMO])) break; if (_sp > XB_SPIN_CAP) { atomicAdd(&(bar)[XB_TMO], 1u); break; } } } } while (0)

struct XcdBarrier {
    unsigned* bar; unsigned x;
    volatile LAS unsigned* st;
};

__device__ __forceinline__ XcdBarrier xcd_barrier_post(unsigned* bar, volatile LAS unsigned* st) {
    XcdBarrier b; b.bar = bar; b.x = xb_xcc_id(); b.st = st;
    if (threadIdx.x == 0) (void)xb_add(&bar[XB_XCNT(b.x)], 1u);
    return b;
}
__device__ __forceinline__ void xcd_barrier_complete(unsigned* bar, unsigned x, unsigned& nloc, unsigned& nx) {
    const unsigned G = gridDim.x * gridDim.y * gridDim.z;
    unsigned sum, cnt, mine, sp = 0u;
    for (;;) {
        sum = 0u; cnt = 0u; mine = 0u;
#pragma unroll
        for (unsigned j = 0; j < 16; ++j) { const unsigned c = xb_ld(&bar[XB_XCNT(j)]); sum += c; cnt += (c > 0u) ? 1u : 0u; mine = (j == x) ? c : mine; }
        if (sum == G) break;
        __builtin_amdgcn_s_sleep(1);
        if ((++sp & 255u) == 0u) { if (xb_ld(&bar[XB_TMO])) break; if (sp > XB_SPIN_CAP) { atomicAdd(&bar[XB_TMO], 1u); break; } }
    }
    nloc = mine > 0u ? mine : 1u; nx = cnt > 0u ? cnt : 1u;
}

__device__ __forceinline__ void xcd_barrier(const XcdBarrier& b) {
    asm volatile("s_waitcnt vmcnt(0)" ::: "memory");
    __syncthreads();
    if (threadIdx.x == 0) {
        unsigned* bar = b.bar;
        __builtin_amdgcn_s_waitcnt(0);
        unsigned nloc = b.st[0], nx = b.st[1];
        if (nloc == 0u) { xcd_barrier_complete(bar, b.x, nloc, nx); b.st[0] = nloc; b.st[1] = nx; }
        const unsigned old = xb_add(&bar[XB_XSUB(b.x)], 1u);
        const unsigned gen = old / nloc;
        if (old + 1u == (gen + 1u) * nloc) {
            __builtin_amdgcn_fence(__ATOMIC_RELEASE, "agent");
            asm volatile("s_waitcnt vmcnt(0)" ::: "memory");
            const unsigned og = xb_add(&bar[XB_TOP], 1u);
            const unsigned tg = og / nx;
            if (og + 1u == (tg + 1u) * nx) xb_add(&bar[XB_TOPGEN], 1u);
            else XB_SPIN(xb_ld(&bar[XB_TOPGEN]) == tg, bar);
            __builtin_amdgcn_fence(__ATOMIC_ACQUIRE, "agent");
            xb_add(&bar[XB_XGEN(b.x)], 1u);
            asm volatile("s_waitcnt vmcnt(0)" ::: "memory");
        } else {
            XB_SPIN(xb_ld(&bar[XB_XGEN(b.x)]) == gen, bar);
            __builtin_amdgcn_fence(__ATOMIC_ACQUIRE, "agent");
            asm volatile("s_waitcnt vmcnt(0)" ::: "memory");
        }
    }
    __syncthreads();
}
namespace mb {
typedef short bf16x8 __attribute__((ext_vector_type(8)));
typedef short s16x4 __attribute__((ext_vector_type(4)));
typedef float f32x16 __attribute__((ext_vector_type(16)));
typedef float f32x2 __attribute__((ext_vector_type(2)));
#ifndef MOBA_SPARSE
#define MOBA_SPARSE 0
#endif
constexpr int D = 128, LDR = 128, ARR = 4096 * 128, NW = 8, QBLK = 32, KVBLK = 64, QB = NW * QBLK;
static_assert(!MOBA_SPARSE, "the sparse sub-phases below still address the token-major q|k|v layout");
constexpr int SHM_V = KVBLK * D * 2, SHM_K = KVBLK * D * 2;
constexpr int OFF_WS = 2 * SHM_V + 2 * SHM_K, OFF_KM = OFF_WS + NW * 64 * 4, ATT_LDS_BYTES = OFF_KM + 16 * 128 * 4;
constexpr float THR = 8.f;
#define KSWZ(row, colB) ((row) * 256 + ((colB) ^ (((row) & 7) << 4)))
#define SBAR() __builtin_amdgcn_sched_barrier(0)
__device__ __forceinline__ int v_st(int k, int c) { const int kk = (k & ~0xC) | ((k & 4) << 1) | ((k & 8) >> 1); return ((kk >> 3) * 4 + (c >> 5)) * 512 + ((kk & 7) * 32 + (c & 31)) * 2; }
__device__ __forceinline__ int v_rd_base(int lane) { return ((lane & 3) << 3) | (((lane >> 2) & 3) << 6) | (((lane >> 4) & 1) << 5) | (((lane >> 5) & 1) << 8); }
constexpr int v_rd_off(int d0, int ks, int half) { return d0 * 512 + ks * 4096 + half * 2048; }
__device__ __forceinline__ int crow(int r, int hi) { return (r & 3) + 8 * (r >> 2) + 4 * hi; }
__device__ __forceinline__ unsigned cvtpk(float lo, float hi) { unsigned r; asm volatile("v_cvt_pk_bf16_f32 %0, %1, %2" : "=v"(r) : "v"(lo), "v"(hi)); return r; }
__device__ __forceinline__ bf16x8 load8(const bf16* p) { return *reinterpret_cast<const bf16x8*>(p); }
__device__ __forceinline__ void mask_causal(f32x16& p0, f32x16& p1, int dq) {
    const float NEG = -__builtin_inff();
#pragma unroll
    for (int r = 0; r < 16; ++r) { const int c = (r & 3) + 8 * (r >> 2); if (dq - c < 0) p0[r] = NEG; if (dq - c - 32 < 0) p1[r] = NEG; }
}
__device__ __forceinline__ void mask_all(f32x16& p0, f32x16& p1, bool keep) {
    const float NEG = -__builtin_inff();
#pragma unroll
    for (int r = 0; r < 16; ++r) { p0[r] = keep ? p0[r] : NEG; p1[r] = keep ? p1[r] : NEG; }
}
__device__ __forceinline__ void partialSM(f32x16& p0, f32x16& p1, float& m_reg, float& mn, float& alpha, bool keep = true) {
    float pmax = p0[0]; for (int r = 1; r < 16; ++r) pmax = fmaxf(pmax, p0[r]); for (int r = 0; r < 16; ++r) pmax = fmaxf(pmax, p1[r]);
    pmax = keep ? pmax : -__builtin_inff();
    { auto rr = __builtin_amdgcn_permlane32_swap(__float_as_uint(pmax), __float_as_uint(pmax), false, false);
      pmax = fmaxf(__uint_as_float(rr[0]), __uint_as_float(rr[1])); }
    constexpr float C2 = 1.4426950408889634f;
    if (__builtin_expect(__all((pmax - m_reg) <= THR), 1)) { mn = m_reg; alpha = 1.f; }
    else { mn = fmaxf(m_reg, pmax); alpha = __builtin_amdgcn_exp2f((m_reg - mn) * C2); m_reg = mn; }
    const float mnL = keep ? -mn * C2 : -__builtin_inff();
    { f32x16 c2v, mlv;
#pragma unroll
      for (int r = 0; r < 16; ++r) { c2v[r] = C2; mlv[r] = mnL; }
      p0 = __builtin_elementwise_fma(p0, c2v, mlv); p1 = __builtin_elementwise_fma(p1, c2v, mlv); }
    for (int r = 0; r < 16; ++r) p0[r] = __builtin_amdgcn_exp2f(p0[r]);
}
__device__ __forceinline__ void finishSM(f32x16& p0, f32x16& p1, float alpha, float& l_reg, bf16x8& pa0, bf16x8& pa1, bf16x8& pa2, bf16x8& pa3) {
    for (int r = 0; r < 16; ++r) p1[r] = __builtin_amdgcn_exp2f(p1[r]);
    float ps;
    { const f32x16 s16 = p0 + p1;
      typedef float f32x8_t __attribute__((ext_vector_type(8))); typedef float f32x4_t __attribute__((ext_vector_type(4))); typedef float f32x2_t __attribute__((ext_vector_type(2)));
      const f32x8_t s8 = __builtin_shufflevector(s16, s16, 0, 1, 2, 3, 4, 5, 6, 7) + __builtin_shufflevector(s16, s16, 8, 9, 10, 11, 12, 13, 14, 15);
      const f32x4_t s4 = __builtin_shufflevector(s8, s8, 0, 1, 2, 3) + __builtin_shufflevector(s8, s8, 4, 5, 6, 7);
      const f32x2_t s2 = __builtin_shufflevector(s4, s4, 0, 1) + __builtin_shufflevector(s4, s4, 2, 3);
      ps = s2[0] + s2[1]; }
    { auto rr = __builtin_amdgcn_permlane32_swap(__float_as_uint(ps), __float_as_uint(ps), false, false);
      ps = __uint_as_float(rr[0]) + __uint_as_float(rr[1]); }
    l_reg = l_reg * alpha + ps;
#define PK4(P, B_, OUT) do { unsigned a0 = cvtpk(P[B_+0], P[B_+1]), a1 = cvtpk(P[B_+2], P[B_+3]);                          \
        unsigned b0 = cvtpk(P[B_+4], P[B_+5]), b1 = cvtpk(P[B_+6], P[B_+7]);                                             \
        auto r0 = __builtin_amdgcn_permlane32_swap(a0, b0, false, false); auto r1 = __builtin_amdgcn_permlane32_swap(a1, b1, false, false); \
        u32x4 w = {r0[0], r1[0], r0[1], r1[1]}; OUT = *reinterpret_cast<bf16x8*>(&w); } while (0)
    PK4(p0, 0, pa0); PK4(p0, 8, pa1); PK4(p1, 0, pa2); PK4(p1, 8, pa3);
#undef PK4
}
template <int KB>
__device__ __forceinline__ void qkt(f32x16& p0, f32x16& p1, const char* K_lds, int r32, int hi, const bf16x8* qr) {
    p0 = f32x16{}; p1 = f32x16{};
    const char* kb[4];
#pragma unroll
    for (int dd = 0; dd < 4; ++dd) kb[dd] = K_lds + KB * SHM_K + KSWZ(r32, (dd * 16 + hi * 8) * 2);
#pragma unroll
    for (int d0 = 0; d0 < 8; ++d0) { const char* a = kb[d0 & 3] + (d0 >> 2) * 128;
        bf16x8 b0 = *reinterpret_cast<const bf16x8*>(a);
        bf16x8 b1 = *reinterpret_cast<const bf16x8*>(a + 32 * 256);
        p0 = __builtin_amdgcn_mfma_f32_32x32x16_bf16(b0, qr[d0], p0, 0, 0, 0);
        p1 = __builtin_amdgcn_mfma_f32_32x32x16_bf16(b1, qr[d0], p1, 0, 0, 0); }
}
template <int VB>
__device__ __forceinline__ void pv_tile(f32x16* o, int vb0, bf16x8 pa0, bf16x8 pa1, bf16x8 pa2, bf16x8 pa3) {
#define TRRD(dst, off) asm volatile("ds_read_b64_tr_b16 %0, %1 offset:%2" : "=&v"(dst) : "v"(vb0), "i"(off) : "memory")
#define PV_D0(d0) do { s16x4 l0, l1, l2, l3, h0, h1, h2, h3; constexpr int b_ = VB * SHM_V + v_rd_off(d0, 0, 0);   \
        TRRD(l0, b_); TRRD(h0, b_ + 2048); TRRD(l1, b_ + 4096); TRRD(h1, b_ + 6144); TRRD(l2, b_ + 8192); TRRD(h2, b_ + 10240); TRRD(l3, b_ + 12288); TRRD(h3, b_ + 14336); \
        asm volatile("s_waitcnt lgkmcnt(0)" ::: "memory"); SBAR();   \
        o[d0] = __builtin_amdgcn_mfma_f32_32x32x16_bf16(pa0, (bf16x8){l0[0], l0[1], l0[2], l0[3], h0[0], h0[1], h0[2], h0[3]}, o[d0], 0, 0, 0);   \
        o[d0] = __builtin_amdgcn_mfma_f32_32x32x16_bf16(pa1, (bf16x8){l1[0], l1[1], l1[2], l1[3], h1[0], h1[1], h1[2], h1[3]}, o[d0], 0, 0, 0);   \
        o[d0] = __builtin_amdgcn_mfma_f32_32x32x16_bf16(pa2, (bf16x8){l2[0], l2[1], l2[2], l2[3], h2[0], h2[1], h2[2], h2[3]}, o[d0], 0, 0, 0);   \
        o[d0] = __builtin_amdgcn_mfma_f32_32x32x16_bf16(pa3, (bf16x8){l3[0], l3[1], l3[2], l3[3], h3[0], h3[1], h3[2], h3[3]}, o[d0], 0, 0, 0); } while (0)
    PV_D0(0); PV_D0(1); PV_D0(2); PV_D0(3);
#undef PV_D0
#undef TRRD
}

struct BlockRef { const bf16* Q; const bf16* K; const bf16* V; bf16* O; const float* KM; int iblk, ldo, store, bh; };
struct Partials { bf16* P[3]; float* ML; };
struct Seam { bf16x8 qr[8]; bf16x8 st_v0, st_v1, st_k0, st_k1; };
#define ROW(p, k0, rr) ((p) + (size_t)((k0) + (rr)) * LDR + sc)
#define VMW() asm volatile("s_waitcnt vmcnt(0)" ::: "memory")
#define VMWN(n) asm volatile("s_waitcnt vmcnt(%0)" :: "i"(n) : "memory")
#define SLOAD_H(Kp, Vp, k0) do { const bf16* k_ = (Kp) + (size_t)(k0) * LDR; const bf16* v_ = (Vp) + (size_t)(k0) * LDR;                     \
                         S.st_v0 = load8(v_ + (size_t)soff); S.st_v1 = load8(v_ + (size_t)32 * LDR + (size_t)soff);                       \
                         S.st_k0 = load8(k_ + (size_t)soff); S.st_k1 = load8(k_ + (size_t)32 * LDR + (size_t)soff); } while (0)
#define SWRITE_HK(bf) do { *(bf16x8*)(K_lds + (bf) * SHM_K + kws) = S.st_k0; *(bf16x8*)(K_lds + (bf) * SHM_K + kws + 32 * 256) = S.st_k1; } while (0)
#define SWRITE_HV(bf) do { *(bf16x8*)(V_lds + (bf) * SHM_V + vst0) = S.st_v0; *(bf16x8*)(V_lds + (bf) * SHM_V + vst1) = S.st_v1; } while (0)
#define SWRITE_H(bf) do { SWRITE_HV(bf); SWRITE_HK(bf); } while (0)
__device__ __forceinline__ void moba_prime(const BlockRef& cur, char* lds, Seam& S, int tid) {
    const int t0c = MOBA_SPARSE ? 4 * cur.iblk : 0;
    const int wid = __builtin_amdgcn_readfirstlane(tid >> 6), lane = tid & 63, r32 = lane & 31, hi = lane >> 5;
    const int sr = tid >> 4, sc = (tid & 15) * 8, kws = KSWZ(sr, sc * 2); char* K_lds = lds + 2 * SHM_V;
    const unsigned soff = (unsigned)(sr * LDR + sc), qoff = (unsigned)(r32 * LDR + hi * 8);
    { const bf16* qb = cur.Q + (size_t)(wid * QBLK) * LDR;
#pragma unroll
      for (int d0 = 0; d0 < 8; ++d0) S.qr[d0] = load8(qb + (size_t)qoff + d0 * 16); }
    SLOAD_H(cur.K, cur.V, t0c * KVBLK); VMW(); SWRITE_HK(0);
    __syncthreads();
}
__device__ __forceinline__ void moba_block(const BlockRef& cur, const BlockRef& nxt, const Partials& PP, char* lds, Seam& S, int tid) {
    const int wid = __builtin_amdgcn_readfirstlane(tid >> 6), lane = tid & 63, r32 = lane & 31, hi = lane >> 5;
    const int iblk = cur.iblk, t0 = MOBA_SPARSE ? 4 * iblk : 0, NT = MOBA_SPARSE ? 4 : 4 * (iblk + 1), P0 = iblk * QB;
    const int qlo = P0 + wid * QBLK, qm = qlo + r32 - 4 * hi;
    unsigned sel = 0u; char* KMt = lds + OFF_KM;
    if (!MOBA_SPARSE && iblk > 0) {
        int t4 = tid; asm volatile("" : "+v"(t4));
        { const f32x4 km = *(const f32x4*)(cur.KM + t4 * 4); const int jrow = t4 >> 5, colB = (t4 & 31) * 8;
          const unsigned h01 = cvtpk(km[0], km[1]), h23 = cvtpk(km[2], km[3]);
          const float r0 = km[0] - __uint_as_float(h01 << 16), r1 = km[1] - __uint_as_float(h01 & 0xffff0000u), r2 = km[2] - __uint_as_float(h23 << 16), r3 = km[3] - __uint_as_float(h23 & 0xffff0000u);
          const unsigned l01 = cvtpk(r0, r1), l23 = cvtpk(r2, r3);
          typedef unsigned u32x2_t __attribute__((ext_vector_type(2)));
          *(u32x2_t*)(KMt + KSWZ(jrow, colB)) = (u32x2_t){h01, h23}; *(u32x2_t*)(KMt + KSWZ(16 + jrow, colB)) = (u32x2_t){l01, l23}; }
        __syncthreads();
        f32x16 pg = f32x16{};
        { const char* kb[4];
#pragma unroll
          for (int dd = 0; dd < 4; ++dd) kb[dd] = KMt + KSWZ(r32, (dd * 16 + hi * 8) * 2);
#pragma unroll
          for (int d0 = 0; d0 < 8; ++d0) pg = __builtin_amdgcn_mfma_f32_32x32x16_bf16(*reinterpret_cast<const bf16x8*>(kb[d0 & 3] + (d0 >> 2) * 128), S.qr[d0], pg, 0, 0, 0); }
        float own[8], oth[8];
#pragma unroll
        for (int r = 0; r < 8; ++r) { own[r] = pg[r] + pg[r + 8]; oth[r] = __shfl_xor(own[r], 32); }
        float v1 = -__builtin_inff(), v2 = v1, v3 = v1; int i1 = -1, i2 = -1, i3 = -1;
#pragma unroll
        for (int j = 0; j < 16; ++j) {
            const int rr = (j & 3) + 4 * (j >> 3); const bool mine = ((j >> 2) & 1) == hi;
            const float a = mine ? own[rr] : oth[rr];
            if (j < iblk) {
                if (a > v1) { v3 = v2; i3 = i2; v2 = v1; i2 = i1; v1 = a; i1 = j; }
                else if (a > v2) { v3 = v2; i3 = i2; v2 = a; i2 = j; }
                else if (a > v3) { v3 = a; i3 = j; } }
        }
        sel = (i1 >= 0 ? 1u << i1 : 0u) | (i2 >= 0 ? 1u << i2 : 0u) | (i3 >= 0 ? 1u << i3 : 0u);
    }
    char* V_lds = lds; char* K_lds = lds + 2 * SHM_V;
    float* ws = (float*)(lds + OFF_WS) + wid * 64; float* li_l = ws, * al_l = ws + 32;
    float m_reg = -1e30f, l_reg = 0; f32x16 o[4] = {};
    const int sr = tid >> 4, sc = (tid & 15) * 8, vst0 = v_st(sr, sc), vst1 = v_st(32 + sr, sc), kws = KSWZ(sr, sc * 2);
    const unsigned soff = (unsigned)(sr * LDR + sc), qoff = (unsigned)(r32 * LDR + hi * 8);
    const int vb0 = (int)(uintptr_t)V_lds + v_rd_base(lane);
    const bf16* Kh = cur.K; const bf16* Vh = cur.V;
#define RESC(a) do { if (__any((a) < 1.f)) { if (hi == 0) al_l[r32] = (a); asm volatile("s_waitcnt lgkmcnt(0)" ::: "memory");              \
                     for (int d_ = 0; d_ < 4; ++d_) for (int r = 0; r < 16; ++r) o[d_][r] *= al_l[crow(r, hi)]; } } while (0)
#define KBASE(t) ((t0 + (t)) * KVBLK)
#define MASKT(P0_, P1_, t, KEEP_) do { const int kb_ = KBASE(t); const int bj_ = (t0 + (t)) >> 2; KEEP_ = true; \
        if (bj_ == iblk) { if (kb_ + KVBLK - 1 > qlo) mask_causal(P0_, P1_, qm - kb_); } else KEEP_ = ((sel >> bj_) & 1u) != 0u; } while (0)
    constexpr int NQL = 8;
#define SEAM_K0() do { VMWN(NQL); SWRITE_HK(0); SBAR(); } while (0)
    f32x16 pA0, pA1, pB0, pB1; float mnA, mnB, alA, alB; bf16x8 pa0, pa1, pa2, pa3;
    SWRITE_HV(0); SBAR();
    if (NT > 1) SLOAD_H(Kh, Vh, KBASE(1));
    SBAR(); qkt<0>(pA0, pA1, K_lds, r32, hi, S.qr);
    { bool kp_; MASKT(pA0, pA1, 0, kp_); partialSM(pA0, pA1, m_reg, mnA, alA, kp_); }
    if (NT > 1) { VMW(); SWRITE_H(1); }
    __syncthreads();
#define HALF_STEP(PX0, PX1, mnX, alX, PY0, PY1, alY, t, KB, VB, SB) do {                                                      \
        SBAR(); qkt<KB>(PX0, PX1, K_lds, r32, hi, S.qr);                                                                      \
        finishSM(PY0, PY1, alY, l_reg, pa0, pa1, pa2, pa3); SBAR();                                                           \
        if ((t) + 1 < NT) { SLOAD_H(Kh, Vh, KBASE((t) + 1)); SBAR(); }                                                        \
        pv_tile<VB>(o, vb0, pa0, pa1, pa2, pa3); { bool kp_; MASKT(PX0, PX1, (t), kp_); partialSM(PX0, PX1, m_reg, mnX, alX, kp_); } \
        __syncthreads();                                                                                                      \
        if ((t) + 1 < NT) { VMW(); SWRITE_H(SB); }                                                                            \
        RESC(alX); __syncthreads(); } while (0)
    for (int t = 1; t + 1 < NT; t += 2) {
        HALF_STEP(pB0, pB1, mnB, alB, pA0, pA1, alA, t, 1, 0, 0);
        HALF_STEP(pA0, pA1, mnA, alA, pB0, pB1, alB, t + 1, 0, 1, 1);
    }
    SBAR(); qkt<1>(pB0, pB1, K_lds, r32, hi, S.qr); SBAR();
    SLOAD_H(nxt.K, nxt.V, (MOBA_SPARSE ? 4 * nxt.iblk : 0) * KVBLK); SBAR();
    { const bf16* qb = nxt.Q + (size_t)(wid * QBLK) * LDR;
#pragma unroll
      for (int d0 = 0; d0 < 8; ++d0) S.qr[d0] = load8(qb + (size_t)qoff + d0 * 16); }
    SBAR();
    finishSM(pA0, pA1, alA, l_reg, pa0, pa1, pa2, pa3); SBAR();
    pv_tile<0>(o, vb0, pa0, pa1, pa2, pa3);
    { bool kp_; MASKT(pB0, pB1, NT - 1, kp_); partialSM(pB0, pB1, m_reg, mnB, alB, kp_); } __syncthreads(); RESC(alB);
    finishSM(pB0, pB1, alB, l_reg, pa0, pa1, pa2, pa3); SBAR(); pv_tile<1>(o, vb0, pa0, pa1, pa2, pa3);
    SBAR(); SEAM_K0();
    int hi_e = hi; asm volatile("" : "+v"(hi_e));
    const int ldo = cur.ldo; bf16* Ow = cur.O + (size_t)(wid * QBLK) * ldo;
    const unsigned ooff = (unsigned)(4 * hi_e * ldo + r32);
    if (!MOBA_SPARSE) {
        if (hi == 0) li_l[r32] = l_reg; asm volatile("s_waitcnt lgkmcnt(0)" ::: "memory");
        float rli[16];
#pragma unroll
        for (int r = 0; r < 16; ++r) rli[r] = __builtin_amdgcn_rcpf(li_l[crow(r, hi_e)]);
#pragma unroll
        for (int r = 0; r < 16; ++r) { bf16* orow = Ow + (size_t)((r & 3) + 8 * (r >> 2)) * ldo;
#pragma unroll
            for (int d0 = 0; d0 < 4; ++d0) { const float v = o[d0][r] * rli[r];
                const float vn = __shfl_xor(v, 1);
                if ((r32 & 1) == 0 && cur.store) *(unsigned*)(orow + (size_t)ooff + d0 * 32) = cvtpk(v, vn); } }
    } else {
        const int np = iblk < 3 ? iblk : 3; constexpr float L2E = 1.4426950408889634f;
        float* mt = (float*)(lds + OFF_KM) + wid * 128;
        const size_t rowg = (size_t)cur.bh * SEQ + (size_t)iblk * QB + wid * QBLK;
        float ms[3], ls[3];
#pragma unroll
        for (int sidx = 0; sidx < 3; ++sidx) { ms[sidx] = -1e30f; ls[sidx] = 0.f;
            if (sidx < np) { const f32x2 v = *(const f32x2*)(PP.ML + ((size_t)sidx * BATCH * NH * SEQ + rowg + r32) * 2); ms[sidx] = v[0]; ls[sidx] = v[1]; } }
        const float M = fmaxf(fmaxf(m_reg, ms[0]), fmaxf(ms[1], ms[2]));
        const float e0 = __builtin_amdgcn_exp2f((m_reg - M) * L2E), e1 = ls[0] * __builtin_amdgcn_exp2f((ms[0] - M) * L2E), e2 = ls[1] * __builtin_amdgcn_exp2f((ms[1] - M) * L2E), e3 = ls[2] * __builtin_amdgcn_exp2f((ms[2] - M) * L2E);
        const float iw = __builtin_amdgcn_rcpf(l_reg * e0 + (e1 + e2 + e3));
        if (hi == 0) *(f32x4*)(mt + 4 * r32) = (f32x4){e0 * iw, e1 * iw, e2 * iw, e3 * iw};
        asm volatile("s_waitcnt lgkmcnt(0)" ::: "memory");
#pragma unroll
        for (int r = 0; r < 16; ++r) { const float w0 = mt[4 * ((r & 3) + 8 * (r >> 2) + 4 * hi_e)];
#pragma unroll
            for (int d0 = 0; d0 < 4; ++d0) o[d0][r] *= w0; }
        const unsigned lofs0 = (unsigned)(4 * hi_e * 128 + r32);
#pragma unroll
        for (int sidx = 0; sidx < 3; ++sidx) {
            if (sidx < np) {
                const bf16* pbase = PP.P[sidx] + rowg * 128; bf16 pv[16][4];
#pragma unroll
                for (int r = 0; r < 16; ++r)
#pragma unroll
                    for (int d0 = 0; d0 < 4; ++d0) pv[r][d0] = pbase[(size_t)((r & 3) + 8 * (r >> 2)) * 128 + lofs0 + d0 * 32];
#pragma unroll
                for (int r = 0; r < 16; ++r) { const float wsl = mt[4 * ((r & 3) + 8 * (r >> 2) + 4 * hi_e) + 1 + sidx];
#pragma unroll
                    for (int d0 = 0; d0 < 4; ++d0) o[d0][r] += wsl * bf2f(pv[r][d0]); }
            }
        }
#pragma unroll
        for (int r = 0; r < 16; ++r) { bf16* orow = Ow + (size_t)((r & 3) + 8 * (r >> 2)) * ldo;
#pragma unroll
            for (int d0 = 0; d0 < 4; ++d0) { const float v = o[d0][r]; const float vn = __shfl_xor(v, 1);
                if ((r32 & 1) == 0 && cur.store) *(unsigned*)(orow + (size_t)ooff + d0 * 32) = cvtpk(v, vn); } }
    }
    __syncthreads();
#undef RESC
#undef KBASE
#undef MASKT
#undef SEAM_K0
#undef HALF_STEP
}

__device__ __forceinline__ void sel_phase(const bf16* qkv, const float* kmean, unsigned short* LIST, unsigned* CNT, char* lds, int tid) {
    const int wid = __builtin_amdgcn_readfirstlane(tid >> 6), lane = tid & 63, r32 = lane & 31, hi = lane >> 5;
    float* KMs = (float*)(lds + OFF_KM); unsigned* cw = (unsigned*)(lds + OFF_WS);
    for (int u = blockIdx.x; u < BATCH * NH * 15; u += gridDim.x) {
        const int bh = u / 15, i = 1 + u % 15, b = bh >> 3, h = bh & 7;
        __syncthreads();
        *(f32x4*)(KMs + tid * 4) = *(const f32x4*)(kmean + (size_t)bh * 2048 + tid * 4);
        bf16x8 qr[8];
        { const bf16* qb = qkv + ((size_t)b * SEQ + (size_t)i * QB + wid * QBLK + r32) * LDR + h * 128 + hi * 8;
#pragma unroll
          for (int d0 = 0; d0 < 8; ++d0) qr[d0] = load8(qb + d0 * 16); }
        __syncthreads();
        float v1 = -__builtin_inff(), v2 = v1, v3 = v1; int i1 = -1, i2 = -1, i3 = -1;
        for (int j = 0; j < i; ++j) {
            const float* km = KMs + j * 128 + 8 * hi; float a = 0.f;
#pragma unroll
            for (int d0 = 0; d0 < 8; ++d0) { const f32x4 k0 = *(const f32x4*)(km + 16 * d0), k1 = *(const f32x4*)(km + 16 * d0 + 4); const bf16x8 q = qr[d0];
#pragma unroll
                for (int e = 0; e < 4; ++e) { a = fmaf(__uint_as_float((unsigned)(unsigned short)q[e] << 16), k0[e], a); a = fmaf(__uint_as_float((unsigned)(unsigned short)q[e + 4] << 16), k1[e], a); } }
            a += __shfl_xor(a, 32);
            if (a > v1) { v3 = v2; i3 = i2; v2 = v1; i2 = i1; v1 = a; i1 = j; }
            else if (a > v2) { v3 = v2; i3 = i2; v2 = a; i2 = j; }
            else if (a > v3) { v3 = a; i3 = j; }
        }
        const unsigned sel = (i1 >= 0 ? 1u << i1 : 0u) | (i2 >= 0 ? 1u << i2 : 0u) | (i3 >= 0 ? 1u << i3 : 0u);
        for (int j = 0; j < i; ++j) {
            const unsigned long long bal = __ballot(((sel >> j) & 1u) != 0u && hi == 0);
            if (lane == 0) cw[j * 8 + wid] = (unsigned)__popcll(bal); }
        __syncthreads();
        for (int j = 0; j < i; ++j) {
            const bool on = ((sel >> j) & 1u) != 0u && hi == 0;
            const unsigned long long bal = __ballot(on);
            unsigned off = 0, tot = 0;
#pragma unroll
            for (int w = 0; w < 8; ++w) { const unsigned c = cw[j * 8 + w]; off += w < wid ? c : 0u; tot += c; }
            if (on) { const unsigned rank = (unsigned)__popcll(bal & ((1ull << lane) - 1ull)), slot = (unsigned)__popc(sel & ((1u << j) - 1u));
                LIST[((size_t)(bh * 16 + i) * 16 + j) * 256 + off + rank] = (unsigned short)((wid * 32 + r32) | (slot << 8)); }
            if (tid == 0) CNT[(bh * 16 + i) * 16 + j] = tot;
        }
    }
}
__device__ __forceinline__ void past_phase(const bf16* qkv, const unsigned short* LIST, const unsigned* CNT, const Partials& PP, unsigned* head, char* lds, int tid) {
    const int wid = __builtin_amdgcn_readfirstlane(tid >> 6), lane = tid & 63, r32 = lane & 31, hi = lane >> 5;
    char* V_lds = lds; char* K_lds = lds + 4 * SHM_V;
    constexpr int OFF_X = 8 * SHM_V;
    float* ws = (float*)(lds + OFF_X) + wid * 96; float* al_l = ws; unsigned* rt = (unsigned*)(ws + 32);
    float* li_l = ws + 64;
    unsigned* gt = (unsigned*)(lds + OFF_X + 8 * 96 * 4);
    const int sr = tid >> 4, sc = (tid & 15) * 8, vst0 = v_st(sr, sc), vst1 = v_st(32 + sr, sc), kws = KSWZ(sr, sc * 2);
    const unsigned soff = (unsigned)(sr * LDR + sc);
    const int vb0 = (int)(uintptr_t)V_lds + v_rd_base(lane);
    for (;;) {
        __syncthreads();
        if (tid == 0) gt[32] = __hip_atomic_fetch_add(head, 1u, __ATOMIC_RELAXED, __HIP_MEMORY_SCOPE_AGENT);
        __syncthreads();
        const int item = (int)gt[32]; if (item >= BATCH * NH * 15) break;
        const int j = item >> 6, bh = item & 63, b = bh >> 3, h = bh & 7;
        { const bf16* kp = qkv + ((size_t)b * SEQ + (size_t)j * QB) * LDR + 1024 + h * 128; const bf16* vp = kp + 1024;
          bf16x8 kk[4][2], vv[4][2];
#pragma unroll
          for (int t = 0; t < 4; ++t) { kk[t][0] = load8(kp + (size_t)(64 * t) * LDR + soff); kk[t][1] = load8(kp + (size_t)(64 * t + 32) * LDR + soff);
                                        vv[t][0] = load8(vp + (size_t)(64 * t) * LDR + soff); vv[t][1] = load8(vp + (size_t)(64 * t + 32) * LDR + soff); }
          if (tid < 16) { const unsigned c = tid > j ? CNT[(bh * 16 + tid) * 16 + j] : 0u; gt[16 + tid] = c; gt[tid] = (c + 31u) >> 5; }
#pragma unroll
          for (int t = 0; t < 4; ++t) { *(bf16x8*)(K_lds + t * SHM_K + kws) = kk[t][0]; *(bf16x8*)(K_lds + t * SHM_K + kws + 32 * 256) = kk[t][1];
                                        *(bf16x8*)(V_lds + t * SHM_V + vst0) = vv[t][0]; *(bf16x8*)(V_lds + t * SHM_V + vst1) = vv[t][1]; } }
        __syncthreads();
        int gtot = 0;
        for (int i = j + 1; i < 16; ++i) gtot += (int)gt[i];
        for (int g = wid; g < gtot; g += 8) {
            int i = j + 1, gl = g;
            while (gl >= (int)gt[i]) { gl -= (int)gt[i]; ++i; }
            const int cnt = (int)gt[16 + i], e = gl * 32 + r32; const bool valid = e < cnt;
            const unsigned ent = LIST[((size_t)(bh * 16 + i) * 16 + j) * 256 + (valid ? e : 0)];
            const int rowl = (int)(ent & 255u);
            if (hi == 0) rt[r32] = ent | (valid ? 0x10000u : 0u);
            bf16x8 qr[8];
            { const bf16* qb = qkv + ((size_t)b * SEQ + (size_t)i * QB + rowl) * LDR + h * 128 + hi * 8;
#pragma unroll
              for (int d0 = 0; d0 < 8; ++d0) qr[d0] = load8(qb + d0 * 16); }
            float m_reg = -1e30f, l_reg = 0.f; f32x16 o[4] = {};
            f32x16 pA0, pA1, pB0, pB1; float mnA, mnB, alA, alB; bf16x8 pa0, pa1, pa2, pa3;
#define RESC2(a) do { if (__any((a) < 1.f)) { if (hi == 0) al_l[r32] = (a); asm volatile("s_waitcnt lgkmcnt(0)" ::: "memory");              \
                     for (int d_ = 0; d_ < 4; ++d_) for (int r = 0; r < 16; ++r) o[d_][r] *= al_l[crow(r, hi)]; } } while (0)
            SBAR(); qkt<0>(pA0, pA1, K_lds, r32, hi, qr); partialSM(pA0, pA1, m_reg, mnA, alA);
            SBAR(); qkt<1>(pB0, pB1, K_lds, r32, hi, qr); finishSM(pA0, pA1, alA, l_reg, pa0, pa1, pa2, pa3); SBAR(); pv_tile<0>(o, vb0, pa0, pa1, pa2, pa3); partialSM(pB0, pB1, m_reg, mnB, alB); RESC2(alB);
            SBAR(); qkt<2>(pA0, pA1, K_lds, r32, hi, qr); finishSM(pB0, pB1, alB, l_reg, pa0, pa1, pa2, pa3); SBAR(); pv_tile<1>(o, vb0, pa0, pa1, pa2, pa3); partialSM(pA0, pA1, m_reg, mnA, alA); RESC2(alA);
            SBAR(); qkt<3>(pB0, pB1, K_lds, r32, hi, qr); finishSM(pA0, pA1, alA, l_reg, pa0, pa1, pa2, pa3); SBAR(); pv_tile<2>(o, vb0, pa0, pa1, pa2, pa3); partialSM(pB0, pB1, m_reg, mnB, alB); RESC2(alB);
            SBAR(); finishSM(pB0, pB1, alB, l_reg, pa0, pa1, pa2, pa3); SBAR(); pv_tile<3>(o, vb0, pa0, pa1, pa2, pa3);
#undef RESC2
            const size_t rowb = (size_t)bh * SEQ + (size_t)i * QB;
            if (hi == 0) { li_l[r32] = __builtin_amdgcn_rcpf(l_reg);
                if (valid) *(f32x2*)(PP.ML + ((size_t)(ent >> 8) * BATCH * NH * SEQ + rowb + rowl) * 2) = (f32x2){m_reg, l_reg}; }
            asm volatile("s_waitcnt lgkmcnt(0)" ::: "memory");
#pragma unroll
            for (int r = 0; r < 16; ++r) { const int rr = crow(r, hi); const unsigned en = rt[rr]; const float il = li_l[rr];
                bf16* pb = ((en >> 8) & 3u) == 0u ? PP.P[0] : ((en >> 8) & 3u) == 1u ? PP.P[1] : PP.P[2];
                bf16* prow = pb + (rowb + (en & 255u)) * 128 + r32;
#pragma unroll
                for (int d0 = 0; d0 < 4; ++d0) { const float v = o[d0][r] * il; const float vn = __shfl_xor(v, 1);
                    if ((r32 & 1) == 0 && (en & 0x10000u)) *(unsigned*)(prow + d0 * 32) = cvtpk(v, vn); } }
        }
    }
}
#ifndef MOBA_PP
#define MOBA_PP 0
#endif
constexpr int PP_OFF_WS = 4 * SHM_V + 4 * SHM_K, PP_OFF_KM = 139264 + 64, PP_LDS_BYTES = PP_OFF_KM + 15 * 128 * 4;
static_assert(PP_OFF_WS + NW * 64 * 4 <= 139264 && PP_LDS_BYTES <= 147456, "LDS map");
#define PPBAR() do { asm volatile("s_waitcnt lgkmcnt(0)" ::: "memory"); __builtin_amdgcn_s_barrier(); asm volatile("" ::: "memory"); } while (0)
__device__ __forceinline__ void moba_block_pp(const BlockRef& cur, char* lds, int tid_) {
    int tid = tid_; asm volatile("" : "+v"(tid));
    const int wid = __builtin_amdgcn_readfirstlane(tid >> 6), lane = tid & 63, r32 = lane & 31, hi = lane >> 5, half = wid >> 2;
    const int iblk = cur.iblk, NT = 4 * (iblk + 1), P0 = iblk * QB;
    const int qlo = P0 + wid * QBLK, qm = qlo + r32 - 4 * hi;
    char* V_lds = lds; char* K_lds = lds + 4 * SHM_V;
    float* KMs = (float*)(lds + PP_OFF_KM);
    float* ws = (float*)(lds + PP_OFF_WS) + wid * 64; float* li_l = ws, * al_l = ws + 32;
    const int sr = tid >> 4, sc = (tid & 15) * 8, vst0 = v_st(sr, sc), vst1 = v_st(32 + sr, sc), kws = KSWZ(sr, sc * 2);
    const unsigned soff = (unsigned)(sr * LDR + sc), qoff = (unsigned)(r32 * LDR + hi * 8);
    const int vb0 = (int)(uintptr_t)V_lds + v_rd_base(lane);
    const bf16* Kh = cur.K; const bf16* Vh = cur.V;
    Seam S;
    { const bf16* qb = cur.Q + (size_t)(wid * QBLK) * LDR;
#pragma unroll
      for (int d0 = 0; d0 < 8; ++d0) S.qr[d0] = load8(qb + (size_t)qoff + d0 * 16); }
    { int t4 = tid; asm volatile("" : "+v"(t4));
      const f32x4 kmv = *(const f32x4*)(cur.KM + t4 * 4);
      SLOAD_H(Kh, Vh, 0); VMW();
      if (t4 < 15 * 32) *(f32x4*)(KMs + t4 * 4) = kmv; SWRITE_H(0); }
    SLOAD_H(Kh, Vh, KVBLK);
    __syncthreads();
    unsigned sel = 0u;
    if (iblk > 0) {
        float v1 = -__builtin_inff(), v2 = v1, v3 = v1; int i1 = -1, i2 = -1, i3 = -1;
        for (int j = 0; j < iblk; ++j) {
            const float* km = KMs + j * 128 + 8 * hi; float a = 0.f;
#pragma unroll
            for (int d0 = 0; d0 < 8; ++d0) { const f32x4 k0 = *(const f32x4*)(km + 16 * d0), k1 = *(const f32x4*)(km + 16 * d0 + 4); const bf16x8 q = S.qr[d0];
#pragma unroll
                for (int e = 0; e < 4; ++e) { a = fmaf(__uint_as_float((unsigned)(unsigned short)q[e] << 16), k0[e], a); a = fmaf(__uint_as_float((unsigned)(unsigned short)q[e + 4] << 16), k1[e], a); } }
            a += __shfl_xor(a, 32);
            if (a > v1) { v3 = v2; i3 = i2; v2 = v1; i2 = i1; v1 = a; i1 = j; }
            else if (a > v2) { v3 = v2; i3 = i2; v2 = a; i2 = j; }
            else if (a > v3) { v3 = a; i3 = j; }
        }
        sel = (i1 >= 0 ? 1u << i1 : 0u) | (i2 >= 0 ? 1u << i2 : 0u) | (i3 >= 0 ? 1u << i3 : 0u);
    }
    VMW(); SWRITE_H(1); SLOAD_H(Kh, Vh, 2 * KVBLK);
    __syncthreads();
    float m_reg = -1e30f, l_reg = 0; f32x16 o[4] = {};
    f32x16 pA0, pA1, pB0 = {}, pB1 = {}; float mnA, mnB, alA = 1.f, alB = 1.f; bf16x8 pa0, pa1, pa2, pa3;
#define RESC(a) do { if (__any((a) < 1.f)) { if (hi == 0) al_l[r32] = (a); asm volatile("s_waitcnt lgkmcnt(0)" ::: "memory");              \
                     for (int d_ = 0; d_ < 4; ++d_) for (int r = 0; r < 16; ++r) o[d_][r] *= al_l[crow(r, hi)]; } } while (0)
#define MASKT(P0_, P1_, t) do { const int kb_ = (t) * KVBLK; const int bj_ = (t) >> 2; \
        if (bj_ == iblk) { if (kb_ + KVBLK - 1 > qlo) mask_causal(P0_, P1_, qm - kb_); } else mask_all(P0_, P1_, ((sel >> bj_) & 1u) != 0u); } while (0)
#define PP_STEP(t, SL, PX0, PX1, mnX, alX, PY0, PY1, alY, HASPREV) do {                                                              \
        __builtin_amdgcn_s_setprio(1); qkt<SL>(PX0, PX1, K_lds, r32, hi, S.qr); __builtin_amdgcn_s_setprio(0); PPBAR();                 \
        if (HASPREV) finishSM(PY0, PY1, alY, l_reg, pa0, pa1, pa2, pa3); PPBAR();                                                       \
        if (HASPREV) { __builtin_amdgcn_s_setprio(1); pv_tile<((SL) + 3) & 3>(o, vb0, pa0, pa1, pa2, pa3); __builtin_amdgcn_s_setprio(0); } PPBAR(); \
        MASKT(PX0, PX1, (t)); partialSM(PX0, PX1, m_reg, mnX, alX); RESC(alX);                                                          \
        if ((t) + 2 < NT) { VMW(); SWRITE_H(((SL) + 2) & 3); if ((t) + 3 < NT) SLOAD_H(Kh, Vh, ((t) + 3) * KVBLK); }                    \
        PPBAR(); } while (0)
    if (half == 1) PPBAR();
    for (int t = 0; t < NT; t += 4) {
        PP_STEP(t,     0, pA0, pA1, mnA, alA, pB0, pB1, alB, t > 0);
        PP_STEP(t + 1, 1, pB0, pB1, mnB, alB, pA0, pA1, alA, true);
        PP_STEP(t + 2, 2, pA0, pA1, mnA, alA, pB0, pB1, alB, true);
        PP_STEP(t + 3, 3, pB0, pB1, mnB, alB, pA0, pA1, alA, true);
    }
    if (half == 0) PPBAR();
    finishSM(pB0, pB1, alB, l_reg, pa0, pa1, pa2, pa3); SBAR(); pv_tile<3>(o, vb0, pa0, pa1, pa2, pa3);
    { int hi_e = hi; asm volatile("" : "+v"(hi_e));
      const int ldo = cur.ldo; bf16* Ow = cur.O + (size_t)(wid * QBLK) * ldo;
      const unsigned ooff = (unsigned)(4 * hi_e * ldo + r32);
      if (hi == 0) li_l[r32] = l_reg; asm volatile("s_waitcnt lgkmcnt(0)" ::: "memory");
      float rli[16];
#pragma unroll
      for (int r = 0; r < 16; ++r) rli[r] = __builtin_amdgcn_rcpf(li_l[crow(r, hi_e)]);
#pragma unroll
      for (int r = 0; r < 16; ++r) { bf16* orow = Ow + (size_t)((r & 3) + 8 * (r >> 2)) * ldo;
#pragma unroll
          for (int d0 = 0; d0 < 4; ++d0) { const float v = o[d0][r] * rli[r];
              const float vn = __shfl_xor(v, 1);
              if ((r32 & 1) == 0 && cur.store) *(unsigned*)(orow + (size_t)ooff + d0 * 32) = cvtpk(v, vn); } } }
    __syncthreads();
#undef PP_STEP
#undef MASKT
#undef RESC
}
#undef ROW
#undef VMW
#undef VMWN
#undef SLOAD_H
#undef SWRITE_HK
#undef SWRITE_HV
#undef SWRITE_H
#undef KSWZ
#undef SBAR

__device__ __forceinline__ void item_decode(int L, int G, int k, int bx, int& bh, int& x) {
    if (G == 256) { const int xcd = bx & 7, q = bx >> 3; bh = ((k * 8 + xcd) << 2) + (q >> 3); x = q & 7; }
    else { bh = L >> 3; x = L & 7; }
}
__device__ __forceinline__ BlockRef make_ref(bf16* qkv, const float* kmean, bf16* ob, int ldo, int bh, int iblk) {
    const int b = bh >> 3, h = bh & 7; BlockRef r; bf16* base = qkv + (size_t)bh * 3 * ARR;
    r.Q = base + (size_t)iblk * QB * LDR; r.O = ob + ((size_t)b * SEQ + (size_t)iblk * QB) * ldo + h * 128; r.K = base + ARR; r.V = base + 2 * ARR; r.KM = kmean + (size_t)bh * 16 * 128; r.iblk = iblk; r.ldo = ldo; r.store = 1; r.bh = bh; return r;
}
__device__ __forceinline__ void attn_phase(bf16* qkv, const float* kmean, bf16* ob, int ldo, const Partials& PP, char* lds, int tid) {
    const int G = gridDim.x, bx = blockIdx.x, real = BATCH * NH * 8, total = (PROBE_DUP & 16) ? 2 * real : real;
    int L = bx, k = 0; if (L >= total) return;
    int bh, x; item_decode(L % real, G, k & 1, bx, bh, x); int pass = 0;
    BlockRef cur = make_ref(qkv, kmean, ob, ldo, bh, x); cur.store = ((PROBE_DUP & 16) == 0) || L >= real;
    Seam S;
    moba_prime(cur, lds, S, tid);
    for (;;) {
        const bool more_pass = pass == 0, more_item = L + G < total, last = !more_pass && !more_item;
        int bhn = bh, xn = x, passn = pass + 1, Ln = L, kn = k;
        if (!more_pass) { passn = 0; if (more_item) { Ln = L + G; kn = k + 1; } item_decode(Ln % real, G, kn & 1, bx, bhn, xn); }
        BlockRef nxt = last ? cur : make_ref(qkv, kmean, ob, ldo, bhn, passn ? 15 - xn : xn); nxt.store = ((PROBE_DUP & 16) == 0) || Ln >= real;
        moba_block(cur, nxt, PP, lds, S, tid);
        if (last) break;
        cur = nxt; bh = bhn; x = xn; pass = passn; L = Ln; k = kn;
    }
}
__device__ __forceinline__ void attn_phase_pp(bf16* qkv, const float* kmean, bf16* ob, int ldo, char* lds, int tid) {
    const int G = gridDim.x, bx = blockIdx.x, real = BATCH * NH * 8, total = (PROBE_DUP & 16) ? 2 * real : real;
    int k = 0;
    for (int L = bx; L < total; L += G, ++k) {
        int bh, x; item_decode(L % real, G, k & 1, bx, bh, x);
#pragma unroll 1
        for (int pass = 0; pass < 2; ++pass) {
            BlockRef cur = make_ref(qkv, kmean, ob, ldo, bh, pass ? 15 - x : x); cur.store = ((PROBE_DUP & 16) == 0) || L >= real;
            moba_block_pp(cur, lds, tid);
        }
    }
}
}
namespace hg {
typedef short bf16x8 __attribute__((ext_vector_type(8)));
typedef short s16x4 __attribute__((ext_vector_type(4)));
typedef float f32x16 __attribute__((ext_vector_type(16)));
constexpr int LDB = 4096, CH = 64, NCH_SEG = 16, NSEG = 4;
constexpr int RS = 272, TS = 144, OST_RS = 528;
constexpr int OFF_QR = 0, OFF_KR = 17408, OFF_QI = 34816, OFF_KT = 52224, OFF_VT = 70656, OFF_DEC = 89088, OFF_OST = 89600, HG_LDS_BYTES = OFF_OST + 64 * OST_RS;
static_assert(HG_LDS_BYTES <= 131072, "HGRN LDS map");
__device__ __forceinline__ unsigned pk(float lo, float hi) { unsigned r; asm volatile("v_cvt_pk_bf16_f32 %0, %1, %2" : "=v"(r) : "v"(lo), "v"(hi)); return r; }
__device__ __forceinline__ bf16x8 join8(s16x4 a, s16x4 b) { return (bf16x8){a[0], a[1], a[2], a[3], b[0], b[1], b[2], b[3]}; }
__device__ __forceinline__ bf16x8 acc_frag(const f32x16& x, int s) {
    u32x4 w; w.x = pk(x[8 * s + 0], x[8 * s + 1]); w.y = pk(x[8 * s + 2], x[8 * s + 3]); w.z = pk(x[8 * s + 4], x[8 * s + 5]); w.w = pk(x[8 * s + 6], x[8 * s + 7]);
    return __builtin_bit_cast(bf16x8, w);
}
template <bool FULL> struct Raw { bf16 z[16], v[16], q[FULL ? 16 : 1]; };
struct Scan { float kk[16], G[16]; };
constexpr int OFF_TQ = 131072;
template <bool FULL>
__device__ __forceinline__ void load_z(Raw<FULL>& R, const bf16* __restrict__ base, int lane, int wave) {
    const bf16* p = base + (size_t)(16 * (wave >> 1)) * LDB + 64 * (wave & 1) + lane + 1024;
#pragma unroll
    for (int i = 0; i < 16; ++i) R.z[i] = p[(size_t)i * LDB];
}
template <bool FULL>
__device__ __forceinline__ void load_qv(Raw<FULL>& R, const bf16* __restrict__ base, int lane, int wave) {
    const bf16* p = base + (size_t)(16 * (wave >> 1)) * LDB + 64 * (wave & 1) + lane;
#pragma unroll
    for (int i = 0; i < 16; ++i) { R.v[i] = p[(size_t)i * LDB + 2048]; if (FULL) R.q[i] = p[(size_t)i * LDB]; }
}
template <bool FULL>
__device__ __forceinline__ void build_scan(Scan& C, const Raw<FULL>& R, float lb, LAS unsigned char* lds, int lane, int wave) {
    const int c = 64 * (wave & 1) + lane, qq = wave >> 1;
    float run = 0.f; const float omlb = 1.0f - lb;
#pragma unroll
    for (int i = 0; i < 16; ++i) { const float e = __expf(-bf2f(R.z[i])); const float sg = __builtin_amdgcn_rcpf(1.0f + e); C.kk[i] = omlb * (e * sg); run += __logf(lb + omlb * sg); C.G[i] = run; }
    *(LAS float*)(lds + OFF_TQ + 4 * (qq * 128 + c)) = run;
}
template <bool FULL>
__device__ __forceinline__ float build_ops(const Scan& C, const Raw<FULL>& R, LAS unsigned char* lds, int lane, int wave) {
    const int c = 64 * (wave & 1) + lane, qq = wave >> 1;
    const float T0 = *(const LAS float*)(lds + OFF_TQ + 4 * c), T1 = *(const LAS float*)(lds + OFF_TQ + 4 * (128 + c)), T2 = *(const LAS float*)(lds + OFF_TQ + 4 * (256 + c)), T3 = *(const LAS float*)(lds + OFF_TQ + 4 * (384 + c));
    const float gmid = T0 + T1, glast = gmid + (T2 + T3);
    const float off = qq == 0 ? 0.f : qq == 1 ? T0 : qq == 2 ? gmid : gmid + T2;
    const float Egm = __expf(gmid), Elm = __expf(glast - gmid);
    unsigned ktw[8], vtw[8];
#pragma unroll
    for (int i = 0; i < 16; i += 2) {
        float ks[2];
#pragma unroll
        for (int e = 0; e < 2; ++e) { const int t = 16 * qq + i + e; const float E1 = __expf(C.G[i + e] + off - gmid), R1 = __builtin_amdgcn_rcpf(E1);
            ks[e] = C.kk[i + e] * R1 * Elm;
            if (FULL) { const float qe = bf2f(R.q[FULL ? i + e : 0]) * QSCALE * E1;
                *(LAS bf16*)(lds + OFF_QR + t * RS + 2 * c) = (bf16)(pk(qe, 0.f) & 0xffffu);
                *(LAS bf16*)(lds + OFF_KR + t * RS + 2 * c) = (bf16)(pk(C.kk[i + e] * R1, 0.f) & 0xffffu);
                *(LAS bf16*)(lds + OFF_QI + t * RS + 2 * c) = (bf16)(pk(qe * Egm, 0.f) & 0xffffu); } }
        ktw[i >> 1] = pk(ks[0], ks[1]); vtw[i >> 1] = (unsigned)R.v[i] | ((unsigned)R.v[i + 1] << 16); }
    *(LAS u32x4*)(lds + OFF_KT + c * TS + 32 * qq) = (u32x4){ktw[0], ktw[1], ktw[2], ktw[3]}; *(LAS u32x4*)(lds + OFF_KT + c * TS + 32 * qq + 16) = (u32x4){ktw[4], ktw[5], ktw[6], ktw[7]};
    *(LAS u32x4*)(lds + OFF_VT + c * TS + 32 * qq) = (u32x4){vtw[0], vtw[1], vtw[2], vtw[3]}; *(LAS u32x4*)(lds + OFF_VT + c * TS + 32 * qq + 16) = (u32x4){vtw[4], vtw[5], vtw[6], vtw[7]};
    if (qq == 0) *(LAS float*)(lds + OFF_DEC + 4 * c) = __expf(glast);
    return glast;
}
__device__ __forceinline__ void state_update(f32x16 (&S)[4], LAS unsigned char* lds, int j, int c, int h) {
#pragma unroll
    for (int i = 0; i < 4; ++i) {
#pragma unroll
        for (int g4 = 0; g4 < 4; ++g4) { const f32x4 dc = *(const LAS f32x4*)(lds + OFF_DEC + 4 * (32 * i + 8 * g4 + 4 * h));
#pragma unroll
            for (int e = 0; e < 4; ++e) S[i][4 * g4 + e] *= dc[e]; }
#pragma unroll
        for (int ks = 0; ks < 4; ++ks) {
            const bf16x8 a = *(const LAS bf16x8*)(lds + OFF_KT + (32 * i + c) * TS + (16 * ks + 8 * h) * 2);
            const bf16x8 b = *(const LAS bf16x8*)(lds + OFF_VT + (32 * j + c) * TS + (16 * ks + 8 * h) * 2);
            S[i] = __builtin_amdgcn_mfma_f32_32x32x16_bf16(a, b, S[i], 0, 0, 0); }
    }
}
__device__ __forceinline__ int crow(int r, int h) { return (r & 3) + 8 * (r >> 2) + 4 * h; }

__device__ __forceinline__ void pass_a(const bf16* __restrict__ big, const float* __restrict__ lbv, float* __restrict__ Eg, float* __restrict__ Dg, LAS unsigned char* lds, int lane, int wave) {
    const int j = wave & 3, th = wave >> 2, c = lane & 31, h = lane >> 5;
    for (int u = blockIdx.x; u < BATCH * NH * NSEG; u += gridDim.x) {
        const int seg = u & 3, hh = (u >> 2) & 7, b = u >> 5;
        if (seg == NSEG - 1) continue;
        const int cch = 64 * (wave & 1) + lane;
        const float lb = lbv[hh * 128 + cch];
        f32x16 S[4];
#pragma unroll
        for (int i = 0; i < 4; ++i) S[i] = f32x16{};
        float dsum = 0.f;
        const bf16* base = big + (size_t)(b * SEQ + seg * NCH_SEG * CH) * LDB + hh * 128;
        Raw<false> R; load_z<false>(R, base, lane, wave); load_qv<false>(R, base, lane, wave);
        Scan C; build_scan<false>(C, R, lb, lds, lane, wave);
        load_z<false>(R, base + (size_t)CH * LDB, lane, wave);
        __syncthreads();
        for (int ch = 0; ch < NCH_SEG; ++ch) {
            dsum += build_ops<false>(C, R, lds, lane, wave);
            __syncthreads();
            if (ch + 1 < NCH_SEG) load_qv<false>(R, base + (size_t)(ch + 1) * CH * LDB, lane, wave);
            state_update(S, lds, j, c, h);
            if (ch + 1 < NCH_SEG) { build_scan<false>(C, R, lb, lds, lane, wave); if (ch + 2 < NCH_SEG) load_z<false>(R, base + (size_t)(ch + 2) * CH * LDB, lane, wave); }
            __syncthreads();
        }
        if ((wave >> 1) == 0) Dg[(size_t)u * 128 + cch] = dsum;
        if (th == 0) {
            float* E = Eg + (size_t)u * 16384;
#pragma unroll
            for (int i = 0; i < 4; ++i)
#pragma unroll
                for (int r = 0; r < 16; ++r) E[(size_t)(32 * i + crow(r, h)) * 128 + 32 * j + c] = S[i][r];
        }
    }
}
__device__ __forceinline__ void pass_b(bf16* big, bf16* outp, int ldo, int store, const float* __restrict__ lbv, const float* __restrict__ og, const float* __restrict__ Eg, const float* __restrict__ Dg, LAS unsigned char* lds, int lane, int wave) {
    const int j = wave & 3, th = wave >> 2, c = lane & 31, h = lane >> 5, tid = wave * 64 + lane;
    for (int u = blockIdx.x; u < BATCH * NH * NSEG; u += gridDim.x) {
        const int seg = u & 3, hh = (u >> 2) & 7, b = u >> 5;
        const float lb = lbv[hh * 128 + 64 * (wave & 1) + lane];
        f32x16 S[4];
#pragma unroll
        for (int i = 0; i < 4; ++i) S[i] = f32x16{};
        for (int sp = 0; sp < seg; ++sp) {
            const float* E = Eg + (size_t)(u - seg + sp) * 16384; const float* Dp = Dg + (size_t)(u - seg + sp) * 128;
#pragma unroll
            for (int i = 0; i < 4; ++i)
#pragma unroll
                for (int r = 0; r < 16; ++r) { const int d = 32 * i + crow(r, h); S[i][r] = __expf(Dp[d]) * S[i][r] + E[(size_t)d * 128 + 32 * j + c]; }
        }
        const bf16* base = big + ((size_t)b * SEQ + (size_t)seg * NCH_SEG * CH) * LDB + hh * 128;
        Raw<true> R; load_z<true>(R, base, lane, wave); load_qv<true>(R, base, lane, wave);
        Scan C; build_scan<true>(C, R, lb, lds, lane, wave);
        load_z<true>(R, base + (size_t)CH * LDB, lane, wave);
        __syncthreads();
        const int ot = tid >> 3, opart = tid & 7;
        u32x4 gn0, gn1;
        { const bf16* gp = base + (size_t)ot * LDB + 3072 + opart * 16; gn0 = *(const u32x4*)gp; gn1 = *(const u32x4*)(gp + 8); }
        for (int ch = 0; ch < NCH_SEG; ++ch) {
            const size_t row0 = (size_t)b * SEQ + (size_t)(seg * NCH_SEG + ch) * CH;
            if (store != 3) (void)build_ops<true>(C, R, lds, lane, wave);
            const u32x4 g0 = gn0, g1 = gn1;
            __syncthreads();
            if (ch + 1 < NCH_SEG) { const bf16* nb = base + (size_t)(ch + 1) * CH * LDB; load_qv<true>(R, nb, lane, wave);
                const bf16* gp = nb + (size_t)ot * LDB + 3072 + opart * 16; gn0 = *(const u32x4*)gp; gn1 = *(const u32x4*)(gp + 8); }
            if (store == 2) { __syncthreads(); continue; }
            bf16x8 P[2][2];
#pragma unroll
            for (int sh = 0; sh < 2; ++sh) {
                if (sh <= th) {
                    f32x16 X = f32x16{};
#pragma unroll
                    for (int ks = 0; ks < 8; ++ks) {
                        const bf16x8 a = *(const LAS bf16x8*)(lds + OFF_KR + (32 * sh + c) * RS + (16 * ks + 8 * h) * 2);
                        const bf16x8 bq = *(const LAS bf16x8*)(lds + OFF_QR + (32 * th + c) * RS + (16 * ks + 8 * h) * 2);
                        X = __builtin_amdgcn_mfma_f32_32x32x16_bf16(a, bq, X, 0, 0, 0); }
                    if (sh == th) {
#pragma unroll
                        for (int r = 0; r < 16; ++r) X[r] = crow(r, h) <= c ? X[r] : 0.f; }
                    P[sh][0] = acc_frag(X, 0); P[sh][1] = acc_frag(X, 1);
                } else { P[sh][0] = bf16x8{}; P[sh][1] = bf16x8{}; }
            }
            f32x16 o = f32x16{};
#pragma unroll
            for (int i = 0; i < 4; ++i)
#pragma unroll
                for (int s = 0; s < 2; ++s) {
                    const LAS unsigned char* qa = lds + OFF_QI + (32 * th + c) * RS + (32 * i + 16 * s + 4 * h) * 2;
                    const bf16x8 a = join8(*(const LAS s16x4*)qa, *(const LAS s16x4*)(qa + 16));
                    o = __builtin_amdgcn_mfma_f32_32x32x16_bf16(a, acc_frag(S[i], s), o, 0, 0, 0); }
#pragma unroll
            for (int sh = 0; sh < 2; ++sh) {
                if (sh <= th) {
#pragma unroll
                    for (int s = 0; s < 2; ++s) {
                        const LAS unsigned char* va = lds + OFF_VT + (32 * j + c) * TS + (32 * sh + 16 * s + 4 * h) * 2;
                        const bf16x8 bv = join8(*(const LAS s16x4*)va, *(const LAS s16x4*)(va + 16));
                        o = __builtin_amdgcn_mfma_f32_32x32x16_bf16(P[sh][s], bv, o, 0, 0, 0); } }
            }
            state_update(S, lds, j, c, h);
            if (ch + 1 < NCH_SEG) { build_scan<true>(C, R, lb, lds, lane, wave); if (ch + 2 < NCH_SEG) load_z<true>(R, base + (size_t)(ch + 2) * CH * LDB, lane, wave); }
#pragma unroll
            for (int r = 0; r < 16; ++r) *(LAS float*)(lds + OFF_OST + (32 * th + crow(r, h)) * OST_RS + (32 * j + c) * 4) = o[r];
            __syncthreads();
            {
                const int t = ot, part = opart;
                const LAS f32x4* op = (const LAS f32x4*)(lds + OFF_OST + t * OST_RS + part * 64);
                const f32x4 o0 = op[0], o1 = op[1], o2 = op[2], o3 = op[3];
                float ss = (o0[0] * o0[0] + o0[1] * o0[1]) + (o0[2] * o0[2] + o0[3] * o0[3]) + (o1[0] * o1[0] + o1[1] * o1[1]) + (o1[2] * o1[2] + o1[3] * o1[3])
                         + (o2[0] * o2[0] + o2[1] * o2[1]) + (o2[2] * o2[2] + o2[3] * o2[3]) + (o3[0] * o3[0] + o3[1] * o3[1]) + (o3[2] * o3[2] + o3[3] * o3[3]);
                ss += __shfl_xor(ss, 1); ss += __shfl_xor(ss, 2); ss += __shfl_xor(ss, 4);
                const float rstd = __builtin_amdgcn_rsqf(ss * (1.0f / 128.0f) + 1e-6f);
                bf16* yp = outp + (row0 + t) * ldo + hh * 128 + part * 16;
                const f32x4 w0 = *(const f32x4*)(og + part * 16), w1 = *(const f32x4*)(og + part * 16 + 4), w2 = *(const f32x4*)(og + part * 16 + 8), w3 = *(const f32x4*)(og + part * 16 + 12);
                const unsigned gw[8] = {g0.x, g0.y, g0.z, g0.w, g1.x, g1.y, g1.z, g1.w};
                const float ov[16] = {o0[0], o0[1], o0[2], o0[3], o1[0], o1[1], o1[2], o1[3], o2[0], o2[1], o2[2], o2[3], o3[0], o3[1], o3[2], o3[3]};
                const float wv[16] = {w0[0], w0[1], w0[2], w0[3], w1[0], w1[1], w1[2], w1[3], w2[0], w2[1], w2[2], w2[3], w3[0], w3[1], w3[2], w3[3]};
                unsigned ow[8];
#pragma unroll
                for (int e = 0; e < 8; ++e) { const float ga = __uint_as_float(gw[e] << 16), gb = __uint_as_float(gw[e] & 0xffff0000u);
                    const float ya = ov[2 * e] * rstd * wv[2 * e] * (ga * __builtin_amdgcn_rcpf(1.0f + __expf(-ga)));
                    const float yb = ov[2 * e + 1] * rstd * wv[2 * e + 1] * (gb * __builtin_amdgcn_rcpf(1.0f + __expf(-gb)));
                    ow[e] = pk(ya, yb); }
                if (store == 1) { *(u32x4*)yp = (u32x4){ow[0], ow[1], ow[2], ow[3]}; *(u32x4*)(yp + 8) = (u32x4){ow[4], ow[5], ow[6], ow[7]}; }
            }
        }
        __syncthreads();
    }
}
}
namespace hg2 {
#define HG2_BAR() do { asm volatile("s_waitcnt lgkmcnt(0)" ::: "memory"); __builtin_amdgcn_s_barrier(); asm volatile("" ::: "memory"); } while (0)
typedef short bf16x8 __attribute__((ext_vector_type(8)));
typedef short s16x4 __attribute__((ext_vector_type(4)));
typedef float f32x16 __attribute__((ext_vector_type(16)));
constexpr int LDB = 128, ARR = 4096 * 128, LDG = 1024, CH = 32, NCH_SEG = 32, NSEG = 4;
constexpr int RS = 272, TS = 80, OST_RS = 528;
constexpr int B_QR = 0, B_KR = 8704, B_KT = 17408, B_VT = 27648, B_DEC = 37888, B_EGM = 38400, BUF_BYTES = 38912;
constexpr int OFF_OST = 2 * BUF_BYTES, OST_BYTES = 32 * OST_RS, OFF_SCR = OFF_OST + 2 * OST_BYTES, HG2_LDS_BYTES = OFF_SCR + 4 * 2560;
static_assert(HG2_LDS_BYTES <= 131072, "HGRN LDS map");
__device__ __forceinline__ unsigned pk(float lo, float hi) { unsigned r; asm volatile("v_cvt_pk_bf16_f32 %0, %1, %2" : "=v"(r) : "v"(lo), "v"(hi)); return r; }
__device__ __forceinline__ bf16x8 join8(s16x4 a, s16x4 b) { return (bf16x8){a[0], a[1], a[2], a[3], b[0], b[1], b[2], b[3]}; }
__device__ __forceinline__ int crow(int r, int h) { return (r & 3) + 8 * (r >> 2) + 4 * h; }
__device__ __forceinline__ bf16x8 acc_frag_scaled(const f32x16& x, int s, const f32x4& e0, const f32x4& e1) {
    u32x4 w; w.x = pk(x[8 * s + 0] * e0[0], x[8 * s + 1] * e0[1]); w.y = pk(x[8 * s + 2] * e0[2], x[8 * s + 3] * e0[3]); w.z = pk(x[8 * s + 4] * e1[0], x[8 * s + 5] * e1[1]); w.w = pk(x[8 * s + 6] * e1[2], x[8 * s + 7] * e1[3]);
    return __builtin_bit_cast(bf16x8, w);
}
__device__ __forceinline__ bf16x8 acc_frag(const f32x16& x, int s) {
    u32x4 w; w.x = pk(x[8 * s + 0], x[8 * s + 1]); w.y = pk(x[8 * s + 2], x[8 * s + 3]); w.z = pk(x[8 * s + 4], x[8 * s + 5]); w.w = pk(x[8 * s + 6], x[8 * s + 7]);
    return __builtin_bit_cast(bf16x8, w);
}
template <bool FULL> struct Raw { u32x4 z[2], v[2], q[FULL ? 2 : 1]; };
constexpr int SCR_RS = 80, SCR_BYTES = 32 * SCR_RS;
template <bool FULL>
__device__ __forceinline__ void load_raw(Raw<FULL>& R, const bf16* __restrict__ base, int lane, int bw) {
    const bf16* p = base + (size_t)(lane >> 2) * LDB + 32 * bw + 8 * (lane & 3);
#pragma unroll
    for (int e = 0; e < 2; ++e) { R.z[e] = *(const u32x4*)(p + (size_t)(16 * e) * LDB + ARR); R.v[e] = *(const u32x4*)(p + (size_t)(16 * e) * LDB + 2 * ARR); if (FULL) R.q[e] = *(const u32x4*)(p + (size_t)(16 * e) * LDB); }
}
__device__ __forceinline__ void transpose16(float (&out)[16], const u32x4 (&src)[2], LAS unsigned char* scr, int lane) {
    *(LAS u32x4*)(scr + (lane >> 2) * SCR_RS + 16 * (lane & 3)) = src[0]; *(LAS u32x4*)(scr + ((lane >> 2) + 16) * SCR_RS + 16 * (lane & 3)) = src[1];
    asm volatile("s_waitcnt lgkmcnt(0)" ::: "memory");
#pragma unroll
    for (int i = 0; i < 16; ++i) out[i] = bf2f(*(const LAS bf16*)(scr + (16 * (lane >> 5) + i) * SCR_RS + 2 * (lane & 31)));
    asm volatile("s_waitcnt lgkmcnt(0)" ::: "memory");
}
template <bool FULL>
__device__ __forceinline__ float build_chunk(const Raw<FULL>& R, float lb, LAS unsigned char* buf, LAS unsigned char* scr, int lane, int bw) {
    const int c = 32 * bw + (lane & 31), half = lane >> 5;
    float Pr[16], kk[16]; float run = 1.f; const float omlb = 1.0f - lb;
    { float z[16]; transpose16(z, R.z, scr, lane);
#pragma unroll
      for (int i = 0; i < 16; ++i) { const float e = __expf(-z[i]); const float sg = __builtin_amdgcn_rcpf(1.0f + e); kk[i] = omlb * (e * sg); run *= lb + omlb * sg; Pr[i] = run; } }
    const float oth = __shfl_xor(run, 32);
    const float T0 = half ? oth : run, T1 = half ? run : oth;
    const float sc1 = half ? 1.0f : __builtin_amdgcn_rcpf(T0);
    const float Elm = T1;
    float qv[16];
    if constexpr (FULL) transpose16(qv, R.q, scr, lane);
    float vv[16]; transpose16(vv, R.v, scr, lane);
    unsigned ktw[8], vtw[8];
#pragma unroll
    for (int i = 0; i < 16; i += 2) {
        float ks[2];
#pragma unroll
        for (int e = 0; e < 2; ++e) { const int t = 16 * half + i + e; const float E1 = Pr[i + e] * sc1, R1 = __builtin_amdgcn_rcpf(E1);
            ks[e] = kk[i + e] * R1 * Elm;
            if (FULL) { *(LAS bf16*)(buf + B_QR + t * RS + 2 * c) = (bf16)(pk(qv[FULL ? i + e : 0] * QSCALE * E1, 0.f) & 0xffffu);
                        *(LAS bf16*)(buf + B_KR + t * RS + 2 * c) = (bf16)(pk(kk[i + e] * R1, 0.f) & 0xffffu); } }
        ktw[i >> 1] = pk(ks[0], ks[1]); vtw[i >> 1] = pk(vv[i], vv[i + 1]); }
    *(LAS u32x4*)(buf + B_KT + c * TS + 32 * half) = (u32x4){ktw[0], ktw[1], ktw[2], ktw[3]}; *(LAS u32x4*)(buf + B_KT + c * TS + 32 * half + 16) = (u32x4){ktw[4], ktw[5], ktw[6], ktw[7]};
    *(LAS u32x4*)(buf + B_VT + c * TS + 32 * half) = (u32x4){vtw[0], vtw[1], vtw[2], vtw[3]}; *(LAS u32x4*)(buf + B_VT + c * TS + 32 * half + 16) = (u32x4){vtw[4], vtw[5], vtw[6], vtw[7]};
    if (half == 0) { *(LAS float*)(buf + B_DEC + 4 * c) = T0 * T1; *(LAS float*)(buf + B_EGM + 4 * c) = T0; }
    return FULL ? 0.f : __logf(T0 * T1);
}
__device__ __forceinline__ void state_update(f32x16 (&S)[4], const LAS unsigned char* buf, int j, int c, int h) {
    bf16x8 a[4][2], bv[2]; f32x4 dc[4][4];
#pragma unroll
    for (int ks = 0; ks < 2; ++ks) bv[ks] = *(const LAS bf16x8*)(buf + B_VT + (32 * j + c) * TS + (16 * ks + 8 * h) * 2);
#pragma unroll
    for (int i = 0; i < 4; ++i) {
#pragma unroll
        for (int ks = 0; ks < 2; ++ks) a[i][ks] = *(const LAS bf16x8*)(buf + B_KT + (32 * i + c) * TS + (16 * ks + 8 * h) * 2);
#pragma unroll
        for (int g4 = 0; g4 < 4; ++g4) dc[i][g4] = *(const LAS f32x4*)(buf + B_DEC + 4 * (32 * i + 8 * g4 + 4 * h)); }
#pragma unroll
    for (int i = 0; i < 4; ++i) {
#pragma unroll
        for (int g4 = 0; g4 < 4; ++g4)
#pragma unroll
            for (int e = 0; e < 4; ++e) S[i][4 * g4 + e] *= dc[i][g4][e];
#pragma unroll
        for (int ks = 0; ks < 2; ++ks) S[i] = __builtin_amdgcn_mfma_f32_32x32x16_bf16(a[i][ks], bv[ks], S[i], 0, 0, 0);
    }
}
__device__ __forceinline__ void pass_a(const bf16* __restrict__ big, const float* __restrict__ lbv, float* __restrict__ Eg, float* __restrict__ Dg, LAS unsigned char* lds, int lane, int wave) {
    const bool builder = wave < 4; const int bw = wave & 3, j = wave & 3, c = lane & 31, h = lane >> 5;
    for (int u = blockIdx.x; u < BATCH * NH * NSEG; u += gridDim.x) {
        const int seg = u & 3, hh = (u >> 2) & 7, b = u >> 5;
        if (seg == NSEG - 1) continue;
        const bf16* base = big + ((size_t)(b * 8 + hh) * 3 * 4096 + (size_t)seg * NCH_SEG * CH) * 128;
        if (builder) {
            const float lb = lbv[hh * 128 + 32 * bw + (lane & 31)];
            float dsum = 0.f; Raw<false> R0, R1;
            load_raw<false>(R0, base, lane, bw); load_raw<false>(R1, base + (size_t)CH * LDB, lane, bw);
#define HG2_A_ITER(kk_, RX) do { const int k_ = (kk_); if (k_ < NCH_SEG) { dsum += build_chunk<false>(RX, lb, lds + (k_ & 1) * BUF_BYTES, lds + OFF_SCR + bw * 2560, lane, bw); \
                if (k_ + 2 < NCH_SEG) load_raw<false>(RX, base + (size_t)(k_ + 2) * CH * LDB, lane, bw); } HG2_BAR(); } while (0)
            for (int k = 0; k < NCH_SEG; k += 2) { HG2_A_ITER(k, R0); HG2_A_ITER(k + 1, R1); }
            HG2_A_ITER(NCH_SEG, R0);
#undef HG2_A_ITER
            if ((lane >> 5) == 0) Dg[(size_t)u * 128 + 32 * bw + (lane & 31)] = dsum;
        } else {
            f32x16 S[4];
#pragma unroll
            for (int i = 0; i < 4; ++i) S[i] = f32x16{};
            for (int k = 0; k <= NCH_SEG; ++k) {
                if (k > 0) state_update(S, lds + ((k - 1) & 1) * BUF_BYTES, j, c, h);
                HG2_BAR();
            }
            float* E = Eg + (size_t)u * 16384;
#pragma unroll
            for (int i = 0; i < 4; ++i)
#pragma unroll
                for (int r = 0; r < 16; ++r) E[(size_t)(32 * i + crow(r, h)) * 128 + 32 * j + c] = S[i][r];
        }
    }
}
__device__ __forceinline__ void pass_b(bf16* big, bf16* outp, int ldo, int store, const float* __restrict__ lbv, const float* __restrict__ og, const float* __restrict__ Eg, const float* __restrict__ Dg, LAS unsigned char* lds, int lane, int wave) {
    const bool builder = wave < 4; const int bw = wave & 3, j = wave & 3, c = lane & 31, h = lane >> 5, btid = (wave & 3) * 64 + lane;
    for (int u = blockIdx.x; u < BATCH * NH * NSEG; u += gridDim.x) {
        const int seg = u & 3, hh = (u >> 2) & 7, b = u >> 5;
        const bf16* base = big + ((size_t)(b * 8 + hh) * 3 * 4096 + (size_t)seg * NCH_SEG * CH) * 128;
        const bf16* gbase = big + (size_t)3 * MROWS * 1024 + ((size_t)b * SEQ + (size_t)seg * NCH_SEG * CH) * LDG + hh * 128;
        if (builder) {
            const float lb = lbv[hh * 128 + 32 * bw + (lane & 31)];
            Raw<true> R0, R1;
            load_raw<true>(R0, base, lane, bw); load_raw<true>(R1, base + (size_t)CH * LDB, lane, bw);
#define HG2_B_ITER(kk_, RX) do { const int k_ = (kk_); \
                if (k_ < NCH_SEG) { if (store != 3) (void)build_chunk<true>(RX, lb, lds + (k_ & 1) * BUF_BYTES, lds + OFF_SCR + bw * 2560, lane, bw); if (k_ + 2 < NCH_SEG) load_raw<true>(RX, base + (size_t)(k_ + 2) * CH * LDB, lane, bw); } \
                HG2_BAR(); } while (0)
            for (int k = 0; k <= NCH_SEG + 1; k += 2) { HG2_B_ITER(k, R0); HG2_B_ITER(k + 1, R1); }
#undef HG2_B_ITER
        } else {
            f32x16 S[4];
#pragma unroll
            for (int i = 0; i < 4; ++i) S[i] = f32x16{};
            for (int sp = 0; sp < seg; ++sp) {
                const float* E = Eg + (size_t)(u - seg + sp) * 16384; const float* Dp = Dg + (size_t)(u - seg + sp) * 128;
#pragma unroll
                for (int i = 0; i < 4; ++i)
#pragma unroll
                    for (int r = 0; r < 16; ++r) { const int d = 32 * i + crow(r, h); S[i][r] = __expf(Dp[d]) * S[i][r] + E[(size_t)d * 128 + 32 * j + c]; }
            }
            u32x4 gn0 = (u32x4){0u, 0u, 0u, 0u}, gn1 = gn0;
            const int ot = btid >> 3, opart = btid & 7;
            for (int k = 0; k <= NCH_SEG + 1; ++k) {
                if (k >= 1 && k <= NCH_SEG && store != 4) {
                const LAS unsigned char* buf = lds + ((k - 1) & 1) * BUF_BYTES;
                f32x16 X = f32x16{};
                { bf16x8 ka[8], qb[8];
#pragma unroll
                  for (int ks = 0; ks < 8; ++ks) { ka[ks] = *(const LAS bf16x8*)(buf + B_KR + c * RS + (16 * ks + 8 * h) * 2); qb[ks] = *(const LAS bf16x8*)(buf + B_QR + c * RS + (16 * ks + 8 * h) * 2); }
#pragma unroll
                  for (int ks = 0; ks < 8; ++ks) X = __builtin_amdgcn_mfma_f32_32x32x16_bf16(ka[ks], qb[ks], X, 0, 0, 0); }
#pragma unroll
                for (int r = 0; r < 16; ++r) X[r] = crow(r, h) <= c ? X[r] : 0.f;
                const bf16x8 P0 = acc_frag(X, 0), P1 = acc_frag(X, 1);
                f32x16 o = f32x16{};
                { bf16x8 qa8[8]; f32x4 eg[8][2];
#pragma unroll
                  for (int i = 0; i < 4; ++i)
#pragma unroll
                    for (int s = 0; s < 2; ++s) { const LAS unsigned char* qa = buf + B_QR + c * RS + (32 * i + 16 * s + 4 * h) * 2; qa8[2 * i + s] = join8(*(const LAS s16x4*)qa, *(const LAS s16x4*)(qa + 16));
                        eg[2 * i + s][0] = *(const LAS f32x4*)(buf + B_EGM + 4 * (32 * i + 16 * s + 4 * h)); eg[2 * i + s][1] = *(const LAS f32x4*)(buf + B_EGM + 4 * (32 * i + 16 * s + 8 + 4 * h)); }
#pragma unroll
                  for (int i = 0; i < 4; ++i)
#pragma unroll
                    for (int s = 0; s < 2; ++s) o = __builtin_amdgcn_mfma_f32_32x32x16_bf16(qa8[2 * i + s], acc_frag_scaled(S[i], s, eg[2 * i + s][0], eg[2 * i + s][1]), o, 0, 0, 0); }
#pragma unroll
                for (int s = 0; s < 2; ++s) {
                    const LAS unsigned char* va = buf + B_VT + (32 * j + c) * TS + (16 * s + 4 * h) * 2;
                    const bf16x8 bv = join8(*(const LAS s16x4*)va, *(const LAS s16x4*)(va + 16));
                    o = __builtin_amdgcn_mfma_f32_32x32x16_bf16(s ? P1 : P0, bv, o, 0, 0, 0); }
                state_update(S, buf, j, c, h);
#pragma unroll
                for (int r = 0; r < 16; ++r) *(LAS float*)(lds + OFF_OST + ((k - 1) & 1) * OST_BYTES + crow(r, h) * OST_RS + (32 * j + c) * 4) = o[r];
                }
                if (k >= 2 && store != 5) {
                    const int kc = k - 2; const u32x4 g0 = gn0, g1 = gn1;
                    const LAS f32x4* op = (const LAS f32x4*)(lds + OFF_OST + (kc & 1) * OST_BYTES + ot * OST_RS + opart * 64);
                    const f32x4 o0 = op[0], o1 = op[1], o2 = op[2], o3 = op[3];
                    float ss = (o0[0] * o0[0] + o0[1] * o0[1]) + (o0[2] * o0[2] + o0[3] * o0[3]) + (o1[0] * o1[0] + o1[1] * o1[1]) + (o1[2] * o1[2] + o1[3] * o1[3])
                             + (o2[0] * o2[0] + o2[1] * o2[1]) + (o2[2] * o2[2] + o2[3] * o2[3]) + (o3[0] * o3[0] + o3[1] * o3[1]) + (o3[2] * o3[2] + o3[3] * o3[3]);
                    ss += __shfl_xor(ss, 1); ss += __shfl_xor(ss, 2); ss += __shfl_xor(ss, 4);
                    const float rstd = __builtin_amdgcn_rsqf(ss * (1.0f / 128.0f) + 1e-6f);
                    const size_t row = (size_t)b * SEQ + (size_t)(seg * NCH_SEG + kc) * CH + ot;
                    bf16* yp = outp + row * ldo + hh * 128 + opart * 16;
                    const f32x4 w0 = *(const f32x4*)(og + opart * 16), w1 = *(const f32x4*)(og + opart * 16 + 4), w2 = *(const f32x4*)(og + opart * 16 + 8), w3 = *(const f32x4*)(og + opart * 16 + 12);
                    const unsigned gw[8] = {g0.x, g0.y, g0.z, g0.w, g1.x, g1.y, g1.z, g1.w};
                    const float ov[16] = {o0[0], o0[1], o0[2], o0[3], o1[0], o1[1], o1[2], o1[3], o2[0], o2[1], o2[2], o2[3], o3[0], o3[1], o3[2], o3[3]};
                    const float wv[16] = {w0[0], w0[1], w0[2], w0[3], w1[0], w1[1], w1[2], w1[3], w2[0], w2[1], w2[2], w2[3], w3[0], w3[1], w3[2], w3[3]};
                    unsigned ow[8];
#pragma unroll
                    for (int e = 0; e < 8; ++e) { const float ga = __uint_as_float(gw[e] << 16), gb = __uint_as_float(gw[e] & 0xffff0000u);
                        const float ya = ov[2 * e] * rstd * wv[2 * e] * (ga * __builtin_amdgcn_rcpf(1.0f + __expf(-ga)));
                        const float yb = ov[2 * e + 1] * rstd * wv[2 * e + 1] * (gb * __builtin_amdgcn_rcpf(1.0f + __expf(-gb)));
                        ow[e] = pk(ya, yb); }
                    if (store == 1) { *(u32x4*)yp = (u32x4){ow[0], ow[1], ow[2], ow[3]}; *(u32x4*)(yp + 8) = (u32x4){ow[4], ow[5], ow[6], ow[7]}; }
                }
                if (k >= 1 && k - 1 < NCH_SEG) { const bf16* gp = gbase + (size_t)((k - 1) * CH + ot) * LDG + opart * 16; gn0 = *(const u32x4*)gp; gn1 = *(const u32x4*)(gp + 8); }
                HG2_BAR();
            }
        }
    }
}
}
#define GAS __attribute__((address_space(1)))
constexpr int NWAVES = 8;
constexpr int RING_OFF = 0, RING_BYTES = 131072;
constexpr int XCH_OFF = 131072;
constexpr int MISC_OFF = 139264;
constexpr int LDS_BYTES = 147456;
constexpr int CW_Q = 2048;
constexpr int CW_BAR = 4096;
constexpr int N_PHASES = 25;
static_assert(pg8::STAGE_BYTES == RING_BYTES && XCH_OFF == RING_BYTES, "LDS map");
static_assert((CW_BAR + 3456) * 4 <= (int)CTL_ZERO_BYTES, "barrier words inside the memset region");

struct Params { const float* in[15]; float* out; unsigned char* ws; int ph_lo, ph_hi, bar_region, pad; };

#define LDS_WAIT() asm volatile("s_waitcnt lgkmcnt(0)" ::: "memory")
#define VM_WAIT() asm volatile("s_waitcnt vmcnt(0)" ::: "memory")

__device__ __forceinline__ void p0_conv_item(const float* __restrict__ W, const float* __restrict__ gain, int K, int N, bf16* __restrict__ WT, int upperm, LAS float* scr, int item, int lane) {
    const int nblk = N / 64, kb = item / nblk, nb = item % nblk, k0 = 64 * kb, n0 = 64 * nb;
    int src0 = n0;
    if (upperm == 1) { const int pn = n0 >> 8, r = n0 & 255, bj = r >> 7, c = r & 127; src0 = bj * 3072 + 128 * pn + c; }
    if (upperm == 2) { const int pn = n0 >> 8, type = pn >> 2; if (type < 2) src0 = type * 1024 + (2 * (pn & 3) + ((n0 >> 6) & 1)) * 128 + 64 * ((n0 >> 7) & 1); }
    const int kr = lane >> 4, n4 = (lane & 15) * 4;
    f32x4 v[16];
#pragma unroll
    for (int i = 0; i < 16; ++i) v[i] = *(const f32x4*)(W + (size_t)(k0 + 4 * i + kr) * N + src0 + n4);
#pragma unroll
    for (int i = 0; i < 16; ++i) { const int k = 4 * i + kr; const float gsc = gain ? gain[k0 + k] : 1.0f;
#pragma unroll
        for (int e = 0; e < 4; ++e) scr[(n4 + e) * 65 + k] = v[i][e] * gsc; }
    LDS_WAIT(); asm volatile("" ::: "memory");
    const int c = lane & 7;
#pragma unroll
    for (int j = 0; j < 8; ++j) { const int n = (lane >> 3) + 8 * j; const LAS float* s = scr + n * 65 + 8 * c;
        u32x4 o; o.x = f2bf(s[0]) | ((unsigned)f2bf(s[1]) << 16); o.y = f2bf(s[2]) | ((unsigned)f2bf(s[3]) << 16);
        o.z = f2bf(s[4]) | ((unsigned)f2bf(s[5]) << 16); o.w = f2bf(s[6]) | ((unsigned)f2bf(s[7]) << 16);
        *(u32x4*)(WT + (size_t)(n0 + n) * K + k0 + 8 * c) = o; }
    LDS_WAIT(); asm volatile("" ::: "memory");
}
__device__ __forceinline__ void p0_prologue(const Params& p, LAS unsigned char* lds, int gw, int NGW, int lane, int wave) {
    unsigned char* ws = p.ws;
    LAS float* scr = (LAS float*)(lds + RING_OFF + wave * 16640);
    const float* attn_norm = p.in[1]; const float* ffn_norm = p.in[2];
    constexpr int I_IN = 16 * 64, I_QKV = 16 * 48, I_O = 16 * 16, I_UP = 16 * 96, I_DN = 48 * 16;
    constexpr int NITEMS = 2 * I_IN + 2 * I_QKV + 4 * I_O + 4 * I_UP + 4 * I_DN;
    for (int it = gw; it < NITEMS; it += NGW) {
        int r = it;
        if (r < 2 * I_IN) { const int s = r / I_IN; p0_conv_item(p.in[3] + (size_t)s * 1024 * 4096, attn_norm + (2 * s) * 1024, 1024, 4096, (bf16*)(ws + WS_WIN) + (size_t)s * 4096 * 1024, 0, scr, r % I_IN, lane); continue; } r -= 2 * I_IN;
        if (r < 2 * I_QKV) { const int s = r / I_QKV; p0_conv_item(p.in[7] + (size_t)s * 1024 * 3072, attn_norm + (2 * s + 1) * 1024, 1024, 3072, (bf16*)(ws + WS_WQKV) + (size_t)s * 3072 * 1024, 2, scr, r % I_QKV, lane); continue; } r -= 2 * I_QKV;
        if (r < 2 * I_O) { const int s = r / I_O; p0_conv_item(p.in[6] + (size_t)s * 1024 * 1024, nullptr, 1024, 1024, (bf16*)(ws + WS_WOH) + (size_t)s * 1024 * 1024, 0, scr, r % I_O, lane); continue; } r -= 2 * I_O;
        if (r < 2 * I_O) { const int s = r / I_O; p0_conv_item(p.in[10] + (size_t)s * 1024 * 1024, nullptr, 1024, 1024, (bf16*)(ws + WS_WOM) + (size_t)s * 1024 * 1024, 0, scr, r % I_O, lane); continue; } r -= 2 * I_O;
        if (r < 4 * I_UP) { const int l = r / I_UP; p0_conv_item(p.in[11] + (size_t)l * 1024 * 6144, ffn_norm + l * 1024, 1024, 6144, (bf16*)(ws + WS_WUP) + (size_t)l * 6144 * 1024, 1, scr, r % I_UP, lane); continue; } r -= 4 * I_UP;
        { const int l = r / I_DN; p0_conv_item(p.in[14] + (size_t)l * 3072 * 1024, nullptr, 3072, 1024, (bf16*)(ws + WS_WDN) + (size_t)l * 1024 * 3072, 0, scr, r % I_DN, lane); }
    }
    const float* x = p.in[0]; bf16* xb = (bf16*)(ws + WS_XB); float* ss = (float*)(ws + WS_SS);
    for (int row0 = gw * 4; row0 < MROWS; row0 += NGW * 4) {
        f32x4 v[4][4];
#pragma unroll
        for (int r = 0; r < 4; ++r)
#pragma unroll
            for (int j = 0; j < 4; ++j) v[r][j] = ((const f32x4*)(x + (size_t)(row0 + r) * DM))[lane + 64 * j];
        float s4[4];
#pragma unroll
        for (int r = 0; r < 4; ++r) { float s = 0.f;
#pragma unroll
            for (int j = 0; j < 4; ++j) { const f32x4 t = v[r][j]; s += (t[0] * t[0] + t[1] * t[1]) + (t[2] * t[2] + t[3] * t[3]);
                unsigned long long w = (unsigned long long)(f2bf(t[0]) | ((unsigned)f2bf(t[1]) << 16)) | ((unsigned long long)(f2bf(t[2]) | ((unsigned)f2bf(t[3]) << 16)) << 32);
                *(unsigned long long*)(xb + (size_t)(row0 + r) * DM + 4 * (lane + 64 * j)) = w; }
            s4[r] = wave_sum(s); }
        { const int slot = lane >> 2, rr = lane & 3; const float sv = rr == 0 ? s4[0] : rr == 1 ? s4[1] : rr == 2 ? s4[2] : s4[3];
          ss[(size_t)slot * MROWS + row0 + rr] = slot == 0 ? sv : 0.f; }
    }
    float* lbv = (float*)(ws + WS_LBV); const float* hgrn_lb = p.in[4];
    if (gw == 0) ((float*)(ws + WS_INVF))[lane] = 1.0f / powf(10000.0f, (float)(2 * lane) / 128.0f);
    for (int idx = gw * 64 + lane; idx < 1024; idx += NGW * 64) { const float l0 = hgrn_lb[idx], l1 = hgrn_lb[1024 + idx]; const float mx = fmaxf(l0, l1), e0 = expf(l0 - mx), e1 = expf(l1 - mx); lbv[idx] = 0.f; lbv[1024 + idx] = e1 / (e0 + e1); }
}

__device__ __forceinline__ void kprep_phase(const bf16* qkv, bf16* qdst, bf16* kdst, int ldd, const float* __restrict__ qg, const float* __restrict__ kg, const float* __restrict__ cs, const float* __restrict__ sn, float* __restrict__ kmean,
                                            LAS unsigned char* lds, int lane, int wave) {
    const int tidk = wave * 64 + lane, rg = lane >> 4, cch = lane & 15;
    LAS float* red = (LAS float*)(lds + RING_OFF);
    for (int u = blockIdx.x; u < 2 * BATCH * NH * NBLK; u += gridDim.x) {
        const int which = u & 1, j = (u >> 1) & 15, h = (u >> 5) & 7, b = u >> 8;
        const float* g = which ? kg : qg; const f32x4 ga = *(const f32x4*)(g + 8 * cch), gb = *(const f32x4*)(g + 8 * cch + 4);
        const float gn[8] = {ga[0], ga[1], ga[2], ga[3], gb[0], gb[1], gb[2], gb[3]};
        const int pos0 = j * MBLK + wave * 32 + rg;
        const bf16* src = qkv + (size_t)(b * SEQ + pos0) * 3072 + which * 1024 + h * 128 + 8 * cch;
        bf16* dst = (which ? kdst : qdst) + (size_t)(b * SEQ + pos0) * ldd + h * 128 + 8 * cch;
        u32x4 raw[8];
#pragma unroll
        for (int it = 0; it < 8; ++it) raw[it] = *(const u32x4*)(src + (size_t)(4 * it) * 3072);
        float acc[8];
#pragma unroll
        for (int e = 0; e < 8; ++e) acc[e] = 0.f;
#pragma unroll
        for (int it = 0; it < 8; ++it) {
            const unsigned w[4] = {raw[it].x, raw[it].y, raw[it].z, raw[it].w};
            float x[8];
#pragma unroll
            for (int e = 0; e < 4; ++e) { x[2 * e] = __uint_as_float(w[e] << 16); x[2 * e + 1] = __uint_as_float(w[e] & 0xffff0000u); }
            float ss = 0.f;
#pragma unroll
            for (int e = 0; e < 8; ++e) ss += x[e] * x[e];
            ss += __shfl_xor(ss, 1); ss += __shfl_xor(ss, 2); ss += __shfl_xor(ss, 4); ss += __shfl_xor(ss, 8);
            const float r = rsqrtf(ss * (1.0f / 128.0f) + 1e-6f);
            const int pos = pos0 + 4 * it;
            const f32x4 c0 = *(const f32x4*)(cs + pos * 64 + 8 * (cch & 7)), c1 = *(const f32x4*)(cs + pos * 64 + 8 * (cch & 7) + 4);
            const f32x4 s0 = *(const f32x4*)(sn + pos * 64 + 8 * (cch & 7)), s1 = *(const f32x4*)(sn + pos * 64 + 8 * (cch & 7) + 4);
            const float cv[8] = {c0[0], c0[1], c0[2], c0[3], c1[0], c1[1], c1[2], c1[3]}, sv[8] = {s0[0], s0[1], s0[2], s0[3], s1[0], s1[1], s1[2], s1[3]};
            float o[8];
#pragma unroll
            for (int e = 0; e < 8; ++e) { const float y = x[e] * r * gn[e]; const float py = __shfl_xor(y, 8);
                float v = cch < 8 ? y * cv[e] - py * sv[e] : y * cv[e] + py * sv[e];
                if (!which) v *= QSCALE;
                o[e] = v; acc[e] += v; }
            u32x4 ow; ow.x = f2bf(o[0]) | ((unsigned)f2bf(o[1]) << 16); ow.y = f2bf(o[2]) | ((unsigned)f2bf(o[3]) << 16); ow.z = f2bf(o[4]) | ((unsigned)f2bf(o[5]) << 16); ow.w = f2bf(o[6]) | ((unsigned)f2bf(o[7]) << 16);
            *(u32x4*)(dst + (size_t)(4 * it) * ldd) = ow;
        }
        if (which) {
#pragma unroll
            for (int e = 0; e < 8; ++e) { acc[e] += __shfl_xor(acc[e], 16); acc[e] += __shfl_xor(acc[e], 32); }
            if (rg == 0) {
#pragma unroll
                for (int e = 0; e < 8; ++e) red[wave * 128 + 8 * cch + e] = acc[e]; }
            __syncthreads();
            if (tidk < 128) { float s = 0.f;
#pragma unroll
                for (int w = 0; w < 8; ++w) s += red[w * 128 + tidk];
                kmean[((size_t)(b * 8 + h) * 16 + j) * 128 + tidk] = s * (1.0f / 256.0f); }
            __syncthreads();
        }
    }
}

__device__ __forceinline__ void hg_naive_phase(bf16* __restrict__ big, const float* __restrict__ lbv, const float* __restrict__ og, LAS unsigned char* lds, const int tid) {
    LAS float* sq = (LAS float*)(lds + RING_OFF); LAS float* sf = sq + 128; LAS float* sk = sq + 256; LAS float* red = sq + 384;
    for (int u = blockIdx.x; u < BATCH * NH; u += gridDim.x) {
        const int b = u >> 3, h = u & 7;
        float S[128];
#pragma unroll
        for (int d = 0; d < 128; ++d) S[d] = 0.f;
        const float lb = tid < 128 ? lbv[h * 128 + tid] : 0.f, gain = tid < 128 ? og[tid] : 0.f;
        for (int t = 0; t < SEQ; ++t) {
            bf16* r = big + (size_t)(b * SEQ + t) * 4096 + h * 128 + (tid & 127);
            float q = 0.f, vv = 0.f, gg = 0.f;
            if (tid < 128) { q = bf2f(r[0]) * QSCALE; const float z = bf2f(r[1024]); vv = bf2f(r[2048]); gg = bf2f(r[3072]);
                const float sg = 1.0f / (1.0f + expf(-z)); const float f = lb + (1.0f - lb) * sg; const float k = (1.0f - lb) * (1.0f - sg);
                sq[tid] = q; sf[tid] = f; sk[tid] = k; }
            __syncthreads();
            float o = 0.f;
            if (tid < 128) {
#pragma unroll
                for (int d = 0; d < 128; ++d) { S[d] = sf[d] * S[d] + sk[d] * vv; o += sq[d] * S[d]; }
                const float w = wave_sum(o * o);
                if ((tid & 63) == 0) red[tid >> 6] = w; }
            __syncthreads();
            if (tid < 128) { const float tot = red[0] + red[1];
                const float on = o * rsqrtf(tot * (1.0f / 128.0f) + 1e-6f) * gain;
                r[3072] = f2bf(on * (gg / (1.0f + expf(-gg)))); }
        }
    }
}
__device__ __forceinline__ void attn_naive_phase(bf16* __restrict__ qkv, const float* __restrict__ kmean, LAS unsigned char* lds, int lane, int wave) {
    LAS float* sq = (LAS float*)(lds + RING_OFF) + wave * 128;
    LAS float* sp = (LAS float*)(lds + RING_OFF + 4096) + wave * 1024;
    for (long it0 = (long)blockIdx.x * 8; it0 < (long)MROWS * 8; it0 += (long)gridDim.x * 8) {
        const long item = it0 + wave; const int h = (int)(item & 7); const long row = item >> 3; const int b = (int)(row >> 12), s = (int)(row & (SEQ - 1)), i = s >> 8;
        bf16* qp = qkv + row * 3072 + h * 128;
        __syncthreads();
        sq[lane] = bf2f(qp[lane]); sq[lane + 64] = bf2f(qp[lane + 64]);
        __syncthreads();
        float gv = -INFINITY;
        if (lane < i) { const float* km = kmean + ((size_t)(b * 8 + h) * 16 + lane) * 128; float a = 0.f; for (int d = 0; d < 128; ++d) a += km[d] * sq[d]; gv = a; }
        const int nsel = i < 3 ? i : 3; int s0 = i, s1 = i, s2 = i;
#pragma unroll
        for (int n = 0; n < 3; ++n) {
            if (n < nsel) { const float m = wave_max(gv); const unsigned long long bal = __ballot(gv == m); const int idx = __ffsll((long long)bal) - 1; if (n == 0) s0 = idx; else if (n == 1) s1 = idx; else s2 = idx; if (lane == idx) gv = -INFINITY; } }
#define PICKB(bi) ((bi) == 0 ? s0 : (bi) == 1 ? s1 : (bi) == 2 ? s2 : i)
        float mx = -INFINITY;
        for (int bi = 0; bi <= nsel; ++bi) { const int kb = PICKB(bi) * MBLK;
            for (int c = 0; c < 4; ++c) { const int key = kb + c * 64 + lane;
                const bf16* kp = qkv + (size_t)(b * SEQ + key) * 3072 + 1024 + h * 128; float a = 0.f;
                for (int d8 = 0; d8 < 16; ++d8) { const u32x4 w = *(const u32x4*)(kp + d8 * 8);
                    const unsigned ww[4] = {w.x, w.y, w.z, w.w};
#pragma unroll
                    for (int e = 0; e < 4; ++e) { a += __uint_as_float(ww[e] << 16) * sq[d8 * 8 + 2 * e]; a += __uint_as_float(ww[e] & 0xffff0000u) * sq[d8 * 8 + 2 * e + 1]; } }
                if (bi == nsel && key > s) a = -INFINITY;
                sp[bi * 256 + c * 64 + lane] = a; mx = fmaxf(mx, a); } }
        mx = wave_max(mx);
        float l = 0.f;
        for (int e = lane; e < (nsel + 1) * 256; e += 64) { const float pr = __expf(sp[e] - mx); sp[e] = pr; l += pr; }
        l = wave_sum(l);
        __syncthreads();
        float o0 = 0.f, o1 = 0.f;
        for (int bi = 0; bi <= nsel; ++bi) { const bf16* vp = qkv + (size_t)(b * SEQ + PICKB(bi) * MBLK) * 3072 + 2048 + h * 128 + lane;
            for (int kk = 0; kk < 256; ++kk) { const float pr = sp[bi * 256 + kk]; o0 += pr * bf2f(vp[(size_t)kk * 3072]); o1 += pr * bf2f(vp[(size_t)kk * 3072 + 64]); } }
#undef PICKB
        const float il = 1.0f / l;
        qp[lane] = f2bf(o0 * il); qp[lane + 64] = f2bf(o1 * il);
    }
}

#ifndef HG_PIPE
#define HG_PIPE 1
#endif
#if HG_PIPE
#define HGNS hg2
#else
#define HGNS hg
#endif
#ifndef PROBE_BMODE
#define PROBE_BMODE 0
#endif
#ifndef STAGGER_TICKS
#define STAGGER_TICKS 0
#endif
__device__ __forceinline__ void phase_stagger() {
    if (STAGGER_TICKS > 0) { const unsigned q = (blockIdx.x >> 3) & 3u; const unsigned long long t0 = __builtin_amdgcn_s_memrealtime();
        while (__builtin_amdgcn_s_memrealtime() - t0 < (unsigned long long)(q * STAGGER_TICKS)) __builtin_amdgcn_s_sleep(8); }
}
__global__ void __launch_bounds__(NWAVES * 64, 2) mega_fwd(Params p) {
    extern __shared__ __attribute__((aligned(16))) unsigned char lds_raw[];
    LAS unsigned char* lds = (LAS unsigned char*)lds_raw;
    const int G = gridDim.x;
    unsigned char* ws = p.ws;
    for (int u = threadIdx.x; u < (LDS_BYTES - MISC_OFF) / 4; u += NWAVES * 64) ((LAS unsigned*)(lds + MISC_OFF))[u] = 0u;
    __syncthreads();
#define PHASE_IDS() int tid = threadIdx.x; asm volatile("" : "+v"(tid)); const int lane = tid & 63, wave = __builtin_amdgcn_readfirstlane(tid >> 6); (void)lane; (void)wave
    const int lo = p.ph_lo, hi = p.ph_hi;
    XcdBarrier bar; bar.bar = (unsigned*)(ws + WS_CTL) + CW_BAR + p.bar_region * XCD_BAR_WORDS; bar.x = 0; bar.st = nullptr;
    if (hi - lo > 1) bar = xcd_barrier_post((unsigned*)(ws + WS_CTL) + CW_BAR + p.bar_region * XCD_BAR_WORDS, (volatile LAS unsigned*)(lds + MISC_OFF));
#define IN(k) (lo <= (k) && (k) < hi)
#define SEAM(k) do { if (IN(k) && IN((k) + 1)) { xcd_barrier(bar); if (PROBE_DUP & 1024) xcd_barrier(bar); } } while (0)
#define PHASE_ENV() PHASE_IDS(); const __attribute__((address_space(4))) Params* pp = (const __attribute__((address_space(4))) Params*)__builtin_amdgcn_kernarg_segment_ptr(); asm volatile("" : "+s"(pp)); \
    unsigned char* ws = pp->ws; float* out = pp->out; bf16* XB = (bf16*)(ws + WS_XB); bf16* BIG = (bf16*)(ws + WS_BIG); float* SS = (float*)(ws + WS_SS); \
    const float* COS = (const float*)(ws + WS_COS); const float* SIN = (const float*)(ws + WS_SIN); const float* LBV = (const float*)(ws + WS_LBV); float* KMEAN = (float*)(ws + WS_KMEAN); \
    float* TAIL = (float*)(ws + WS_TAIL); float* HEADA = (float*)(ws + WS_HEADA); float* HEADU = (float*)(ws + WS_HEADU); \
    (void)out; (void)XB; (void)BIG; (void)SS; (void)COS; (void)SIN; (void)LBV; (void)KMEAN; (void)TAIL; (void)HEADA; (void)HEADU

    if (IN(0)) {
#pragma unroll 1
        for (int rep = (PROBE_DUP & 8) ? 0 : 1; rep < 2; ++rep) { PHASE_IDS(); p0_prologue(p, lds, blockIdx.x * NWAVES + wave, G * NWAVES, lane, wave); __syncthreads(); }
    }
    SEAM(0);
    for (int l = 0; l < DEPTH; ++l) {
        const int pb = 1 + 6 * l, slot = l >> 1; const bool moba = (l & 1) != 0;
        if (IN(pb)) { PHASE_ENV();
            if (moba) {
                pg8::Gemm g{XB, (const bf16*)(ws + WS_WQKV) + (size_t)slot * 3072 * 1024, MROWS, 3072, 1024, 1024}; pg8::StaticOrder S; S.init(MROWS, 3072, G, (int)blockIdx.x);
                pg8::EpiQKV E{BIG, SS, pp->in[8] + slot * 128, pp->in[9] + slot * 128, (const float*)(ws + WS_INVF), KMEAN, 0, 0, pg8::rstd_tab_build(lds + RING_OFF, S, SS, tid)};
#pragma unroll 1
                for (int rep = (PROBE_DUP & 65536) ? 0 : 1; rep < 2; ++rep) { E.dry = rep ? 0 : PROBE_BMODE; pg8::gemm_phase<pg8::EpiQKV, pg8::StaticOrder, true, true>(lds + RING_OFF, g, S, E); __syncthreads(); }
            } else {
                pg8::Gemm g{XB, (const bf16*)(ws + WS_WIN) + (size_t)slot * 4096 * 1024, MROWS, 4096, 1024, 1024}; pg8::StaticOrder S; S.init(MROWS, 4096, G, (int)blockIdx.x);
                pg8::EpiRowScale E{BIG, SS, 0, 0, pg8::rstd_tab_build(lds + RING_OFF, S, SS, tid)};
#pragma unroll 1
                for (int rep = (PROBE_DUP & 1) ? 0 : 1; rep < 2; ++rep) { E.pad = ((PROBE_DUP & 128) && rep == 0) ? (PROBE_BMODE ? PROBE_BMODE : 1) : 0; pg8::gemm_phase<pg8::EpiRowScale, pg8::StaticOrder, true, true>(lds + RING_OFF, g, S, E); __syncthreads(); }
            }
        }
        SEAM(pb);
        if (moba) {
#if MOBA_SPARSE
            if (IN(pb + 1)) { PHASE_ENV();
#pragma unroll 1
                for (int rep = (PROBE_DUP & 16384) ? 0 : 1; rep < 2; ++rep) { mb::sel_phase(BIG, KMEAN, (unsigned short*)(ws + WS_HGE), (unsigned*)(ws + WS_HGE + 8 * MiB), (char*)lds_raw, tid); __syncthreads(); } }
            SEAM(pb + 1);
            if (IN(pb + 2)) { PHASE_ENV();
                mb::Partials PP; PP.P[0] = (bf16*)out; PP.P[1] = (bf16*)out + (size_t)BATCH * NH * SEQ * 128; PP.P[2] = (bf16*)(ws + WS_AU); PP.ML = (float*)(ws + WS_ML);
#pragma unroll 1
                for (int rep = (PROBE_DUP & 32768) ? 0 : 1; rep < 2; ++rep) {
                    mb::past_phase(BIG, (const unsigned short*)(ws + WS_HGE), (const unsigned*)(ws + WS_HGE + 8 * MiB), PP, (unsigned*)(ws + WS_CTL) + CW_Q + 64 * l + 32 * rep, (char*)lds_raw, tid); __syncthreads(); }
                xcd_barrier(bar);
                mb::attn_phase(BIG, KMEAN, BIG, 3072, PP, (char*)lds_raw, tid); }
#else
            if (IN(pb + 2)) { PHASE_ENV(); if (MOBA_PP) mb::attn_phase_pp(BIG, KMEAN, BIG + (size_t)3 * MROWS * 1024, 1024, (char*)lds_raw, tid); else { mb::Partials PP{}; mb::attn_phase(BIG, KMEAN, BIG + (size_t)3 * MROWS * 1024, 1024, PP, (char*)lds_raw, tid); } }
#endif
            SEAM(pb + 2);
        } else {
#if defined(NAIVE_HG)
            SEAM(pb + 1);
            if (IN(pb + 2)) { PHASE_ENV(); hg_naive_phase(BIG, LBV + slot * 1024, pp->in[5] + slot * 128, lds, tid); }
#elif !defined(NO_HG)
            if (IN(pb + 1)) { PHASE_ENV();
#pragma unroll 1
                for (int rep = (PROBE_DUP & 4) ? 0 : 1; rep < 2; ++rep) { HGNS::pass_a(BIG, LBV + slot * 1024, (float*)(ws + WS_HGE), (float*)(ws + WS_HGD), lds, lane, wave); __syncthreads(); } }
            SEAM(pb + 1);
            if (IN(pb + 2)) { PHASE_ENV();
#pragma unroll 1
                for (int rep = (PROBE_DUP & 32) ? 0 : 1; rep < 2; ++rep) {
                    HGNS::pass_b(BIG, BIG + (size_t)3 * MROWS * 1024, 1024, rep ? 1 : PROBE_BMODE, LBV + slot * 1024, pp->in[5] + slot * 128, (const float*)(ws + WS_HGE), (const float*)(ws + WS_HGD), lds, lane, wave); __syncthreads(); } }
#endif
            SEAM(pb + 2);
        }
        if (IN(pb + 3)) { PHASE_ENV();
            const bf16* A = BIG + (size_t)3 * MROWS * 1024; const int lda = 1024;
            const bf16* Bt = moba ? (const bf16*)(ws + WS_WOM) + (size_t)slot * 1024 * 1024 : (const bf16*)(ws + WS_WOH) + (size_t)slot * 1024 * 1024;
            pg8::Gemm g{A, Bt, MROWS, 1024, 1024, lda}; pg8::StaticOrder S; S.init(MROWS, 1024, G, (int)blockIdx.x);
            pg8::EpiResid<0> E{l == 0 ? pp->in[0] : nullptr, nullptr, XB, SS, XB, SS, 0, 0};
#pragma unroll 1
            for (int rep = (PROBE_DUP & (256 | 4096)) ? 0 : 1; rep < 2; ++rep) { E.dry = (rep == 0) && !((PROBE_DUP & 4096) && moba); if ((PROBE_DUP & 4096) && moba) { E.xbw = (rep || PROBE_BMODE >= 5) ? XB : (bf16*)(ws + WS_AU); E.ssw = (rep || PROBE_BMODE >= 5) ? SS : (float*)(ws + WS_END); E.dry = rep ? 0 : PROBE_BMODE; } pg8::gemm_phase<pg8::EpiResid<0>, pg8::StaticOrder, true, true>(lds + RING_OFF, g, S, E); __syncthreads(); }
        }
        SEAM(pb + 3);
#ifndef NO_GLU
        if (IN(pb + 4)) { PHASE_ENV();
            const float* cw = pp->in[12] + (size_t)l * 3 * FF; const float* cb = pp->in[13] + (size_t)l * FF;
            pg8::Gemm g{XB, (const bf16*)(ws + WS_WUP) + (size_t)l * 6144 * 1024, MROWS, 6144, 1024, 1024}; pg8::StaticOrder S; S.init(MROWS, 6144, G, (int)blockIdx.x);
            pg8::EpiGLU E{BIG, SS, cw, cb, TAIL, HEADA, HEADU, 0, 0, pg8::rstd_tab_build(lds + RING_OFF, S, SS, tid)}; phase_stagger();
#pragma unroll 1
            for (int rep = (PROBE_DUP & 2) ? 0 : 1; rep < 2; ++rep) { E.dry = rep ? 0 : PROBE_BMODE; E.G = (rep == 0 && PROBE_BMODE == 4) ? (bf16*)(ws + WS_END) : BIG; pg8::gemm_phase<pg8::EpiGLU, pg8::StaticOrder, true, true>(lds + RING_OFF, g, S, E); __syncthreads(); }
        }
#endif
        SEAM(pb + 4);
        if (IN(pb + 5)) { PHASE_ENV();
            const float* cw = pp->in[12] + (size_t)l * 3 * FF; const float* cb = pp->in[13] + (size_t)l * FF;
            pg8::Gemm g{BIG, (const bf16*)(ws + WS_WDN) + (size_t)l * 1024 * 3072, MROWS, 1024, 3072, 3072}; pg8::StaticOrder S; S.init(MROWS, 1024, G, (int)blockIdx.x);
            pg8::Unit u; int pm_done = -1;
            for (int i = 0; S.next(i, u); ++i) {
                if (u.pm == pm_done) continue;
                pm_done = u.pm;
#pragma unroll
                for (int e0 = 0; e0 < 2 * FF; e0 += NWAVES * 64) { const int e = e0 + tid; glu_fixup_elem(u.pm, e >= FF, e >= FF ? e - FF : e, BIG, TAIL, HEADA, HEADU, cw, cb); } }
            VM_WAIT(); __syncthreads();
            pg8::EpiResid<1> E{nullptr, l == DEPTH - 1 ? out : nullptr, XB, SS, XB, SS, 0, 0};
#pragma unroll 1
            for (int rep = (PROBE_DUP & (512 | 8192)) ? 0 : 1; rep < 2; ++rep) { E.dry = (rep == 0) && !(PROBE_DUP & 8192); if (PROBE_DUP & 8192) { E.xbw = rep ? XB : (bf16*)(ws + WS_AU); E.ssw = rep ? SS : (float*)(ws + WS_END); E.out = (rep && l == DEPTH - 1) ? out : nullptr; } pg8::gemm_phase<pg8::EpiResid<1>, pg8::StaticOrder, true, true>(lds + RING_OFF, g, S, E); __syncthreads(); }
        }
        if (l < DEPTH - 1) SEAM(pb + 5);
    }
#undef IN
#undef SEAM
}

#ifndef MK_PER_PHASE
#define MK_PER_PHASE 0
#endif
extern "C" void kernel_launch(void* const* d_in, const int* in_sizes, int n_in, void* d_out, int out_size, void* d_ws, size_t ws_size, hipStream_t stream) {
    static int grid = 0;
    if (grid == 0) {
        if (n_in != 15 || in_sizes[0] != MROWS * DM || out_size != MROWS * DM || ws_size < WS_END) {
            fprintf(stderr, "kernel_launch: unexpected shapes (n_in %d, in0 %d, out %d, ws %zu < %zu); nothing launched\n", n_in, n_in > 0 ? in_sizes[0] : -1, out_size, ws_size, (size_t)WS_END); grid = -1; return; }
        int dev = 0, cus = 0, per_cu = 0;
        if (hipGetDevice(&dev) != hipSuccess || hipDeviceGetAttribute(&cus, hipDeviceAttributeMultiprocessorCount, dev) != hipSuccess || cus <= 0) { fprintf(stderr, "kernel_launch: no device attributes\n"); grid = -1; return; }
        if (hipFuncSetAttribute((const void*)mega_fwd, hipFuncAttributeMaxDynamicSharedMemorySize, LDS_BYTES) != hipSuccess) { fprintf(stderr, "kernel_launch: hipFuncSetAttribute failed\n"); grid = -1; return; }
        if (hipOccupancyMaxActiveBlocksPerMultiprocessor(&per_cu, (const void*)mega_fwd, NWAVES * 64, LDS_BYTES) != hipSuccess || per_cu < 1)
            fprintf(stderr, "kernel_launch: note: occupancy query reports %d workgroups per CU; launching one per CU (144 KiB LDS each admits exactly one)\n", per_cu);
        (void)hipGetLastError();
        grid = cus;
    }
    if (grid < 0) return;
    (void)hipMemsetAsync((char*)d_ws + WS_CTL, 0, CTL_ZERO_BYTES, stream);
    Params p{};
    for (int i = 0; i < 15; ++i) p.in[i] = (const float*)d_in[i];
    p.out = (float*)d_out; p.ws = (unsigned char*)d_ws;
#if MK_PER_PHASE
    for (int k = 0; k < N_PHASES; ++k) { p.ph_lo = k; p.ph_hi = k + 1; p.bar_region = 0; hipLaunchKernelGGL(mega_fwd, dim3(grid), dim3(NWAVES * 64), LDS_BYTES, stream, p); }
#else
    p.ph_lo = 0; p.ph_hi = N_PHASES; p.bar_region = 0;
    hipLaunchKernelGGL(mega_fwd, dim3(grid), dim3(NWAVES * 64), LDS_BYTES, stream, p);
#endif
}
```

```cpp
#define PG8_PRE 1
#define PG8_ST_SC1 0
#define PG8_RESID_PF 0
#define PG8_PF_DIST 4
#include <hip/hip_runtime.h>
#include <cstdio>
#include <cstdint>
#include <cmath>
namespace pg8 {
#define PG8_LAS __attribute__((address_space(3)))
typedef unsigned short bf16_t;
typedef short bf16x8 __attribute__((ext_vector_type(8)));
typedef float f32x4 __attribute__((ext_vector_type(4)));
typedef unsigned u32x4 __attribute__((ext_vector_type(4)));
constexpr int BM = 256, BK = 64, HALF = 128, HTB = HALF * BK * 2  , STAGE_BYTES = 8 * HTB, NXCD = 8, WGM = 8;

__host__ __device__ __forceinline__ int lds_byte(int r, int c) { const int st = (r >> 4) * 2 + (c >> 5), rr = r & 15, cc = c & 31, ob = rr * 64 + cc * 2; return st * 1024 + (ob ^ (((ob >> 9) & 1) << 5)); }
__host__ __device__ __forceinline__ void stage_rc(int b, int& R, int& C) { const int st = b / 1024, sb = b % 1024, swz = sb ^ (((sb >> 9) & 1) << 5); R = (st >> 1) * 16 + swz / 64; C = (st & 1) * 32 + (swz % 64) / 2; }
__host__ __device__ __forceinline__ int perm32(int rho) { const int n = rho >> 4, i = rho & 15; return 8 * (i >> 2) + 4 * n + (i & 3); }

struct Unit { int pm, pn; };
struct Gemm { const bf16_t* A; const bf16_t* Bt; int M, N, K, lda; };

struct StaticOrder {
    int nM, nN, nwg, G, c;
    __host__ __device__ __forceinline__ void init(int M, int N, int G_, int c_) { nM = M / BM; nN = N / BM; nwg = nM * nN; G = G_; c = c_; }
    __host__ __device__ __forceinline__ bool next(int i, Unit& u) const {
        const long L = (long)i * G + c; if (L >= nwg) return false;
        int wgid = (int)L; { const int q = nwg / NXCD, r = nwg % NXCD, xcd = wgid % NXCD, off = wgid / NXCD; wgid = (xcd < r ? xcd * (q + 1) : r * (q + 1) + (xcd - r) * q) + off; }
        const int nig = WGM * nN, gid = wgid / nig, fm = gid * WGM, gsz = (nM - fm) < WGM ? (nM - fm) : WGM;
        u.pm = fm + ((wgid % nig) % gsz); u.pn = (wgid % nig) / gsz; return true;
    }
    __device__ __forceinline__ void a_ready(const Unit&) const {}
    __device__ __forceinline__ void done(const Unit&) const {}
};

__device__ __forceinline__ unsigned cvt_pk_bf16(float lo, float hi) { unsigned r; asm volatile("v_cvt_pk_bf16_f32 %0, %1, %2" : "=v"(r) : "v"(lo), "v"(hi)); return r; }
typedef float f32x2 __attribute__((ext_vector_type(2)));
constexpr int SS_M = 32768;
__device__ __forceinline__ void st16(void* p, const u32x4& w) {
#if PG8_ST_SC1
    asm volatile("global_store_dwordx4 %0, %1, off sc1" :: "v"(p), "v"(w) : "memory");
#else
    *(u32x4*)p = w;
#endif
}
struct RstdTab { int p0, p1, ok; };
constexpr int RSTD_TAB_OFF = STAGE_BYTES + 6144;
template <class Sched>
__device__ __forceinline__ RstdTab rstd_tab_build(PG8_LAS unsigned char* lds, const Sched& S, const float* ss, int tid) {
    RstdTab T; T.p0 = -1; T.p1 = -1; T.ok = 1; Unit u;
    for (int i = 0; S.next(i, u); ++i) { if (T.p0 < 0) T.p0 = u.pm; else if (u.pm != T.p0) { if (T.p1 < 0) T.p1 = u.pm; else if (u.pm != T.p1) T.ok = 0; } }
    if (T.ok) { const int slot = tid >> 8, row = tid & 255, pm = slot ? T.p1 : T.p0;
        if (pm >= 0) { const float* sp = ss + (size_t)pm * BM + row; float a[4], b[4], c[4], d[4];
#pragma unroll
            for (int k = 0; k < 4; ++k) { a[k] = sp[(size_t)k * SS_M]; b[k] = sp[(size_t)(4 + k) * SS_M]; c[k] = sp[(size_t)(8 + k) * SS_M]; d[k] = sp[(size_t)(12 + k) * SS_M]; }
            const float s = (((a[0] + a[1]) + (a[2] + a[3])) + ((b[0] + b[1]) + (b[2] + b[3]))) + (((c[0] + c[1]) + (c[2] + c[3])) + ((d[0] + d[1]) + (d[2] + d[3])));
            ((PG8_LAS float*)(lds + RSTD_TAB_OFF))[slot * BM + row] = __builtin_amdgcn_rsqf(s * (1.0f / 1024.0f) + 1e-6f); } }
    asm volatile("s_waitcnt lgkmcnt(0)" ::: "memory"); __builtin_amdgcn_s_barrier(); asm volatile("" ::: "memory");
    return T;
}
template <bool APERM = false> __device__ __forceinline__ void row_rstd8_tab(float (&rs)[2][4], PG8_LAS unsigned char* lds, const RstdTab& tab, int pm, int rt0, int fr4) {
    const PG8_LAS float* T = (const PG8_LAS float*)(lds + RSTD_TAB_OFF) + (pm == tab.p0 ? 0 : BM);
#pragma unroll
    for (int ai = 0; ai < 2; ++ai)
#pragma unroll
        for (int m = 0; m < 4; ++m) rs[ai][m] = T[rt0 + ai * HALF + (APERM ? fr4 + m : m * 16)];
}
template <bool APERM = false> __device__ __forceinline__ void row_rstd8(float (&rs)[2][4], const float* ss, int row0, int fq, int fr4 = 0) {
    f32x4 a[2][4];
#pragma unroll
    for (int ai = 0; ai < 2; ++ai)
#pragma unroll
        for (int m = 0; m < 4; ++m)
#pragma unroll
            for (int k = 0; k < 4; ++k) a[ai][m][k] = ss[(size_t)(4 * fq + k) * SS_M + (row0 + ai * HALF + (APERM ? fr4 + m : m * 16))];
#pragma unroll
    for (int ai = 0; ai < 2; ++ai)
#pragma unroll
        for (int m = 0; m < 4; ++m) { float s = (a[ai][m][0] + a[ai][m][1]) + (a[ai][m][2] + a[ai][m][3]);
            s += __shfl_xor(s, 16); s += __shfl_xor(s, 32);
            rs[ai][m] = __builtin_amdgcn_rsqf(s * (1.0f / 1024.0f) + 1e-6f); }
}
constexpr int MROWS_HM = 32768;
struct EpiRowScale {
    static constexpr bool PERM = true, AFTER_DRAIN = false, APERM = false; static constexpr int NST = 16; static constexpr bool PF = false;
    bf16_t* O; const float* ss; int ldc, pad; RstdTab tab;
    __device__ __forceinline__ void operator()(f32x4 (&acc)[2][2][4][2], const Unit& u, int wr, int wc, int fr, int fq, PG8_LAS unsigned char* lds) const {
        if (pad) asm volatile("s_waitcnt vmcnt(0)" ::: "memory");
        if (pad == 1) return;
        asm volatile("" : "+v"(fr), "+v"(fq));
        const int row0 = u.pm * BM + wr * 64 + fr; const int col0 = u.pn * BM + wc * 32 + 8 * fq;
        float rs8[2][4]; if (tab.ok) row_rstd8_tab(rs8, lds, tab, u.pm, wr * 64 + fr, 0); else row_rstd8(rs8, ss, row0, fq);
#pragma unroll
        for (int ai = 0; ai < 2; ++ai)
#pragma unroll
            for (int m = 0; m < 4; ++m) { const int row = row0 + ai * HALF + m * 16; const float rs = rs8[ai][m];
                bf16_t* rowp = ldc ? O + (size_t)row * ldc + col0
                                   : (u.pn < 12 ? O + ((((size_t)(row >> 12) * 8 + 2 * (u.pn & 3)) * 3 + (u.pn >> 2)) * 4096 + (row & 4095)) * 128 + wc * 32 + 8 * fq
                                                : O + (size_t)3 * MROWS_HM * 1024 + (size_t)row * 1024 + (u.pn - 12) * BM + wc * 32 + 8 * fq);
                const size_t bjstep = ldc ? (size_t)HALF : (u.pn < 12 ? (size_t)3 * 4096 * 128 : (size_t)HALF);
#pragma unroll
                for (int bj = 0; bj < 2; ++bj) { const f32x4 v0 = acc[ai][bj][m][0] * rs, v1 = acc[ai][bj][m][1] * rs;
                    u32x4 w; w.x = cvt_pk_bf16(v0[0], v0[1]); w.y = cvt_pk_bf16(v0[2], v0[3]); w.z = cvt_pk_bf16(v1[0], v1[1]); w.w = cvt_pk_bf16(v1[2], v1[3]);
                    if (pad != 2) st16(rowp + bj * bjstep, w); } }
    }
};
typedef unsigned u32x2 __attribute__((ext_vector_type(2)));
template <int SITE  > struct EpiResid {
    static constexpr bool PERM = true, AFTER_DRAIN = false, APERM = false; static constexpr int NST = 16; static constexpr bool PF = PG8_RESID_PF;
    const float* base32; float* out; bf16_t* xb; float* ss; bf16_t* xbw; float* ssw; int dry, pad;
    template <bool F32IN, bool F32OUT>
    __device__ __forceinline__ void run(f32x4 (&acc)[2][2][4][2], const Unit& u, int wr, int wc, int fr, int fq) const {
        asm volatile("" : "+v"(fr), "+v"(fq));
        const int col0 = u.pn * BM + wc * 32 + 8 * fq;
#pragma unroll
        for (int ai = 0; ai < 2; ++ai) {
            const size_t off0 = (size_t)(u.pm * BM + ai * HALF + wr * 64 + fr) * 1024 + col0;
            f32x4 bf[F32IN ? 4 : 1][2][2]; u32x4 bh[F32IN ? 1 : 4][2];
#pragma unroll
            for (int m = 0; m < 4; ++m)
#pragma unroll
                for (int bj = 0; bj < 2; ++bj) { const size_t off = off0 + (size_t)m * 16 * 1024 + bj * HALF;
                    if (F32IN) { bf[F32IN ? m : 0][bj][0] = *(const f32x4*)(base32 + off); bf[F32IN ? m : 0][bj][1] = *(const f32x4*)(base32 + off + 4); }
                    else bh[F32IN ? 0 : m][bj] = dry == 2 ? (u32x4){0u, 0u, 0u, 0u} : *(const u32x4*)(xb + off); }
#pragma unroll
            for (int m = 0; m < 4; ++m) { float s = 0.f;
#pragma unroll
                for (int bj = 0; bj < 2; ++bj) { const size_t off = off0 + (size_t)m * 16 * 1024 + bj * HALF; f32x4 b0, b1;
                    if (F32IN) { b0 = bf[F32IN ? m : 0][bj][0]; b1 = bf[F32IN ? m : 0][bj][1]; }
                    else { const u32x4 r = bh[F32IN ? 0 : m][bj];
                        b0 = (f32x4){__uint_as_float(r.x << 16), __uint_as_float(r.x & 0xffff0000u), __uint_as_float(r.y << 16), __uint_as_float(r.y & 0xffff0000u)};
                        b1 = (f32x4){__uint_as_float(r.z << 16), __uint_as_float(r.z & 0xffff0000u), __uint_as_float(r.w << 16), __uint_as_float(r.w & 0xffff0000u)}; }
                    const f32x4 o0 = b0 + acc[ai][bj][m][0], o1 = b1 + acc[ai][bj][m][1];
                    if (F32OUT) { *(f32x4*)(out + off) = o0; *(f32x4*)(out + off + 4) = o1; }
                    s += ((o0[0] * o0[0] + o0[1] * o0[1]) + (o0[2] * o0[2] + o0[3] * o0[3])) + ((o1[0] * o1[0] + o1[1] * o1[1]) + (o1[2] * o1[2] + o1[3] * o1[3]));
                    u32x4 w; w.x = cvt_pk_bf16(o0[0], o0[1]); w.y = cvt_pk_bf16(o0[2], o0[3]); w.z = cvt_pk_bf16(o1[0], o1[1]); w.w = cvt_pk_bf16(o1[2], o1[3]); if (dry != 4 && dry != 6) st16(xbw + off, w); }
                s += __shfl_xor(s, 16); s += __shfl_xor(s, 32);
                if (fq == 0 && dry != 3 && dry != 7) ssw[(size_t)(u.pn * 4 + wc) * SS_M + (u.pm * BM + ai * HALF + wr * 64 + m * 16 + fr)] = s; }
        }
    }
    __device__ __forceinline__ void prefetch(const Unit& u, int tid, int wid, PG8_LAS unsigned char* lds) const {
        if (base32 != nullptr || dry == 1 || dry == 2) return;
#pragma unroll
        for (int i = 0; i < 2; ++i) { const int L = tid + i * 512;
            __builtin_amdgcn_global_load_lds((const unsigned*)(xb + (size_t)(u.pm * BM + (L >> 2)) * 1024 + u.pn * BM + (L & 3) * 64), (PG8_LAS unsigned*)(lds + STAGE_BYTES + wid * 256), 4, 0, 0); }
    }
    __device__ __forceinline__ void operator()(f32x4 (&acc)[2][2][4][2], const Unit& u, int wr, int wc, int fr, int fq, PG8_LAS unsigned char* lds) const {
        if (dry) asm volatile("s_waitcnt vmcnt(0)" ::: "memory");
        if (dry == 1) return;
        if (dry >= 5) {
#pragma unroll
            for (int a = 0; a < 2; ++a)
#pragma unroll
                for (int b = 0; b < 2; ++b)
#pragma unroll
                    for (int m = 0; m < 4; ++m)
#pragma unroll
                        for (int n = 0; n < 2; ++n) acc[a][b][m][n] = (f32x4){0.f, 0.f, 0.f, 0.f}; }
        if (SITE == 0) { if (base32) run<true, false>(acc, u, wr, wc, fr, fq); else run<false, false>(acc, u, wr, wc, fr, fq); }
        else { if (out) run<false, true>(acc, u, wr, wc, fr, fq); else run<false, false>(acc, u, wr, wc, fr, fq); }
    }
};
template <int CTRL> __device__ __forceinline__ float dpp_mov(float old, float src) {
    return __builtin_bit_cast(float, __builtin_amdgcn_update_dpp(__builtin_bit_cast(int, old), __builtin_bit_cast(int, src), CTRL, 0xf, 0xf, false)); }
__device__ __forceinline__ float silu_f(float c) { return c * __builtin_amdgcn_rcpf(1.0f + __expf(-c)); }
struct EpiGLU {
    static constexpr bool PERM = true, AFTER_DRAIN = false, APERM = true; static constexpr int NST = 20; static constexpr bool PF = false;
    bf16_t* G; const float* ss; const float* cw; const float* cb; float* tail; float* head_a; float* head_u; int dry, pad; RstdTab tab;
    __device__ __forceinline__ void operator()(f32x4 (&acc)[2][2][4][2], const Unit& u, int wr, int wc, int fr, int fq, PG8_LAS unsigned char* lds) const {
        if (dry) asm volatile("s_waitcnt vmcnt(0)" ::: "memory");
        if (dry == 1) { __builtin_amdgcn_s_barrier(); return; }
        asm volatile("" : "+v"(fr), "+v"(fq));
        const int f0 = u.pn * 128 + wc * 32 + 8 * fq;
        PG8_LAS float* X = (PG8_LAS float*)(lds + STAGE_BYTES);
        f32x4 w0 = *(const f32x4*)(cw + f0), w1 = *(const f32x4*)(cw + 3072 + f0), w2 = *(const f32x4*)(cw + 6144 + f0), bb = *(const f32x4*)(cb + f0);
        const f32x4 v0 = *(const f32x4*)(cw + f0 + 4), v1 = *(const f32x4*)(cw + 3072 + f0 + 4), v2 = *(const f32x4*)(cw + 6144 + f0 + 4), vb = *(const f32x4*)(cb + f0 + 4);
        { float rs8[2][4]; if (tab.ok) row_rstd8_tab<true>(rs8, lds, tab, u.pm, wr * 64, 4 * fr); else row_rstd8<true>(rs8, ss, u.pm * BM + wr * 64, fq, 4 * fr);
#pragma unroll
          for (int ai = 0; ai < 2; ++ai)
#pragma unroll
            for (int m = 0; m < 4; ++m) {
#pragma unroll
                for (int bj = 0; bj < 2; ++bj)
#pragma unroll
                    for (int n = 0; n < 2; ++n) acc[ai][bj][m][n] = acc[ai][bj][m][n] * rs8[ai][m]; } }
        if (fr == 15) {
#pragma unroll
            for (int ai = 0; ai < 2; ++ai)
#pragma unroll
                for (int n = 0; n < 2; ++n) { *(PG8_LAS f32x4*)(X + ((((ai * 2 + wr) * 4 + wc) * 2 + 0) * 32 + 8 * fq + 4 * n)) = acc[ai][0][2][n]; *(PG8_LAS f32x4*)(X + ((((ai * 2 + wr) * 4 + wc) * 2 + 1) * 32 + 8 * fq + 4 * n)) = acc[ai][0][3][n]; }
        }
        asm volatile("s_waitcnt lgkmcnt(0)" ::: "memory"); __builtin_amdgcn_s_barrier(); asm volatile("" ::: "memory");
#pragma unroll
        for (int ai = 0; ai < 2; ++ai) {
            const int blk = ai * 2 + wr;
            unsigned pk[2][4][2];
#pragma unroll
            for (int n = 0; n < 2; ++n) {
                const f32x4 c_w0 = n ? v0 : w0, c_w1 = n ? v1 : w1, c_w2 = n ? v2 : w2, c_bb = n ? vb : bb;
                f32x4 P1 = (f32x4){0.f, 0.f, 0.f, 0.f}, P2 = P1;
                if (blk > 0) { P2 = *(const PG8_LAS f32x4*)(X + (((blk - 1) * 4 + wc) * 2 + 0) * 32 + 8 * fq + 4 * n); P1 = *(const PG8_LAS f32x4*)(X + (((blk - 1) * 4 + wc) * 2 + 1) * 32 + 8 * fq + 4 * n); }
                f32x4 gv[4];
#pragma unroll
                for (int j = 0; j < 4; ++j) {
                    const float a0 = acc[ai][0][0][n][j], a1 = acc[ai][0][1][n][j], a2 = acc[ai][0][2][n][j], a3 = acc[ai][0][3][n][j];
                    const float L3 = dpp_mov<0x111>(P1[j], a3), L2 = dpp_mov<0x111>(P2[j], a2);
                    const float c0 = fmaf(c_w0[j], L2, fmaf(c_w1[j], L3, fmaf(c_w2[j], a0, c_bb[j])));
                    const float c1 = fmaf(c_w0[j], L3, fmaf(c_w1[j], a0, fmaf(c_w2[j], a1, c_bb[j])));
                    const float c2 = fmaf(c_w0[j], a0, fmaf(c_w1[j], a1, fmaf(c_w2[j], a2, c_bb[j])));
                    const float c3 = fmaf(c_w0[j], a1, fmaf(c_w1[j], a2, fmaf(c_w2[j], a3, c_bb[j])));
                    if (dry == 3) { gv[0][j] = a0 * acc[ai][1][0][n][j]; gv[1][j] = a1 * acc[ai][1][1][n][j]; gv[2][j] = a2 * acc[ai][1][2][n][j]; gv[3][j] = a3 * acc[ai][1][3][n][j]; } else {
                    gv[0][j] = silu_f(c0) * acc[ai][1][0][n][j]; gv[1][j] = silu_f(c1) * acc[ai][1][1][n][j]; gv[2][j] = silu_f(c2) * acc[ai][1][2][n][j]; gv[3][j] = silu_f(c3) * acc[ai][1][3][n][j]; } }
#pragma unroll
                for (int m = 0; m < 4; ++m) { pk[n][m][0] = cvt_pk_bf16(gv[m][0], gv[m][1]); pk[n][m][1] = cvt_pk_bf16(gv[m][2], gv[m][3]); }
            }
#pragma unroll
            for (int m = 0; m < 4; ++m) {
                const u32x4 w = (u32x4){pk[0][m][0], pk[0][m][1], pk[1][m][0], pk[1][m][1]};
                if (dry == 5) { const int li = fr + 16 * fq; *(u32x4*)(G + (size_t)(u.pm * BM + (wr * 4 + wc) * 32 + (ai * 4 + m) * 4 + (li >> 4)) * 3072 + u.pn * 128 + (li & 15) * 8) = w; }
                else if (dry == 4) *(u32x4*)(G + (size_t)((u.pm & 1) * BM + ai * HALF + wr * 64 + 4 * fr + m) * 3072 + f0) = w;
                else if (dry != 2) st16(G + (size_t)(u.pm * BM + ai * HALF + wr * 64 + 4 * fr + m) * 3072 + f0, w); }
            asm volatile("" ::: "memory");
        }
        if (fr == 15 && wr == 1) {
#pragma unroll
            for (int n = 0; n < 2; ++n) { *(f32x4*)(tail + ((size_t)u.pm * 2 + 0) * 3072 + f0 + 4 * n) = acc[1][0][2][n]; *(f32x4*)(tail + ((size_t)u.pm * 2 + 1) * 3072 + f0 + 4 * n) = acc[1][0][3][n]; } }
        if (wr == 0 && fr == 0) {
#pragma unroll
            for (int n = 0; n < 2; ++n)
#pragma unroll
                for (int m = 0; m < 2; ++m) { *(f32x4*)(head_a + ((size_t)u.pm * 2 + m) * 3072 + f0 + 4 * n) = acc[0][0][m][n]; *(f32x4*)(head_u + ((size_t)u.pm * 2 + m) * 3072 + f0 + 4 * n) = acc[0][1][m][n]; } }
    }
};
struct EpiQKV {
    static constexpr bool PERM = true, AFTER_DRAIN = false, APERM = false; static constexpr int NST = 16; static constexpr bool PF = false;
    bf16_t* O; const float* ss; const float* qg; const float* kg; const float* invf; float* kmean; int dry, pad; RstdTab tab;
    __device__ __forceinline__ void operator()(f32x4 (&acc)[2][2][4][2], const Unit& u, int wr, int wc, int fr, int fq, PG8_LAS unsigned char* lds) const {
        if (dry) asm volatile("s_waitcnt vmcnt(0)" ::: "memory");
        asm volatile("" : "+v"(fr), "+v"(fq));
        const int type = u.pn >> 2, wv = wr * 4 + wc;
        const int dlo_ = 32 * (wc & 1) + 8 * fq; const float* g_ = type == 1 ? kg : qg;
        const f32x4 glo_a = *(const f32x4*)(g_ + dlo_), ghi_a = *(const f32x4*)(g_ + 64 + dlo_), if_a = *(const f32x4*)(invf + dlo_), glo_b = *(const f32x4*)(g_ + dlo_ + 4), ghi_b = *(const f32x4*)(g_ + 64 + dlo_ + 4), if_b = *(const f32x4*)(invf + dlo_ + 4);
        PG8_LAS float* X = (PG8_LAS float*)(lds + STAGE_BYTES);
        PG8_LAS float* KS = X + 1024;
        { float rs8[2][4]; if (tab.ok) row_rstd8_tab(rs8, lds, tab, u.pm, wr * 64 + fr, 0); else row_rstd8(rs8, ss, u.pm * BM + wr * 64 + fr, fq);
#pragma unroll
          for (int ai = 0; ai < 2; ++ai)
#pragma unroll
            for (int m = 0; m < 4; ++m)
#pragma unroll
                for (int bj = 0; bj < 2; ++bj)
#pragma unroll
                    for (int n = 0; n < 2; ++n) acc[ai][bj][m][n] = acc[ai][bj][m][n] * rs8[ai][m]; }
        if (type == 2) {
#pragma unroll
            for (int ai = 0; ai < 2; ++ai)
#pragma unroll
                for (int m = 0; m < 4; ++m) { const int row = u.pm * BM + ai * HALF + wr * 64 + m * 16 + fr;
                    bf16_t* rowp = O + ((((size_t)(row >> 12) * 8 + 2 * (u.pn & 3)) * 3 + 2) * 4096 + (row & 4095)) * 128 + wc * 32 + 8 * fq;
#pragma unroll
                    for (int bj = 0; bj < 2; ++bj) { const f32x4 v0 = acc[ai][bj][m][0], v1 = acc[ai][bj][m][1];
                        u32x4 w; w.x = cvt_pk_bf16(v0[0], v0[1]); w.y = cvt_pk_bf16(v0[2], v0[3]); w.z = cvt_pk_bf16(v1[0], v1[1]); w.w = cvt_pk_bf16(v1[2], v1[3]);
                        st16(rowp + (size_t)bj * 3 * 4096 * 128, w); } }
        } else {
#pragma unroll
            for (int ai = 0; ai < 2; ++ai)
#pragma unroll
                for (int m = 0; m < 4; ++m) { float s = 0.f;
#pragma unroll
                    for (int bj = 0; bj < 2; ++bj)
#pragma unroll
                        for (int n = 0; n < 2; ++n) { const f32x4 v = acc[ai][bj][m][n]; s += (v[0] * v[0] + v[1] * v[1]) + (v[2] * v[2] + v[3] * v[3]); }
                    s += __shfl_xor(s, 16); s += __shfl_xor(s, 32);
                    if (fq == 0) X[wv * 128 + ai * 64 + m * 16 + fr] = s; }
        }
        asm volatile("s_waitcnt lgkmcnt(0)" ::: "memory"); __builtin_amdgcn_s_barrier(); asm volatile("" ::: "memory");
        if (type < 2 && dry != 1) {
            const int head = 2 * (u.pn & 3) + (wc >> 1), dlo = 32 * (wc & 1) + 8 * fq;
            const float* g = type ? kg : qg; const float qs = type ? 1.0f : 0.08838834764831845f;
            f32x4 clo[2], chi[2];
#pragma unroll
            for (int n = 0; n < 2; ++n) { clo[n] = (f32x4){0.f, 0.f, 0.f, 0.f}; chi[n] = clo[n]; }
#pragma unroll
            for (int ai = 0; ai < 2; ++ai)
#pragma unroll
                for (int m = 0; m < 4; ++m) {
                    const int r = ai * 64 + m * 16 + fr, row = u.pm * BM + ai * HALF + wr * 64 + m * 16 + fr; const float pos = (float)(row & 4095);
                    const float tot = X[(wv & ~1) * 128 + r] + X[(wv | 1) * 128 + r];
                    const float rh = __builtin_amdgcn_rsqf(tot * (1.0f / 128.0f) + 1e-6f);
                    u32x4 wlo, whi; unsigned pl[4], ph[4];
#pragma unroll
                    for (int n = 0; n < 2; ++n) {
                        const f32x4 glo = n ? glo_b : glo_a, ghi = n ? ghi_b : ghi_a, ifq = n ? if_b : if_a;
                        f32x4 olo, ohi;
#pragma unroll
                        for (int j = 0; j < 4; ++j) {
                            const float ylo = acc[ai][0][m][n][j] * rh * glo[j], yhi = acc[ai][1][m][n][j] * rh * ghi[j];
                            const float ang = pos * ifq[j];
                            const float rev = __builtin_amdgcn_fractf(ang * 0.15915494309189535f);
                            const float c = __builtin_amdgcn_cosf(rev), sn = __builtin_amdgcn_sinf(rev);
                            olo[j] = (ylo * c - yhi * sn) * qs; ohi[j] = (yhi * c + ylo * sn) * qs; }
                        clo[n] = clo[n] + olo; chi[n] = chi[n] + ohi;
                        pl[2 * n] = cvt_pk_bf16(olo[0], olo[1]); pl[2 * n + 1] = cvt_pk_bf16(olo[2], olo[3]); ph[2 * n] = cvt_pk_bf16(ohi[0], ohi[1]); ph[2 * n + 1] = cvt_pk_bf16(ohi[2], ohi[3]); }
                    wlo = (u32x4){pl[0], pl[1], pl[2], pl[3]}; whi = (u32x4){ph[0], ph[1], ph[2], ph[3]};
                    bf16_t* op = O + ((((size_t)(row >> 12) * 8 + head) * 3 + type) * 4096 + (row & 4095)) * 128 + dlo;
                    if (dry != 2) { st16(op, wlo); st16(op + 64, whi); }
                }
            if (type == 1) {
#pragma unroll
                for (int n = 0; n < 2; ++n)
#pragma unroll
                    for (int j = 0; j < 4; ++j) {
                        float a = clo[n][j], bsum = chi[n][j];
                        a += __shfl_xor(a, 1); a += __shfl_xor(a, 2); a += __shfl_xor(a, 4); a += __shfl_xor(a, 8);
                        bsum += __shfl_xor(bsum, 1); bsum += __shfl_xor(bsum, 2); bsum += __shfl_xor(bsum, 4); bsum += __shfl_xor(bsum, 8);
                        if (fr == 0) { KS[wv * 64 + 8 * fq + 4 * n + j] = a; KS[wv * 64 + 32 + 8 * fq + 4 * n + j] = bsum; } }
            }
        }
        asm volatile("s_waitcnt lgkmcnt(0)" ::: "memory"); __builtin_amdgcn_s_barrier(); asm volatile("" ::: "memory");
        if (type == 1 && wr == 0) {
            const int lane = fr + 16 * fq, head = 2 * (u.pn & 3) + (wc >> 1), d = 64 * (lane >> 5) + 32 * (wc & 1) + (lane & 31);
            const float s = KS[wv * 64 + lane] + KS[(wv + 4) * 64 + lane];
            kmean[((size_t)((u.pm >> 4) * 8 + head) * 16 + (u.pm & 15)) * 128 + d] = s * (1.0f / 256.0f);
        }
    }
};
template <class Epi, class Sched, bool ALIGN_EPI = false, bool SP2 = false>
__device__ __forceinline__ void gemm_phase(PG8_LAS unsigned char* lds, const Gemm g, const Sched& S, const Epi& E) {
    int tid_ = threadIdx.x; asm volatile("" : "+v"(tid_));
    const int tid = tid_, wid = __builtin_amdgcn_readfirstlane(tid >> 6), lane = tid & 63, wr = wid >> 2, wc = wid & 3, fr = lane & 15, fq = lane >> 4;
    const int K = g.K, nt = K / BK;
    unsigned voffA[2], voffB[2];
#pragma unroll
    for (int i = 0; i < 2; ++i) { int R, C; stage_rc(tid * 16 + i * 8192, R, C); const int Rb = Epi::PERM ? ((R & ~31) + perm32(R & 31)) : R;
        const int Ra = Epi::APERM ? ((R & ~63) + 4 * (R & 15) + ((R >> 4) & 3)) : R;
        voffA[i] = (unsigned)(Ra * g.lda + C) * 2u; voffB[i] = (unsigned)(Rb * K + C) * 2u; }
    const size_t kstep = (size_t)(BK * 2);
    const size_t hstepB = (size_t)HALF * K * 2, hstepA = (size_t)HALF * g.lda * 2;
    const size_t tstepA = 2 * hstepA, tstepB = 2 * hstepB;
    const unsigned ldsw = (unsigned)wid * 1024u;
    const int aoff = lds_byte(wr * 64 + fr, fq * 8), boff = lds_byte(wc * 32 + fr, fq * 8);
#define PG8_SA(b, h) (((b) * 2 + (h)) * HTB)
#define PG8_SB(b, h) ((4 + (b) * 2 + (h)) * HTB)
#define PG8_STAGE(bufoff, gbase, voff) do { _Pragma("unroll") for (int _i = 0; _i < 2; ++_i) \
        __builtin_amdgcn_global_load_lds((const unsigned*)((const char*)(gbase) + (voff)[_i]), (PG8_LAS unsigned*)(lds + (bufoff) + ldsw + _i * 8192), 16, 0, 0); } while (0)
#define PG8_LDA(dst, b, h) do { _Pragma("unroll") for (int m = 0; m < 4; ++m) _Pragma("unroll") for (int k = 0; k < 2; ++k) dst[m][k] = *(const PG8_LAS bf16x8*)(lds + PG8_SA(b, h) + aoff + m * 2048 + k * 1024); } while (0)
#define PG8_LDB(dst, b, h) do { _Pragma("unroll") for (int n = 0; n < 2; ++n) _Pragma("unroll") for (int k = 0; k < 2; ++k) dst[n][k] = *(const PG8_LAS bf16x8*)(lds + PG8_SB(b, h) + boff + n * 2048 + k * 1024); } while (0)
#define PG8_MMA(ai, bj, At, Bt) do { __builtin_amdgcn_s_setprio(1); _Pragma("unroll") for (int m = 0; m < 4; ++m) _Pragma("unroll") for (int n = 0; n < 2; ++n) _Pragma("unroll") for (int k = 0; k < 2; ++k) \
        acc[ai][bj][m][n] = __builtin_amdgcn_mfma_f32_16x16x32_bf16(Bt[n][k], At[m][k], acc[ai][bj][m][n], 0, 0, 0); __builtin_amdgcn_s_setprio(0); } while (0)
#define PG8_WAIT_V(n) asm volatile("s_waitcnt vmcnt(" #n ")" ::: "memory")
#define PG8_WAIT_L(n) asm volatile("s_waitcnt lgkmcnt(" #n ")" ::: "memory")
#define PG8_BAR __builtin_amdgcn_s_barrier()
#define PG8_SCHED __builtin_amdgcn_sched_barrier(0)
    Unit cur, nxt; int ui = 0;
    if (!S.next(0, cur)) return;
    f32x4 acc[2][2][4][2];
#pragma unroll
    for (int a = 0; a < 2; ++a)
#pragma unroll
        for (int b = 0; b < 2; ++b)
#pragma unroll
            for (int m = 0; m < 4; ++m)
#pragma unroll
                for (int n = 0; n < 2; ++n) acc[a][b][m][n] = (f32x4){0.f, 0.f, 0.f, 0.f};
    bf16x8 At[4][2], B0[2][2], B1[2][2];
    const char* cA = (const char*)g.A + (size_t)cur.pm * tstepA; const char* cB = (const char*)g.Bt + (size_t)cur.pn * tstepB;
    S.a_ready(cur);
    if constexpr (SP2) {
        PG8_STAGE(PG8_SB(0, 0), cB, voffB); PG8_STAGE(PG8_SB(0, 1), cB + hstepB, voffB); PG8_STAGE(PG8_SA(0, 0), cA, voffA); PG8_STAGE(PG8_SA(0, 1), cA + hstepA, voffA);
        if (wr == 1) PG8_BAR;
        PG8_WAIT_V(2); PG8_BAR;
        PG8_STAGE(PG8_SB(1, 0), cB + kstep, voffB); PG8_STAGE(PG8_SA(1, 0), cA + kstep, voffA); PG8_STAGE(PG8_SB(1, 1), cB + hstepB + kstep, voffB);
        PG8_WAIT_V(6); PG8_BAR;
    } else {
        PG8_STAGE(PG8_SB(0, 0), cB, voffB); PG8_STAGE(PG8_SA(0, 0), cA, voffA); PG8_STAGE(PG8_SB(0, 1), cB + hstepB, voffB); PG8_STAGE(PG8_SA(0, 1), cA + hstepA, voffA);
        if (wr == 1) PG8_BAR;
        PG8_WAIT_V(4); PG8_BAR;
        PG8_STAGE(PG8_SB(1, 0), cB + kstep, voffB); PG8_STAGE(PG8_SA(1, 0), cA + kstep, voffA); PG8_STAGE(PG8_SB(1, 1), cB + hstepB + kstep, voffB);
        PG8_WAIT_V(6); PG8_BAR;
    }
    constexpr bool PRE = PG8_PRE && SP2 && ALIGN_EPI;
    for (;;) {
        const bool has_next = S.next(ui + 1, nxt);
        const char* nA = has_next ? (const char*)g.A + (size_t)nxt.pm * tstepA : cA; const char* nB = has_next ? (const char*)g.Bt + (size_t)nxt.pn * tstepB : cB;
        for (int t = 0; t < nt; t += 2) {
            const bool last = (t == nt - 2);
            const char* a1 = cA + (size_t)(t + 1) * kstep;
            const char* a2 = last ? nA : cA + (size_t)(t + 2) * kstep; const char* b2 = last ? nB : cB + (size_t)(t + 2) * kstep;
            const char* a3 = a2 + kstep; const char* b3 = b2 + kstep;
            int pre_s = __builtin_amdgcn_readfirstlane(t | (ui == 0)); asm volatile("" : "+s"(pre_s)); const bool pre = PRE && pre_s == 0;
            if (last && has_next) S.a_ready(nxt);
            if constexpr (SP2) {
            PG8_LDB(B0, 0, 0); PG8_LDB(B1, 0, 1); PG8_SCHED; PG8_LDA(At, 0, 0); if (!(PRE && pre)) PG8_STAGE(PG8_SA(1, 1), a1 + hstepA, voffA);
            if (PRE && pre) asm volatile("s_waitcnt vmcnt(%0)" :: "n"(Epi::NST) : "memory"); else PG8_WAIT_V(8);
            if constexpr (Epi::PF) { int pf_s = __builtin_amdgcn_readfirstlane(t - (nt - PG8_PF_DIST)); asm volatile("" : "+s"(pf_s)); if (pf_s == 0) E.prefetch(cur, tid, wid, lds); }
            PG8_WAIT_L(0); PG8_BAR; PG8_MMA(0, 0, At, B0); PG8_MMA(0, 1, At, B1); PG8_BAR; PG8_SCHED;
            PG8_LDA(At, 0, 1); PG8_STAGE(PG8_SB(0, 0), b2, voffB); PG8_STAGE(PG8_SB(0, 1), b2 + hstepB, voffB); PG8_STAGE(PG8_SA(0, 0), a2, voffA);
            if (!(PRE && pre)) PG8_WAIT_V(8);
            PG8_WAIT_L(0); PG8_BAR; PG8_MMA(1, 0, At, B0); PG8_MMA(1, 1, At, B1); PG8_BAR; PG8_SCHED;
            PG8_LDB(B0, 1, 0); PG8_LDB(B1, 1, 1); PG8_SCHED; PG8_LDA(At, 1, 0); PG8_STAGE(PG8_SA(0, 1), a2 + hstepA, voffA);
            if (!(PRE && pre)) PG8_WAIT_V(8);
            PG8_WAIT_L(0); PG8_BAR; PG8_MMA(0, 0, At, B0); PG8_MMA(0, 1, At, B1); PG8_BAR; PG8_SCHED;
            PG8_LDA(At, 1, 1); PG8_STAGE(PG8_SB(1, 0), b3, voffB); PG8_STAGE(PG8_SB(1, 1), b3 + hstepB, voffB); PG8_STAGE(PG8_SA(1, 0), a3, voffA);
            PG8_WAIT_V(8); PG8_WAIT_L(0); PG8_BAR; PG8_MMA(1, 0, At, B0); PG8_MMA(1, 1, At, B1); PG8_BAR; PG8_SCHED;
            } else {
            PG8_LDB(B0, 0, 0); PG8_SCHED; PG8_LDA(At, 0, 0); PG8_STAGE(PG8_SA(1, 1), a1 + hstepA, voffA);
            PG8_WAIT_L(8); PG8_BAR; PG8_WAIT_L(0); PG8_MMA(0, 0, At, B0); PG8_BAR; PG8_SCHED;
            PG8_LDB(B1, 0, 1); PG8_STAGE(PG8_SB(0, 0), b2, voffB);
            PG8_BAR; PG8_WAIT_L(0); PG8_MMA(0, 1, At, B1); PG8_BAR;
            PG8_LDA(At, 0, 1); PG8_STAGE(PG8_SA(0, 0), a2, voffA);
            PG8_BAR; PG8_WAIT_L(0); PG8_MMA(1, 0, At, B0); PG8_BAR; PG8_SCHED;
            PG8_STAGE(PG8_SB(0, 1), b2 + hstepB, voffB);
            PG8_WAIT_V(6); PG8_BAR; PG8_MMA(1, 1, At, B1); PG8_BAR;
            PG8_LDB(B0, 1, 0); PG8_SCHED; PG8_LDA(At, 1, 0); PG8_STAGE(PG8_SA(0, 1), a2 + hstepA, voffA);
            PG8_WAIT_L(8); PG8_BAR; PG8_WAIT_L(0); PG8_MMA(0, 0, At, B0); PG8_BAR; PG8_SCHED;
            PG8_LDB(B1, 1, 1); PG8_STAGE(PG8_SB(1, 0), b3, voffB);
            PG8_BAR; PG8_WAIT_L(0); PG8_MMA(0, 1, At, B1); PG8_BAR;
            PG8_LDA(At, 1, 1); PG8_STAGE(PG8_SA(1, 0), a3, voffA);
            PG8_BAR; PG8_WAIT_L(0); PG8_MMA(1, 0, At, B0); PG8_BAR; PG8_SCHED;
            PG8_STAGE(PG8_SB(1, 1), b3 + hstepB, voffB);
            PG8_WAIT_V(6); PG8_BAR; PG8_MMA(1, 1, At, B1); PG8_BAR;
            }
        }
        if constexpr (ALIGN_EPI) { if (wr == 0) PG8_BAR; }
        if constexpr (PRE) { if (has_next) { PG8_STAGE(PG8_SA(1, 1), nA + kstep + hstepA, voffA); } }
        if constexpr (!Epi::AFTER_DRAIN) { E(acc, cur, wr, wc, fr, fq, lds); S.done(cur); }
        if (!has_next) break;
#pragma unroll
        for (int a = 0; a < 2; ++a)
#pragma unroll
            for (int b = 0; b < 2; ++b)
#pragma unroll
                for (int m = 0; m < 4; ++m)
#pragma unroll
                    for (int n = 0; n < 2; ++n) acc[a][b][m][n] = (f32x4){0.f, 0.f, 0.f, 0.f};
        cur = nxt; cA = nA; cB = nB; ++ui;
        if constexpr (ALIGN_EPI) { if (wr == 1) PG8_BAR; }
    }
    PG8_WAIT_V(0);
    if constexpr (!ALIGN_EPI) { if (wr == 0) PG8_BAR; }
    PG8_BAR;
    if constexpr (Epi::AFTER_DRAIN) { E.fused(acc, cur, wr, wc, fr, fq, lds, wid, lane); S.done(cur); }
#undef PG8_SA
#undef PG8_SB
#undef PG8_STAGE
#undef PG8_LDA
#undef PG8_LDB
#undef PG8_MMA
#undef PG8_WAIT_V
#undef PG8_WAIT_L
#undef PG8_BAR
#undef PG8_SCHED
}
}
#ifndef PROBE_DUP
#define PROBE_DUP 0
#endif
constexpr int BATCH = 8, SEQ = 4096, DM = 1024, MROWS = BATCH * SEQ, DEPTH = 4;
constexpr int NH = 8, HD = 128;
constexpr int FF = 3072, NBLK = 16, MBLK = 256;
constexpr float QSCALE = 0.08838834764831845f;
typedef unsigned short bf16;
typedef float f32x4 __attribute__((ext_vector_type(4)));
typedef unsigned u32x4 __attribute__((ext_vector_type(4)));

constexpr size_t MiB = 1u << 20;
constexpr size_t WS_CTL = 0, CTL_ZERO_BYTES = 64 * 1024;
constexpr size_t WS_WIN = 2 * MiB, WS_WQKV = 18 * MiB, WS_WOH = 30 * MiB, WS_WOM = 34 * MiB, WS_WUP = 38 * MiB, WS_WDN = 86 * MiB;
constexpr size_t WS_SS = 110 * MiB, WS_COS = 112 * MiB, WS_SIN = 113 * MiB, WS_LBV = 114 * MiB, WS_KMEAN = 115 * MiB;
constexpr size_t WS_INVF = 114 * MiB + 16384;
constexpr size_t WS_HGD = 115 * MiB + 512 * 1024, WS_HGE = 116 * MiB;
constexpr size_t WS_TAIL = 132 * MiB, WS_HEADA = 135 * MiB, WS_HEADU = 138 * MiB;
constexpr size_t WS_XB = 144 * MiB, WS_BIG = 208 * MiB, WS_AU = 400 * MiB, WS_ML = 464 * MiB, WS_END = 472 * MiB;

__device__ __forceinline__ float bf2f(bf16 v) { return __uint_as_float((unsigned)v << 16); }
__device__ __forceinline__ bf16 f2bf(float f) { unsigned u = __float_as_uint(f); return (bf16)((u + 0x7fffu + ((u >> 16) & 1u)) >> 16); }
__device__ __forceinline__ float wave_sum(float v) {
#pragma unroll
    for (int o = 1; o < 64; o <<= 1) v += __shfl_xor(v, o);
    return v;
}
__device__ __forceinline__ float wave_max(float v) {
#pragma unroll
    for (int o = 1; o < 64; o <<= 1) v = fmaxf(v, __shfl_xor(v, o));
    return v;
}

__device__ __forceinline__ void glu_fixup_elem(int pm, int rr, int f, bf16* __restrict__ g, const float* __restrict__ tail, const float* __restrict__ head_a, const float* __restrict__ head_u, const float* __restrict__ cw, const float* __restrict__ cb) {
    const bool first = (pm & 15) == 0;
    const float cur = head_a[((size_t)pm * 2 + rr) * FF + f];
    const float t1 = first ? 0.f : tail[((size_t)(pm - 1) * 2 + 1) * FF + f], t0 = first ? 0.f : tail[((size_t)(pm - 1) * 2 + 0) * FF + f];
    const float prev1 = rr == 0 ? t1 : head_a[((size_t)pm * 2) * FF + f], prev2 = rr == 0 ? t0 : t1;
    const float c = cw[f] * prev2 + cw[FF + f] * prev1 + cw[2 * FF + f] * cur + cb[f];
    g[((size_t)pm * 256 + rr) * FF + f] = f2bf(c / (1.0f + __expf(-c)) * head_u[((size_t)pm * 2 + rr) * FF + f]);
}
#define XB_TMO      128
#define XB_XCNT(j)  (256  + 64 * (j))
#define XB_XSUB(j)  (1280 + 64 * (j))
#define XB_XGEN(j)  (2304 + 64 * (j))
#define XB_TOP      3328
#define XB_TOPGEN   3392
#define XCD_BAR_WORDS 3456
#define XB_SPIN_CAP (1u << 18)
#define LAS __attribute__((address_space(3)))

__device__ __forceinline__ unsigned xb_ld(unsigned* p)              { return __hip_atomic_load(p, __ATOMIC_RELAXED, __HIP_MEMORY_SCOPE_AGENT); }
__device__ __forceinline__ unsigned xb_add(unsigned* p, unsigned v) { return __hip_atomic_fetch_add(p, v, __ATOMIC_RELAXED, __HIP_MEMORY_SCOPE_AGENT); }
__device__ __forceinline__ unsigned xb_xcc_id() { return (unsigned)__builtin_amdgcn_s_getreg((3 << 11) | 20) & 0xFu; }
#define XB_SPIN(cond, bar) do { unsigned _sp = 0; while (cond) { __builtin_amdgcn_s_sleep(1); \
    if ((++_sp & 255u) == 0u) { if (xb_ld(&(bar)[XB_TMO])) break; if (_sp > XB_SPIN_CAP) { atomicAdd(&(bar)[XB_TMO], 1u); break; } } } } while (0)

struct XcdBarrier {
    unsigned* bar; unsigned x;
    volatile LAS unsigned* st;
};

__device__ __forceinline__ XcdBarrier xcd_barrier_post(unsigned* bar, volatile LAS unsigned* st) {
    XcdBarrier b; b.bar = bar; b.x = xb_xcc_id(); b.st = st;
    if (threadIdx.x == 0) (void)xb_add(&bar[XB_XCNT(b.x)], 1u);
    return b;
}
__device__ __forceinline__ void xcd_barrier_complete(unsigned* bar, unsigned x, unsigned& nloc, unsigned& nx) {
    const unsigned G = gridDim.x * gridDim.y * gridDim.z;
    unsigned sum, cnt, mine, sp = 0u;
    for (;;) {
        sum = 0u; cnt = 0u; mine = 0u;
#pragma unroll
        for (unsigned j = 0; j < 16; ++j) { const unsigned c = xb_ld(&bar[XB_XCNT(j)]); sum += c; cnt += (c > 0u) ? 1u : 0u; mine = (j == x) ? c : mine; }
        if (sum == G) break;
        __builtin_amdgcn_s_sleep(1);
        if ((++sp & 255u) == 0u) { if (xb_ld(&bar[XB_TMO])) break; if (sp > XB_SPIN_CAP) { atomicAdd(&bar[XB_TMO], 1u); break; } }
    }
    nloc = mine > 0u ? mine : 1u; nx = cnt > 0u ? cnt : 1u;
}

__device__ __forceinline__ void xcd_barrier(const XcdBarrier& b) {
    asm volatile("s_waitcnt vmcnt(0)" ::: "memory");
    __syncthreads();
    if (threadIdx.x == 0) {
        unsigned* bar = b.bar;
        __builtin_amdgcn_s_waitcnt(0);
        unsigned nloc = b.st[0], nx = b.st[1];
        if (nloc == 0u) { xcd_barrier_complete(bar, b.x, nloc, nx); b.st[0] = nloc; b.st[1] = nx; }
        const unsigned old = xb_add(&bar[XB_XSUB(b.x)], 1u);
        const unsigned gen = old / nloc;
        if (old + 1u == (gen + 1u) * nloc) {
            __builtin_amdgcn_fence(__ATOMIC_RELEASE, "agent");
            asm volatile("s_waitcnt vmcnt(0)" ::: "memory");
            const unsigned og = xb_add(&bar[XB_TOP], 1u);
            const unsigned tg = og / nx;
            if (og + 1u == (tg + 1u) * nx) xb_add(&bar[XB_TOPGEN], 1u);
            else XB_SPIN(xb_ld(&bar[XB_TOPGEN]) == tg, bar);
            __builtin_amdgcn_fence(__ATOMIC_ACQUIRE, "agent");
            xb_add(&bar[XB_XGEN(b.x)], 1u);
            asm volatile("s_waitcnt vmcnt(0)" ::: "memory");
        } else {
            XB_SPIN(xb_ld(&bar[XB_XGEN(b.x)]) == gen, bar);
            __builtin_amdgcn_fence(__ATOMIC_ACQUIRE, "agent");
            asm volatile("s_waitcnt vmcnt(0)" ::: "memory");
        }
    }
    __syncthreads();
}
namespace mb {
typedef short bf16x8 __attribute__((ext_vector_type(8)));
typedef short s16x4 __attribute__((ext_vector_type(4)));
typedef float f32x16 __attribute__((ext_vector_type(16)));
typedef float f32x2 __attribute__((ext_vector_type(2)));
#ifndef MOBA_SPARSE
#define MOBA_SPARSE 0
#endif
constexpr int D = 128, LDR = 128, ARR = 4096 * 128, NW = 8, QBLK = 32, KVBLK = 64, QB = NW * QBLK;
static_assert(!MOBA_SPARSE, "the sparse sub-phases below still address the token-major q|k|v layout");
constexpr int SHM_V = KVBLK * D * 2, SHM_K = KVBLK * D * 2;
constexpr int OFF_WS = 2 * SHM_V + 2 * SHM_K, OFF_KM = OFF_WS + NW * 64 * 4, ATT_LDS_BYTES = OFF_KM + 16 * 128 * 4;
constexpr float THR = 8.f;
#define KSWZ(row, colB) ((row) * 256 + ((colB) ^ (((row) & 7) << 4)))
#define SBAR() __builtin_amdgcn_sched_barrier(0)
__device__ __forceinline__ int v_st(int k, int c) { const int kk = (k & ~0xC) | ((k & 4) << 1) | ((k & 8) >> 1); return ((kk >> 3) * 4 + (c >> 5)) * 512 + ((kk & 7) * 32 + (c & 31)) * 2; }
__device__ __forceinline__ int v_rd_base(int lane) { return ((lane & 3) << 3) | (((lane >> 2) & 3) << 6) | (((lane >> 4) & 1) << 5) | (((lane >> 5) & 1) << 8); }
constexpr int v_rd_off(int d0, int ks, int half) { return d0 * 512 + ks * 4096 + half * 2048; }
__device__ __forceinline__ int crow(int r, int hi) { return (r & 3) + 8 * (r >> 2) + 4 * hi; }
__device__ __forceinline__ unsigned cvtpk(float lo, float hi) { unsigned r; asm volatile("v_cvt_pk_bf16_f32 %0, %1, %2" : "=v"(r) : "v"(lo), "v"(hi)); return r; }
__device__ __forceinline__ bf16x8 load8(const bf16* p) { return *reinterpret_cast<const bf16x8*>(p); }
__device__ __forceinline__ void mask_causal(f32x16& p0, f32x16& p1, int dq) {
    const float NEG = -__builtin_inff();
#pragma unroll
    for (int r = 0; r < 16; ++r) { const int c = (r & 3) + 8 * (r >> 2); if (dq - c < 0) p0[r] = NEG; if (dq - c - 32 < 0) p1[r] = NEG; }
}
__device__ __forceinline__ void mask_all(f32x16& p0, f32x16& p1, bool keep) {
    const float NEG = -__builtin_inff();
#pragma unroll
    for (int r = 0; r < 16; ++r) { p0[r] = keep ? p0[r] : NEG; p1[r] = keep ? p1[r] : NEG; }
}
__device__ __forceinline__ void partialSM(f32x16& p0, f32x16& p1, float& m_reg, float& mn, float& alpha, bool keep = true) {
    float pmax = p0[0]; for (int r = 1; r < 16; ++r) pmax = fmaxf(pmax, p0[r]); for (int r = 0; r < 16; ++r) pmax = fmaxf(pmax, p1[r]);
    pmax = keep ? pmax : -__builtin_inff();
    { auto rr = __builtin_amdgcn_permlane32_swap(__float_as_uint(pmax), __float_as_uint(pmax), false, false);
      pmax = fmaxf(__uint_as_float(rr[0]), __uint_as_float(rr[1])); }
    constexpr float C2 = 1.4426950408889634f;
    if (__builtin_expect(__all((pmax - m_reg) <= THR), 1)) { mn = m_reg; alpha = 1.f; }
    else { mn = fmaxf(m_reg, pmax); alpha = __builtin_amdgcn_exp2f((m_reg - mn) * C2); m_reg = mn; }
    const float mnL = keep ? -mn * C2 : -__builtin_inff();
    { f32x16 c2v, mlv;
#pragma unroll
      for (int r = 0; r < 16; ++r) { c2v[r] = C2; mlv[r] = mnL; }
      p0 = __builtin_elementwise_fma(p0, c2v, mlv); p1 = __builtin_elementwise_fma(p1, c2v, mlv); }
    for (int r = 0; r < 16; ++r) p0[r] = __builtin_amdgcn_exp2f(p0[r]);
}
__device__ __forceinline__ void finishSM(f32x16& p0, f32x16& p1, float alpha, float& l_reg, bf16x8& pa0, bf16x8& pa1, bf16x8& pa2, bf16x8& pa3) {
    for (int r = 0; r < 16; ++r) p1[r] = __builtin_amdgcn_exp2f(p1[r]);
    float ps;
    { const f32x16 s16 = p0 + p1;
      typedef float f32x8_t __attribute__((ext_vector_type(8))); typedef float f32x4_t __attribute__((ext_vector_type(4))); typedef float f32x2_t __attribute__((ext_vector_type(2)));
      const f32x8_t s8 = __builtin_shufflevector(s16, s16, 0, 1, 2, 3, 4, 5, 6, 7) + __builtin_shufflevector(s16, s16, 8, 9, 10, 11, 12, 13, 14, 15);
      const f32x4_t s4 = __builtin_shufflevector(s8, s8, 0, 1, 2, 3) + __builtin_shufflevector(s8, s8, 4, 5, 6, 7);
      const f32x2_t s2 = __builtin_shufflevector(s4, s4, 0, 1) + __builtin_shufflevector(s4, s4, 2, 3);
      ps = s2[0] + s2[1]; }
    { auto rr = __builtin_amdgcn_permlane32_swap(__float_as_uint(ps), __float_as_uint(ps), false, false);
      ps = __uint_as_float(rr[0]) + __uint_as_float(rr[1]); }
    l_reg = l_reg * alpha + ps;
#define PK4(P, B_, OUT) do { unsigned a0 = cvtpk(P[B_+0], P[B_+1]), a1 = cvtpk(P[B_+2], P[B_+3]);                          \
        unsigned b0 = cvtpk(P[B_+4], P[B_+5]), b1 = cvtpk(P[B_+6], P[B_+7]);                                             \
        auto r0 = __builtin_amdgcn_permlane32_swap(a0, b0, false, false); auto r1 = __builtin_amdgcn_permlane32_swap(a1, b1, false, false); \
        u32x4 w = {r0[0], r1[0], r0[1], r1[1]}; OUT = *reinterpret_cast<bf16x8*>(&w); } while (0)
    PK4(p0, 0, pa0); PK4(p0, 8, pa1); PK4(p1, 0, pa2); PK4(p1, 8, pa3);
#undef PK4
}
template <int KB>
__device__ __forceinline__ void qkt(f32x16& p0, f32x16& p1, const char* K_lds, int r32, int hi, const bf16x8* qr) {
    p0 = f32x16{}; p1 = f32x16{};
    const char* kb[4];
#pragma unroll
    for (int dd = 0; dd < 4; ++dd) kb[dd] = K_lds + KB * SHM_K + KSWZ(r32, (dd * 16 + hi * 8) * 2);
#pragma unroll
    for (int d0 = 0; d0 < 8; ++d0) { const char* a = kb[d0 & 3] + (d0 >> 2) * 128;
        bf16x8 b0 = *reinterpret_cast<const bf16x8*>(a);
        bf16x8 b1 = *reinterpret_cast<const bf16x8*>(a + 32 * 256);
        p0 = __builtin_amdgcn_mfma_f32_32x32x16_bf16(b0, qr[d0], p0, 0, 0, 0);
        p1 = __builtin_amdgcn_mfma_f32_32x32x16_bf16(b1, qr[d0], p1, 0, 0, 0); }
}
template <int VB>
__device__ __forceinline__ void pv_tile(f32x16* o, int vb0, bf16x8 pa0, bf16x8 pa1, bf16x8 pa2, bf16x8 pa3) {
#define TRRD(dst, off) asm volatile("ds_read_b64_tr_b16 %0, %1 offset:%2" : "=&v"(dst) : "v"(vb0), "i"(off) : "memory")
#define PV_D0(d0) do { s16x4 l0, l1, l2, l3, h0, h1, h2, h3; constexpr int b_ = VB * SHM_V + v_rd_off(d0, 0, 0);   \
        TRRD(l0, b_); TRRD(h0, b_ + 2048); TRRD(l1, b_ + 4096); TRRD(h1, b_ + 6144); TRRD(l2, b_ + 8192); TRRD(h2, b_ + 10240); TRRD(l3, b_ + 12288); TRRD(h3, b_ + 14336); \
        asm volatile("s_waitcnt lgkmcnt(0)" ::: "memory"); SBAR();   \
        o[d0] = __builtin_amdgcn_mfma_f32_32x32x16_bf16(pa0, (bf16x8){l0[0], l0[1], l0[2], l0[3], h0[0], h0[1], h0[2], h0[3]}, o[d0], 0, 0, 0);   \
        o[d0] = __builtin_amdgcn_mfma_f32_32x32x16_bf16(pa1, (bf16x8){l1[0], l1[1], l1[2], l1[3], h1[0], h1[1], h1[2], h1[3]}, o[d0], 0, 0, 0);   \
        o[d0] = __builtin_amdgcn_mfma_f32_32x32x16_bf16(pa2, (bf16x8){l2[0], l2[1], l2[2], l2[3], h2[0], h2[1], h2[2], h2[3]}, o[d0], 0, 0, 0);   \
        o[d0] = __builtin_amdgcn_mfma_f32_32x32x16_bf16(pa3, (bf16x8){l3[0], l3[1], l3[2], l3[3], h3[0], h3[1], h3[2], h3[3]}, o[d0], 0, 0, 0); } while (0)
    PV_D0(0); PV_D0(1); PV_D0(2); PV_D0(3);
#undef PV_D0
#undef TRRD
}

struct BlockRef { const bf16* Q; const bf16* K; const bf16* V; bf16* O; const float* KM; int iblk, ldo, store, bh; };
struct Partials { bf16* P[3]; float* ML; };
struct Seam { bf16x8 qr[8]; bf16x8 st_v0, st_v1, st_k0, st_k1; };
#define ROW(p, k0, rr) ((p) + (size_t)((k0) + (rr)) * LDR + sc)
#define VMW() asm volatile("s_waitcnt vmcnt(0)" ::: "memory")
#define VMWN(n) asm volatile("s_waitcnt vmcnt(%0)" :: "i"(n) : "memory")
#define SLOAD_H(Kp, Vp, k0) do { const bf16* k_ = (Kp) + (size_t)(k0) * LDR; const bf16* v_ = (Vp) + (size_t)(k0) * LDR;                     \
                         S.st_v0 = load8(v_ + (size_t)soff); S.st_v1 = load8(v_ + (size_t)32 * LDR + (size_t)soff);                       \
                         S.st_k0 = load8(k_ + (size_t)soff); S.st_k1 = load8(k_ + (size_t)32 * LDR + (size_t)soff); } while (0)
#define SWRITE_HK(bf) do { *(bf16x8*)(K_lds + (bf) * SHM_K + kws) = S.st_k0; *(bf16x8*)(K_lds + (bf) * SHM_K + kws + 32 * 256) = S.st_k1; } while (0)
#define SWRITE_HV(bf) do { *(bf16x8*)(V_lds + (bf) * SHM_V + vst0) = S.st_v0; *(bf16x8*)(V_lds + (bf) * SHM_V + vst1) = S.st_v1; } while (0)
#define SWRITE_H(bf) do { SWRITE_HV(bf); SWRITE_HK(bf); } while (0)
__device__ __forceinline__ void moba_prime(const BlockRef& cur, char* lds, Seam& S, int tid) {
    const int t0c = MOBA_SPARSE ? 4 * cur.iblk : 0;
    const int wid = __builtin_amdgcn_readfirstlane(tid >> 6), lane = tid & 63, r32 = lane & 31, hi = lane >> 5;
    const int sr = tid >> 4, sc = (tid & 15) * 8, kws = KSWZ(sr, sc * 2); char* K_lds = lds + 2 * SHM_V;
    const unsigned soff = (unsigned)(sr * LDR + sc), qoff = (unsigned)(r32 * LDR + hi * 8);
    { const bf16* qb = cur.Q + (size_t)(wid * QBLK) * LDR;
#pragma unroll
      for (int d0 = 0; d0 < 8; ++d0) S.qr[d0] = load8(qb + (size_t)qoff + d0 * 16); }
    SLOAD_H(cur.K, cur.V, t0c * KVBLK); VMW(); SWRITE_HK(0);
    __syncthreads();
}
__device__ __forceinline__ void moba_block(const BlockRef& cur, const BlockRef& nxt, const Partials& PP, char* lds, Seam& S, int tid) {
    const int wid = __builtin_amdgcn_readfirstlane(tid >> 6), lane = tid & 63, r32 = lane & 31, hi = lane >> 5;
    const int iblk = cur.iblk, t0 = MOBA_SPARSE ? 4 * iblk : 0, NT = MOBA_SPARSE ? 4 : 4 * (iblk + 1), P0 = iblk * QB;
    const int qlo = P0 + wid * QBLK, qm = qlo + r32 - 4 * hi;
    unsigned sel = 0u; char* KMt = lds + OFF_KM;
    if (!MOBA_SPARSE && iblk > 0) {
        int t4 = tid; asm volatile("" : "+v"(t4));
        { const f32x4 km = *(const f32x4*)(cur.KM + t4 * 4); const int jrow = t4 >> 5, colB = (t4 & 31) * 8;
          const unsigned h01 = cvtpk(km[0], km[1]), h23 = cvtpk(km[2], km[3]);
          const float r0 = km[0] - __uint_as_float(h01 << 16), r1 = km[1] - __uint_as_float(h01 & 0xffff0000u), r2 = km[2] - __uint_as_float(h23 << 16), r3 = km[3] - __uint_as_float(h23 & 0xffff0000u);
          const unsigned l01 = cvtpk(r0, r1), l23 = cvtpk(r2, r3);
          typedef unsigned u32x2_t __attribute__((ext_vector_type(2)));
          *(u32x2_t*)(KMt + KSWZ(jrow, colB)) = (u32x2_t){h01, h23}; *(u32x2_t*)(KMt + KSWZ(16 + jrow, colB)) = (u32x2_t){l01, l23}; }
        __syncthreads();
        f32x16 pg = f32x16{};
        { const char* kb[4];
#pragma unroll
          for (int dd = 0; dd < 4; ++dd) kb[dd] = KMt + KSWZ(r32, (dd * 16 + hi * 8) * 2);
#pragma unroll
          for (int d0 = 0; d0 < 8; ++d0) pg = __builtin_amdgcn_mfma_f32_32x32x16_bf16(*reinterpret_cast<const bf16x8*>(kb[d0 & 3] + (d0 >> 2) * 128), S.qr[d0], pg, 0, 0, 0); }
        float own[8], oth[8];
#pragma unroll
        for (int r = 0; r < 8; ++r) { own[r] = pg[r] + pg[r + 8]; oth[r] = __shfl_xor(own[r], 32); }
        float v1 = -__builtin_inff(), v2 = v1, v3 = v1; int i1 = -1, i2 = -1, i3 = -1;
#pragma unroll
        for (int j = 0; j < 16; ++j) {
            const int rr = (j & 3) + 4 * (j >> 3); const bool mine = ((j >> 2) & 1) == hi;
            const float a = mine ? own[rr] : oth[rr];
            if (j < iblk) {
                if (a > v1) { v3 = v2; i3 = i2; v2 = v1; i2 = i1; v1 = a; i1 = j; }
                else if (a > v2) { v3 = v2; i3 = i2; v2 = a; i2 = j; }
                else if (a > v3) { v3 = a; i3 = j; } }
        }
        sel = (i1 >= 0 ? 1u << i1 : 0u) | (i2 >= 0 ? 1u << i2 : 0u) | (i3 >= 0 ? 1u << i3 : 0u);
    }
    char* V_lds = lds; char* K_lds = lds + 2 * SHM_V;
    float* ws = (float*)(lds + OFF_WS) + wid * 64; float* li_l = ws, * al_l = ws + 32;
    float m_reg = -1e30f, l_reg = 0; f32x16 o[4] = {};
    const int sr = tid >> 4, sc = (tid & 15) * 8, vst0 = v_st(sr, sc), vst1 = v_st(32 + sr, sc), kws = KSWZ(sr, sc * 2);
    const unsigned soff = (unsigned)(sr * LDR + sc), qoff = (unsigned)(r32 * LDR + hi * 8);
    const int vb0 = (int)(uintptr_t)V_lds + v_rd_base(lane);
    const bf16* Kh = cur.K; const bf16* Vh = cur.V;
#define RESC(a) do { if (__any((a) < 1.f)) { if (hi == 0) al_l[r32] = (a); asm volatile("s_waitcnt lgkmcnt(0)" ::: "memory");              \
                     for (int d_ = 0; d_ < 4; ++d_) for (int r = 0; r < 16; ++r) o[d_][r] *= al_l[crow(r, hi)]; } } while (0)
#define KBASE(t) ((t0 + (t)) * KVBLK)
#define MASKT(P0_, P1_, t, KEEP_) do { const int kb_ = KBASE(t); const int bj_ = (t0 + (t)) >> 2; KEEP_ = true; \
        if (bj_ == iblk) { if (kb_ + KVBLK - 1 > qlo) mask_causal(P0_, P1_, qm - kb_); } else KEEP_ = ((sel >> bj_) & 1u) != 0u; } while (0)
    constexpr int NQL = 8;
#define SEAM_K0() do { VMWN(NQL); SWRITE_HK(0); SBAR(); } while (0)
    f32x16 pA0, pA1, pB0, pB1; float mnA, mnB, alA, alB; bf16x8 pa0, pa1, pa2, pa3;
    SWRITE_HV(0); SBAR();
    if (NT > 1) SLOAD_H(Kh, Vh, KBASE(1));
    SBAR(); qkt<0>(pA0, pA1, K_lds, r32, hi, S.qr);
    { bool kp_; MASKT(pA0, pA1, 0, kp_); partialSM(pA0, pA1, m_reg, mnA, alA, kp_); }
    if (NT > 1) { VMW(); SWRITE_H(1); }
    __syncthreads();
#define HALF_STEP(PX0, PX1, mnX, alX, PY0, PY1, alY, t, KB, VB, SB) do {                                                      \
        SBAR(); qkt<KB>(PX0, PX1, K_lds, r32, hi, S.qr);                                                                      \
        finishSM(PY0, PY1, alY, l_reg, pa0, pa1, pa2, pa3); SBAR();                                                           \
        if ((t) + 1 < NT) { SLOAD_H(Kh, Vh, KBASE((t) + 1)); SBAR(); }                                                        \
        pv_tile<VB>(o, vb0, pa0, pa1, pa2, pa3); { bool kp_; MASKT(PX0, PX1, (t), kp_); partialSM(PX0, PX1, m_reg, mnX, alX, kp_); } \
        __syncthreads();                                                                                                      \
        if ((t) + 1 < NT) { VMW(); SWRITE_H(SB); }                                                                            \
        RESC(alX); __syncthreads(); } while (0)
    for (int t = 1; t + 1 < NT; t += 2) {
        HALF_STEP(pB0, pB1, mnB, alB, pA0, pA1, alA, t, 1, 0, 0);
        HALF_STEP(pA0, pA1, mnA, alA, pB0, pB1, alB, t + 1, 0, 1, 1);
    }
    SBAR(); qkt<1>(pB0, pB1, K_lds, r32, hi, S.qr); SBAR();
    SLOAD_H(nxt.K, nxt.V, (MOBA_SPARSE ? 4 * nxt.iblk : 0) * KVBLK); SBAR();
    { const bf16* qb = nxt.Q + (size_t)(wid * QBLK) * LDR;
#pragma unroll
      for (int d0 = 0; d0 < 8; ++d0) S.qr[d0] = load8(qb + (size_t)qoff + d0 * 16); }
    SBAR();
    finishSM(pA0, pA1, alA, l_reg, pa0, pa1, pa2, pa3); SBAR();
    pv_tile<0>(o, vb0, pa0, pa1, pa2, pa3);
    { bool kp_; MASKT(pB0, pB1, NT - 1, kp_); partialSM(pB0, pB1, m_reg, mnB, alB, kp_); } __syncthreads(); RESC(alB);
    finishSM(pB0, pB1, alB, l_reg, pa0, pa1, pa2, pa3); SBAR(); pv_tile<1>(o, vb0, pa0, pa1, pa2, pa3);
    SBAR(); SEAM_K0();
    int hi_e = hi; asm volatile("" : "+v"(hi_e));
    const int ldo = cur.ldo; bf16* Ow = cur.O + (size_t)(wid * QBLK) * ldo;
    const unsigned ooff = (unsigned)(4 * hi_e * ldo + r32);
    if (!MOBA_SPARSE) {
        if (hi == 0) li_l[r32] = l_reg; asm volatile("s_waitcnt lgkmcnt(0)" ::: "memory");
        float rli[16];
#pragma unroll
        for (int r = 0; r < 16; ++r) rli[r] = __builtin_amdgcn_rcpf(li_l[crow(r, hi_e)]);
#pragma unroll
        for (int r = 0; r < 16; ++r) { bf16* orow = Ow + (size_t)((r & 3) + 8 * (r >> 2)) * ldo;
#pragma unroll
            for (int d0 = 0; d0 < 4; ++d0) { const float v = o[d0][r] * rli[r];
                const float vn = __shfl_xor(v, 1);
                if ((r32 & 1) == 0 && cur.store) *(unsigned*)(orow + (size_t)ooff + d0 * 32) = cvtpk(v, vn); } }
    } else {
        const int np = iblk < 3 ? iblk : 3; constexpr float L2E = 1.4426950408889634f;
        float* mt = (float*)(lds + OFF_KM) + wid * 128;
        const size_t rowg = (size_t)cur.bh * SEQ + (size_t)iblk * QB + wid * QBLK;
        float ms[3], ls[3];
#pragma unroll
        for (int sidx = 0; sidx < 3; ++sidx) { ms[sidx] = -1e30f; ls[sidx] = 0.f;
            if (sidx < np) { const f32x2 v = *(const f32x2*)(PP.ML + ((size_t)sidx * BATCH * NH * SEQ + rowg + r32) * 2); ms[sidx] = v[0]; ls[sidx] = v[1]; } }
        const float M = fmaxf(fmaxf(m_reg, ms[0]), fmaxf(ms[1], ms[2]));
        const float e0 = __builtin_amdgcn_exp2f((m_reg - M) * L2E), e1 = ls[0] * __builtin_amdgcn_exp2f((ms[0] - M) * L2E), e2 = ls[1] * __builtin_amdgcn_exp2f((ms[1] - M) * L2E), e3 = ls[2] * __builtin_amdgcn_exp2f((ms[2] - M) * L2E);
        const float iw = __builtin_amdgcn_rcpf(l_reg * e0 + (e1 + e2 + e3));
        if (hi == 0) *(f32x4*)(mt + 4 * r32) = (f32x4){e0 * iw, e1 * iw, e2 * iw, e3 * iw};
        asm volatile("s_waitcnt lgkmcnt(0)" ::: "memory");
#pragma unroll
        for (int r = 0; r < 16; ++r) { const float w0 = mt[4 * ((r & 3) + 8 * (r >> 2) + 4 * hi_e)];
#pragma unroll
            for (int d0 = 0; d0 < 4; ++d0) o[d0][r] *= w0; }
        const unsigned lofs0 = (unsigned)(4 * hi_e * 128 + r32);
#pragma unroll
        for (int sidx = 0; sidx < 3; ++sidx) {
            if (sidx < np) {
                const bf16* pbase = PP.P[sidx] + rowg * 128; bf16 pv[16][4];
#pragma unroll
                for (int r = 0; r < 16; ++r)
#pragma unroll
                    for (int d0 = 0; d0 < 4; ++d0) pv[r][d0] = pbase[(size_t)((r & 3) + 8 * (r >> 2)) * 128 + lofs0 + d0 * 32];
#pragma unroll
                for (int r = 0; r < 16; ++r) { const float wsl = mt[4 * ((r & 3) + 8 * (r >> 2) + 4 * hi_e) + 1 + sidx];
#pragma unroll
                    for (int d0 = 0; d0 < 4; ++d0) o[d0][r] += wsl * bf2f(pv[r][d0]); }
            }
        }
#pragma unroll
        for (int r = 0; r < 16; ++r) { bf16* orow = Ow + (size_t)((r & 3) + 8 * (r >> 2)) * ldo;
#pragma unroll
            for (int d0 = 0; d0 < 4; ++d0) { const float v = o[d0][r]; const float vn = __shfl_xor(v, 1);
                if ((r32 & 1) == 0 && cur.store) *(unsigned*)(orow + (size_t)ooff + d0 * 32) = cvtpk(v, vn); } }
    }
    __syncthreads();
#undef RESC
#undef KBASE
#undef MASKT
#undef SEAM_K0
#undef HALF_STEP
}

__device__ __forceinline__ void sel_phase(const bf16* qkv, const float* kmean, unsigned short* LIST, unsigned* CNT, char* lds, int tid) {
    const int wid = __builtin_amdgcn_readfirstlane(tid >> 6), lane = tid & 63, r32 = lane & 31, hi = lane >> 5;
    float* KMs = (float*)(lds + OFF_KM); unsigned* cw = (unsigned*)(lds + OFF_WS);
    for (int u = blockIdx.x; u < BATCH * NH * 15; u += gridDim.x) {
        const int bh = u / 15, i = 1 + u % 15, b = bh >> 3, h = bh & 7;
        __syncthreads();
        *(f32x4*)(KMs + tid * 4) = *(const f32x4*)(kmean + (size_t)bh * 2048 + tid * 4);
        bf16x8 qr[8];
        { const bf16* qb = qkv + ((size_t)b * SEQ + (size_t)i * QB + wid * QBLK + r32) * LDR + h * 128 + hi * 8;
#pragma unroll
          for (int d0 = 0; d0 < 8; ++d0) qr[d0] = load8(qb + d0 * 16); }
        __syncthreads();
        float v1 = -__builtin_inff(), v2 = v1, v3 = v1; int i1 = -1, i2 = -1, i3 = -1;
        for (int j = 0; j < i; ++j) {
            const float* km = KMs + j * 128 + 8 * hi; float a = 0.f;
#pragma unroll
            for (int d0 = 0; d0 < 8; ++d0) { const f32x4 k0 = *(const f32x4*)(km + 16 * d0), k1 = *(const f32x4*)(km + 16 * d0 + 4); const bf16x8 q = qr[d0];
#pragma unroll
                for (int e = 0; e < 4; ++e) { a = fmaf(__uint_as_float((unsigned)(unsigned short)q[e] << 16), k0[e], a); a = fmaf(__uint_as_float((unsigned)(unsigned short)q[e + 4] << 16), k1[e], a); } }
            a += __shfl_xor(a, 32);
            if (a > v1) { v3 = v2; i3 = i2; v2 = v1; i2 = i1; v1 = a; i1 = j; }
            else if (a > v2) { v3 = v2; i3 = i2; v2 = a; i2 = j; }
            else if (a > v3) { v3 = a; i3 = j; }
        }
        const unsigned sel = (i1 >= 0 ? 1u << i1 : 0u) | (i2 >= 0 ? 1u << i2 : 0u) | (i3 >= 0 ? 1u << i3 : 0u);
        for (int j = 0; j < i; ++j) {
            const unsigned long long bal = __ballot(((sel >> j) & 1u) != 0u && hi == 0);
            if (lane == 0) cw[j * 8 + wid] = (unsigned)__popcll(bal); }
        __syncthreads();
        for (int j = 0; j < i; ++j) {
            const bool on = ((sel >> j) & 1u) != 0u && hi == 0;
            const unsigned long long bal = __ballot(on);
            unsigned off = 0, tot = 0;
#pragma unroll
            for (int w = 0; w < 8; ++w) { const unsigned c = cw[j * 8 + w]; off += w < wid ? c : 0u; tot += c; }
            if (on) { const unsigned rank = (unsigned)__popcll(bal & ((1ull << lane) - 1ull)), slot = (unsigned)__popc(sel & ((1u << j) - 1u));
                LIST[((size_t)(bh * 16 + i) * 16 + j) * 256 + off + rank] = (unsigned short)((wid * 32 + r32) | (slot << 8)); }
            if (tid == 0) CNT[(bh * 16 + i) * 16 + j] = tot;
        }
    }
}
__device__ __forceinline__ void past_phase(const bf16* qkv, const unsigned short* LIST, const unsigned* CNT, const Partials& PP, unsigned* head, char* lds, int tid) {
    const int wid = __builtin_amdgcn_readfirstlane(tid >> 6), lane = tid & 63, r32 = lane & 31, hi = lane >> 5;
    char* V_lds = lds; char* K_lds = lds + 4 * SHM_V;
    constexpr int OFF_X = 8 * SHM_V;
    float* ws = (float*)(lds + OFF_X) + wid * 96; float* al_l = ws; unsigned* rt = (unsigned*)(ws + 32);
    float* li_l = ws + 64;
    unsigned* gt = (unsigned*)(lds + OFF_X + 8 * 96 * 4);
    const int sr = tid >> 4, sc = (tid & 15) * 8, vst0 = v_st(sr, sc), vst1 = v_st(32 + sr, sc), kws = KSWZ(sr, sc * 2);
    const unsigned soff = (unsigned)(sr * LDR + sc);
    const int vb0 = (int)(uintptr_t)V_lds + v_rd_base(lane);
    for (;;) {
        __syncthreads();
        if (tid == 0) gt[32] = __hip_atomic_fetch_add(head, 1u, __ATOMIC_RELAXED, __HIP_MEMORY_SCOPE_AGENT);
        __syncthreads();
        const int item = (int)gt[32]; if (item >= BATCH * NH * 15) break;
        const int j = item >> 6, bh = item & 63, b = bh >> 3, h = bh & 7;
        { const bf16* kp = qkv + ((size_t)b * SEQ + (size_t)j * QB) * LDR + 1024 + h * 128; const bf16* vp = kp + 1024;
          bf16x8 kk[4][2], vv[4][2];
#pragma unroll
          for (int t = 0; t < 4; ++t) { kk[t][0] = load8(kp + (size_t)(64 * t) * LDR + soff); kk[t][1] = load8(kp + (size_t)(64 * t + 32) * LDR + soff);
                                        vv[t][0] = load8(vp + (size_t)(64 * t) * LDR + soff); vv[t][1] = load8(vp + (size_t)(64 * t + 32) * LDR + soff); }
          if (tid < 16) { const unsigned c = tid > j ? CNT[(bh * 16 + tid) * 16 + j] : 0u; gt[16 + tid] = c; gt[tid] = (c + 31u) >> 5; }
#pragma unroll
          for (int t = 0; t < 4; ++t) { *(bf16x8*)(K_lds + t * SHM_K + kws) = kk[t][0]; *(bf16x8*)(K_lds + t * SHM_K + kws + 32 * 256) = kk[t][1];
                                        *(bf16x8*)(V_lds + t * SHM_V + vst0) = vv[t][0]; *(bf16x8*)(V_lds + t * SHM_V + vst1) = vv[t][1]; } }
        __syncthreads();
        int gtot = 0;
        for (int i = j + 1; i < 16; ++i) gtot += (int)gt[i];
        for (int g = wid; g < gtot; g += 8) {
            int i = j + 1, gl = g;
            while (gl >= (int)gt[i]) { gl -= (int)gt[i]; ++i; }
            const int cnt = (int)gt[16 + i], e = gl * 32 + r32; const bool valid = e < cnt;
            const unsigned ent = LIST[((size_t)(bh * 16 + i) * 16 + j) * 256 + (valid ? e : 0)];
            const int rowl = (int)(ent & 255u);
            if (hi == 0) rt[r32] = ent | (valid ? 0x10000u : 0u);
            bf16x8 qr[8];
            { const bf16* qb = qkv + ((size_t)b * SEQ + (size_t)i * QB + rowl) * LDR + h * 128 + hi * 8;
#pragma unroll
              for (int d0 = 0; d0 < 8; ++d0) qr[d0] = load8(qb + d0 * 16); }
            float m_reg = -1e30f, l_reg = 0.f; f32x16 o[4] = {};
            f32x16 pA0, pA1, pB0, pB1; float mnA, mnB, alA, alB; bf16x8 pa0, pa1, pa2, pa3;
#define RESC2(a) do { if (__any((a) < 1.f)) { if (hi == 0) al_l[r32] = (a); asm volatile("s_waitcnt lgkmcnt(0)" ::: "memory");              \
                     for (int d_ = 0; d_ < 4; ++d_) for (int r = 0; r < 16; ++r) o[d_][r] *= al_l[crow(r, hi)]; } } while (0)
            SBAR(); qkt<0>(pA0, pA1, K_lds, r32, hi, qr); partialSM(pA0, pA1, m_reg, mnA, alA);
            SBAR(); qkt<1>(pB0, pB1, K_lds, r32, hi, qr); finishSM(pA0, pA1, alA, l_reg, pa0, pa1, pa2, pa3); SBAR(); pv_tile<0>(o, vb0, pa0, pa1, pa2, pa3); partialSM(pB0, pB1, m_reg, mnB, alB); RESC2(alB);
            SBAR(); qkt<2>(pA0, pA1, K_lds, r32, hi, qr); finishSM(pB0, pB1, alB, l_reg, pa0, pa1, pa2, pa3); SBAR(); pv_tile<1>(o, vb0, pa0, pa1, pa2, pa3); partialSM(pA0, pA1, m_reg, mnA, alA); RESC2(alA);
            SBAR(); qkt<3>(pB0, pB1, K_lds, r32, hi, qr); finishSM(pA0, pA1, alA, l_reg, pa0, pa1, pa2, pa3); SBAR(); pv_tile<2>(o, vb0, pa0, pa1, pa2, pa3); partialSM(pB0, pB1, m_reg, mnB, alB); RESC2(alB);
            SBAR(); finishSM(pB0, pB1, alB, l_reg, pa0, pa1, pa2, pa3); SBAR(); pv_tile<3>(o, vb0, pa0, pa1, pa2, pa3);
#undef RESC2
            const size_t rowb = (size_t)bh * SEQ + (size_t)i * QB;
            if (hi == 0) { li_l[r32] = __builtin_amdgcn_rcpf(l_reg);
                if (valid) *(f32x2*)(PP.ML + ((size_t)(ent >> 8) * BATCH * NH * SEQ + rowb + rowl) * 2) = (f32x2){m_reg, l_reg}; }
            asm volatile("s_waitcnt lgkmcnt(0)" ::: "memory");
#pragma unroll
            for (int r = 0; r < 16; ++r) { const int rr = crow(r, hi); const unsigned en = rt[rr]; const float il = li_l[rr];
                bf16* pb = ((en >> 8) & 3u) == 0u ? PP.P[0] : ((en >> 8) & 3u) == 1u ? PP.P[1] : PP.P[2];
                bf16* prow = pb + (rowb + (en & 255u)) * 128 + r32;
#pragma unroll
                for (int d0 = 0; d0 < 4; ++d0) { const float v = o[d0][r] * il; const float vn = __shfl_xor(v, 1);
                    if ((r32 & 1) == 0 && (en & 0x10000u)) *(unsigned*)(prow + d0 * 32) = cvtpk(v, vn); } }
        }
    }
}
#ifndef MOBA_PP
#define MOBA_PP 0
#endif
constexpr int PP_OFF_WS = 4 * SHM_V + 4 * SHM_K, PP_OFF_KM = 139264 + 64, PP_LDS_BYTES = PP_OFF_KM + 15 * 128 * 4;
static_assert(PP_OFF_WS + NW * 64 * 4 <= 139264 && PP_LDS_BYTES <= 147456, "LDS map");
#define PPBAR() do { asm volatile("s_waitcnt lgkmcnt(0)" ::: "memory"); __builtin_amdgcn_s_barrier(); asm volatile("" ::: "memory"); } while (0)
__device__ __forceinline__ void moba_block_pp(const BlockRef& cur, char* lds, int tid_) {
    int tid = tid_; asm volatile("" : "+v"(tid));
    const int wid = __builtin_amdgcn_readfirstlane(tid >> 6), lane = tid & 63, r32 = lane & 31, hi = lane >> 5, half = wid >> 2;
    const int iblk = cur.iblk, NT = 4 * (iblk + 1), P0 = iblk * QB;
    const int qlo = P0 + wid * QBLK, qm = qlo + r32 - 4 * hi;
    char* V_lds = lds; char* K_lds = lds + 4 * SHM_V;
    float* KMs = (float*)(lds + PP_OFF_KM);
    float* ws = (float*)(lds + PP_OFF_WS) + wid * 64; float* li_l = ws, * al_l = ws + 32;
    const int sr = tid >> 4, sc = (tid & 15) * 8, vst0 = v_st(sr, sc), vst1 = v_st(32 + sr, sc), kws = KSWZ(sr, sc * 2);
    const unsigned soff = (unsigned)(sr * LDR + sc), qoff = (unsigned)(r32 * LDR + hi * 8);
    const int vb0 = (int)(uintptr_t)V_lds + v_rd_base(lane);
    const bf16* Kh = cur.K; const bf16* Vh = cur.V;
    Seam S;
    { const bf16* qb = cur.Q + (size_t)(wid * QBLK) * LDR;
#pragma unroll
      for (int d0 = 0; d0 < 8; ++d0) S.qr[d0] = load8(qb + (size_t)qoff + d0 * 16); }
    { int t4 = tid; asm volatile("" : "+v"(t4));
      const f32x4 kmv = *(const f32x4*)(cur.KM + t4 * 4);
      SLOAD_H(Kh, Vh, 0); VMW();
      if (t4 < 15 * 32) *(f32x4*)(KMs + t4 * 4) = kmv; SWRITE_H(0); }
    SLOAD_H(Kh, Vh, KVBLK);
    __syncthreads();
    unsigned sel = 0u;
    if (iblk > 0) {
        float v1 = -__builtin_inff(), v2 = v1, v3 = v1; int i1 = -1, i2 = -1, i3 = -1;
        for (int j = 0; j < iblk; ++j) {
            const float* km = KMs + j * 128 + 8 * hi; float a = 0.f;
#pragma unroll
            for (int d0 = 0; d0 < 8; ++d0) { const f32x4 k0 = *(const f32x4*)(km + 16 * d0), k1 = *(const f32x4*)(km + 16 * d0 + 4); const bf16x8 q = S.qr[d0];
#pragma unroll
                for (int e = 0; e < 4; ++e) { a = fmaf(__uint_as_float((unsigned)(unsigned short)q[e] << 16), k0[e], a); a = fmaf(__uint_as_float((unsigned)(unsigned short)q[e + 4] << 16), k1[e], a); } }
            a += __shfl_xor(a, 32);
            if (a > v1) { v3 = v2; i3 = i2; v2 = v1; i2 = i1; v1 = a; i1 = j; }
            else if (a > v2) { v3 = v2; i3 = i2; v2 = a; i2 = j; }
            else if (a > v3) { v3 = a; i3 = j; }
        }
        sel = (i1 >= 0 ? 1u << i1 : 0u) | (i2 >= 0 ? 1u << i2 : 0u) | (i3 >= 0 ? 1u << i3 : 0u);
    }
    VMW(); SWRITE_H(1); SLOAD_H(Kh, Vh, 2 * KVBLK);
    __syncthreads();
    float m_reg = -1e30f, l_reg = 0; f32x16 o[4] = {};
    f32x16 pA0, pA1, pB0 = {}, pB1 = {}; float mnA, mnB, alA = 1.f, alB = 1.f; bf16x8 pa0, pa1, pa2, pa3;
#define RESC(a) do { if (__any((a) < 1.f)) { if (hi == 0) al_l[r32] = (a); asm volatile("s_waitcnt lgkmcnt(0)" ::: "memory");              \
                     for (int d_ = 0; d_ < 4; ++d_) for (int r = 0; r < 16; ++r) o[d_][r] *= al_l[crow(r, hi)]; } } while (0)
#define MASKT(P0_, P1_, t) do { const int kb_ = (t) * KVBLK; const int bj_ = (t) >> 2; \
        if (bj_ == iblk) { if (kb_ + KVBLK - 1 > qlo) mask_causal(P0_, P1_, qm - kb_); } else mask_all(P0_, P1_, ((sel >> bj_) & 1u) != 0u); } while (0)
#define PP_STEP(t, SL, PX0, PX1, mnX, alX, PY0, PY1, alY, HASPREV) do {                                                              \
        __builtin_amdgcn_s_setprio(1); qkt<SL>(PX0, PX1, K_lds, r32, hi, S.qr); __builtin_amdgcn_s_setprio(0); PPBAR();                 \
        if (HASPREV) finishSM(PY0, PY1, alY, l_reg, pa0, pa1, pa2, pa3); PPBAR();                                                       \
        if (HASPREV) { __builtin_amdgcn_s_setprio(1); pv_tile<((SL) + 3) & 3>(o, vb0, pa0, pa1, pa2, pa3); __builtin_amdgcn_s_setprio(0); } PPBAR(); \
        MASKT(PX0, PX1, (t)); partialSM(PX0, PX1, m_reg, mnX, alX); RESC(alX);                                                          \
        if ((t) + 2 < NT) { VMW(); SWRITE_H(((SL) + 2) & 3); if ((t) + 3 < NT) SLOAD_H(Kh, Vh, ((t) + 3) * KVBLK); }                    \
        PPBAR(); } while (0)
    if (half == 1) PPBAR();
    for (int t = 0; t < NT; t += 4) {
        PP_STEP(t,     0, pA0, pA1, mnA, alA, pB0, pB1, alB, t > 0);
        PP_STEP(t + 1, 1, pB0, pB1, mnB, alB, pA0, pA1, alA, true);
        PP_STEP(t + 2, 2, pA0, pA1, mnA, alA, pB0, pB1, alB, true);
        PP_STEP(t + 3, 3, pB0, pB1, mnB, alB, pA0, pA1, alA, true);
    }
    if (half == 0) PPBAR();
    finishSM(pB0, pB1, alB, l_reg, pa0, pa1, pa2, pa3); SBAR(); pv_tile<3>(o, vb0, pa0, pa1, pa2, pa3);
    { int hi_e = hi; asm volatile("" : "+v"(hi_e));
      const int ldo = cur.ldo; bf16* Ow = cur.O + (size_t)(wid * QBLK) * ldo;
      const unsigned ooff = (unsigned)(4 * hi_e * ldo + r32);
      if (hi == 0) li_l[r32] = l_reg; asm volatile("s_waitcnt lgkmcnt(0)" ::: "memory");
      float rli[16];
#pragma unroll
      for (int r = 0; r < 16; ++r) rli[r] = __builtin_amdgcn_rcpf(li_l[crow(r, hi_e)]);
#pragma unroll
      for (int r = 0; r < 16; ++r) { bf16* orow = Ow + (size_t)((r & 3) + 8 * (r >> 2)) * ldo;
#pragma unroll
          for (int d0 = 0; d0 < 4; ++d0) { const float v = o[d0][r] * rli[r];
              const float vn = __shfl_xor(v, 1);
              if ((r32 & 1) == 0 && cur.store) *(unsigned*)(orow + (size_t)ooff + d0 * 32) = cvtpk(v, vn); } } }
    __syncthreads();
#undef PP_STEP
#undef MASKT
#undef RESC
}
#undef ROW
#undef VMW
#undef VMWN
#undef SLOAD_H
#undef SWRITE_HK
#undef SWRITE_HV
#undef SWRITE_H
#undef KSWZ
#undef SBAR

__device__ __forceinline__ void item_decode(int L, int G, int k, int bx, int& bh, int& x) {
    if (G == 256) { const int xcd = bx & 7, q = bx >> 3; bh = ((k * 8 + xcd) << 2) + (q >> 3); x = q & 7; }
    else { bh = L >> 3; x = L & 7; }
}
__device__ __forceinline__ BlockRef make_ref(bf16* qkv, const float* kmean, bf16* ob, int ldo, int bh, int iblk) {
    const int b = bh >> 3, h = bh & 7; BlockRef r; bf16* base = qkv + (size_t)bh * 3 * ARR;
    r.Q = base + (size_t)iblk * QB * LDR; r.O = ob + ((size_t)b * SEQ + (size_t)iblk * QB) * ldo + h * 128; r.K = base + ARR; r.V = base + 2 * ARR; r.KM = kmean + (size_t)bh * 16 * 128; r.iblk = iblk; r.ldo = ldo; r.store = 1; r.bh = bh; return r;
}
__device__ __forceinline__ void attn_phase(bf16* qkv, const float* kmean, bf16* ob, int ldo, const Partials& PP, char* lds, int tid) {
    const int G = gridDim.x, bx = blockIdx.x, real = BATCH * NH * 8, total = (PROBE_DUP & 16) ? 2 * real : real;
    int L = bx, k = 0; if (L >= total) return;
    int bh, x; item_decode(L % real, G, k & 1, bx, bh, x); int pass = 0;
    BlockRef cur = make_ref(qkv, kmean, ob, ldo, bh, x); cur.store = ((PROBE_DUP & 16) == 0) || L >= real;
    Seam S;
    moba_prime(cur, lds, S, tid);
    for (;;) {
        const bool more_pass = pass == 0, more_item = L + G < total, last = !more_pass && !more_item;
        int bhn = bh, xn = x, passn = pass + 1, Ln = L, kn = k;
        if (!more_pass) { passn = 0; if (more_item) { Ln = L + G; kn = k + 1; } item_decode(Ln % real, G, kn & 1, bx, bhn, xn); }
        BlockRef nxt = last ? cur : make_ref(qkv, kmean, ob, ldo, bhn, passn ? 15 - xn : xn); nxt.store = ((PROBE_DUP & 16) == 0) || Ln >= real;
        moba_block(cur, nxt, PP, lds, S, tid);
        if (last) break;
        cur = nxt; bh = bhn; x = xn; pass = passn; L = Ln; k = kn;
    }
}
__device__ __forceinline__ void attn_phase_pp(bf16* qkv, const float* kmean, bf16* ob, int ldo, char* lds, int tid) {
    const int G = gridDim.x, bx = blockIdx.x, real = BATCH * NH * 8, total = (PROBE_DUP & 16) ? 2 * real : real;
    int k = 0;
    for (int L = bx; L < total; L += G, ++k) {
        int bh, x; item_decode(L % real, G, k & 1, bx, bh, x);
#pragma unroll 1
        for (int pass = 0; pass < 2; ++pass) {
            BlockRef cur = make_ref(qkv, kmean, ob, ldo, bh, pass ? 15 - x : x); cur.store = ((PROBE_DUP & 16) == 0) || L >= real;
            moba_block_pp(cur, lds, tid);
        }
    }
}
}
namespace hg {
typedef short bf16x8 __attribute__((ext_vector_type(8)));
typedef short s16x4 __attribute__((ext_vector_type(4)));
typedef float f32x16 __attribute__((ext_vector_type(16)));
constexpr int LDB = 4096, CH = 64, NCH_SEG = 16, NSEG = 4;
constexpr int RS = 272, TS = 144, OST_RS = 528;
constexpr int OFF_QR = 0, OFF_KR = 17408, OFF_QI = 34816, OFF_KT = 52224, OFF_VT = 70656, OFF_DEC = 89088, OFF_OST = 89600, HG_LDS_BYTES = OFF_OST + 64 * OST_RS;
static_assert(HG_LDS_BYTES <= 131072, "HGRN LDS map");
__device__ __forceinline__ unsigned pk(float lo, float hi) { unsigned r; asm volatile("v_cvt_pk_bf16_f32 %0, %1, %2" : "=v"(r) : "v"(lo), "v"(hi)); return r; }
__device__ __forceinline__ bf16x8 join8(s16x4 a, s16x4 b) { return (bf16x8){a[0], a[1], a[2], a[3], b[0], b[1], b[2], b[3]}; }
__device__ __forceinline__ bf16x8 acc_frag(const f32x16& x, int s) {
    u32x4 w; w.x = pk(x[8 * s + 0], x[8 * s + 1]); w.y = pk(x[8 * s + 2], x[8 * s + 3]); w.z = pk(x[8 * s + 4], x[8 * s + 5]); w.w = pk(x[8 * s + 6], x[8 * s + 7]);
    return __builtin_bit_cast(bf16x8, w);
}
template <bool FULL> struct Raw { bf16 z[16], v[16], q[FULL ? 16 : 1]; };
struct Scan { float kk[16], G[16]; };
constexpr int OFF_TQ = 131072;
template <bool FULL>
__device__ __forceinline__ void load_z(Raw<FULL>& R, const bf16* __restrict__ base, int lane, int wave) {
    const bf16* p = base + (size_t)(16 * (wave >> 1)) * LDB + 64 * (wave & 1) + lane + 1024;
#pragma unroll
    for (int i = 0; i < 16; ++i) R.z[i] = p[(size_t)i * LDB];
}
template <bool FULL>
__device__ __forceinline__ void load_qv(Raw<FULL>& R, const bf16* __restrict__ base, int lane, int wave) {
    const bf16* p = base + (size_t)(16 * (wave >> 1)) * LDB + 64 * (wave & 1) + lane;
#pragma unroll
    for (int i = 0; i < 16; ++i) { R.v[i] = p[(size_t)i * LDB + 2048]; if (FULL) R.q[i] = p[(size_t)i * LDB]; }
}
template <bool FULL>
__device__ __forceinline__ void build_scan(Scan& C, const Raw<FULL>& R, float lb, LAS unsigned char* lds, int lane, int wave) {
    const int c = 64 * (wave & 1) + lane, qq = wave >> 1;
    float run = 0.f; const float omlb = 1.0f - lb;
#pragma unroll
    for (int i = 0; i < 16; ++i) { const float e = __expf(-bf2f(R.z[i])); const float sg = __builtin_amdgcn_rcpf(1.0f + e); C.kk[i] = omlb * (e * sg); run += __logf(lb + omlb * sg); C.G[i] = run; }
    *(LAS float*)(lds + OFF_TQ + 4 * (qq * 128 + c)) = run;
}
template <bool FULL>
__device__ __forceinline__ float build_ops(const Scan& C, const Raw<FULL>& R, LAS unsigned char* lds, int lane, int wave) {
    const int c = 64 * (wave & 1) + lane, qq = wave >> 1;
    const float T0 = *(const LAS float*)(lds + OFF_TQ + 4 * c), T1 = *(const LAS float*)(lds + OFF_TQ + 4 * (128 + c)), T2 = *(const LAS float*)(lds + OFF_TQ + 4 * (256 + c)), T3 = *(const LAS float*)(lds + OFF_TQ + 4 * (384 + c));
    const float gmid = T0 + T1, glast = gmid + (T2 + T3);
    const float off = qq == 0 ? 0.f : qq == 1 ? T0 : qq == 2 ? gmid : gmid + T2;
    const float Egm = __expf(gmid), Elm = __expf(glast - gmid);
    unsigned ktw[8], vtw[8];
#pragma unroll
    for (int i = 0; i < 16; i += 2) {
        float ks[2];
#pragma unroll
        for (int e = 0; e < 2; ++e) { const int t = 16 * qq + i + e; const float E1 = __expf(C.G[i + e] + off - gmid), R1 = __builtin_amdgcn_rcpf(E1);
            ks[e] = C.kk[i + e] * R1 * Elm;
            if (FULL) { const float qe = bf2f(R.q[FULL ? i + e : 0]) * QSCALE * E1;
                *(LAS bf16*)(lds + OFF_QR + t * RS + 2 * c) = (bf16)(pk(qe, 0.f) & 0xffffu);
                *(LAS bf16*)(lds + OFF_KR + t * RS + 2 * c) = (bf16)(pk(C.kk[i + e] * R1, 0.f) & 0xffffu);
                *(LAS bf16*)(lds + OFF_QI + t * RS + 2 * c) = (bf16)(pk(qe * Egm, 0.f) & 0xffffu); } }
        ktw[i >> 1] = pk(ks[0], ks[1]); vtw[i >> 1] = (unsigned)R.v[i] | ((unsigned)R.v[i + 1] << 16); }
    *(LAS u32x4*)(lds + OFF_KT + c * TS + 32 * qq) = (u32x4){ktw[0], ktw[1], ktw[2], ktw[3]}; *(LAS u32x4*)(lds + OFF_KT + c * TS + 32 * qq + 16) = (u32x4){ktw[4], ktw[5], ktw[6], ktw[7]};
    *(LAS u32x4*)(lds + OFF_VT + c * TS + 32 * qq) = (u32x4){vtw[0], vtw[1], vtw[2], vtw[3]}; *(LAS u32x4*)(lds + OFF_VT + c * TS + 32 * qq + 16) = (u32x4){vtw[4], vtw[5], vtw[6], vtw[7]};
    if (qq == 0) *(LAS float*)(lds + OFF_DEC + 4 * c) = __expf(glast);
    return glast;
}
__device__ __forceinline__ void state_update(f32x16 (&S)[4], LAS unsigned char* lds, int j, int c, int h) {
#pragma unroll
    for (int i = 0; i < 4; ++i) {
#pragma unroll
        for (int g4 = 0; g4 < 4; ++g4) { const f32x4 dc = *(const LAS f32x4*)(lds + OFF_DEC + 4 * (32 * i + 8 * g4 + 4 * h));
#pragma unroll
            for (int e = 0; e < 4; ++e) S[i][4 * g4 + e] *= dc[e]; }
#pragma unroll
        for (int ks = 0; ks < 4; ++ks) {
            const bf16x8 a = *(const LAS bf16x8*)(lds + OFF_KT + (32 * i + c) * TS + (16 * ks + 8 * h) * 2);
            const bf16x8 b = *(const LAS bf16x8*)(lds + OFF_VT + (32 * j + c) * TS + (16 * ks + 8 * h) * 2);
            S[i] = __builtin_amdgcn_mfma_f32_32x32x16_bf16(a, b, S[i], 0, 0, 0); }
    }
}
__device__ __forceinline__ int crow(int r, int h) { return (r & 3) + 8 * (r >> 2) + 4 * h; }

__device__ __forceinline__ void pass_a(const bf16* __restrict__ big, const float* __restrict__ lbv, float* __restrict__ Eg, float* __restrict__ Dg, LAS unsigned char* lds, int lane, int wave) {
    const int j = wave & 3, th = wave >> 2, c = lane & 31, h = lane >> 5;
    for (int u = blockIdx.x; u < BATCH * NH * NSEG; u += gridDim.x) {
        const int seg = u & 3, hh = (u >> 2) & 7, b = u >> 5;
        if (seg == NSEG - 1) continue;
        const int cch = 64 * (wave & 1) + lane;
        const float lb = lbv[hh * 128 + cch];
        f32x16 S[4];
#pragma unroll
        for (int i = 0; i < 4; ++i) S[i] = f32x16{};
        float dsum = 0.f;
        const bf16* base = big + (size_t)(b * SEQ + seg * NCH_SEG * CH) * LDB + hh * 128;
        Raw<false> R; load_z<false>(R, base, lane, wave); load_qv<false>(R, base, lane, wave);
        Scan C; build_scan<false>(C, R, lb, lds, lane, wave);
        load_z<false>(R, base + (size_t)CH * LDB, lane, wave);
        __syncthreads();
        for (int ch = 0; ch < NCH_SEG; ++ch) {
            dsum += build_ops<false>(C, R, lds, lane, wave);
            __syncthreads();
            if (ch + 1 < NCH_SEG) load_qv<false>(R, base + (size_t)(ch + 1) * CH * LDB, lane, wave);
            state_update(S, lds, j, c, h);
            if (ch + 1 < NCH_SEG) { build_scan<false>(C, R, lb, lds, lane, wave); if (ch + 2 < NCH_SEG) load_z<false>(R, base + (size_t)(ch + 2) * CH * LDB, lane, wave); }
            __syncthreads();
        }
        if ((wave >> 1) == 0) Dg[(size_t)u * 128 + cch] = dsum;
        if (th == 0) {
            float* E = Eg + (size_t)u * 16384;
#pragma unroll
            for (int i = 0; i < 4; ++i)
#pragma unroll
                for (int r = 0; r < 16; ++r) E[(size_t)(32 * i + crow(r, h)) * 128 + 32 * j + c] = S[i][r];
        }
    }
}
__device__ __forceinline__ void pass_b(bf16* big, bf16* outp, int ldo, int store, const float* __restrict__ lbv, const float* __restrict__ og, const float* __restrict__ Eg, const float* __restrict__ Dg, LAS unsigned char* lds, int lane, int wave) {
    const int j = wave & 3, th = wave >> 2, c = lane & 31, h = lane >> 5, tid = wave * 64 + lane;
    for (int u = blockIdx.x; u < BATCH * NH * NSEG; u += gridDim.x) {
        const int seg = u & 3, hh = (u >> 2) & 7, b = u >> 5;
        const float lb = lbv[hh * 128 + 64 * (wave & 1) + lane];
        f32x16 S[4];
#pragma unroll
        for (int i = 0; i < 4; ++i) S[i] = f32x16{};
        for (int sp = 0; sp < seg; ++sp) {
            const float* E = Eg + (size_t)(u - seg + sp) * 16384; const float* Dp = Dg + (size_t)(u - seg + sp) * 128;
#pragma unroll
            for (int i = 0; i < 4; ++i)
#pragma unroll
                for (int r = 0; r < 16; ++r) { const int d = 32 * i + crow(r, h); S[i][r] = __expf(Dp[d]) * S[i][r] + E[(size_t)d * 128 + 32 * j + c]; }
        }
        const bf16* base = big + ((size_t)b * SEQ + (size_t)seg * NCH_SEG * CH) * LDB + hh * 128;
        Raw<true> R; load_z<true>(R, base, lane, wave); load_qv<true>(R, base, lane, wave);
        Scan C; build_scan<true>(C, R, lb, lds, lane, wave);
        load_z<true>(R, base + (size_t)CH * LDB, lane, wave);
        __syncthreads();
        const int ot = tid >> 3, opart = tid & 7;
        u32x4 gn0, gn1;
        { const bf16* gp = base + (size_t)ot * LDB + 3072 + opart * 16; gn0 = *(const u32x4*)gp; gn1 = *(const u32x4*)(gp + 8); }
        for (int ch = 0; ch < NCH_SEG; ++ch) {
            const size_t row0 = (size_t)b * SEQ + (size_t)(seg * NCH_SEG + ch) * CH;
            if (store != 3) (void)build_ops<true>(C, R, lds, lane, wave);
            const u32x4 g0 = gn0, g1 = gn1;
            __syncthreads();
            if (ch + 1 < NCH_SEG) { const bf16* nb = base + (size_t)(ch + 1) * CH * LDB; load_qv<true>(R, nb, lane, wave);
                const bf16* gp = nb + (size_t)ot * LDB + 3072 + opart * 16; gn0 = *(const u32x4*)gp; gn1 = *(const u32x4*)(gp + 8); }
            if (store == 2) { __syncthreads(); continue; }
            bf16x8 P[2][2];
#pragma unroll
            for (int sh = 0; sh < 2; ++sh) {
                if (sh <= th) {
                    f32x16 X = f32x16{};
#pragma unroll
                    for (int ks = 0; ks < 8; ++ks) {
                        const bf16x8 a = *(const LAS bf16x8*)(lds + OFF_KR + (32 * sh + c) * RS + (16 * ks + 8 * h) * 2);
                        const bf16x8 bq = *(const LAS bf16x8*)(lds + OFF_QR + (32 * th + c) * RS + (16 * ks + 8 * h) * 2);
                        X = __builtin_amdgcn_mfma_f32_32x32x16_bf16(a, bq, X, 0, 0, 0); }
                    if (sh == th) {
#pragma unroll
                        for (int r = 0; r < 16; ++r) X[r] = crow(r, h) <= c ? X[r] : 0.f; }
                    P[sh][0] = acc_frag(X, 0); P[sh][1] = acc_frag(X, 1);
                } else { P[sh][0] = bf16x8{}; P[sh][1] = bf16x8{}; }
            }
            f32x16 o = f32x16{};
#pragma unroll
            for (int i = 0; i < 4; ++i)
#pragma unroll
                for (int s = 0; s < 2; ++s) {
                    const LAS unsigned char* qa = lds + OFF_QI + (32 * th + c) * RS + (32 * i + 16 * s + 4 * h) * 2;
                    const bf16x8 a = join8(*(const LAS s16x4*)qa, *(const LAS s16x4*)(qa + 16));
                    o = __builtin_amdgcn_mfma_f32_32x32x16_bf16(a, acc_frag(S[i], s), o, 0, 0, 0); }
#pragma unroll
            for (int sh = 0; sh < 2; ++sh) {
                if (sh <= th) {
#pragma unroll
                    for (int s = 0; s < 2; ++s) {
                        const LAS unsigned char* va = lds + OFF_VT + (32 * j + c) * TS + (32 * sh + 16 * s + 4 * h) * 2;
                        const bf16x8 bv = join8(*(const LAS s16x4*)va, *(const LAS s16x4*)(va + 16));
                        o = __builtin_amdgcn_mfma_f32_32x32x16_bf16(P[sh][s], bv, o, 0, 0, 0); } }
            }
            state_update(S, lds, j, c, h);
            if (ch + 1 < NCH_SEG) { build_scan<true>(C, R, lb, lds, lane, wave); if (ch + 2 < NCH_SEG) load_z<true>(R, base + (size_t)(ch + 2) * CH * LDB, lane, wave); }
#pragma unroll
            for (int r = 0; r < 16; ++r) *(LAS float*)(lds + OFF_OST + (32 * th + crow(r, h)) * OST_RS + (32 * j + c) * 4) = o[r];
            __syncthreads();
            {
                const int t = ot, part = opart;
                const LAS f32x4* op = (const LAS f32x4*)(lds + OFF_OST + t * OST_RS + part * 64);
                const f32x4 o0 = op[0], o1 = op[1], o2 = op[2], o3 = op[3];
                float ss = (o0[0] * o0[0] + o0[1] * o0[1]) + (o0[2] * o0[2] + o0[3] * o0[3]) + (o1[0] * o1[0] + o1[1] * o1[1]) + (o1[2] * o1[2] + o1[3] * o1[3])
                         + (o2[0] * o2[0] + o2[1] * o2[1]) + (o2[2] * o2[2] + o2[3] * o2[3]) + (o3[0] * o3[0] + o3[1] * o3[1]) + (o3[2] * o3[2] + o3[3] * o3[3]);
                ss += __shfl_xor(ss, 1); ss += __shfl_xor(ss, 2); ss += __shfl_xor(ss, 4);
                const float rstd = __builtin_amdgcn_rsqf(ss * (1.0f / 128.0f) + 1e-6f);
                bf16* yp = outp + (row0 + t) * ldo + hh * 128 + part * 16;
                const f32x4 w0 = *(const f32x4*)(og + part * 16), w1 = *(const f32x4*)(og + part * 16 + 4), w2 = *(const f32x4*)(og + part * 16 + 8), w3 = *(const f32x4*)(og + part * 16 + 12);
                const unsigned gw[8] = {g0.x, g0.y, g0.z, g0.w, g1.x, g1.y, g1.z, g1.w};
                const float ov[16] = {o0[0], o0[1], o0[2], o0[3], o1[0], o1[1], o1[2], o1[3], o2[0], o2[1], o2[2], o2[3], o3[0], o3[1], o3[2], o3[3]};
                const float wv[16] = {w0[0], w0[1], w0[2], w0[3], w1[0], w1[1], w1[2], w1[3], w2[0], w2[1], w2[2], w2[3], w3[0], w3[1], w3[2], w3[3]};
                unsigned ow[8];
#pragma unroll
                for (int e = 0; e < 8; ++e) { const float ga = __uint_as_float(gw[e] << 16), gb = __uint_as_float(gw[e] & 0xffff0000u);
                    const float ya = ov[2 * e] * rstd * wv[2 * e] * (ga * __builtin_amdgcn_rcpf(1.0f + __expf(-ga)));
                    const float yb = ov[2 * e + 1] * rstd * wv[2 * e + 1] * (gb * __builtin_amdgcn_rcpf(1.0f + __expf(-gb)));
                    ow[e] = pk(ya, yb); }
                if (store == 1) { *(u32x4*)yp = (u32x4){ow[0], ow[1], ow[2], ow[3]}; *(u32x4*)(yp + 8) = (u32x4){ow[4], ow[5], ow[6], ow[7]}; }
            }
        }
        __syncthreads();
    }
}
}
namespace hg2 {
#define HG2_BAR() do { asm volatile("s_waitcnt lgkmcnt(0)" ::: "memory"); __builtin_amdgcn_s_barrier(); asm volatile("" ::: "memory"); } while (0)
typedef short bf16x8 __attribute__((ext_vector_type(8)));
typedef short s16x4 __attribute__((ext_vector_type(4)));
typedef float f32x16 __attribute__((ext_vector_type(16)));
constexpr int LDB = 128, ARR = 4096 * 128, LDG = 1024, CH = 32, NCH_SEG = 32, NSEG = 4;
constexpr int RS = 272, TS = 80, OST_RS = 528;
constexpr int B_QR = 0, B_KR = 8704, B_KT = 17408, B_VT = 27648, B_DEC = 37888, B_EGM = 38400, BUF_BYTES = 38912;
constexpr int OFF_OST = 2 * BUF_BYTES, OST_BYTES = 32 * OST_RS, OFF_SCR = OFF_OST + 2 * OST_BYTES, HG2_LDS_BYTES = OFF_SCR + 4 * 2560;
static_assert(HG2_LDS_BYTES <= 131072, "HGRN LDS map");
__device__ __forceinline__ unsigned pk(float lo, float hi) { unsigned r; asm volatile("v_cvt_pk_bf16_f32 %0, %1, %2" : "=v"(r) : "v"(lo), "v"(hi)); return r; }
__device__ __forceinline__ bf16x8 join8(s16x4 a, s16x4 b) { return (bf16x8){a[0], a[1], a[2], a[3], b[0], b[1], b[2], b[3]}; }
__device__ __forceinline__ int crow(int r, int h) { return (r & 3) + 8 * (r >> 2) + 4 * h; }
__device__ __forceinline__ bf16x8 acc_frag_scaled(const f32x16& x, int s, const f32x4& e0, const f32x4& e1) {
    u32x4 w; w.x = pk(x[8 * s + 0] * e0[0], x[8 * s + 1] * e0[1]); w.y = pk(x[8 * s + 2] * e0[2], x[8 * s + 3] * e0[3]); w.z = pk(x[8 * s + 4] * e1[0], x[8 * s + 5] * e1[1]); w.w = pk(x[8 * s + 6] * e1[2], x[8 * s + 7] * e1[3]);
    return __builtin_bit_cast(bf16x8, w);
}
__device__ __forceinline__ bf16x8 acc_frag(const f32x16& x, int s) {
    u32x4 w; w.x = pk(x[8 * s + 0], x[8 * s + 1]); w.y = pk(x[8 * s + 2], x[8 * s + 3]); w.z = pk(x[8 * s + 4], x[8 * s + 5]); w.w = pk(x[8 * s + 6], x[8 * s + 7]);
    return __builtin_bit_cast(bf16x8, w);
}
template <bool FULL> struct Raw { u32x4 z[2], v[2], q[FULL ? 2 : 1]; };
constexpr int SCR_RS = 80, SCR_BYTES = 32 * SCR_RS;
template <bool FULL>
__device__ __forceinline__ void load_raw(Raw<FULL>& R, const bf16* __restrict__ base, int lane, int bw) {
    const bf16* p = base + (size_t)(lane >> 2) * LDB + 32 * bw + 8 * (lane & 3);
#pragma unroll
    for (int e = 0; e < 2; ++e) { R.z[e] = *(const u32x4*)(p + (size_t)(16 * e) * LDB + ARR); R.v[e] = *(const u32x4*)(p + (size_t)(16 * e) * LDB + 2 * ARR); if (FULL) R.q[e] = *(const u32x4*)(p + (size_t)(16 * e) * LDB); }
}
__device__ __forceinline__ void transpose16(float (&out)[16], const u32x4 (&src)[2], LAS unsigned char* scr, int lane) {
    *(LAS u32x4*)(scr + (lane >> 2) * SCR_RS + 16 * (lane & 3)) = src[0]; *(LAS u32x4*)(scr + ((lane >> 2) + 16) * SCR_RS + 16 * (lane & 3)) = src[1];
    asm volatile("s_waitcnt lgkmcnt(0)" ::: "memory");
#pragma unroll
    for (int i = 0; i < 16; ++i) out[i] = bf2f(*(const LAS bf16*)(scr + (16 * (lane >> 5) + i) * SCR_RS + 2 * (lane & 31)));
    asm volatile("s_waitcnt lgkmcnt(0)" ::: "memory");
}
template <bool FULL>
__device__ __forceinline__ float build_chunk(const Raw<FULL>& R, float lb, LAS unsigned char* buf, LAS unsigned char* scr, int lane, int bw) {
    const int c = 32 * bw + (lane & 31), half = lane >> 5;
    float Pr[16], kk[16]; float run = 1.f; const float omlb = 1.0f - lb;
    { float z[16]; transpose16(z, R.z, scr, lane);
#pragma unroll
      for (int i = 0; i < 16; ++i) { const float e = __expf(-z[i]); const float sg = __builtin_amdgcn_rcpf(1.0f + e); kk[i] = omlb * (e * sg); run *= lb + omlb * sg; Pr[i] = run; } }
    const float oth = __shfl_xor(run, 32);
    const float T0 = half ? oth : run, T1 = half ? run : oth;
    const float sc1 = half ? 1.0f : __builtin_amdgcn_rcpf(T0);
    const float Elm = T1;
    float qv[16];
    if constexpr (FULL) transpose16(qv, R.q, scr, lane);
    float vv[16]; transpose16(vv, R.v, scr, lane);
    unsigned ktw[8], vtw[8];
#pragma unroll
    for (int i = 0; i < 16; i += 2) {
        float ks[2];
#pragma unroll
        for (int e = 0; e < 2; ++e) { const int t = 16 * half + i + e; const float E1 = Pr[i + e] * sc1, R1 = __builtin_amdgcn_rcpf(E1);
            ks[e] = kk[i + e] * R1 * Elm;
            if (FULL) { *(LAS bf16*)(buf + B_QR + t * RS + 2 * c) = (bf16)(pk(qv[FULL ? i + e : 0] * QSCALE * E1, 0.f) & 0xffffu);
                        *(LAS bf16*)(buf + B_KR + t * RS + 2 * c) = (bf16)(pk(kk[i + e] * R1, 0.f) & 0xffffu); } }
        ktw[i >> 1] = pk(ks[0], ks[1]); vtw[i >> 1] = pk(vv[i], vv[i + 1]); }
    *(LAS u32x4*)(buf + B_KT + c * TS + 32 * half) = (u32x4){ktw[0], ktw[1], ktw[2], ktw[3]}; *(LAS u32x4*)(buf + B_KT + c * TS + 32 * half + 16) = (u32x4){ktw[4], ktw[5], ktw[6], ktw[7]};
    *(LAS u32x4*)(buf + B_VT + c * TS + 32 * half) = (u32x4){vtw[0], vtw[1], vtw[2], vtw[3]}; *(LAS u32x4*)(buf + B_VT + c * TS + 32 * half + 16) = (u32x4){vtw[4], vtw[5], vtw[6], vtw[7]};
    if (half == 0) { *(LAS float*)(buf + B_DEC + 4 * c) = T0 * T1; *(LAS float*)(buf + B_EGM + 4 * c) = T0; }
    return FULL ? 0.f : __logf(T0 * T1);
}
__device__ __forceinline__ void state_update(f32x16 (&S)[4], const LAS unsigned char* buf, int j, int c, int h) {
    bf16x8 a[4][2], bv[2]; f32x4 dc[4][4];
#pragma unroll
    for (int ks = 0; ks < 2; ++ks) bv[ks] = *(const LAS bf16x8*)(buf + B_VT + (32 * j + c) * TS + (16 * ks + 8 * h) * 2);
#pragma unroll
    for (int i = 0; i < 4; ++i) {
#pragma unroll
        for (int ks = 0; ks < 2; ++ks) a[i][ks] = *(const LAS bf16x8*)(buf + B_KT + (32 * i + c) * TS + (16 * ks + 8 * h) * 2);
#pragma unroll
        for (int g4 = 0; g4 < 4; ++g4) dc[i][g4] = *(const LAS f32x4*)(buf + B_DEC + 4 * (32 * i + 8 * g4 + 4 * h)); }
#pragma unroll
    for (int i = 0; i < 4; ++i) {
#pragma unroll
        for (int g4 = 0; g4 < 4; ++g4)
#pragma unroll
            for (int e = 0; e < 4; ++e) S[i][4 * g4 + e] *= dc[i][g4][e];
#pragma unroll
        for (int ks = 0; ks < 2; ++ks) S[i] = __builtin_amdgcn_mfma_f32_32x32x16_bf16(a[i][ks], bv[ks], S[i], 0, 0, 0);
    }
}
__device__ __forceinline__ void pass_a(const bf16* __restrict__ big, const float* __restrict__ lbv, float* __restrict__ Eg, float* __restrict__ Dg, LAS unsigned char* lds, int lane, int wave) {
    const bool builder = wave < 4; const int bw = wave & 3, j = wave & 3, c = lane & 31, h = lane >> 5;
    for (int u = blockIdx.x; u < BATCH * NH * NSEG; u += gridDim.x) {
        const int seg = u & 3, hh = (u >> 2) & 7, b = u >> 5;
        if (seg == NSEG - 1) continue;
        const bf16* base = big + ((size_t)(b * 8 + hh) * 3 * 4096 + (size_t)seg * NCH_SEG * CH) * 128;
        if (builder) {
            __builtin_amdgcn_s_setprio(1);
            const float lb = lbv[hh * 128 + 32 * bw + (lane & 31)];
            float dsum = 0.f; Raw<false> R0, R1;
            load_raw<false>(R0, base, lane, bw); load_raw<false>(R1, base + (size_t)CH * LDB, lane, bw);
#define HG2_A_ITER(kk_, RX) do { const int k_ = (kk_); if (k_ < NCH_SEG) { dsum += build_chunk<false>(RX, lb, lds + (k_ & 1) * BUF_BYTES, lds + OFF_SCR + bw * 2560, lane, bw); \
                if (k_ + 2 < NCH_SEG) load_raw<false>(RX, base + (size_t)(k_ + 2) * CH * LDB, lane, bw); } HG2_BAR(); } while (0)
            for (int k = 0; k < NCH_SEG; k += 2) { HG2_A_ITER(k, R0); HG2_A_ITER(k + 1, R1); }
            HG2_A_ITER(NCH_SEG, R0);
#undef HG2_A_ITER
            if ((lane >> 5) == 0) Dg[(size_t)u * 128 + 32 * bw + (lane & 31)] = dsum;
            __builtin_amdgcn_s_setprio(0);
        } else {
            f32x16 S[4];
#pragma unroll
            for (int i = 0; i < 4; ++i) S[i] = f32x16{};
            for (int k = 0; k <= NCH_SEG; ++k) {
                if (k > 0) state_update(S, lds + ((k - 1) & 1) * BUF_BYTES, j, c, h);
                HG2_BAR();
            }
            float* E = Eg + (size_t)u * 16384;
#pragma unroll
            for (int i = 0; i < 4; ++i)
#pragma unroll
                for (int r = 0; r < 16; ++r) E[(size_t)(32 * i + crow(r, h)) * 128 + 32 * j + c] = S[i][r];
        }
    }
}
__device__ __forceinline__ void pass_b(bf16* big, bf16* outp, int ldo, int store, const float* __restrict__ lbv, const float* __restrict__ og, const float* __restrict__ Eg, const float* __restrict__ Dg, LAS unsigned char* lds, int lane, int wave) {
    const bool builder = wave < 4; const int bw = wave & 3, j = wave & 3, c = lane & 31, h = lane >> 5, btid = (wave & 3) * 64 + lane;
    for (int u = blockIdx.x; u < BATCH * NH * NSEG; u += gridDim.x) {
        const int seg = u & 3, hh = (u >> 2) & 7, b = u >> 5;
        const bf16* base = big + ((size_t)(b * 8 + hh) * 3 * 4096 + (size_t)seg * NCH_SEG * CH) * 128;
        const bf16* gbase = big + (size_t)3 * MROWS * 1024 + ((size_t)b * SEQ + (size_t)seg * NCH_SEG * CH) * LDG + hh * 128;
        if (builder) {
            __builtin_amdgcn_s_setprio(1);
            const float lb = lbv[hh * 128 + 32 * bw + (lane & 31)];
            Raw<true> R0, R1;
            load_raw<true>(R0, base, lane, bw); load_raw<true>(R1, base + (size_t)CH * LDB, lane, bw);
#define HG2_B_ITER(kk_, RX) do { const int k_ = (kk_); \
                if (k_ < NCH_SEG) { if (store != 3) (void)build_chunk<true>(RX, lb, lds + (k_ & 1) * BUF_BYTES, lds + OFF_SCR + bw * 2560, lane, bw); if (k_ + 2 < NCH_SEG) load_raw<true>(RX, base + (size_t)(k_ + 2) * CH * LDB, lane, bw); } \
                HG2_BAR(); } while (0)
            for (int k = 0; k <= NCH_SEG + 1; k += 2) { HG2_B_ITER(k, R0); HG2_B_ITER(k + 1, R1); }
#undef HG2_B_ITER
            __builtin_amdgcn_s_setprio(0);
        } else {
            f32x16 S[4];
#pragma unroll
            for (int i = 0; i < 4; ++i) S[i] = f32x16{};
            for (int sp = 0; sp < seg; ++sp) {
                const float* E = Eg + (size_t)(u - seg + sp) * 16384; const float* Dp = Dg + (size_t)(u - seg + sp) * 128;
#pragma unroll
                for (int i = 0; i < 4; ++i)
#pragma unroll
                    for (int r = 0; r < 16; ++r) { const int d = 32 * i + crow(r, h); S[i][r] = __expf(Dp[d]) * S[i][r] + E[(size_t)d * 128 + 32 * j + c]; }
            }
            u32x4 gn0 = (u32x4){0u, 0u, 0u, 0u}, gn1 = gn0;
            const int ot = btid >> 3, opart = btid & 7;
            for (int k = 0; k <= NCH_SEG + 1; ++k) {
                if (k >= 1 && k <= NCH_SEG && store != 4) {
                const LAS unsigned char* buf = lds + ((k - 1) & 1) * BUF_BYTES;
                f32x16 X = f32x16{};
                { bf16x8 ka[8], qb[8];
#pragma unroll
                  for (int ks = 0; ks < 8; ++ks) { ka[ks] = *(const LAS bf16x8*)(buf + B_KR + c * RS + (16 * ks + 8 * h) * 2); qb[ks] = *(const LAS bf16x8*)(buf + B_QR + c * RS + (16 * ks + 8 * h) * 2); }
#pragma unroll
                  for (int ks = 0; ks < 8; ++ks) X = __builtin_amdgcn_mfma_f32_32x32x16_bf16(ka[ks], qb[ks], X, 0, 0, 0); }
#pragma unroll
                for (int r = 0; r < 16; ++r) X[r] = crow(r, h) <= c ? X[r] : 0.f;
                const bf16x8 P0 = acc_frag(X, 0), P1 = acc_frag(X, 1);
                f32x16 o = f32x16{};
                { bf16x8 qa8[8]; f32x4 eg[8][2];
#pragma unroll
                  for (int i = 0; i < 4; ++i)
#pragma unroll
                    for (int s = 0; s < 2; ++s) { const LAS unsigned char* qa = buf + B_QR + c * RS + (32 * i + 16 * s + 4 * h) * 2; qa8[2 * i + s] = join8(*(const LAS s16x4*)qa, *(const LAS s16x4*)(qa + 16));
                        eg[2 * i + s][0] = *(const LAS f32x4*)(buf + B_EGM + 4 * (32 * i + 16 * s + 4 * h)); eg[2 * i + s][1] = *(const LAS f32x4*)(buf + B_EGM + 4 * (32 * i + 16 * s + 8 + 4 * h)); }
#pragma unroll
                  for (int i = 0; i < 4; ++i)
#pragma unroll
                    for (int s = 0; s < 2; ++s) o = __builtin_amdgcn_mfma_f32_32x32x16_bf16(qa8[2 * i + s], acc_frag_scaled(S[i], s, eg[2 * i + s][0], eg[2 * i + s][1]), o, 0, 0, 0); }
#pragma unroll
                for (int s = 0; s < 2; ++s) {
                    const LAS unsigned char* va = buf + B_VT + (32 * j + c) * TS + (16 * s + 4 * h) * 2;
                    const bf16x8 bv = join8(*(const LAS s16x4*)va, *(const LAS s16x4*)(va + 16));
                    o = __builtin_amdgcn_mfma_f32_32x32x16_bf16(s ? P1 : P0, bv, o, 0, 0, 0); }
                state_update(S, buf, j, c, h);
#pragma unroll
                for (int r = 0; r < 16; ++r) *(LAS float*)(lds + OFF_OST + ((k - 1) & 1) * OST_BYTES + crow(r, h) * OST_RS + (32 * j + c) * 4) = o[r];
                }
                if (k >= 2 && store != 5) {
                    const int kc = k - 2; const u32x4 g0 = gn0, g1 = gn1;
                    const LAS f32x4* op = (const LAS f32x4*)(lds + OFF_OST + (kc & 1) * OST_BYTES + ot * OST_RS + opart * 64);
                    const f32x4 o0 = op[0], o1 = op[1], o2 = op[2], o3 = op[3];
                    float ss = (o0[0] * o0[0] + o0[1] * o0[1]) + (o0[2] * o0[2] + o0[3] * o0[3]) + (o1[0] * o1[0] + o1[1] * o1[1]) + (o1[2] * o1[2] + o1[3] * o1[3])
                             + (o2[0] * o2[0] + o2[1] * o2[1]) + (o2[2] * o2[2] + o2[3] * o2[3]) + (o3[0] * o3[0] + o3[1] * o3[1]) + (o3[2] * o3[2] + o3[3] * o3[3]);
                    ss += __shfl_xor(ss, 1); ss += __shfl_xor(ss, 2); ss += __shfl_xor(ss, 4);
                    const float rstd = __builtin_amdgcn_rsqf(ss * (1.0f / 128.0f) + 1e-6f);
                    const size_t row = (size_t)b * SEQ + (size_t)(seg * NCH_SEG + kc) * CH + ot;
                    bf16* yp = outp + row * ldo + hh * 128 + opart * 16;
                    const f32x4 w0 = *(const f32x4*)(og + opart * 16), w1 = *(const f32x4*)(og + opart * 16 + 4), w2 = *(const f32x4*)(og + opart * 16 + 8), w3 = *(const f32x4*)(og + opart * 16 + 12);
                    const unsigned gw[8] = {g0.x, g0.y, g0.z, g0.w, g1.x, g1.y, g1.z, g1.w};
                    const float ov[16] = {o0[0], o0[1], o0[2], o0[3], o1[0], o1[1], o1[2], o1[3], o2[0], o2[1], o2[2], o2[3], o3[0], o3[1], o3[2], o3[3]};
                    const float wv[16] = {w0[0], w0[1], w0[2], w0[3], w1[0], w1[1], w1[2], w1[3], w2[0], w2[1], w2[2], w2[3], w3[0], w3[1], w3[2], w3[3]};
                    unsigned ow[8];
#pragma unroll
                    for (int e = 0; e < 8; ++e) { const float ga = __uint_as_float(gw[e] << 16), gb = __uint_as_float(gw[e] & 0xffff0000u);
                        const float ya = ov[2 * e] * rstd * wv[2 * e] * (ga * __builtin_amdgcn_rcpf(1.0f + __expf(-ga)));
                        const float yb = ov[2 * e + 1] * rstd * wv[2 * e + 1] * (gb * __builtin_amdgcn_rcpf(1.0f + __expf(-gb)));
                        ow[e] = pk(ya, yb); }
                    if (store == 1) { *(u32x4*)yp = (u32x4){ow[0], ow[1], ow[2], ow[3]}; *(u32x4*)(yp + 8) = (u32x4){ow[4], ow[5], ow[6], ow[7]}; }
                }
                if (k >= 1 && k - 1 < NCH_SEG) { const bf16* gp = gbase + (size_t)((k - 1) * CH + ot) * LDG + opart * 16; gn0 = *(const u32x4*)gp; gn1 = *(const u32x4*)(gp + 8); }
                HG2_BAR();
            }
        }
    }
}
}
#define GAS __attribute__((address_space(1)))
constexpr int NWAVES = 8;
constexpr int RING_OFF = 0, RING_BYTES = 131072;
constexpr int XCH_OFF = 131072;
constexpr int MISC_OFF = 139264;
constexpr int LDS_BYTES = 147456;
constexpr int CW_Q = 2048;
constexpr int CW_BAR = 4096;
constexpr int N_PHASES = 25;
static_assert(pg8::STAGE_BYTES == RING_BYTES && XCH_OFF == RING_BYTES, "LDS map");
static_assert((CW_BAR + 3456) * 4 <= (int)CTL_ZERO_BYTES, "barrier words inside the memset region");

struct Params { const float* in[15]; float* out; unsigned char* ws; int ph_lo, ph_hi, bar_region, pad; };

#define LDS_WAIT() asm volatile("s_waitcnt lgkmcnt(0)" ::: "memory")
#define VM_WAIT() asm volatile("s_waitcnt vmcnt(0)" ::: "memory")

__device__ __forceinline__ void p0_conv_item(const float* __restrict__ W, const float* __restrict__ gain, int K, int N, bf16* __restrict__ WT, int upperm, LAS float* scr, int item, int lane) {
    const int nblk = N / 64, kb = item / nblk, nb = item % nblk, k0 = 64 * kb, n0 = 64 * nb;
    int src0 = n0;
    if (upperm == 1) { const int pn = n0 >> 8, r = n0 & 255, bj = r >> 7, c = r & 127; src0 = bj * 3072 + 128 * pn + c; }
    if (upperm == 2) { const int pn = n0 >> 8, type = pn >> 2; if (type < 2) src0 = type * 1024 + (2 * (pn & 3) + ((n0 >> 6) & 1)) * 128 + 64 * ((n0 >> 7) & 1); }
    const int kr = lane >> 4, n4 = (lane & 15) * 4;
    f32x4 v[16];
#pragma unroll
    for (int i = 0; i < 16; ++i) v[i] = *(const f32x4*)(W + (size_t)(k0 + 4 * i + kr) * N + src0 + n4);
#pragma unroll
    for (int i = 0; i < 16; ++i) { const int k = 4 * i + kr; const float gsc = gain ? gain[k0 + k] : 1.0f;
#pragma unroll
        for (int e = 0; e < 4; ++e) scr[(n4 + e) * 65 + k] = v[i][e] * gsc; }
    LDS_WAIT(); asm volatile("" ::: "memory");
    const int c = lane & 7;
#pragma unroll
    for (int j = 0; j < 8; ++j) { const int n = (lane >> 3) + 8 * j; const LAS float* s = scr + n * 65 + 8 * c;
        u32x4 o; o.x = f2bf(s[0]) | ((unsigned)f2bf(s[1]) << 16); o.y = f2bf(s[2]) | ((unsigned)f2bf(s[3]) << 16);
        o.z = f2bf(s[4]) | ((unsigned)f2bf(s[5]) << 16); o.w = f2bf(s[6]) | ((unsigned)f2bf(s[7]) << 16);
        *(u32x4*)(WT + (size_t)(n0 + n) * K + k0 + 8 * c) = o; }
    LDS_WAIT(); asm volatile("" ::: "memory");
}
__device__ __forceinline__ void p0_prologue(const Params& p, LAS unsigned char* lds, int gw, int NGW, int lane, int wave) {
    unsigned char* ws = p.ws;
    LAS float* scr = (LAS float*)(lds + RING_OFF + wave * 16640);
    const float* attn_norm = p.in[1]; const float* ffn_norm = p.in[2];
    constexpr int I_IN = 16 * 64, I_QKV = 16 * 48, I_O = 16 * 16, I_UP = 16 * 96, I_DN = 48 * 16;
    constexpr int NITEMS = 2 * I_IN + 2 * I_QKV + 4 * I_O + 4 * I_UP + 4 * I_DN;
    for (int it = gw; it < NITEMS; it += NGW) {
        int r = it;
        if (r < 2 * I_IN) { const int s = r / I_IN; p0_conv_item(p.in[3] + (size_t)s * 1024 * 4096, attn_norm + (2 * s) * 1024, 1024, 4096, (bf16*)(ws + WS_WIN) + (size_t)s * 4096 * 1024, 0, scr, r % I_IN, lane); continue; } r -= 2 * I_IN;
        if (r < 2 * I_QKV) { const int s = r / I_QKV; p0_conv_item(p.in[7] + (size_t)s * 1024 * 3072, attn_norm + (2 * s + 1) * 1024, 1024, 3072, (bf16*)(ws + WS_WQKV) + (size_t)s * 3072 * 1024, 2, scr, r % I_QKV, lane); continue; } r -= 2 * I_QKV;
        if (r < 2 * I_O) { const int s = r / I_O; p0_conv_item(p.in[6] + (size_t)s * 1024 * 1024, nullptr, 1024, 1024, (bf16*)(ws + WS_WOH) + (size_t)s * 1024 * 1024, 0, scr, r % I_O, lane); continue; } r -= 2 * I_O;
        if (r < 2 * I_O) { const int s = r / I_O; p0_conv_item(p.in[10] + (size_t)s * 1024 * 1024, nullptr, 1024, 1024, (bf16*)(ws + WS_WOM) + (size_t)s * 1024 * 1024, 0, scr, r % I_O, lane); continue; } r -= 2 * I_O;
        if (r < 4 * I_UP) { const int l = r / I_UP; p0_conv_item(p.in[11] + (size_t)l * 1024 * 6144, ffn_norm + l * 1024, 1024, 6144, (bf16*)(ws + WS_WUP) + (size_t)l * 6144 * 1024, 1, scr, r % I_UP, lane); continue; } r -= 4 * I_UP;
        { const int l = r / I_DN; p0_conv_item(p.in[14] + (size_t)l * 3072 * 1024, nullptr, 3072, 1024, (bf16*)(ws + WS_WDN) + (size_t)l * 1024 * 3072, 0, scr, r % I_DN, lane); }
    }
    const float* x = p.in[0]; bf16* xb = (bf16*)(ws + WS_XB); float* ss = (float*)(ws + WS_SS);
    for (int row0 = gw * 4; row0 < MROWS; row0 += NGW * 4) {
        f32x4 v[4][4];
#pragma unroll
        for (int r = 0; r < 4; ++r)
#pragma unroll
            for (int j = 0; j < 4; ++j) v[r][j] = ((const f32x4*)(x + (size_t)(row0 + r) * DM))[lane + 64 * j];
        float s4[4];
#pragma unroll
        for (int r = 0; r < 4; ++r) { float s = 0.f;
#pragma unroll
            for (int j = 0; j < 4; ++j) { const f32x4 t = v[r][j]; s += (t[0] * t[0] + t[1] * t[1]) + (t[2] * t[2] + t[3] * t[3]);
                unsigned long long w = (unsigned long long)(f2bf(t[0]) | ((unsigned)f2bf(t[1]) << 16)) | ((unsigned long long)(f2bf(t[2]) | ((unsigned)f2bf(t[3]) << 16)) << 32);
                *(unsigned long long*)(xb + (size_t)(row0 + r) * DM + 4 * (lane + 64 * j)) = w; }
            s4[r] = wave_sum(s); }
        { const int slot = lane >> 2, rr = lane & 3; const float sv = rr == 0 ? s4[0] : rr == 1 ? s4[1] : rr == 2 ? s4[2] : s4[3];
          ss[(size_t)slot * MROWS + row0 + rr] = slot == 0 ? sv : 0.f; }
    }
    float* lbv = (float*)(ws + WS_LBV); const float* hgrn_lb = p.in[4];
    if (gw == 0) ((float*)(ws + WS_INVF))[lane] = 1.0f / powf(10000.0f, (float)(2 * lane) / 128.0f);
    for (int idx = gw * 64 + lane; idx < 1024; idx += NGW * 64) { const float l0 = hgrn_lb[idx], l1 = hgrn_lb[1024 + idx]; const float mx = fmaxf(l0, l1), e0 = expf(l0 - mx), e1 = expf(l1 - mx); lbv[idx] = 0.f; lbv[1024 + idx] = e1 / (e0 + e1); }
}

__device__ __forceinline__ void kprep_phase(const bf16* qkv, bf16* qdst, bf16* kdst, int ldd, const float* __restrict__ qg, const float* __restrict__ kg, const float* __restrict__ cs, const float* __restrict__ sn, float* __restrict__ kmean,
                                            LAS unsigned char* lds, int lane, int wave) {
    const int tidk = wave * 64 + lane, rg = lane >> 4, cch = lane & 15;
    LAS float* red = (LAS float*)(lds + RING_OFF);
    for (int u = blockIdx.x; u < 2 * BATCH * NH * NBLK; u += gridDim.x) {
        const int which = u & 1, j = (u >> 1) & 15, h = (u >> 5) & 7, b = u >> 8;
        const float* g = which ? kg : qg; const f32x4 ga = *(const f32x4*)(g + 8 * cch), gb = *(const f32x4*)(g + 8 * cch + 4);
        const float gn[8] = {ga[0], ga[1], ga[2], ga[3], gb[0], gb[1], gb[2], gb[3]};
        const int pos0 = j * MBLK + wave * 32 + rg;
        const bf16* src = qkv + (size_t)(b * SEQ + pos0) * 3072 + which * 1024 + h * 128 + 8 * cch;
        bf16* dst = (which ? kdst : qdst) + (size_t)(b * SEQ + pos0) * ldd + h * 128 + 8 * cch;
        u32x4 raw[8];
#pragma unroll
        for (int it = 0; it < 8; ++it) raw[it] = *(const u32x4*)(src + (size_t)(4 * it) * 3072);
        float acc[8];
#pragma unroll
        for (int e = 0; e < 8; ++e) acc[e] = 0.f;
#pragma unroll
        for (int it = 0; it < 8; ++it) {
            const unsigned w[4] = {raw[it].x, raw[it].y, raw[it].z, raw[it].w};
            float x[8];
#pragma unroll
            for (int e = 0; e < 4; ++e) { x[2 * e] = __uint_as_float(w[e] << 16); x[2 * e + 1] = __uint_as_float(w[e] & 0xffff0000u); }
            float ss = 0.f;
#pragma unroll
            for (int e = 0; e < 8; ++e) ss += x[e] * x[e];
            ss += __shfl_xor(ss, 1); ss += __shfl_xor(ss, 2); ss += __shfl_xor(ss, 4); ss += __shfl_xor(ss, 8);
            const float r = rsqrtf(ss * (1.0f / 128.0f) + 1e-6f);
            const int pos = pos0 + 4 * it;
            const f32x4 c0 = *(const f32x4*)(cs + pos * 64 + 8 * (cch & 7)), c1 = *(const f32x4*)(cs + pos * 64 + 8 * (cch & 7) + 4);
            const f32x4 s0 = *(const f32x4*)(sn + pos * 64 + 8 * (cch & 7)), s1 = *(const f32x4*)(sn + pos * 64 + 8 * (cch & 7) + 4);
            const float cv[8] = {c0[0], c0[1], c0[2], c0[3], c1[0], c1[1], c1[2], c1[3]}, sv[8] = {s0[0], s0[1], s0[2], s0[3], s1[0], s1[1], s1[2], s1[3]};
            float o[8];
#pragma unroll
            for (int e = 0; e < 8; ++e) { const float y = x[e] * r * gn[e]; const float py = __shfl_xor(y, 8);
                float v = cch < 8 ? y * cv[e] - py * sv[e] : y * cv[e] + py * sv[e];
                if (!which) v *= QSCALE;
                o[e] = v; acc[e] += v; }
            u32x4 ow; ow.x = f2bf(o[0]) | ((unsigned)f2bf(o[1]) << 16); ow.y = f2bf(o[2]) | ((unsigned)f2bf(o[3]) << 16); ow.z = f2bf(o[4]) | ((unsigned)f2bf(o[5]) << 16); ow.w = f2bf(o[6]) | ((unsigned)f2bf(o[7]) << 16);
            *(u32x4*)(dst + (size_t)(4 * it) * ldd) = ow;
        }
        if (which) {
#pragma unroll
            for (int e = 0; e < 8; ++e) { acc[e] += __shfl_xor(acc[e], 16); acc[e] += __shfl_xor(acc[e], 32); }
            if (rg == 0) {
#pragma unroll
                for (int e = 0; e < 8; ++e) red[wave * 128 + 8 * cch + e] = acc[e]; }
            __syncthreads();
            if (tidk < 128) { float s = 0.f;
#pragma unroll
                for (int w = 0; w < 8; ++w) s += red[w * 128 + tidk];
                kmean[((size_t)(b * 8 + h) * 16 + j) * 128 + tidk] = s * (1.0f / 256.0f); }
            __syncthreads();
        }
    }
}

__device__ __forceinline__ void hg_naive_phase(bf16* __restrict__ big, const float* __restrict__ lbv, const float* __restrict__ og, LAS unsigned char* lds, const int tid) {
    LAS float* sq = (LAS float*)(lds + RING_OFF); LAS float* sf = sq + 128; LAS float* sk = sq + 256; LAS float* red = sq + 384;
    for (int u = blockIdx.x; u < BATCH * NH; u += gridDim.x) {
        const int b = u >> 3, h = u & 7;
        float S[128];
#pragma unroll
        for (int d = 0; d < 128; ++d) S[d] = 0.f;
        const float lb = tid < 128 ? lbv[h * 128 + tid] : 0.f, gain = tid < 128 ? og[tid] : 0.f;
        for (int t = 0; t < SEQ; ++t) {
            bf16* r = big + (size_t)(b * SEQ + t) * 4096 + h * 128 + (tid & 127);
            float q = 0.f, vv = 0.f, gg = 0.f;
            if (tid < 128) { q = bf2f(r[0]) * QSCALE; const float z = bf2f(r[1024]); vv = bf2f(r[2048]); gg = bf2f(r[3072]);
                const float sg = 1.0f / (1.0f + expf(-z)); const float f = lb + (1.0f - lb) * sg; const float k = (1.0f - lb) * (1.0f - sg);
                sq[tid] = q; sf[tid] = f; sk[tid] = k; }
            __syncthreads();
            float o = 0.f;
            if (tid < 128) {
#pragma unroll
                for (int d = 0; d < 128; ++d) { S[d] = sf[d] * S[d] + sk[d] * vv; o += sq[d] * S[d]; }
                const float w = wave_sum(o * o);
                if ((tid & 63) == 0) red[tid >> 6] = w; }
            __syncthreads();
            if (tid < 128) { const float tot = red[0] + red[1];
                const float on = o * rsqrtf(tot * (1.0f / 128.0f) + 1e-6f) * gain;
                r[3072] = f2bf(on * (gg / (1.0f + expf(-gg)))); }
        }
    }
}
__device__ __forceinline__ void attn_naive_phase(bf16* __restrict__ qkv, const float* __restrict__ kmean, LAS unsigned char* lds, int lane, int wave) {
    LAS float* sq = (LAS float*)(lds + RING_OFF) + wave * 128;
    LAS float* sp = (LAS float*)(lds + RING_OFF + 4096) + wave * 1024;
    for (long it0 = (long)blockIdx.x * 8; it0 < (long)MROWS * 8; it0 += (long)gridDim.x * 8) {
        const long item = it0 + wave; const int h = (int)(item & 7); const long row = item >> 3; const int b = (int)(row >> 12), s = (int)(row & (SEQ - 1)), i = s >> 8;
        bf16* qp = qkv + row * 3072 + h * 128;
        __syncthreads();
        sq[lane] = bf2f(qp[lane]); sq[lane + 64] = bf2f(qp[lane + 64]);
        __syncthreads();
        float gv = -INFINITY;
        if (lane < i) { const float* km = kmean + ((size_t)(b * 8 + h) * 16 + lane) * 128; float a = 0.f; for (int d = 0; d < 128; ++d) a += km[d] * sq[d]; gv = a; }
        const int nsel = i < 3 ? i : 3; int s0 = i, s1 = i, s2 = i;
#pragma unroll
        for (int n = 0; n < 3; ++n) {
            if (n < nsel) { const float m = wave_max(gv); const unsigned long long bal = __ballot(gv == m); const int idx = __ffsll((long long)bal) - 1; if (n == 0) s0 = idx; else if (n == 1) s1 = idx; else s2 = idx; if (lane == idx) gv = -INFINITY; } }
#define PICKB(bi) ((bi) == 0 ? s0 : (bi) == 1 ? s1 : (bi) == 2 ? s2 : i)
        float mx = -INFINITY;
        for (int bi = 0; bi <= nsel; ++bi) { const int kb = PICKB(bi) * MBLK;
            for (int c = 0; c < 4; ++c) { const int key = kb + c * 64 + lane;
                const bf16* kp = qkv + (size_t)(b * SEQ + key) * 3072 + 1024 + h * 128; float a = 0.f;
                for (int d8 = 0; d8 < 16; ++d8) { const u32x4 w = *(const u32x4*)(kp + d8 * 8);
                    const unsigned ww[4] = {w.x, w.y, w.z, w.w};
#pragma unroll
                    for (int e = 0; e < 4; ++e) { a += __uint_as_float(ww[e] << 16) * sq[d8 * 8 + 2 * e]; a += __uint_as_float(ww[e] & 0xffff0000u) * sq[d8 * 8 + 2 * e + 1]; } }
                if (bi == nsel && key > s) a = -INFINITY;
                sp[bi * 256 + c * 64 + lane] = a; mx = fmaxf(mx, a); } }
        mx = wave_max(mx);
        float l = 0.f;
        for (int e = lane; e < (nsel + 1) * 256; e += 64) { const float pr = __expf(sp[e] - mx); sp[e] = pr; l += pr; }
        l = wave_sum(l);
        __syncthreads();
        float o0 = 0.f, o1 = 0.f;
        for (int bi = 0; bi <= nsel; ++bi) { const bf16* vp = qkv + (size_t)(b * SEQ + PICKB(bi) * MBLK) * 3072 + 2048 + h * 128 + lane;
            for (int kk = 0; kk < 256; ++kk) { const float pr = sp[bi * 256 + kk]; o0 += pr * bf2f(vp[(size_t)kk * 3072]); o1 += pr * bf2f(vp[(size_t)kk * 3072 + 64]); } }
#undef PICKB
        const float il = 1.0f / l;
        qp[lane] = f2bf(o0 * il); qp[lane + 64] = f2bf(o1 * il);
    }
}

#ifndef HG_PIPE
#define HG_PIPE 1
#endif
#if HG_PIPE
#define HGNS hg2
#else
#define HGNS hg
#endif
#ifndef PROBE_BMODE
#define PROBE_BMODE 0
#endif
#ifndef STAGGER_TICKS
#define STAGGER_TICKS 0
#endif
__device__ __forceinline__ void phase_stagger() {
    if (STAGGER_TICKS > 0) { const unsigned q = (blockIdx.x >> 3) & 3u; const unsigned long long t0 = __builtin_amdgcn_s_memrealtime();
        while (__builtin_amdgcn_s_memrealtime() - t0 < (unsigned long long)(q * STAGGER_TICKS)) __builtin_amdgcn_s_sleep(8); }
}
__global__ void __launch_bounds__(NWAVES * 64, 2) mega_fwd(Params p) {
    extern __shared__ __attribute__((aligned(16))) unsigned char lds_raw[];
    LAS unsigned char* lds = (LAS unsigned char*)lds_raw;
    const int G = gridDim.x;
    unsigned char* ws = p.ws;
    for (int u = threadIdx.x; u < (LDS_BYTES - MISC_OFF) / 4; u += NWAVES * 64) ((LAS unsigned*)(lds + MISC_OFF))[u] = 0u;
    __syncthreads();
#define PHASE_IDS() int tid = threadIdx.x; asm volatile("" : "+v"(tid)); const int lane = tid & 63, wave = __builtin_amdgcn_readfirstlane(tid >> 6); (void)lane; (void)wave
    const int lo = p.ph_lo, hi = p.ph_hi;
    XcdBarrier bar; bar.bar = (unsigned*)(ws + WS_CTL) + CW_BAR + p.bar_region * XCD_BAR_WORDS; bar.x = 0; bar.st = nullptr;
    if (hi - lo > 1) bar = xcd_barrier_post((unsigned*)(ws + WS_CTL) + CW_BAR + p.bar_region * XCD_BAR_WORDS, (volatile LAS unsigned*)(lds + MISC_OFF));
#define IN(k) (lo <= (k) && (k) < hi)
#define SEAM(k) do { if (IN(k) && IN((k) + 1)) { xcd_barrier(bar); if (PROBE_DUP & 1024) xcd_barrier(bar); } } while (0)
#define PHASE_ENV() PHASE_IDS(); const __attribute__((address_space(4))) Params* pp = (const __attribute__((address_space(4))) Params*)__builtin_amdgcn_kernarg_segment_ptr(); asm volatile("" : "+s"(pp)); \
    unsigned char* ws = pp->ws; float* out = pp->out; bf16* XB = (bf16*)(ws + WS_XB); bf16* BIG = (bf16*)(ws + WS_BIG); float* SS = (float*)(ws + WS_SS); \
    const float* COS = (const float*)(ws + WS_COS); const float* SIN = (const float*)(ws + WS_SIN); const float* LBV = (const float*)(ws + WS_LBV); float* KMEAN = (float*)(ws + WS_KMEAN); \
    float* TAIL = (float*)(ws + WS_TAIL); float* HEADA = (float*)(ws + WS_HEADA); float* HEADU = (float*)(ws + WS_HEADU); \
    (void)out; (void)XB; (void)BIG; (void)SS; (void)COS; (void)SIN; (void)LBV; (void)KMEAN; (void)TAIL; (void)HEADA; (void)HEADU

    if (IN(0)) {
#pragma unroll 1
        for (int rep = (PROBE_DUP & 8) ? 0 : 1; rep < 2; ++rep) { PHASE_IDS(); p0_prologue(p, lds, blockIdx.x * NWAVES + wave, G * NWAVES, lane, wave); __syncthreads(); }
    }
    SEAM(0);
    for (int l = 0; l < DEPTH; ++l) {
        const int pb = 1 + 6 * l, slot = l >> 1; const bool moba = (l & 1) != 0;
        if (IN(pb)) { PHASE_ENV();
            if (moba) {
                pg8::Gemm g{XB, (const bf16*)(ws + WS_WQKV) + (size_t)slot * 3072 * 1024, MROWS, 3072, 1024, 1024}; pg8::StaticOrder S; S.init(MROWS, 3072, G, (int)blockIdx.x);
                pg8::EpiQKV E{BIG, SS, pp->in[8] + slot * 128, pp->in[9] + slot * 128, (const float*)(ws + WS_INVF), KMEAN, 0, 0, pg8::rstd_tab_build(lds + RING_OFF, S, SS, tid)};
#pragma unroll 1
                for (int rep = (PROBE_DUP & 65536) ? 0 : 1; rep < 2; ++rep) { E.dry = rep ? 0 : PROBE_BMODE; pg8::gemm_phase<pg8::EpiQKV, pg8::StaticOrder, true, true>(lds + RING_OFF, g, S, E); __syncthreads(); }
            } else {
                pg8::Gemm g{XB, (const bf16*)(ws + WS_WIN) + (size_t)slot * 4096 * 1024, MROWS, 4096, 1024, 1024}; pg8::StaticOrder S; S.init(MROWS, 4096, G, (int)blockIdx.x);
                pg8::EpiRowScale E{BIG, SS, 0, 0, pg8::rstd_tab_build(lds + RING_OFF, S, SS, tid)};
#pragma unroll 1
                for (int rep = (PROBE_DUP & 1) ? 0 : 1; rep < 2; ++rep) { E.pad = ((PROBE_DUP & 128) && rep == 0) ? (PROBE_BMODE ? PROBE_BMODE : 1) : 0; pg8::gemm_phase<pg8::EpiRowScale, pg8::StaticOrder, true, true>(lds + RING_OFF, g, S, E); __syncthreads(); }
            }
        }
        SEAM(pb);
        if (moba) {
#if MOBA_SPARSE
            if (IN(pb + 1)) { PHASE_ENV();
#pragma unroll 1
                for (int rep = (PROBE_DUP & 16384) ? 0 : 1; rep < 2; ++rep) { mb::sel_phase(BIG, KMEAN, (unsigned short*)(ws + WS_HGE), (unsigned*)(ws + WS_HGE + 8 * MiB), (char*)lds_raw, tid); __syncthreads(); } }
            SEAM(pb + 1);
            if (IN(pb + 2)) { PHASE_ENV();
                mb::Partials PP; PP.P[0] = (bf16*)out; PP.P[1] = (bf16*)out + (size_t)BATCH * NH * SEQ * 128; PP.P[2] = (bf16*)(ws + WS_AU); PP.ML = (float*)(ws + WS_ML);
#pragma unroll 1
                for (int rep = (PROBE_DUP & 32768) ? 0 : 1; rep < 2; ++rep) {
                    mb::past_phase(BIG, (const unsigned short*)(ws + WS_HGE), (const unsigned*)(ws + WS_HGE + 8 * MiB), PP, (unsigned*)(ws + WS_CTL) + CW_Q + 64 * l + 32 * rep, (char*)lds_raw, tid); __syncthreads(); }
                xcd_barrier(bar);
                mb::attn_phase(BIG, KMEAN, BIG, 3072, PP, (char*)lds_raw, tid); }
#else
            if (IN(pb + 2)) { PHASE_ENV(); if (MOBA_PP) mb::attn_phase_pp(BIG, KMEAN, BIG + (size_t)3 * MROWS * 1024, 1024, (char*)lds_raw, tid); else { mb::Partials PP{}; mb::attn_phase(BIG, KMEAN, BIG + (size_t)3 * MROWS * 1024, 1024, PP, (char*)lds_raw, tid); } }
#endif
            SEAM(pb + 2);
        } else {
#if defined(NAIVE_HG)
            SEAM(pb + 1);
            if (IN(pb + 2)) { PHASE_ENV(); hg_naive_phase(BIG, LBV + slot * 1024, pp->in[5] + slot * 128, lds, tid); }
#elif !defined(NO_HG)
            if (IN(pb + 1)) { PHASE_ENV();
#pragma unroll 1
                for (int rep = (PROBE_DUP & 4) ? 0 : 1; rep < 2; ++rep) { HGNS::pass_a(BIG, LBV + slot * 1024, (float*)(ws + WS_HGE), (float*)(ws + WS_HGD), lds, lane, wave); __syncthreads(); } }
            SEAM(pb + 1);
            if (IN(pb + 2)) { PHASE_ENV();
#pragma unroll 1
                for (int rep = (PROBE_DUP & 32) ? 0 : 1; rep < 2; ++rep) {
                    HGNS::pass_b(BIG, BIG + (size_t)3 * MROWS * 1024, 1024, rep ? 1 : PROBE_BMODE, LBV + slot * 1024, pp->in[5] + slot * 128, (const float*)(ws + WS_HGE), (const float*)(ws + WS_HGD), lds, lane, wave); __syncthreads(); } }
#endif
            SEAM(pb + 2);
        }
        if (IN(pb + 3)) { PHASE_ENV();
            const bf16* A = BIG + (size_t)3 * MROWS * 1024; const int lda = 1024;
            const bf16* Bt = moba ? (const bf16*)(ws + WS_WOM) + (size_t)slot * 1024 * 1024 : (const bf16*)(ws + WS_WOH) + (size_t)slot * 1024 * 1024;
            pg8::Gemm g{A, Bt, MROWS, 1024, 1024, lda}; pg8::StaticOrder S; S.init(MROWS, 1024, G, (int)blockIdx.x);
            pg8::EpiResid<0> E{l == 0 ? pp->in[0] : nullptr, nullptr, XB, SS, XB, SS, 0, 0};
#pragma unroll 1
            for (int rep = (PROBE_DUP & (256 | 4096)) ? 0 : 1; rep < 2; ++rep) { E.dry = (rep == 0) && !((PROBE_DUP & 4096) && moba); if ((PROBE_DUP & 4096) && moba) { E.xbw = (rep || PROBE_BMODE >= 5) ? XB : (bf16*)(ws + WS_AU); E.ssw = (rep || PROBE_BMODE >= 5) ? SS : (float*)(ws + WS_END); E.dry = rep ? 0 : PROBE_BMODE; } pg8::gemm_phase<pg8::EpiResid<0>, pg8::StaticOrder, true, true>(lds + RING_OFF, g, S, E); __syncthreads(); }
        }
        SEAM(pb + 3);
#ifndef NO_GLU
        if (IN(pb + 4)) { PHASE_ENV();
            const float* cw = pp->in[12] + (size_t)l * 3 * FF; const float* cb = pp->in[13] + (size_t)l * FF;
            pg8::Gemm g{XB, (const bf16*)(ws + WS_WUP) + (size_t)l * 6144 * 1024, MROWS, 6144, 1024, 1024}; pg8::StaticOrder S; S.init(MROWS, 6144, G, (int)blockIdx.x);
            pg8::EpiGLU E{BIG, SS, cw, cb, TAIL, HEADA, HEADU, 0, 0, pg8::rstd_tab_build(lds + RING_OFF, S, SS, tid)}; phase_stagger();
#pragma unroll 1
            for (int rep = (PROBE_DUP & 2) ? 0 : 1; rep < 2; ++rep) { E.dry = rep ? 0 : PROBE_BMODE; E.G = (rep == 0 && PROBE_BMODE == 4) ? (bf16*)(ws + WS_END) : BIG; pg8::gemm_phase<pg8::EpiGLU, pg8::StaticOrder, true, true>(lds + RING_OFF, g, S, E); __syncthreads(); }
        }
#endif
        SEAM(pb + 4);
        if (IN(pb + 5)) { PHASE_ENV();
            const float* cw = pp->in[12] + (size_t)l * 3 * FF; const float* cb = pp->in[13] + (size_t)l * FF;
            pg8::Gemm g{BIG, (const bf16*)(ws + WS_WDN) + (size_t)l * 1024 * 3072, MROWS, 1024, 3072, 3072}; pg8::StaticOrder S; S.init(MROWS, 1024, G, (int)blockIdx.x);
            pg8::Unit u; int pm_done = -1;
            for (int i = 0; S.next(i, u); ++i) {
                if (u.pm == pm_done) continue;
                pm_done = u.pm;
#pragma unroll
                for (int e0 = 0; e0 < 2 * FF; e0 += NWAVES * 64) { const int e = e0 + tid; glu_fixup_elem(u.pm, e >= FF, e >= FF ? e - FF : e, BIG, TAIL, HEADA, HEADU, cw, cb); } }
            VM_WAIT(); __syncthreads();
            pg8::EpiResid<1> E{nullptr, l == DEPTH - 1 ? out : nullptr, XB, SS, XB, SS, 0, 0};
#pragma unroll 1
            for (int rep = (PROBE_DUP & (512 | 8192)) ? 0 : 1; rep < 2; ++rep) { E.dry = (rep == 0) && !(PROBE_DUP & 8192); if (PROBE_DUP & 8192) { E.xbw = rep ? XB : (bf16*)(ws + WS_AU); E.ssw = rep ? SS : (float*)(ws + WS_END); E.out = (rep && l == DEPTH - 1) ? out : nullptr; } pg8::gemm_phase<pg8::EpiResid<1>, pg8::StaticOrder, true, true>(lds + RING_OFF, g, S, E); __syncthreads(); }
        }
        if (l < DEPTH - 1) SEAM(pb + 5);
    }
#undef IN
#undef SEAM
}

#ifndef MK_PER_PHASE
#define MK_PER_PHASE 0
#endif
extern "C" void kernel_launch(void* const* d_in, const int* in_sizes, int n_in, void* d_out, int out_size, void* d_ws, size_t ws_size, hipStream_t stream) {
    static int grid = 0;
    if (grid == 0) {
        if (n_in != 15 || in_sizes[0] != MROWS * DM || out_size != MROWS * DM || ws_size < WS_END) {
            fprintf(stderr, "kernel_launch: unexpected shapes (n_in %d, in0 %d, out %d, ws %zu < %zu); nothing launched\n", n_in, n_in > 0 ? in_sizes[0] : -1, out_size, ws_size, (size_t)WS_END); grid = -1; return; }
        int dev = 0, cus = 0, per_cu = 0;
        if (hipGetDevice(&dev) != hipSuccess || hipDeviceGetAttribute(&cus, hipDeviceAttributeMultiprocessorCount, dev) != hipSuccess || cus <= 0) { fprintf(stderr, "kernel_launch: no device attributes\n"); grid = -1; return; }
        if (hipFuncSetAttribute((const void*)mega_fwd, hipFuncAttributeMaxDynamicSharedMemorySize, LDS_BYTES) != hipSuccess) { fprintf(stderr, "kernel_launch: hipFuncSetAttribute failed\n"); grid = -1; return; }
        if (hipOccupancyMaxActiveBlocksPerMultiprocessor(&per_cu, (const void*)mega_fwd, NWAVES * 64, LDS_BYTES) != hipSuccess || per_cu < 1)
            fprintf(stderr, "kernel_launch: note: occupancy query reports %d workgroups per CU; launching one per CU (144 KiB LDS each admits exactly one)\n", per_cu);
        (void)hipGetLastError();
        grid = cus;
    }
    if (grid < 0) return;
    (void)hipMemsetAsync((char*)d_ws + WS_CTL, 0, CTL_ZERO_BYTES, stream);
    Params p{};
    for (int i = 0; i < 15; ++i) p.in[i] = (const float*)d_in[i];
    p.out = (float*)d_out; p.ws = (unsigned char*)d_ws;
#if MK_PER_PHASE
    for (int k = 0; k < N_PHASES; ++k) { p.ph_lo = k; p.ph_hi = k + 1; p.bar_region = 0; hipLaunchKernelGGL(mega_fwd, dim3(grid), dim3(NWAVES * 64), LDS_BYTES, stream, p); }
#else
    p.ph_lo = 0; p.ph_hi = N_PHASES; p.bar_region = 0;
    hipLaunchKernelGGL(mega_fwd, dim3(grid), dim3(NWAVES * 64), LDS_BYTES, stream, p);
#endif
}
```

```cpp
#define PG8_PRE 1
#define PG8_MMA_PRIO 1
#define PG8_ST_SC1 0
#define PG8_RESID_PF 0
#define PG8_PF_DIST 4
#include <hip/hip_runtime.h>
#include <cstdio>
#include <cstdint>
#include <cmath>
#define WG_TAB_ADDR 139776u
__device__ __forceinline__ unsigned wg_slot() { return (unsigned)__builtin_amdgcn_s_getreg((5 << 11) | 4) & 63u; }
__device__ __forceinline__ int wg_lane() { return (int)__builtin_amdgcn_mbcnt_hi(~0u, __builtin_amdgcn_mbcnt_lo(~0u, 0u)); }
__device__ __forceinline__ int wg_wave() { return __builtin_amdgcn_readfirstlane((int)*(const volatile __attribute__((address_space(3))) unsigned*)(WG_TAB_ADDR + 4u * wg_slot())); }
__device__ __forceinline__ int wg_tid() { return wg_wave() * 64 + wg_lane(); }
namespace pg8 {
#define PG8_LAS __attribute__((address_space(3)))
typedef unsigned short bf16_t;
typedef short bf16x8 __attribute__((ext_vector_type(8)));
typedef float f32x4 __attribute__((ext_vector_type(4)));
typedef unsigned u32x4 __attribute__((ext_vector_type(4)));
constexpr int BM = 256, BK = 64, HALF = 128, HTB = HALF * BK * 2  , STAGE_BYTES = 8 * HTB, NXCD = 8, WGM = 8;

__host__ __device__ __forceinline__ int lds_byte(int r, int c) { const int st = (r >> 4) * 2 + (c >> 5), rr = r & 15, cc = c & 31, ob = rr * 64 + cc * 2; return st * 1024 + (ob ^ (((ob >> 9) & 1) << 5)); }
__host__ __device__ __forceinline__ void stage_rc(int b, int& R, int& C) { const int st = b / 1024, sb = b % 1024, swz = sb ^ (((sb >> 9) & 1) << 5); R = (st >> 1) * 16 + swz / 64; C = (st & 1) * 32 + (swz % 64) / 2; }
__host__ __device__ __forceinline__ int perm32(int rho) { const int n = rho >> 4, i = rho & 15; return 8 * (i >> 2) + 4 * n + (i & 3); }

struct Unit { int pm, pn; };
struct Gemm { const bf16_t* A; const bf16_t* Bt; int M, N, K, lda; };

struct StaticOrder {
    int nM, nN, nwg, G, c;
    __host__ __device__ __forceinline__ void init(int M, int N, int G_, int c_) { nM = M / BM; nN = N / BM; nwg = nM * nN; G = G_; c = c_; }
    __host__ __device__ __forceinline__ bool next(int i, Unit& u) const {
        const long L = (long)i * G + c; if (L >= nwg) return false;
        int wgid = (int)L; { const int q = nwg / NXCD, r = nwg % NXCD, xcd = wgid % NXCD, off = wgid / NXCD; wgid = (xcd < r ? xcd * (q + 1) : r * (q + 1) + (xcd - r) * q) + off; }
        const int nig = WGM * nN, gid = wgid / nig, fm = gid * WGM, gsz = (nM - fm) < WGM ? (nM - fm) : WGM;
        u.pm = fm + ((wgid % nig) % gsz); u.pn = (wgid % nig) / gsz; return true;
    }
    __device__ __forceinline__ void a_ready(const Unit&) const {}
    __device__ __forceinline__ void done(const Unit&) const {}
};

__device__ __forceinline__ unsigned cvt_pk_bf16(float lo, float hi) { unsigned r; asm volatile("v_cvt_pk_bf16_f32 %0, %1, %2" : "=v"(r) : "v"(lo), "v"(hi)); return r; }
typedef float f32x2 __attribute__((ext_vector_type(2)));
constexpr int SS_M = 32768;
__device__ __forceinline__ void st16(void* p, const u32x4& w) {
#if PG8_ST_SC1
    asm volatile("global_store_dwordx4 %0, %1, off sc1" :: "v"(p), "v"(w) : "memory");
#else
    *(u32x4*)p = w;
#endif
}
struct RstdTab { int p0, p1, ok; };
constexpr int RSTD_TAB_OFF = STAGE_BYTES + 6144;
template <class Sched>
__device__ __forceinline__ RstdTab rstd_tab_build(PG8_LAS unsigned char* lds, const Sched& S, const float* ss, int tid) {
    RstdTab T; T.p0 = -1; T.p1 = -1; T.ok = 1; Unit u;
    for (int i = 0; S.next(i, u); ++i) { if (T.p0 < 0) T.p0 = u.pm; else if (u.pm != T.p0) { if (T.p1 < 0) T.p1 = u.pm; else if (u.pm != T.p1) T.ok = 0; } }
    if (T.ok) { const int slot = tid >> 8, row = tid & 255, pm = slot ? T.p1 : T.p0;
        if (pm >= 0) { const float* sp = ss + (size_t)pm * BM + row; float a[4], b[4], c[4], d[4];
#pragma unroll
            for (int k = 0; k < 4; ++k) { a[k] = sp[(size_t)k * SS_M]; b[k] = sp[(size_t)(4 + k) * SS_M]; c[k] = sp[(size_t)(8 + k) * SS_M]; d[k] = sp[(size_t)(12 + k) * SS_M]; }
            const float s = (((a[0] + a[1]) + (a[2] + a[3])) + ((b[0] + b[1]) + (b[2] + b[3]))) + (((c[0] + c[1]) + (c[2] + c[3])) + ((d[0] + d[1]) + (d[2] + d[3])));
            ((PG8_LAS float*)(lds + RSTD_TAB_OFF))[slot * BM + row] = __builtin_amdgcn_rsqf(s * (1.0f / 1024.0f) + 1e-6f); } }
    asm volatile("s_waitcnt lgkmcnt(0)" ::: "memory"); __builtin_amdgcn_s_barrier(); asm volatile("" ::: "memory");
    return T;
}
template <bool APERM = false> __device__ __forceinline__ void row_rstd8_tab(float (&rs)[2][4], PG8_LAS unsigned char* lds, const RstdTab& tab, int pm, int rt0, int fr4) {
    const PG8_LAS float* T = (const PG8_LAS float*)(lds + RSTD_TAB_OFF) + (pm == tab.p0 ? 0 : BM);
#pragma unroll
    for (int ai = 0; ai < 2; ++ai)
#pragma unroll
        for (int m = 0; m < 4; ++m) rs[ai][m] = T[rt0 + ai * HALF + (APERM ? fr4 + m : m * 16)];
}
template <bool APERM = false> __device__ __forceinline__ void row_rstd8(float (&rs)[2][4], const float* ss, int row0, int fq, int fr4 = 0) {
    f32x4 a[2][4];
#pragma unroll
    for (int ai = 0; ai < 2; ++ai)
#pragma unroll
        for (int m = 0; m < 4; ++m)
#pragma unroll
            for (int k = 0; k < 4; ++k) a[ai][m][k] = ss[(size_t)(4 * fq + k) * SS_M + (row0 + ai * HALF + (APERM ? fr4 + m : m * 16))];
#pragma unroll
    for (int ai = 0; ai < 2; ++ai)
#pragma unroll
        for (int m = 0; m < 4; ++m) { float s = (a[ai][m][0] + a[ai][m][1]) + (a[ai][m][2] + a[ai][m][3]);
            s += __shfl_xor(s, 16); s += __shfl_xor(s, 32);
            rs[ai][m] = __builtin_amdgcn_rsqf(s * (1.0f / 1024.0f) + 1e-6f); }
}
constexpr int MROWS_HM = 32768;
struct EpiRowScale {
    static constexpr bool PERM = true, AFTER_DRAIN = false, APERM = false; static constexpr int NST = 16; static constexpr bool PF = false;
    bf16_t* O; const float* ss; int ldc, pad; RstdTab tab;
    __device__ __forceinline__ void operator()(f32x4 (&acc)[2][2][4][2], const Unit& u, int wr, int wc, int fr, int fq, PG8_LAS unsigned char* lds) const {
        if (pad) asm volatile("s_waitcnt vmcnt(0)" ::: "memory");
        if (pad == 1) return;
        asm volatile("" : "+v"(fr), "+v"(fq));
        const int row0 = u.pm * BM + wr * 64 + fr; const int col0 = u.pn * BM + wc * 32 + 8 * fq;
        float rs8[2][4]; if (tab.ok) row_rstd8_tab(rs8, lds, tab, u.pm, wr * 64 + fr, 0); else row_rstd8(rs8, ss, row0, fq);
#pragma unroll
        for (int ai = 0; ai < 2; ++ai)
#pragma unroll
            for (int m = 0; m < 4; ++m) { const int row = row0 + ai * HALF + m * 16; const float rs = rs8[ai][m];
                bf16_t* rowp = ldc ? O + (size_t)row * ldc + col0
                                   : (u.pn < 12 ? O + ((((size_t)(row >> 12) * 8 + 2 * (u.pn & 3)) * 3 + (u.pn >> 2)) * 4096 + (row & 4095)) * 128 + wc * 32 + 8 * fq
                                                : O + (size_t)3 * MROWS_HM * 1024 + (size_t)row * 1024 + (u.pn - 12) * BM + wc * 32 + 8 * fq);
                const size_t bjstep = ldc ? (size_t)HALF : (u.pn < 12 ? (size_t)3 * 4096 * 128 : (size_t)HALF);
#pragma unroll
                for (int bj = 0; bj < 2; ++bj) { const f32x4 v0 = acc[ai][bj][m][0] * rs, v1 = acc[ai][bj][m][1] * rs;
                    u32x4 w; w.x = cvt_pk_bf16(v0[0], v0[1]); w.y = cvt_pk_bf16(v0[2], v0[3]); w.z = cvt_pk_bf16(v1[0], v1[1]); w.w = cvt_pk_bf16(v1[2], v1[3]);
                    if (pad != 2) st16(rowp + bj * bjstep, w); } }
    }
};
typedef unsigned u32x2 __attribute__((ext_vector_type(2)));
template <int SITE  > struct EpiResid {
    static constexpr bool PERM = true, AFTER_DRAIN = false, APERM = false; static constexpr int NST = 16; static constexpr bool PF = PG8_RESID_PF;
    const float* base32; float* out; bf16_t* xb; float* ss; bf16_t* xbw; float* ssw; int dry, pad;
    template <bool F32IN, bool F32OUT>
    __device__ __forceinline__ void run(f32x4 (&acc)[2][2][4][2], const Unit& u, int wr, int wc, int fr, int fq) const {
        asm volatile("" : "+v"(fr), "+v"(fq));
        const int col0 = u.pn * BM + wc * 32 + 8 * fq;
#pragma unroll
        for (int ai = 0; ai < 2; ++ai) {
            const size_t off0 = (size_t)(u.pm * BM + ai * HALF + wr * 64 + fr) * 1024 + col0;
            f32x4 bf[F32IN ? 4 : 1][2][2]; u32x4 bh[F32IN ? 1 : 4][2];
#pragma unroll
            for (int m = 0; m < 4; ++m)
#pragma unroll
                for (int bj = 0; bj < 2; ++bj) { const size_t off = off0 + (size_t)m * 16 * 1024 + bj * HALF;
                    if (F32IN) { bf[F32IN ? m : 0][bj][0] = *(const f32x4*)(base32 + off); bf[F32IN ? m : 0][bj][1] = *(const f32x4*)(base32 + off + 4); }
                    else bh[F32IN ? 0 : m][bj] = dry == 2 ? (u32x4){0u, 0u, 0u, 0u} : *(const u32x4*)(xb + off); }
#pragma unroll
            for (int m = 0; m < 4; ++m) { float s = 0.f;
#pragma unroll
                for (int bj = 0; bj < 2; ++bj) { const size_t off = off0 + (size_t)m * 16 * 1024 + bj * HALF; f32x4 b0, b1;
                    if (F32IN) { b0 = bf[F32IN ? m : 0][bj][0]; b1 = bf[F32IN ? m : 0][bj][1]; }
                    else { const u32x4 r = bh[F32IN ? 0 : m][bj];
                        b0 = (f32x4){__uint_as_float(r.x << 16), __uint_as_float(r.x & 0xffff0000u), __uint_as_float(r.y << 16), __uint_as_float(r.y & 0xffff0000u)};
                        b1 = (f32x4){__uint_as_float(r.z << 16), __uint_as_float(r.z & 0xffff0000u), __uint_as_float(r.w << 16), __uint_as_float(r.w & 0xffff0000u)}; }
                    const f32x4 o0 = b0 + acc[ai][bj][m][0], o1 = b1 + acc[ai][bj][m][1];
                    if (F32OUT) { *(f32x4*)(out + off) = o0; *(f32x4*)(out + off + 4) = o1; }
                    s += ((o0[0] * o0[0] + o0[1] * o0[1]) + (o0[2] * o0[2] + o0[3] * o0[3])) + ((o1[0] * o1[0] + o1[1] * o1[1]) + (o1[2] * o1[2] + o1[3] * o1[3]));
                    u32x4 w; w.x = cvt_pk_bf16(o0[0], o0[1]); w.y = cvt_pk_bf16(o0[2], o0[3]); w.z = cvt_pk_bf16(o1[0], o1[1]); w.w = cvt_pk_bf16(o1[2], o1[3]); if (!F32OUT && dry != 4 && dry != 6) st16(xbw + off, w); }
                s += __shfl_xor(s, 16); s += __shfl_xor(s, 32);
                if (!F32OUT && fq == 0 && dry != 3 && dry != 7) ssw[(size_t)(u.pn * 4 + wc) * SS_M + (u.pm * BM + ai * HALF + wr * 64 + m * 16 + fr)] = s; }
        }
    }
    __device__ __forceinline__ void prefetch(const Unit& u, int tid, int wid, PG8_LAS unsigned char* lds) const {
        if (base32 != nullptr || dry == 1 || dry == 2) return;
#pragma unroll
        for (int i = 0; i < 2; ++i) { const int L = tid + i * 512;
            __builtin_amdgcn_global_load_lds((const unsigned*)(xb + (size_t)(u.pm * BM + (L >> 2)) * 1024 + u.pn * BM + (L & 3) * 64), (PG8_LAS unsigned*)(lds + STAGE_BYTES + wid * 256), 4, 0, 0); }
    }
    __device__ __forceinline__ void operator()(f32x4 (&acc)[2][2][4][2], const Unit& u, int wr, int wc, int fr, int fq, PG8_LAS unsigned char* lds) const {
        if (dry) asm volatile("s_waitcnt vmcnt(0)" ::: "memory");
        if (dry == 1) return;
        if (dry >= 5) {
#pragma unroll
            for (int a = 0; a < 2; ++a)
#pragma unroll
                for (int b = 0; b < 2; ++b)
#pragma unroll
                    for (int m = 0; m < 4; ++m)
#pragma unroll
                        for (int n = 0; n < 2; ++n) acc[a][b][m][n] = (f32x4){0.f, 0.f, 0.f, 0.f}; }
        if (SITE == 0) { if (base32) run<true, false>(acc, u, wr, wc, fr, fq); else run<false, false>(acc, u, wr, wc, fr, fq); }
        else { if (out) run<false, true>(acc, u, wr, wc, fr, fq); else run<false, false>(acc, u, wr, wc, fr, fq); }
    }
};
template <int CTRL> __device__ __forceinline__ float dpp_mov(float old, float src) {
    return __builtin_bit_cast(float, __builtin_amdgcn_update_dpp(__builtin_bit_cast(int, old), __builtin_bit_cast(int, src), CTRL, 0xf, 0xf, false)); }
__device__ __forceinline__ float silu_f(float c) { return c * __builtin_amdgcn_rcpf(1.0f + __expf(-c)); }
struct EpiGLU {
    static constexpr bool PERM = true, AFTER_DRAIN = false, APERM = true; static constexpr int NST = 20; static constexpr bool PF = false;
    bf16_t* G; const float* ss; const float* cw; const float* cb; float* tail; float* head_a; float* head_u; int dry, pad; RstdTab tab;
    __device__ __forceinline__ void operator()(f32x4 (&acc)[2][2][4][2], const Unit& u, int wr, int wc, int fr, int fq, PG8_LAS unsigned char* lds) const {
        if (dry) asm volatile("s_waitcnt vmcnt(0)" ::: "memory");
        if (dry == 1) { __builtin_amdgcn_s_barrier(); return; }
        asm volatile("" : "+v"(fr), "+v"(fq));
        const int f0 = u.pn * 128 + wc * 32 + 8 * fq;
        PG8_LAS float* X = (PG8_LAS float*)(lds + STAGE_BYTES);
        f32x4 w0 = *(const f32x4*)(cw + f0), w1 = *(const f32x4*)(cw + 3072 + f0), w2 = *(const f32x4*)(cw + 6144 + f0), bb = *(const f32x4*)(cb + f0);
        const f32x4 v0 = *(const f32x4*)(cw + f0 + 4), v1 = *(const f32x4*)(cw + 3072 + f0 + 4), v2 = *(const f32x4*)(cw + 6144 + f0 + 4), vb = *(const f32x4*)(cb + f0 + 4);
        { float rs8[2][4]; if (tab.ok) row_rstd8_tab<true>(rs8, lds, tab, u.pm, wr * 64, 4 * fr); else row_rstd8<true>(rs8, ss, u.pm * BM + wr * 64, fq, 4 * fr);
#pragma unroll
          for (int ai = 0; ai < 2; ++ai)
#pragma unroll
            for (int m = 0; m < 4; ++m) {
#pragma unroll
                for (int bj = 0; bj < 2; ++bj)
#pragma unroll
                    for (int n = 0; n < 2; ++n) acc[ai][bj][m][n] = acc[ai][bj][m][n] * (bj ? rs8[ai][m] * -0.6931471805599453f : rs8[ai][m]); } }
        if (fr == 15) {
#pragma unroll
            for (int ai = 0; ai < 2; ++ai)
#pragma unroll
                for (int n = 0; n < 2; ++n) { *(PG8_LAS f32x4*)(X + ((((ai * 2 + wr) * 4 + wc) * 2 + 0) * 32 + 8 * fq + 4 * n)) = acc[ai][0][2][n]; *(PG8_LAS f32x4*)(X + ((((ai * 2 + wr) * 4 + wc) * 2 + 1) * 32 + 8 * fq + 4 * n)) = acc[ai][0][3][n]; }
        }
        asm volatile("s_waitcnt lgkmcnt(0)" ::: "memory"); __builtin_amdgcn_s_barrier(); asm volatile("" ::: "memory");
#pragma unroll
        for (int ai = 0; ai < 2; ++ai) {
            const int blk = ai * 2 + wr;
            unsigned pk[2][4][2];
#pragma unroll
            for (int n = 0; n < 2; ++n) {
                const f32x4 c_w0 = (n ? v0 : w0) * -1.4426950408889634f, c_w1 = (n ? v1 : w1) * -1.4426950408889634f, c_w2 = (n ? v2 : w2) * -1.4426950408889634f, c_bb = (n ? vb : bb) * -1.4426950408889634f;
                f32x4 P1 = (f32x4){0.f, 0.f, 0.f, 0.f}, P2 = P1;
                if (blk > 0) { P2 = *(const PG8_LAS f32x4*)(X + (((blk - 1) * 4 + wc) * 2 + 0) * 32 + 8 * fq + 4 * n); P1 = *(const PG8_LAS f32x4*)(X + (((blk - 1) * 4 + wc) * 2 + 1) * 32 + 8 * fq + 4 * n); }
                f32x4 gv[4];
                {
                    const f32x4 a0 = acc[ai][0][0][n], a1 = acc[ai][0][1][n], a2 = acc[ai][0][2][n], a3 = acc[ai][0][3][n];
                    f32x4 L3, L2;
#pragma unroll
                    for (int j = 0; j < 4; ++j) { L3[j] = dpp_mov<0x111>(P1[j], a3[j]); L2[j] = dpp_mov<0x111>(P2[j], a2[j]); }
                    f32x4 c[4];
                    c[0] = __builtin_elementwise_fma(c_w0, L2, __builtin_elementwise_fma(c_w1, L3, __builtin_elementwise_fma(c_w2, a0, c_bb)));
                    c[1] = __builtin_elementwise_fma(c_w0, L3, __builtin_elementwise_fma(c_w1, a0, __builtin_elementwise_fma(c_w2, a1, c_bb)));
                    c[2] = __builtin_elementwise_fma(c_w0, a0, __builtin_elementwise_fma(c_w1, a1, __builtin_elementwise_fma(c_w2, a2, c_bb)));
                    c[3] = __builtin_elementwise_fma(c_w0, a1, __builtin_elementwise_fma(c_w1, a2, __builtin_elementwise_fma(c_w2, a3, c_bb)));
                    if (dry == 3) { gv[0] = a0 * acc[ai][1][0][n]; gv[1] = a1 * acc[ai][1][1][n]; gv[2] = a2 * acc[ai][1][2][n]; gv[3] = a3 * acc[ai][1][3][n]; }
                    else {
#pragma unroll
                        for (int m = 0; m < 4; ++m) {
                            f32x4 en;
#pragma unroll
                            for (int j = 0; j < 4; ++j) en[j] = __builtin_amdgcn_exp2f(c[m][j]);
                            const f32x4 den = en + 1.0f; f32x4 rc;
#pragma unroll
                            for (int j = 0; j < 4; ++j) rc[j] = __builtin_amdgcn_rcpf(den[j]);
                            gv[m] = (c[m] * acc[ai][1][m][n]) * rc; } }
                }
#pragma unroll
                for (int m = 0; m < 4; ++m) { pk[n][m][0] = cvt_pk_bf16(gv[m][0], gv[m][1]); pk[n][m][1] = cvt_pk_bf16(gv[m][2], gv[m][3]); }
            }
#pragma unroll
            for (int m = 0; m < 4; ++m) {
                const u32x4 w = (u32x4){pk[0][m][0], pk[0][m][1], pk[1][m][0], pk[1][m][1]};
                if (dry == 5) { const int li = fr + 16 * fq; *(u32x4*)(G + (size_t)(u.pm * BM + (wr * 4 + wc) * 32 + (ai * 4 + m) * 4 + (li >> 4)) * 3072 + u.pn * 128 + (li & 15) * 8) = w; }
                else if (dry == 4) *(u32x4*)(G + (size_t)((u.pm & 1) * BM + ai * HALF + wr * 64 + 4 * fr + m) * 3072 + f0) = w;
                else if (dry != 2) st16(G + (size_t)(u.pm * BM + ai * HALF + wr * 64 + 4 * fr + m) * 3072 + f0, w); }
            asm volatile("" ::: "memory");
        }
        if (fr == 15 && wr == 1) {
#pragma unroll
            for (int n = 0; n < 2; ++n) { *(f32x4*)(tail + ((size_t)u.pm * 2 + 0) * 3072 + f0 + 4 * n) = acc[1][0][2][n]; *(f32x4*)(tail + ((size_t)u.pm * 2 + 1) * 3072 + f0 + 4 * n) = acc[1][0][3][n]; } }
        if (wr == 0 && fr == 0) {
#pragma unroll
            for (int n = 0; n < 2; ++n)
#pragma unroll
                for (int m = 0; m < 2; ++m) { *(f32x4*)(head_a + ((size_t)u.pm * 2 + m) * 3072 + f0 + 4 * n) = acc[0][0][m][n]; *(f32x4*)(head_u + ((size_t)u.pm * 2 + m) * 3072 + f0 + 4 * n) = acc[0][1][m][n]; } }
    }
};
struct EpiQKV {
    static constexpr bool PERM = true, AFTER_DRAIN = false, APERM = false; static constexpr int NST = 16; static constexpr bool PF = false;
    bf16_t* O; const float* ss; const float* qg; const float* kg; const float* invf; float* kmean; int dry, pad; RstdTab tab;
    __device__ __forceinline__ void operator()(f32x4 (&acc)[2][2][4][2], const Unit& u, int wr, int wc, int fr, int fq, PG8_LAS unsigned char* lds) const {
        if (dry) asm volatile("s_waitcnt vmcnt(0)" ::: "memory");
        asm volatile("" : "+v"(fr), "+v"(fq));
        const int type = u.pn >> 2, wv = wr * 4 + wc;
        const int dlo_ = 32 * (wc & 1) + 8 * fq; const float* g_ = type == 1 ? kg : qg;
        const f32x4 glo_a = *(const f32x4*)(g_ + dlo_), ghi_a = *(const f32x4*)(g_ + 64 + dlo_), if_a = *(const f32x4*)(invf + dlo_), glo_b = *(const f32x4*)(g_ + dlo_ + 4), ghi_b = *(const f32x4*)(g_ + 64 + dlo_ + 4), if_b = *(const f32x4*)(invf + dlo_ + 4);
        PG8_LAS float* X = (PG8_LAS float*)(lds + STAGE_BYTES);
        PG8_LAS float* KS = X + 1024;
        { float rs8[2][4]; if (tab.ok) row_rstd8_tab(rs8, lds, tab, u.pm, wr * 64 + fr, 0); else row_rstd8(rs8, ss, u.pm * BM + wr * 64 + fr, fq);
#pragma unroll
          for (int ai = 0; ai < 2; ++ai)
#pragma unroll
            for (int m = 0; m < 4; ++m)
#pragma unroll
                for (int bj = 0; bj < 2; ++bj)
#pragma unroll
                    for (int n = 0; n < 2; ++n) acc[ai][bj][m][n] = acc[ai][bj][m][n] * rs8[ai][m]; }
        if (type == 2) {
#pragma unroll
            for (int ai = 0; ai < 2; ++ai)
#pragma unroll
                for (int m = 0; m < 4; ++m) { const int row = u.pm * BM + ai * HALF + wr * 64 + m * 16 + fr;
                    bf16_t* rowp = O + ((((size_t)(row >> 12) * 8 + 2 * (u.pn & 3)) * 3 + 2) * 4096 + (row & 4095)) * 128 + wc * 32 + 8 * fq;
#pragma unroll
                    for (int bj = 0; bj < 2; ++bj) { const f32x4 v0 = acc[ai][bj][m][0], v1 = acc[ai][bj][m][1];
                        u32x4 w; w.x = cvt_pk_bf16(v0[0], v0[1]); w.y = cvt_pk_bf16(v0[2], v0[3]); w.z = cvt_pk_bf16(v1[0], v1[1]); w.w = cvt_pk_bf16(v1[2], v1[3]);
                        st16(rowp + (size_t)bj * 3 * 4096 * 128, w); } }
        } else {
#pragma unroll
            for (int ai = 0; ai < 2; ++ai)
#pragma unroll
                for (int m = 0; m < 4; ++m) { float s = 0.f;
#pragma unroll
                    for (int bj = 0; bj < 2; ++bj)
#pragma unroll
                        for (int n = 0; n < 2; ++n) { const f32x4 v = acc[ai][bj][m][n]; s += (v[0] * v[0] + v[1] * v[1]) + (v[2] * v[2] + v[3] * v[3]); }
                    s += __shfl_xor(s, 16); s += __shfl_xor(s, 32);
                    if (fq == 0) X[wv * 128 + ai * 64 + m * 16 + fr] = s; }
        }
        asm volatile("s_waitcnt lgkmcnt(0)" ::: "memory"); __builtin_amdgcn_s_barrier(); asm volatile("" ::: "memory");
        if (type < 2 && dry != 1) {
            const int head = 2 * (u.pn & 3) + (wc >> 1), dlo = 32 * (wc & 1) + 8 * fq;
            const float* g = type ? kg : qg; const float qs = type ? 1.0f : 0.08838834764831845f;
            f32x4 clo[2], chi[2];
#pragma unroll
            for (int n = 0; n < 2; ++n) { clo[n] = (f32x4){0.f, 0.f, 0.f, 0.f}; chi[n] = clo[n]; }
#pragma unroll
            for (int ai = 0; ai < 2; ++ai)
#pragma unroll
                for (int m = 0; m < 4; ++m) {
                    const int r = ai * 64 + m * 16 + fr, row = u.pm * BM + ai * HALF + wr * 64 + m * 16 + fr; const float pos = (float)(row & 4095);
                    const float tot = X[(wv & ~1) * 128 + r] + X[(wv | 1) * 128 + r];
                    const float rh = __builtin_amdgcn_rsqf(tot * (1.0f / 128.0f) + 1e-6f);
                    u32x4 wlo, whi; unsigned pl[4], ph[4];
#pragma unroll
                    for (int n = 0; n < 2; ++n) {
                        const f32x4 glo = n ? glo_b : glo_a, ghi = n ? ghi_b : ghi_a, ifq = n ? if_b : if_a;
                        f32x4 olo, ohi;
#pragma unroll
                        for (int j = 0; j < 4; ++j) {
                            const float ylo = acc[ai][0][m][n][j] * rh * glo[j], yhi = acc[ai][1][m][n][j] * rh * ghi[j];
                            const float ang = pos * ifq[j];
                            const float rev = __builtin_amdgcn_fractf(ang * 0.15915494309189535f);
                            const float c = __builtin_amdgcn_cosf(rev), sn = __builtin_amdgcn_sinf(rev);
                            olo[j] = (ylo * c - yhi * sn) * qs; ohi[j] = (yhi * c + ylo * sn) * qs; }
                        clo[n] = clo[n] + olo; chi[n] = chi[n] + ohi;
                        pl[2 * n] = cvt_pk_bf16(olo[0], olo[1]); pl[2 * n + 1] = cvt_pk_bf16(olo[2], olo[3]); ph[2 * n] = cvt_pk_bf16(ohi[0], ohi[1]); ph[2 * n + 1] = cvt_pk_bf16(ohi[2], ohi[3]); }
                    wlo = (u32x4){pl[0], pl[1], pl[2], pl[3]}; whi = (u32x4){ph[0], ph[1], ph[2], ph[3]};
                    bf16_t* op = O + ((((size_t)(row >> 12) * 8 + head) * 3 + type) * 4096 + (row & 4095)) * 128 + dlo;
                    if (dry != 2) { st16(op, wlo); st16(op + 64, whi); }
                }
            if (type == 1) {
#pragma unroll
                for (int n = 0; n < 2; ++n)
#pragma unroll
                    for (int j = 0; j < 4; ++j) {
                        float a = clo[n][j], bsum = chi[n][j];
                        a += __shfl_xor(a, 1); a += __shfl_xor(a, 2); a += __shfl_xor(a, 4); a += __shfl_xor(a, 8);
                        bsum += __shfl_xor(bsum, 1); bsum += __shfl_xor(bsum, 2); bsum += __shfl_xor(bsum, 4); bsum += __shfl_xor(bsum, 8);
                        if (fr == 0) { KS[wv * 64 + 8 * fq + 4 * n + j] = a; KS[wv * 64 + 32 + 8 * fq + 4 * n + j] = bsum; } }
            }
        }
        asm volatile("s_waitcnt lgkmcnt(0)" ::: "memory"); __builtin_amdgcn_s_barrier(); asm volatile("" ::: "memory");
        if (type == 1 && wr == 0) {
            const int lane = fr + 16 * fq, head = 2 * (u.pn & 3) + (wc >> 1), d = 64 * (lane >> 5) + 32 * (wc & 1) + (lane & 31);
            const float s = KS[wv * 64 + lane] + KS[(wv + 4) * 64 + lane];
            kmean[((size_t)((u.pm >> 4) * 8 + head) * 16 + (u.pm & 15)) * 128 + d] = s * (1.0f / 256.0f);
        }
    }
};
template <class Epi, class Sched, bool ALIGN_EPI = false, bool SP2 = false>
__device__ __forceinline__ void gemm_phase(PG8_LAS unsigned char* lds, const Gemm g, const Sched& S, const Epi& E) {
    int tid_ = wg_tid(); asm volatile("" : "+v"(tid_));
    const int tid = tid_, wid = __builtin_amdgcn_readfirstlane(tid >> 6), lane = tid & 63, wr = wid >> 2, wc = wid & 3, fr = lane & 15, fq = lane >> 4;
    const int K = g.K, nt = K / BK;
    unsigned voffA[2], voffB[2];
#pragma unroll
    for (int i = 0; i < 2; ++i) { int R, C; stage_rc(tid * 16 + i * 8192, R, C); const int Rb = Epi::PERM ? ((R & ~31) + perm32(R & 31)) : R;
        const int Ra = Epi::APERM ? ((R & ~63) + 4 * (R & 15) + ((R >> 4) & 3)) : R;
        voffA[i] = (unsigned)(Ra * g.lda + C) * 2u; voffB[i] = (unsigned)(Rb * K + C) * 2u; }
    const size_t kstep = (size_t)(BK * 2);
    const size_t hstepB = (size_t)HALF * K * 2, hstepA = (size_t)HALF * g.lda * 2;
    const size_t tstepA = 2 * hstepA, tstepB = 2 * hstepB;
    const unsigned ldsw = (unsigned)wid * 1024u;
    const int aoff = lds_byte(wr * 64 + fr, fq * 8), boff = lds_byte(wc * 32 + fr, fq * 8);
#define PG8_SA(b, h) (((b) * 2 + (h)) * HTB)
#define PG8_SB(b, h) ((4 + (b) * 2 + (h)) * HTB)
#define PG8_STAGE(bufoff, gbase, voff) do { _Pragma("unroll") for (int _i = 0; _i < 2; ++_i) \
        __builtin_amdgcn_global_load_lds((const unsigned*)((const char*)(gbase) + (voff)[_i]), (PG8_LAS unsigned*)(lds + (bufoff) + ldsw + _i * 8192), 16, 0, 0); } while (0)
#define PG8_LDA(dst, b, h) do { _Pragma("unroll") for (int m = 0; m < 4; ++m) _Pragma("unroll") for (int k = 0; k < 2; ++k) dst[m][k] = *(const PG8_LAS bf16x8*)(lds + PG8_SA(b, h) + aoff + m * 2048 + k * 1024); } while (0)
#define PG8_LDB(dst, b, h) do { _Pragma("unroll") for (int n = 0; n < 2; ++n) _Pragma("unroll") for (int k = 0; k < 2; ++k) dst[n][k] = *(const PG8_LAS bf16x8*)(lds + PG8_SB(b, h) + boff + n * 2048 + k * 1024); } while (0)
#define PG8_MMA(ai, bj, At, Bt) do { if (PG8_MMA_PRIO) __builtin_amdgcn_s_setprio(PG8_MMA_PRIO); _Pragma("unroll") for (int m = 0; m < 4; ++m) _Pragma("unroll") for (int n = 0; n < 2; ++n) _Pragma("unroll") for (int k = 0; k < 2; ++k) \
        acc[ai][bj][m][n] = __builtin_amdgcn_mfma_f32_16x16x32_bf16(Bt[n][k], At[m][k], acc[ai][bj][m][n], 0, 0, 0); if (PG8_MMA_PRIO) __builtin_amdgcn_s_setprio(0); } while (0)
#define PG8_WAIT_V(n) asm volatile("s_waitcnt vmcnt(" #n ")" ::: "memory")
#define PG8_WAIT_L(n) asm volatile("s_waitcnt lgkmcnt(" #n ")" ::: "memory")
#define PG8_BAR __builtin_amdgcn_s_barrier()
#define PG8_SCHED __builtin_amdgcn_sched_barrier(0)
    Unit cur, nxt; int ui = 0;
    if (!S.next(0, cur)) return;
#if PROBE_STAMP == 4 || PROBE_STAMP == 5
    unsigned s_acc = 0u, s_t = (unsigned)__builtin_amdgcn_s_memrealtime();
#endif
    f32x4 acc[2][2][4][2];
#pragma unroll
    for (int a = 0; a < 2; ++a)
#pragma unroll
        for (int b = 0; b < 2; ++b)
#pragma unroll
            for (int m = 0; m < 4; ++m)
#pragma unroll
                for (int n = 0; n < 2; ++n) acc[a][b][m][n] = (f32x4){0.f, 0.f, 0.f, 0.f};
    bf16x8 At[4][2], B0[2][2], B1[2][2];
    const char* cA = (const char*)g.A + (size_t)cur.pm * tstepA; const char* cB = (const char*)g.Bt + (size_t)cur.pn * tstepB;
    S.a_ready(cur);
    if constexpr (SP2) {
        PG8_STAGE(PG8_SB(0, 0), cB, voffB); PG8_STAGE(PG8_SB(0, 1), cB + hstepB, voffB); PG8_STAGE(PG8_SA(0, 0), cA, voffA); PG8_STAGE(PG8_SA(0, 1), cA + hstepA, voffA);
        if (wr == 1) PG8_BAR;
        PG8_WAIT_V(2); PG8_BAR;
        PG8_STAGE(PG8_SB(1, 0), cB + kstep, voffB); PG8_STAGE(PG8_SA(1, 0), cA + kstep, voffA); PG8_STAGE(PG8_SB(1, 1), cB + hstepB + kstep, voffB);
        PG8_WAIT_V(6); PG8_BAR;
    } else {
        PG8_STAGE(PG8_SB(0, 0), cB, voffB); PG8_STAGE(PG8_SA(0, 0), cA, voffA); PG8_STAGE(PG8_SB(0, 1), cB + hstepB, voffB); PG8_STAGE(PG8_SA(0, 1), cA + hstepA, voffA);
        if (wr == 1) PG8_BAR;
        PG8_WAIT_V(4); PG8_BAR;
        PG8_STAGE(PG8_SB(1, 0), cB + kstep, voffB); PG8_STAGE(PG8_SA(1, 0), cA + kstep, voffA); PG8_STAGE(PG8_SB(1, 1), cB + hstepB + kstep, voffB);
        PG8_WAIT_V(6); PG8_BAR;
    }
    constexpr bool PRE = PG8_PRE && SP2 && ALIGN_EPI;
    for (;;) {
        const bool has_next = S.next(ui + 1, nxt);
        const char* nA = has_next ? (const char*)g.A + (size_t)nxt.pm * tstepA : cA; const char* nB = has_next ? (const char*)g.Bt + (size_t)nxt.pn * tstepB : cB;
        for (int t = 0; t < nt; t += 2) {
            const bool last = (t == nt - 2);
            const char* a1 = cA + (size_t)(t + 1) * kstep;
            const char* a2 = last ? nA : cA + (size_t)(t + 2) * kstep; const char* b2 = last ? nB : cB + (size_t)(t + 2) * kstep;
            const char* a3 = a2 + kstep; const char* b3 = b2 + kstep;
            int pre_s = __builtin_amdgcn_readfirstlane(t | (ui == 0)); asm volatile("" : "+s"(pre_s)); const bool pre = PRE && pre_s == 0;
            if (last && has_next) S.a_ready(nxt);
            if constexpr (SP2) {
            PG8_LDB(B0, 0, 0); PG8_LDB(B1, 0, 1); PG8_SCHED; PG8_LDA(At, 0, 0); if (!(PRE && pre)) PG8_STAGE(PG8_SA(1, 1), a1 + hstepA, voffA);
            if (PRE && pre) asm volatile("s_waitcnt vmcnt(%0)" :: "n"(Epi::NST) : "memory"); else PG8_WAIT_V(8);
            if constexpr (Epi::PF) { int pf_s = __builtin_amdgcn_readfirstlane(t - (nt - PG8_PF_DIST)); asm volatile("" : "+s"(pf_s)); if (pf_s == 0) E.prefetch(cur, tid, wid, lds); }
            PG8_WAIT_L(0); PG8_BAR; PG8_MMA(0, 0, At, B0); PG8_MMA(0, 1, At, B1); PG8_BAR; PG8_SCHED;
            PG8_LDA(At, 0, 1); PG8_STAGE(PG8_SB(0, 0), b2, voffB); PG8_STAGE(PG8_SB(0, 1), b2 + hstepB, voffB); PG8_STAGE(PG8_SA(0, 0), a2, voffA);
            if (!(PRE && pre)) PG8_WAIT_V(8);
            PG8_WAIT_L(0); PG8_BAR; PG8_MMA(1, 0, At, B0); PG8_MMA(1, 1, At, B1); PG8_BAR; PG8_SCHED;
            PG8_LDB(B0, 1, 0); PG8_LDB(B1, 1, 1); PG8_SCHED; PG8_LDA(At, 1, 0); PG8_STAGE(PG8_SA(0, 1), a2 + hstepA, voffA);
            if (!(PRE && pre)) PG8_WAIT_V(8);
            PG8_WAIT_L(0); PG8_BAR; PG8_MMA(0, 0, At, B0); PG8_MMA(0, 1, At, B1); PG8_BAR; PG8_SCHED;
            PG8_LDA(At, 1, 1); PG8_STAGE(PG8_SB(1, 0), b3, voffB); PG8_STAGE(PG8_SB(1, 1), b3 + hstepB, voffB); PG8_STAGE(PG8_SA(1, 0), a3, voffA);
            PG8_WAIT_V(8); PG8_WAIT_L(0); PG8_BAR; PG8_MMA(1, 0, At, B0); PG8_MMA(1, 1, At, B1); PG8_BAR; PG8_SCHED;
            } else {
            PG8_LDB(B0, 0, 0); PG8_SCHED; PG8_LDA(At, 0, 0); PG8_STAGE(PG8_SA(1, 1), a1 + hstepA, voffA);
            PG8_WAIT_L(8); PG8_BAR; PG8_WAIT_L(0); PG8_MMA(0, 0, At, B0); PG8_BAR; PG8_SCHED;
            PG8_LDB(B1, 0, 1); PG8_STAGE(PG8_SB(0, 0), b2, voffB);
            PG8_BAR; PG8_WAIT_L(0); PG8_MMA(0, 1, At, B1); PG8_BAR;
            PG8_LDA(At, 0, 1); PG8_STAGE(PG8_SA(0, 0), a2, voffA);
            PG8_BAR; PG8_WAIT_L(0); PG8_MMA(1, 0, At, B0); PG8_BAR; PG8_SCHED;
            PG8_STAGE(PG8_SB(0, 1), b2 + hstepB, voffB);
            PG8_WAIT_V(6); PG8_BAR; PG8_MMA(1, 1, At, B1); PG8_BAR;
            PG8_LDB(B0, 1, 0); PG8_SCHED; PG8_LDA(At, 1, 0); PG8_STAGE(PG8_SA(0, 1), a2 + hstepA, voffA);
            PG8_WAIT_L(8); PG8_BAR; PG8_WAIT_L(0); PG8_MMA(0, 0, At, B0); PG8_BAR; PG8_SCHED;
            PG8_LDB(B1, 1, 1); PG8_STAGE(PG8_SB(1, 0), b3, voffB);
            PG8_BAR; PG8_WAIT_L(0); PG8_MMA(0, 1, At, B1); PG8_BAR;
            PG8_LDA(At, 1, 1); PG8_STAGE(PG8_SA(1, 0), a3, voffA);
            PG8_BAR; PG8_WAIT_L(0); PG8_MMA(1, 0, At, B0); PG8_BAR; PG8_SCHED;
            PG8_STAGE(PG8_SB(1, 1), b3 + hstepB, voffB);
            PG8_WAIT_V(6); PG8_BAR; PG8_MMA(1, 1, At, B1); PG8_BAR;
            }
        }
        if constexpr (ALIGN_EPI) { if (wr == 0) PG8_BAR; }
        if constexpr (PRE) { if (has_next) { PG8_STAGE(PG8_SA(1, 1), nA + kstep + hstepA, voffA); } }
#if PROBE_STAMP == 4 || PROBE_STAMP == 5
        { const unsigned now_ = (unsigned)__builtin_amdgcn_s_memrealtime(); if (PROBE_STAMP == 5) s_acc += now_ - s_t; s_t = now_; }
#endif
        if constexpr (!Epi::AFTER_DRAIN) { E(acc, cur, wr, wc, fr, fq, lds); S.done(cur); }
#if PROBE_STAMP == 4 || PROBE_STAMP == 5
        { const unsigned now_ = (unsigned)__builtin_amdgcn_s_memrealtime(); if (PROBE_STAMP == 4) s_acc += now_ - s_t; s_t = now_; }
#endif
        if (!has_next) break;
#pragma unroll
        for (int a = 0; a < 2; ++a)
#pragma unroll
            for (int b = 0; b < 2; ++b)
#pragma unroll
                for (int m = 0; m < 4; ++m)
#pragma unroll
                    for (int n = 0; n < 2; ++n) acc[a][b][m][n] = (f32x4){0.f, 0.f, 0.f, 0.f};
        cur = nxt; cA = nA; cB = nB; ++ui;
        if constexpr (ALIGN_EPI) { if (wr == 1) PG8_BAR; }
    }
    PG8_WAIT_V(0);
    if constexpr (!ALIGN_EPI) { if (wr == 0) PG8_BAR; }
    PG8_BAR;
    if constexpr (Epi::AFTER_DRAIN) { E.fused(acc, cur, wr, wc, fr, fq, lds, wid, lane); S.done(cur); }
#if PROBE_STAMP == 4 || PROBE_STAMP == 5
    if (tid == 0) { volatile PG8_LAS unsigned long long* st_ = (volatile PG8_LAS unsigned long long*)(lds + 139264 + 256); if (st_[3]) st_[1] += (unsigned long long)s_acc; }
#endif
#undef PG8_SA
#undef PG8_SB
#undef PG8_STAGE
#undef PG8_LDA
#undef PG8_LDB
#undef PG8_MMA
#undef PG8_WAIT_V
#undef PG8_WAIT_L
#undef PG8_BAR
#undef PG8_SCHED
}
}
#ifndef PROBE_DUP
#define PROBE_DUP 0
#endif
constexpr int BATCH = 8, SEQ = 4096, DM = 1024, MROWS = BATCH * SEQ, DEPTH = 4;
constexpr int NH = 8, HD = 128;
constexpr int FF = 3072, NBLK = 16, MBLK = 256;
constexpr float QSCALE = 0.08838834764831845f;
typedef unsigned short bf16;
typedef float f32x4 __attribute__((ext_vector_type(4)));
typedef unsigned u32x4 __attribute__((ext_vector_type(4)));

constexpr size_t MiB = 1u << 20;
constexpr size_t WS_CTL = 0, CTL_ZERO_BYTES = 64 * 1024;
constexpr size_t WS_WIN = 2 * MiB, WS_WQKV = 18 * MiB, WS_WOH = 30 * MiB, WS_WOM = 34 * MiB, WS_WUP = 38 * MiB, WS_WDN = 86 * MiB;
constexpr size_t WS_SS = 110 * MiB, WS_COS = 112 * MiB, WS_SIN = 113 * MiB, WS_LBV = 114 * MiB, WS_KMEAN = 115 * MiB;
constexpr size_t WS_INVF = 114 * MiB + 16384;
constexpr size_t WS_HGD = 115 * MiB + 512 * 1024, WS_HGE = 116 * MiB;
constexpr size_t WS_TAIL = 132 * MiB, WS_HEADA = 135 * MiB, WS_HEADU = 138 * MiB;
constexpr size_t WS_XB = 144 * MiB, WS_BIG = 208 * MiB, WS_AU = 400 * MiB, WS_ML = 464 * MiB, WS_END = 472 * MiB;

__device__ __forceinline__ float bf2f(bf16 v) { return __uint_as_float((unsigned)v << 16); }
__device__ __forceinline__ bf16 f2bf(float f) { unsigned u = __float_as_uint(f); return (bf16)((u + 0x7fffu + ((u >> 16) & 1u)) >> 16); }
__device__ __forceinline__ float wave_sum(float v) {
#pragma unroll
    for (int o = 1; o < 64; o <<= 1) v += __shfl_xor(v, o);
    return v;
}
__device__ __forceinline__ float wave_max(float v) {
#pragma unroll
    for (int o = 1; o < 64; o <<= 1) v = fmaxf(v, __shfl_xor(v, o));
    return v;
}

__device__ __forceinline__ void glu_fixup_elem(int pm, int rr, int f, bf16* __restrict__ g, const float* __restrict__ tail, const float* __restrict__ head_a, const float* __restrict__ head_u, const float* __restrict__ cw, const float* __restrict__ cb) {
    const bool first = (pm & 15) == 0;
    const float cur = head_a[((size_t)pm * 2 + rr) * FF + f];
    const float t1 = first ? 0.f : tail[((size_t)(pm - 1) * 2 + 1) * FF + f], t0 = first ? 0.f : tail[((size_t)(pm - 1) * 2 + 0) * FF + f];
    const float prev1 = rr == 0 ? t1 : head_a[((size_t)pm * 2) * FF + f], prev2 = rr == 0 ? t0 : t1;
    const float c = cw[f] * prev2 + cw[FF + f] * prev1 + cw[2 * FF + f] * cur + cb[f];
    g[((size_t)pm * 256 + rr) * FF + f] = f2bf(c / (1.0f + __expf(-c)) * head_u[((size_t)pm * 2 + rr) * FF + f]);
}
#define XB_TMO      128
#define XB_XCNT(j)  (256  + 64 * (j))
#define XB_XSUB(j)  (1280 + 64 * (j))
#define XB_XGEN(j)  (2304 + 64 * (j))
#define XB_TOP      3328
#define XB_TOPGEN   3392
#define XCD_BAR_WORDS 3456
#define XB_SPIN_CAP (1u << 18)
#define LAS __attribute__((address_space(3)))

__device__ __forceinline__ unsigned xb_ld(unsigned* p)              { return __hip_atomic_load(p, __ATOMIC_RELAXED, __HIP_MEMORY_SCOPE_AGENT); }
__device__ __forceinline__ unsigned xb_add(unsigned* p, unsigned v) { return __hip_atomic_fetch_add(p, v, __ATOMIC_RELAXED, __HIP_MEMORY_SCOPE_AGENT); }
__device__ __forceinline__ unsigned xb_xcc_id() { return (unsigned)__builtin_amdgcn_s_getreg((3 << 11) | 20) & 0xFu; }
#define XB_SPIN(cond, bar) do { unsigned _sp = 0; while (cond) { __builtin_amdgcn_s_sleep(1); \
    if ((++_sp & 255u) == 0u) { if (xb_ld(&(bar)[XB_TMO])) break; if (_sp > XB_SPIN_CAP) { atomicAdd(&(bar)[XB_TMO], 1u); break; } } } } while (0)

struct XcdBarrier {
    unsigned* bar; unsigned x;
    volatile LAS unsigned* st;
};

__device__ __forceinline__ XcdBarrier xcd_barrier_post(unsigned* bar, volatile LAS unsigned* st) {
    XcdBarrier b; b.bar = bar; b.x = xb_xcc_id(); b.st = st;
    if (wg_tid() == 0) (void)xb_add(&bar[XB_XCNT(b.x)], 1u);
    return b;
}
__device__ __forceinline__ void xcd_barrier_complete(unsigned* bar, unsigned x, unsigned& nloc, unsigned& nx) {
    const unsigned G = gridDim.x * gridDim.y * gridDim.z;
    unsigned sum, cnt, mine, sp = 0u;
    for (;;) {
        sum = 0u; cnt = 0u; mine = 0u;
#pragma unroll
        for (unsigned j = 0; j < 16; ++j) { const unsigned c = xb_ld(&bar[XB_XCNT(j)]); sum += c; cnt += (c > 0u) ? 1u : 0u; mine = (j == x) ? c : mine; }
        if (sum == G) break;
        __builtin_amdgcn_s_sleep(1);
        if ((++sp & 255u) == 0u) { if (xb_ld(&bar[XB_TMO])) break; if (sp > XB_SPIN_CAP) { atomicAdd(&bar[XB_TMO], 1u); break; } }
    }
    nloc = mine > 0u ? mine : 1u; nx = cnt > 0u ? cnt : 1u;
}

__device__ __forceinline__ void xcd_barrier(const XcdBarrier& b) {
    asm volatile("s_waitcnt vmcnt(0)" ::: "memory");
    __syncthreads();
    if (wg_tid() == 0) {
        unsigned* bar = b.bar;
        __builtin_amdgcn_s_waitcnt(0);
        unsigned nloc = b.st[0], nx = b.st[1];
        if (nloc == 0u) { xcd_barrier_complete(bar, b.x, nloc, nx); b.st[0] = nloc; b.st[1] = nx; }
        const unsigned old = xb_add(&bar[XB_XSUB(b.x)], 1u);
        const unsigned gen = old / nloc;
        if (old + 1u == (gen + 1u) * nloc) {
            __builtin_amdgcn_fence(__ATOMIC_RELEASE, "agent");
            asm volatile("s_waitcnt vmcnt(0)" ::: "memory");
            const unsigned og = xb_add(&bar[XB_TOP], 1u);
            const unsigned tg = og / nx;
            if (og + 1u == (tg + 1u) * nx) xb_add(&bar[XB_TOPGEN], 1u);
            else XB_SPIN(xb_ld(&bar[XB_TOPGEN]) == tg, bar);
            __builtin_amdgcn_fence(__ATOMIC_ACQUIRE, "agent");
            xb_add(&bar[XB_XGEN(b.x)], 1u);
            asm volatile("s_waitcnt vmcnt(0)" ::: "memory");
        } else {
            XB_SPIN(xb_ld(&bar[XB_XGEN(b.x)]) == gen, bar);
            __builtin_amdgcn_fence(__ATOMIC_ACQUIRE, "agent");
            asm volatile("s_waitcnt vmcnt(0)" ::: "memory");
        }
    }
    __syncthreads();
}

#ifndef LB_FORCE2
#define LB_FORCE2 0
#endif
#define LB_CENSUS(g, x) (8192 + 16 * (g) + (x))
#define LB_CNT(g)       (8448 + 64 * (g))
#define LB_GEN(g)       (9216 + 64 * (g))
__device__ __forceinline__ void lb_post(unsigned* ctl) { if (wg_tid() == 0) (void)xb_add(&ctl[LB_CENSUS(blockIdx.x & 7u, xb_xcc_id())], 1u); }
__device__ __forceinline__ void lb_decide(unsigned* ctl, volatile LAS unsigned* lst) {
    {
        const unsigned G = gridDim.x;
        if (wg_tid() < 128u) { const unsigned g = wg_tid() >> 4, x = wg_tid() & 15u, n = (G > g) ? (G - g + 7u) >> 3 : 0u;
            const unsigned c = xb_ld(&ctl[LB_CENSUS(g, x)]);
            const unsigned long long m = __ballot(n == 0u ? x == 0u : c == n);
            const unsigned ok4 = ((m & 0xFFFFull) != 0ull ? 1u : 0u) | (((m >> 16) & 0xFFFFull) != 0ull ? 2u : 0u) | (((m >> 32) & 0xFFFFull) != 0ull ? 4u : 0u) | (((m >> 48) & 0xFFFFull) != 0ull ? 8u : 0u);
            if ((wg_tid() & 63u) == 0u) lst[1 + (wg_tid() >> 6)] = ok4; }
        __syncthreads();
        if (wg_tid() == 0) lst[0] = G != 256u ? 3u : (!LB_FORCE2 && lst[1] == 0xFu && lst[2] == 0xFu) ? 1u : 2u;
        __syncthreads();
    }
}
#define LB2_CNT(sg)     (9728 + 64 * (sg))
#define LB3_CNT(sg)     (13824 + 32 * (sg))
template <bool SUB, bool NB = false, bool HEAD = false>
__device__ __forceinline__ void local_or_grid_barrier(const XcdBarrier& b, unsigned* ctl, volatile LAS unsigned* lst) {
    if (lst[0] == 3u) { xcd_barrier(b); return; }
    asm volatile("s_waitcnt vmcnt(0)" ::: "memory");
    __syncthreads();
    int t_ = wg_tid(); asm volatile("" : "+v"(t_));
    if (t_ == 0) {
        __builtin_amdgcn_s_waitcnt(0);
        if (lst[0] != 1u) { __builtin_amdgcn_fence(__ATOMIC_RELEASE, "agent"); asm volatile("s_waitcnt vmcnt(0)" ::: "memory"); }
        const unsigned g = blockIdx.x & 7u, n = SUB ? 4u : (gridDim.x - g + 7u) >> 3;
        unsigned* cnt = SUB ? (HEAD ? &ctl[LB3_CNT(8u * g + ((blockIdx.x >> 5) & 7u))] : &ctl[LB2_CNT(8u * g + ((blockIdx.x >> 3) & 7u))]) : &ctl[LB_CNT(g)];
        const unsigned gen = lst[SUB ? (HEAD ? 5 : 4) : 3]; lst[SUB ? (HEAD ? 5 : 4) : 3] = gen + 1u;
        const unsigned target = (gen + 1u) * n, old = xb_add(cnt, 1u);
        if (old + 1u < target) XB_SPIN(xb_ld(cnt) < target, b.bar);
        if (SUB && NB) { unsigned* cnb = &ctl[LB2_CNT(8u * g + (((blockIdx.x >> 3) + 7u) & 7u))]; XB_SPIN(xb_ld(cnb) < target, b.bar); }
        __builtin_amdgcn_fence(__ATOMIC_ACQUIRE, "agent");
        asm volatile("s_waitcnt vmcnt(0)" ::: "memory");
    }
    __syncthreads();
}
namespace mb {
typedef short bf16x8 __attribute__((ext_vector_type(8)));
typedef short s16x4 __attribute__((ext_vector_type(4)));
typedef float f32x16 __attribute__((ext_vector_type(16)));
typedef float f32x2 __attribute__((ext_vector_type(2)));
#ifndef MOBA_CMAX
#define MOBA_CMAX 1
#endif
#ifndef MOBA_SPARSE
#define MOBA_SPARSE 0
#endif
constexpr int D = 128, LDR = 128, ARR = 4096 * 128, NW = 8, QBLK = 32, KVBLK = 64, QB = NW * QBLK;
static_assert(!MOBA_SPARSE, "the sparse sub-phases below still address the token-major q|k|v layout");
constexpr int SHM_V = KVBLK * D * 2, SHM_K = KVBLK * D * 2;
constexpr int OFF_WS = 2 * SHM_V + 2 * SHM_K, OFF_KM = OFF_WS + NW * 64 * 4, ATT_LDS_BYTES = OFF_KM + 16 * 128 * 4;
constexpr float THR = 8.f;
#ifndef MOBA_QFIN
#define MOBA_QFIN 0
#endif
#ifndef MOBA_EXPALL
#define MOBA_EXPALL 0
#endif
static_assert(!(MOBA_QFIN && MOBA_EXPALL), "qkt_fin exponentiates the second half itself");
#ifndef MOBA_BAR3
#define MOBA_BAR3 0
#endif
#ifndef MOBA_SMSPLIT
#define MOBA_SMSPLIT 1
#endif
#ifndef MOBA_OWIDE
#define MOBA_OWIDE 0
#endif
typedef unsigned u32x4_t __attribute__((ext_vector_type(4)));
constexpr int OSTG_RS = 272, OSTG_WAVE = 16 * OSTG_RS, OFF_OSTG = ATT_LDS_BYTES;
static_assert(OFF_OSTG + NW * OSTG_WAVE <= 133120, "attention LDS map");
#define KSWZ(row, colB) ((row) * 256 + ((colB) ^ (((row) & 7) << 4)))
#define SBAR() __builtin_amdgcn_sched_barrier(0)
__device__ __forceinline__ int v_st(int k, int c) { const int kk = (k & ~0xC) | ((k & 4) << 1) | ((k & 8) >> 1); return ((kk >> 3) * 4 + (c >> 5)) * 512 + ((kk & 7) * 32 + (c & 31)) * 2; }
__device__ __forceinline__ int v_rd_base(int lane) { return ((lane & 3) << 3) | (((lane >> 2) & 3) << 6) | (((lane >> 4) & 1) << 5) | (((lane >> 5) & 1) << 8); }
constexpr int v_rd_off(int d0, int ks, int half) { return d0 * 512 + ks * 4096 + half * 2048; }
__device__ __forceinline__ int crow(int r, int hi) { return (r & 3) + 8 * (r >> 2) + 4 * hi; }
__device__ __forceinline__ unsigned cvtpk(float lo, float hi) { unsigned r; asm volatile("v_cvt_pk_bf16_f32 %0, %1, %2" : "=v"(r) : "v"(lo), "v"(hi)); return r; }
__device__ __forceinline__ bf16x8 load8(const bf16* p) { return *reinterpret_cast<const bf16x8*>(p); }
__device__ __forceinline__ void mask_causal(f32x16& p0, f32x16& p1, int dq) {
    const float NEG = -__builtin_inff();
#pragma unroll
    for (int r = 0; r < 16; ++r) { const int c = (r & 3) + 8 * (r >> 2); if (dq - c < 0) p0[r] = NEG; if (dq - c - 32 < 0) p1[r] = NEG; }
}
__device__ __forceinline__ void mask_all(f32x16& p0, f32x16& p1, bool keep) {
    const float NEG = -__builtin_inff();
#pragma unroll
    for (int r = 0; r < 16; ++r) { p0[r] = keep ? p0[r] : NEG; p1[r] = keep ? p1[r] : NEG; }
}
__device__ __forceinline__ void partialSM(f32x16& p0, f32x16& p1, float& m_reg, float& mn, float& alpha, bool keep = true) {
    constexpr float C2 = 1.4426950408889634f;
#if MOBA_CMAX
    mn = m_reg; alpha = 1.f;
#else
    float pmax = p0[0]; for (int r = 1; r < 16; ++r) pmax = fmaxf(pmax, p0[r]); for (int r = 0; r < 16; ++r) pmax = fmaxf(pmax, p1[r]);
    pmax = keep ? pmax : -__builtin_inff();
    { auto rr = __builtin_amdgcn_permlane32_swap(__float_as_uint(pmax), __float_as_uint(pmax), false, false);
      pmax = fmaxf(__uint_as_float(rr[0]), __uint_as_float(rr[1])); }
    if (__builtin_expect(__all((pmax - m_reg) <= THR), 1)) { mn = m_reg; alpha = 1.f; }
    else { mn = fmaxf(m_reg, pmax); alpha = __builtin_amdgcn_exp2f((m_reg - mn) * C2); m_reg = mn; }
#endif
    const float mnL = keep ? -mn * C2 : -__builtin_inff();
    { f32x16 c2v, mlv;
#pragma unroll
      for (int r = 0; r < 16; ++r) { c2v[r] = C2; mlv[r] = mnL; }
      p0 = __builtin_elementwise_fma(p0, c2v, mlv); p1 = __builtin_elementwise_fma(p1, c2v, mlv); }
    for (int r = 0; r < 16; ++r) p0[r] = __builtin_amdgcn_exp2f(p0[r]);
}
template <bool P1DONE = false>
__device__ __forceinline__ void finishSM(f32x16& p0, f32x16& p1, float alpha, float& l_reg, bf16x8& pa0, bf16x8& pa1, bf16x8& pa2, bf16x8& pa3) {
    if (!P1DONE) for (int r = 0; r < 16; ++r) p1[r] = __builtin_amdgcn_exp2f(p1[r]);
    float ps;
    { const f32x16 s16 = p0 + p1;
      typedef float f32x8_t __attribute__((ext_vector_type(8))); typedef float f32x4_t __attribute__((ext_vector_type(4))); typedef float f32x2_t __attribute__((ext_vector_type(2)));
      const f32x8_t s8 = __builtin_shufflevector(s16, s16, 0, 1, 2, 3, 4, 5, 6, 7) + __builtin_shufflevector(s16, s16, 8, 9, 10, 11, 12, 13, 14, 15);
      const f32x4_t s4 = __builtin_shufflevector(s8, s8, 0, 1, 2, 3) + __builtin_shufflevector(s8, s8, 4, 5, 6, 7);
      const f32x2_t s2 = __builtin_shufflevector(s4, s4, 0, 1) + __builtin_shufflevector(s4, s4, 2, 3);
      ps = s2[0] + s2[1]; }
    { auto rr = __builtin_amdgcn_permlane32_swap(__float_as_uint(ps), __float_as_uint(ps), false, false);
      ps = __uint_as_float(rr[0]) + __uint_as_float(rr[1]); }
    l_reg = l_reg * alpha + ps;
#define PK4(P, B_, OUT) do { unsigned a0 = cvtpk(P[B_+0], P[B_+1]), a1 = cvtpk(P[B_+2], P[B_+3]);                          \
        unsigned b0 = cvtpk(P[B_+4], P[B_+5]), b1 = cvtpk(P[B_+6], P[B_+7]);                                             \
        auto r0 = __builtin_amdgcn_permlane32_swap(a0, b0, false, false); auto r1 = __builtin_amdgcn_permlane32_swap(a1, b1, false, false); \
        u32x4 w = {r0[0], r1[0], r0[1], r1[1]}; OUT = *reinterpret_cast<bf16x8*>(&w); } while (0)
    PK4(p0, 0, pa0); PK4(p0, 8, pa1); PK4(p1, 0, pa2); PK4(p1, 8, pa3);
#undef PK4
}
template <int KB>
__device__ __forceinline__ void qkt(f32x16& p0, f32x16& p1, const char* K_lds, int r32, int hi, const bf16x8* qr) {
    p0 = f32x16{}; p1 = f32x16{};
    const char* kb[4];
#pragma unroll
    for (int dd = 0; dd < 4; ++dd) kb[dd] = K_lds + KB * SHM_K + KSWZ(r32, (dd * 16 + hi * 8) * 2);
#pragma unroll
    for (int d0 = 0; d0 < 8; ++d0) { const char* a = kb[d0 & 3] + (d0 >> 2) * 128;
        bf16x8 b0 = *reinterpret_cast<const bf16x8*>(a);
        bf16x8 b1 = *reinterpret_cast<const bf16x8*>(a + 32 * 256);
        p0 = __builtin_amdgcn_mfma_f32_32x32x16_bf16(b0, qr[d0], p0, 0, 0, 0);
        p1 = __builtin_amdgcn_mfma_f32_32x32x16_bf16(b1, qr[d0], p1, 0, 0, 0); }
}
template <int VB>
__device__ __forceinline__ void pv_tile(f32x16* o, int vb0, bf16x8 pa0, bf16x8 pa1, bf16x8 pa2, bf16x8 pa3) {
#define TRRD(dst, off) asm volatile("ds_read_b64_tr_b16 %0, %1 offset:%2" : "=&v"(dst) : "v"(vb0), "i"(off) : "memory")
#define PV_D0(d0) do { s16x4 l0, l1, l2, l3, h0, h1, h2, h3; constexpr int b_ = VB * SHM_V + v_rd_off(d0, 0, 0);   \
        TRRD(l0, b_); TRRD(h0, b_ + 2048); TRRD(l1, b_ + 4096); TRRD(h1, b_ + 6144); TRRD(l2, b_ + 8192); TRRD(h2, b_ + 10240); TRRD(l3, b_ + 12288); TRRD(h3, b_ + 14336); \
        asm volatile("s_waitcnt lgkmcnt(0)" ::: "memory"); SBAR();   \
        o[d0] = __builtin_amdgcn_mfma_f32_32x32x16_bf16(pa0, (bf16x8){l0[0], l0[1], l0[2], l0[3], h0[0], h0[1], h0[2], h0[3]}, o[d0], 0, 0, 0);   \
        o[d0] = __builtin_amdgcn_mfma_f32_32x32x16_bf16(pa1, (bf16x8){l1[0], l1[1], l1[2], l1[3], h1[0], h1[1], h1[2], h1[3]}, o[d0], 0, 0, 0);   \
        o[d0] = __builtin_amdgcn_mfma_f32_32x32x16_bf16(pa2, (bf16x8){l2[0], l2[1], l2[2], l2[3], h2[0], h2[1], h2[2], h2[3]}, o[d0], 0, 0, 0);   \
        o[d0] = __builtin_amdgcn_mfma_f32_32x32x16_bf16(pa3, (bf16x8){l3[0], l3[1], l3[2], l3[3], h3[0], h3[1], h3[2], h3[3]}, o[d0], 0, 0, 0); } while (0)
    PV_D0(0); PV_D0(1); PV_D0(2); PV_D0(3);
#undef PV_D0
#undef TRRD
}

template <int KB>
__device__ __forceinline__ void qkt_fin(f32x16& p0, f32x16& p1, const char* K_lds, int r32, int hi, const bf16x8* qr,
                                        f32x16& y0, f32x16& y1, float alpha, float& l_reg, bf16x8& pa0, bf16x8& pa1, bf16x8& pa2, bf16x8& pa3) {
    p0 = f32x16{}; p1 = f32x16{};
    const char* kb[4];
#pragma unroll
    for (int dd = 0; dd < 4; ++dd) kb[dd] = K_lds + KB * SHM_K + KSWZ(r32, (dd * 16 + hi * 8) * 2);
#define KFR(d0, w) (*reinterpret_cast<const bf16x8*>(kb[(d0) & 3] + ((d0) >> 2) * 128 + (w) * 32 * 256))
#define PK4(P, B_, OUT) do { unsigned a0 = cvtpk(P[B_+0], P[B_+1]), a1 = cvtpk(P[B_+2], P[B_+3]);                          \
        unsigned b0 = cvtpk(P[B_+4], P[B_+5]), b1 = cvtpk(P[B_+6], P[B_+7]);                                             \
        auto r0 = __builtin_amdgcn_permlane32_swap(a0, b0, false, false); auto r1 = __builtin_amdgcn_permlane32_swap(a1, b1, false, false); \
        u32x4 w = {r0[0], r1[0], r0[1], r1[1]}; OUT = *reinterpret_cast<bf16x8*>(&w); } while (0)
#define EXP8(P, B_) do { _Pragma("unroll") for (int e_ = 0; e_ < 8; ++e_) P[B_ + e_] = __builtin_amdgcn_exp2f(P[B_ + e_]); } while (0)
    bf16x8 c0 = KFR(0, 0), c1 = KFR(0, 1), n0 = c0, n1 = c1; float ps = 0.f;
#define QF_STEP(d0, SLICE) do { if ((d0) < 7) { n0 = KFR((d0) + 1, 0); n1 = KFR((d0) + 1, 1); }                             \
        p0 = __builtin_amdgcn_mfma_f32_32x32x16_bf16(c0, qr[d0], p0, 0, 0, 0); p1 = __builtin_amdgcn_mfma_f32_32x32x16_bf16(c1, qr[d0], p1, 0, 0, 0); \
        SLICE; c0 = n0; c1 = n1; SBAR(); } while (0)
#define EXP2_(P, B_) do { P[B_] = __builtin_amdgcn_exp2f(P[B_]); P[B_ + 1] = __builtin_amdgcn_exp2f(P[B_ + 1]); } while (0)
    typedef float f32x2_q __attribute__((ext_vector_type(2)));
    f32x2_q sacc = {0.f, 0.f};
#define SUM4(P, B_) do { sacc += (f32x2_q){P[B_], P[B_ + 1]}; sacc += (f32x2_q){P[B_ + 2], P[B_ + 3]}; } while (0)
    QF_STEP(0, { EXP2_(y1, 0);  PK4(y0, 0, pa0); });
    QF_STEP(1, { EXP2_(y1, 2);  PK4(y0, 8, pa1); });
    QF_STEP(2, { EXP2_(y1, 4);  SUM4(y0, 0); SUM4(y0, 4); });
    QF_STEP(3, { EXP2_(y1, 6);  SUM4(y0, 8); SUM4(y0, 12); });
    QF_STEP(4, { EXP2_(y1, 8);  PK4(y1, 0, pa2); });
    QF_STEP(5, { EXP2_(y1, 10); SUM4(y1, 0); SUM4(y1, 4); });
    QF_STEP(6, { EXP2_(y1, 12); SUM4(y1, 8); });
    QF_STEP(7, { EXP2_(y1, 14); });
    PK4(y1, 8, pa3); SUM4(y1, 12);
    { ps = sacc[0] + sacc[1]; auto rr = __builtin_amdgcn_permlane32_swap(__float_as_uint(ps), __float_as_uint(ps), false, false);
      ps = __uint_as_float(rr[0]) + __uint_as_float(rr[1]); l_reg = l_reg * alpha + ps; }
#undef SUM4
#undef EXP2_
#undef QF_STEP
#undef EXP8
#undef PK4
#undef KFR
}

typedef float f32x2_t __attribute__((ext_vector_type(2)));
template <int VB>
__device__ __forceinline__ void pv_tile_sm(f32x16* o, int vb0, bf16x8 pa0, bf16x8 pa1, bf16x8 pa2, bf16x8 pa3, f32x16& p0, f32x16& p1, float biasL) {
    constexpr float C2 = 1.4426950408889634f; const f32x2_t c2v = {C2, C2}, blv = {biasL, biasL};
#define TRRD(dst, off) asm volatile("ds_read_b64_tr_b16 %0, %1 offset:%2" : "=&v"(dst) : "v"(vb0), "i"(off) : "memory")
#define PV_D0S(d0) do { s16x4 l0, l1, l2, l3, h0, h1, h2, h3; constexpr int b_ = VB * SHM_V + v_rd_off(d0, 0, 0);   \
        TRRD(l0, b_); TRRD(h0, b_ + 2048); TRRD(l1, b_ + 4096); TRRD(h1, b_ + 6144); TRRD(l2, b_ + 8192); TRRD(h2, b_ + 10240); TRRD(l3, b_ + 12288); TRRD(h3, b_ + 14336); \
        asm volatile("s_waitcnt lgkmcnt(0)" ::: "memory"); SBAR();   \
        o[d0] = __builtin_amdgcn_mfma_f32_32x32x16_bf16(pa0, (bf16x8){l0[0], l0[1], l0[2], l0[3], h0[0], h0[1], h0[2], h0[3]}, o[d0], 0, 0, 0);   \
        o[d0] = __builtin_amdgcn_mfma_f32_32x32x16_bf16(pa1, (bf16x8){l1[0], l1[1], l1[2], l1[3], h1[0], h1[1], h1[2], h1[3]}, o[d0], 0, 0, 0);   \
        o[d0] = __builtin_amdgcn_mfma_f32_32x32x16_bf16(pa2, (bf16x8){l2[0], l2[1], l2[2], l2[3], h2[0], h2[1], h2[2], h2[3]}, o[d0], 0, 0, 0);   \
        o[d0] = __builtin_amdgcn_mfma_f32_32x32x16_bf16(pa3, (bf16x8){l3[0], l3[1], l3[2], l3[3], h3[0], h3[1], h3[2], h3[3]}, o[d0], 0, 0, 0);   \
        _Pragma("unroll") for (int q_ = 0; q_ < 2; ++q_) { const int r_ = 4 * (d0) + 2 * q_;                                                       \
            f32x2_t a_ = {p0[r_], p0[r_ + 1]}, b2_ = {p1[r_], p1[r_ + 1]};                                                                         \
            a_ = __builtin_elementwise_fma(a_, c2v, blv); b2_ = __builtin_elementwise_fma(b2_, c2v, blv);                                           \
            p0[r_] = __builtin_amdgcn_exp2f(a_[0]); p0[r_ + 1] = __builtin_amdgcn_exp2f(a_[1]);                                                 \
            if (MOBA_EXPALL) { p1[r_] = __builtin_amdgcn_exp2f(b2_[0]); p1[r_ + 1] = __builtin_amdgcn_exp2f(b2_[1]); } else { p1[r_] = b2_[0]; p1[r_ + 1] = b2_[1]; } } } while (0)
    PV_D0S(0); PV_D0S(1); PV_D0S(2); PV_D0S(3);
#undef PV_D0S
#undef TRRD
}

struct BlockRef { const bf16* Q; const bf16* K; const bf16* V; bf16* O; const float* KM; int iblk, ldo, store, bh; float mfix; };
struct Partials { bf16* P[3]; float* ML; };
struct Seam { bf16x8 qr[8]; bf16x8 st_v0, st_v1, st_k0, st_k1; };
#define ROW(p, k0, rr) ((p) + (size_t)((k0) + (rr)) * LDR + sc)
#define VMW() asm volatile("s_waitcnt vmcnt(0)" ::: "memory")
#define VMWN(n) asm volatile("s_waitcnt vmcnt(%0)" :: "i"(n) : "memory")
#define SLOAD_H(Kp, Vp, k0) do { const bf16* k_ = (Kp) + (size_t)(k0) * LDR; const bf16* v_ = (Vp) + (size_t)(k0) * LDR;                     \
                         S.st_v0 = load8(v_ + (size_t)soff); S.st_v1 = load8(v_ + (size_t)32 * LDR + (size_t)soff);                       \
                         S.st_k0 = load8(k_ + (size_t)soff); S.st_k1 = load8(k_ + (size_t)32 * LDR + (size_t)soff); } while (0)
#define SWRITE_HK(bf) do { *(bf16x8*)(K_lds + (bf) * SHM_K + kws) = S.st_k0; *(bf16x8*)(K_lds + (bf) * SHM_K + kws + 32 * 256) = S.st_k1; } while (0)
#define SWRITE_HV(bf) do { *(bf16x8*)(V_lds + (bf) * SHM_V + vst0) = S.st_v0; *(bf16x8*)(V_lds + (bf) * SHM_V + vst1) = S.st_v1; } while (0)
#define SWRITE_H(bf) do { SWRITE_HV(bf); SWRITE_HK(bf); } while (0)
__device__ __forceinline__ void moba_prime(const BlockRef& cur, char* lds, Seam& S, int tid) {
    const int t0c = MOBA_SPARSE ? 4 * cur.iblk : 0;
    const int wid = __builtin_amdgcn_readfirstlane(tid >> 6), lane = tid & 63, r32 = lane & 31, hi = lane >> 5;
    const int sr = tid >> 4, sc = (tid & 15) * 8, kws = KSWZ(sr, sc * 2); char* K_lds = lds + 2 * SHM_V;
    const unsigned soff = (unsigned)(sr * LDR + sc), qoff = (unsigned)(r32 * LDR + hi * 8);
    { const bf16* qb = cur.Q + (size_t)(wid * QBLK) * LDR;
#pragma unroll
      for (int d0 = 0; d0 < 8; ++d0) S.qr[d0] = load8(qb + (size_t)qoff + d0 * 16); }
    SLOAD_H(cur.K, cur.V, t0c * KVBLK); VMW(); SWRITE_HK(0);
    __syncthreads();
}
__device__ __forceinline__ void moba_block(const BlockRef& cur, const BlockRef& nxt, const Partials& PP, char* lds, Seam& S, int tid) {
    const int wid = __builtin_amdgcn_readfirstlane(tid >> 6), lane = tid & 63, r32 = lane & 31, hi = lane >> 5;
    const int iblk = cur.iblk, t0 = MOBA_SPARSE ? 4 * iblk : 0, NT = MOBA_SPARSE ? 4 : 4 * (iblk + 1), P0 = iblk * QB;
    const int qlo = P0 + wid * QBLK, qm = qlo + r32 - 4 * hi;
#if PROBE_STAMP >= 7 && PROBE_STAMP <= 9
    const unsigned a_t0 = (unsigned)__builtin_amdgcn_s_memrealtime();
#endif
    unsigned sel = 0u; char* KMt = lds + OFF_KM;
    if (!MOBA_SPARSE && iblk > 0) {
        int t4 = tid; asm volatile("" : "+v"(t4));
        { const f32x4 km = *(const f32x4*)(cur.KM + t4 * 4); const int jrow = t4 >> 5, colB = (t4 & 31) * 8;
          const unsigned h01 = cvtpk(km[0], km[1]), h23 = cvtpk(km[2], km[3]);
          const float r0 = km[0] - __uint_as_float(h01 << 16), r1 = km[1] - __uint_as_float(h01 & 0xffff0000u), r2 = km[2] - __uint_as_float(h23 << 16), r3 = km[3] - __uint_as_float(h23 & 0xffff0000u);
          const unsigned l01 = cvtpk(r0, r1), l23 = cvtpk(r2, r3);
          typedef unsigned u32x2_t __attribute__((ext_vector_type(2)));
          *(u32x2_t*)(KMt + KSWZ(jrow, colB)) = (u32x2_t){h01, h23}; *(u32x2_t*)(KMt + KSWZ(16 + jrow, colB)) = (u32x2_t){l01, l23}; }
        __syncthreads();
        f32x16 pg = f32x16{};
        { const char* kb[4];
#pragma unroll
          for (int dd = 0; dd < 4; ++dd) kb[dd] = KMt + KSWZ(r32, (dd * 16 + hi * 8) * 2);
#pragma unroll
          for (int d0 = 0; d0 < 8; ++d0) pg = __builtin_amdgcn_mfma_f32_32x32x16_bf16(*reinterpret_cast<const bf16x8*>(kb[d0 & 3] + (d0 >> 2) * 128), S.qr[d0], pg, 0, 0, 0); }
        float own[8], oth[8];
#pragma unroll
        for (int r = 0; r < 8; ++r) { own[r] = pg[r] + pg[r + 8]; oth[r] = __shfl_xor(own[r], 32); }
        float v1 = -__builtin_inff(), v2 = v1, v3 = v1; int i1 = -1, i2 = -1, i3 = -1;
#pragma unroll
        for (int j = 0; j < 16; ++j) {
            const int rr = (j & 3) + 4 * (j >> 3); const bool mine = ((j >> 2) & 1) == hi;
            const float a = mine ? own[rr] : oth[rr];
            if (j < iblk) {
                if (a > v1) { v3 = v2; i3 = i2; v2 = v1; i2 = i1; v1 = a; i1 = j; }
                else if (a > v2) { v3 = v2; i3 = i2; v2 = a; i2 = j; }
                else if (a > v3) { v3 = a; i3 = j; } }
        }
        sel = (i1 >= 0 ? 1u << i1 : 0u) | (i2 >= 0 ? 1u << i2 : 0u) | (i3 >= 0 ? 1u << i3 : 0u);
    }
#if PROBE_STAMP >= 7 && PROBE_STAMP <= 9
    const unsigned a_t1 = (unsigned)__builtin_amdgcn_s_memrealtime();
#endif
    char* V_lds = lds; char* K_lds = lds + 2 * SHM_V;
    float* ws = (float*)(lds + OFF_WS) + wid * 64; float* li_l = ws, * al_l = ws + 32;
    float m_reg = MOBA_CMAX ? cur.mfix : -1e30f, l_reg = 0; f32x16 o[4] = {};
    const int sr = tid >> 4, sc = (tid & 15) * 8, vst0 = v_st(sr, sc), vst1 = v_st(32 + sr, sc), kws = KSWZ(sr, sc * 2);
    const unsigned soff = (unsigned)(sr * LDR + sc), qoff = (unsigned)(r32 * LDR + hi * 8);
    const int vb0 = (int)(uintptr_t)V_lds + v_rd_base(lane);
    const bf16* Kh = cur.K; const bf16* Vh = cur.V;
#define RESC(a) do { if (__any((a) < 1.f)) { if (hi == 0) al_l[r32] = (a); asm volatile("s_waitcnt lgkmcnt(0)" ::: "memory");              \
                     for (int d_ = 0; d_ < 4; ++d_) for (int r = 0; r < 16; ++r) o[d_][r] *= al_l[crow(r, hi)]; } } while (0)
#define KBASE(t) ((t0 + (t)) * KVBLK)
#define MASKT(P0_, P1_, t, KEEP_) do { const int kb_ = KBASE(t); const int bj_ = (t0 + (t)) >> 2; KEEP_ = true; \
        if (bj_ == iblk) { if (kb_ + KVBLK - 1 > qlo) mask_causal(P0_, P1_, qm - kb_); } else KEEP_ = ((sel >> bj_) & 1u) != 0u; } while (0)
    constexpr int NQL = 8;
#define SEAM_K0() do { VMWN(NQL); SWRITE_HK(0); SBAR(); } while (0)
    f32x16 pA0, pA1, pB0, pB1; float mnA, mnB, alA, alB; bf16x8 pa0, pa1, pa2, pa3;
    SWRITE_HV(0); SBAR();
    if (NT > 1) SLOAD_H(Kh, Vh, KBASE(1));
    SBAR(); qkt<0>(pA0, pA1, K_lds, r32, hi, S.qr);
    { bool kp_; MASKT(pA0, pA1, 0, kp_); partialSM(pA0, pA1, m_reg, mnA, alA, kp_); }
    if (MOBA_CMAX && MOBA_SMSPLIT && MOBA_EXPALL) { for (int r = 0; r < 16; ++r) pA1[r] = __builtin_amdgcn_exp2f(pA1[r]); }
    if (NT > 1) { VMW(); SWRITE_H(1); }
    __syncthreads();
#define HALF_STEP(PX0, PX1, mnX, alX, PY0, PY1, alY, t, KB, VB, SB) do {                                                      \
        SBAR(); if (MOBA_QFIN) qkt_fin<KB>(PX0, PX1, K_lds, r32, hi, S.qr, PY0, PY1, alY, l_reg, pa0, pa1, pa2, pa3);         \
        else { qkt<KB>(PX0, PX1, K_lds, r32, hi, S.qr); finishSM<MOBA_CMAX && MOBA_SMSPLIT && MOBA_EXPALL>(PY0, PY1, alY, l_reg, pa0, pa1, pa2, pa3); } SBAR();   \
        if ((t) + 1 < NT) { SLOAD_H(Kh, Vh, KBASE((t) + 1)); SBAR(); }                                                        \
        if (MOBA_BAR3) { asm volatile("s_waitcnt lgkmcnt(0)" ::: "memory"); __builtin_amdgcn_s_barrier(); SBAR(); }     \
        if (MOBA_CMAX && MOBA_SMSPLIT) { bool kp_; MASKT(PX0, PX1, (t), kp_); pv_tile_sm<VB>(o, vb0, pa0, pa1, pa2, pa3, PX0, PX1, kp_ ? -m_reg * 1.4426950408889634f : -__builtin_inff()); mnX = m_reg; alX = 1.f; } \
        else { pv_tile<VB>(o, vb0, pa0, pa1, pa2, pa3); bool kp_; MASKT(PX0, PX1, (t), kp_); partialSM(PX0, PX1, m_reg, mnX, alX, kp_); } \
        __syncthreads();                                                                                                      \
        if ((t) + 1 < NT) { VMW(); SWRITE_H(SB); }                                                                            \
        RESC(alX); __syncthreads(); } while (0)
    for (int t = 1; t + 1 < NT; t += 2) {
        HALF_STEP(pB0, pB1, mnB, alB, pA0, pA1, alA, t, 1, 0, 0);
        HALF_STEP(pA0, pA1, mnA, alA, pB0, pB1, alB, t + 1, 0, 1, 1);
    }
    SBAR(); qkt<1>(pB0, pB1, K_lds, r32, hi, S.qr); SBAR();
    SLOAD_H(nxt.K, nxt.V, (MOBA_SPARSE ? 4 * nxt.iblk : 0) * KVBLK); SBAR();
    { const bf16* qb = nxt.Q + (size_t)(wid * QBLK) * LDR;
#pragma unroll
      for (int d0 = 0; d0 < 8; ++d0) S.qr[d0] = load8(qb + (size_t)qoff + d0 * 16); }
    SBAR();
    finishSM<MOBA_CMAX && MOBA_SMSPLIT && MOBA_EXPALL>(pA0, pA1, alA, l_reg, pa0, pa1, pa2, pa3); SBAR();
    pv_tile<0>(o, vb0, pa0, pa1, pa2, pa3);
    { bool kp_; MASKT(pB0, pB1, NT - 1, kp_); partialSM(pB0, pB1, m_reg, mnB, alB, kp_); } __syncthreads(); RESC(alB);
    finishSM(pB0, pB1, alB, l_reg, pa0, pa1, pa2, pa3); SBAR(); pv_tile<1>(o, vb0, pa0, pa1, pa2, pa3);
    SBAR(); SEAM_K0();
#if PROBE_STAMP >= 7 && PROBE_STAMP <= 9
    const unsigned a_t2 = (unsigned)__builtin_amdgcn_s_memrealtime();
#endif
    int hi_e = hi; asm volatile("" : "+v"(hi_e));
    const int ldo = cur.ldo; bf16* Ow = cur.O + (size_t)(wid * QBLK) * ldo;
    const unsigned ooff = (unsigned)(4 * hi_e * ldo + r32);
    if (!MOBA_SPARSE) {
        if (hi == 0) li_l[r32] = l_reg; asm volatile("s_waitcnt lgkmcnt(0)" ::: "memory");
        float rli[16];
#pragma unroll
        for (int r = 0; r < 16; ++r) rli[r] = __builtin_amdgcn_rcpf(li_l[crow(r, hi_e)]);
#if MOBA_OWIDE
        { char* ost = lds + OFF_OSTG + wid * OSTG_WAVE; (void)ooff;
          const int wrow = 4 * hi_e, wcol = r32 * 2;
#pragma unroll
          for (int hf = 0; hf < 2; ++hf) {
#pragma unroll
              for (int rr = 0; rr < 8; ++rr) { const int r = 8 * hf + rr; const int srow = (rr & 3) + 8 * (rr >> 2) + wrow;
#pragma unroll
                  for (int d0 = 0; d0 < 4; ++d0) { const float v = o[d0][r] * rli[r]; const float vn = __shfl_xor(v, 1);
                      if ((r32 & 1) == 0) *(unsigned*)(ost + srow * OSTG_RS + wcol + 64 * d0) = cvtpk(v, vn); } }
              asm volatile("s_waitcnt lgkmcnt(0)" ::: "memory");
#pragma unroll
              for (int i = 0; i < 4; ++i) { const int idx = i * 64 + lane, row = idx >> 4, ch = idx & 15;
                  const u32x4_t w = *(const u32x4_t*)(ost + row * OSTG_RS + ch * 16);
                  if (cur.store) *(u32x4_t*)(Ow + (size_t)(16 * hf + row) * ldo + ch * 8) = w; }
              asm volatile("s_waitcnt lgkmcnt(0)" ::: "memory"); } }
#else
#pragma unroll
        for (int r = 0; r < 16; ++r) { bf16* orow = Ow + (size_t)((r & 3) + 8 * (r >> 2)) * ldo;
#pragma unroll
            for (int d0 = 0; d0 < 4; ++d0) { const float v = o[d0][r] * rli[r];
                const float vn = __shfl_xor(v, 1);
                if ((r32 & 1) == 0 && cur.store) *(unsigned*)(orow + (size_t)ooff + d0 * 32) = cvtpk(v, vn); } }
#endif
    } else {
        const int np = iblk < 3 ? iblk : 3; constexpr float L2E = 1.4426950408889634f;
        float* mt = (float*)(lds + OFF_KM) + wid * 128;
        const size_t rowg = (size_t)cur.bh * SEQ + (size_t)iblk * QB + wid * QBLK;
        float ms[3], ls[3];
#pragma unroll
        for (int sidx = 0; sidx < 3; ++sidx) { ms[sidx] = -1e30f; ls[sidx] = 0.f;
            if (sidx < np) { const f32x2 v = *(const f32x2*)(PP.ML + ((size_t)sidx * BATCH * NH * SEQ + rowg + r32) * 2); ms[sidx] = v[0]; ls[sidx] = v[1]; } }
        const float M = fmaxf(fmaxf(m_reg, ms[0]), fmaxf(ms[1], ms[2]));
        const float e0 = __builtin_amdgcn_exp2f((m_reg - M) * L2E), e1 = ls[0] * __builtin_amdgcn_exp2f((ms[0] - M) * L2E), e2 = ls[1] * __builtin_amdgcn_exp2f((ms[1] - M) * L2E), e3 = ls[2] * __builtin_amdgcn_exp2f((ms[2] - M) * L2E);
        const float iw = __builtin_amdgcn_rcpf(l_reg * e0 + (e1 + e2 + e3));
        if (hi == 0) *(f32x4*)(mt + 4 * r32) = (f32x4){e0 * iw, e1 * iw, e2 * iw, e3 * iw};
        asm volatile("s_waitcnt lgkmcnt(0)" ::: "memory");
#pragma unroll
        for (int r = 0; r < 16; ++r) { const float w0 = mt[4 * ((r & 3) + 8 * (r >> 2) + 4 * hi_e)];
#pragma unroll
            for (int d0 = 0; d0 < 4; ++d0) o[d0][r] *= w0; }
        const unsigned lofs0 = (unsigned)(4 * hi_e * 128 + r32);
#pragma unroll
        for (int sidx = 0; sidx < 3; ++sidx) {
            if (sidx < np) {
                const bf16* pbase = PP.P[sidx] + rowg * 128; bf16 pv[16][4];
#pragma unroll
                for (int r = 0; r < 16; ++r)
#pragma unroll
                    for (int d0 = 0; d0 < 4; ++d0) pv[r][d0] = pbase[(size_t)((r & 3) + 8 * (r >> 2)) * 128 + lofs0 + d0 * 32];
#pragma unroll
                for (int r = 0; r < 16; ++r) { const float wsl = mt[4 * ((r & 3) + 8 * (r >> 2) + 4 * hi_e) + 1 + sidx];
#pragma unroll
                    for (int d0 = 0; d0 < 4; ++d0) o[d0][r] += wsl * bf2f(pv[r][d0]); }
            }
        }
#pragma unroll
        for (int r = 0; r < 16; ++r) { bf16* orow = Ow + (size_t)((r & 3) + 8 * (r >> 2)) * ldo;
#pragma unroll
            for (int d0 = 0; d0 < 4; ++d0) { const float v = o[d0][r]; const float vn = __shfl_xor(v, 1);
                if ((r32 & 1) == 0 && cur.store) *(unsigned*)(orow + (size_t)ooff + d0 * 32) = cvtpk(v, vn); } }
    }
#if PROBE_STAMP >= 7 && PROBE_STAMP <= 9
    { asm volatile("s_waitcnt vmcnt(0)" ::: "memory"); const unsigned a_t3 = (unsigned)__builtin_amdgcn_s_memrealtime();
      if (tid == 0) { volatile unsigned long long* st_ = (volatile unsigned long long*)(lds + 139264 + 256); st_[1] += (unsigned long long)(PROBE_STAMP == 7 ? a_t1 - a_t0 : PROBE_STAMP == 8 ? a_t2 - a_t1 : a_t3 - a_t2); } }
#endif
    __syncthreads();
#undef RESC
#undef KBASE
#undef MASKT
#undef SEAM_K0
#undef HALF_STEP
}

__device__ __forceinline__ void sel_phase(const bf16* qkv, const float* kmean, unsigned short* LIST, unsigned* CNT, char* lds, int tid) {
    const int wid = __builtin_amdgcn_readfirstlane(tid >> 6), lane = tid & 63, r32 = lane & 31, hi = lane >> 5;
    float* KMs = (float*)(lds + OFF_KM); unsigned* cw = (unsigned*)(lds + OFF_WS);
    for (int u = blockIdx.x; u < BATCH * NH * 15; u += gridDim.x) {
        const int bh = u / 15, i = 1 + u % 15, b = bh >> 3, h = bh & 7;
        __syncthreads();
        *(f32x4*)(KMs + tid * 4) = *(const f32x4*)(kmean + (size_t)bh * 2048 + tid * 4);
        bf16x8 qr[8];
        { const bf16* qb = qkv + ((size_t)b * SEQ + (size_t)i * QB + wid * QBLK + r32) * LDR + h * 128 + hi * 8;
#pragma unroll
          for (int d0 = 0; d0 < 8; ++d0) qr[d0] = load8(qb + d0 * 16); }
        __syncthreads();
        float v1 = -__builtin_inff(), v2 = v1, v3 = v1; int i1 = -1, i2 = -1, i3 = -1;
        for (int j = 0; j < i; ++j) {
            const float* km = KMs + j * 128 + 8 * hi; float a = 0.f;
#pragma unroll
            for (int d0 = 0; d0 < 8; ++d0) { const f32x4 k0 = *(const f32x4*)(km + 16 * d0), k1 = *(const f32x4*)(km + 16 * d0 + 4); const bf16x8 q = qr[d0];
#pragma unroll
                for (int e = 0; e < 4; ++e) { a = fmaf(__uint_as_float((unsigned)(unsigned short)q[e] << 16), k0[e], a); a = fmaf(__uint_as_float((unsigned)(unsigned short)q[e + 4] << 16), k1[e], a); } }
            a += __shfl_xor(a, 32);
            if (a > v1) { v3 = v2; i3 = i2; v2 = v1; i2 = i1; v1 = a; i1 = j; }
            else if (a > v2) { v3 = v2; i3 = i2; v2 = a; i2 = j; }
            else if (a > v3) { v3 = a; i3 = j; }
        }
        const unsigned sel = (i1 >= 0 ? 1u << i1 : 0u) | (i2 >= 0 ? 1u << i2 : 0u) | (i3 >= 0 ? 1u << i3 : 0u);
        for (int j = 0; j < i; ++j) {
            const unsigned long long bal = __ballot(((sel >> j) & 1u) != 0u && hi == 0);
            if (lane == 0) cw[j * 8 + wid] = (unsigned)__popcll(bal); }
        __syncthreads();
        for (int j = 0; j < i; ++j) {
            const bool on = ((sel >> j) & 1u) != 0u && hi == 0;
            const unsigned long long bal = __ballot(on);
            unsigned off = 0, tot = 0;
#pragma unroll
            for (int w = 0; w < 8; ++w) { const unsigned c = cw[j * 8 + w]; off += w < wid ? c : 0u; tot += c; }
            if (on) { const unsigned rank = (unsigned)__popcll(bal & ((1ull << lane) - 1ull)), slot = (unsigned)__popc(sel & ((1u << j) - 1u));
                LIST[((size_t)(bh * 16 + i) * 16 + j) * 256 + off + rank] = (unsigned short)((wid * 32 + r32) | (slot << 8)); }
            if (tid == 0) CNT[(bh * 16 + i) * 16 + j] = tot;
        }
    }
}
__device__ __forceinline__ void past_phase(const bf16* qkv, const unsigned short* LIST, const unsigned* CNT, const Partials& PP, unsigned* head, char* lds, int tid) {
    const int wid = __builtin_amdgcn_readfirstlane(tid >> 6), lane = tid & 63, r32 = lane & 31, hi = lane >> 5;
    char* V_lds = lds; char* K_lds = lds + 4 * SHM_V;
    constexpr int OFF_X = 8 * SHM_V;
    float* ws = (float*)(lds + OFF_X) + wid * 96; float* al_l = ws; unsigned* rt = (unsigned*)(ws + 32);
    float* li_l = ws + 64;
    unsigned* gt = (unsigned*)(lds + OFF_X + 8 * 96 * 4);
    const int sr = tid >> 4, sc = (tid & 15) * 8, vst0 = v_st(sr, sc), vst1 = v_st(32 + sr, sc), kws = KSWZ(sr, sc * 2);
    const unsigned soff = (unsigned)(sr * LDR + sc);
    const int vb0 = (int)(uintptr_t)V_lds + v_rd_base(lane);
    for (;;) {
        __syncthreads();
        if (tid == 0) gt[32] = __hip_atomic_fetch_add(head, 1u, __ATOMIC_RELAXED, __HIP_MEMORY_SCOPE_AGENT);
        __syncthreads();
        const int item = (int)gt[32]; if (item >= BATCH * NH * 15) break;
        const int j = item >> 6, bh = item & 63, b = bh >> 3, h = bh & 7;
        { const bf16* kp = qkv + ((size_t)b * SEQ + (size_t)j * QB) * LDR + 1024 + h * 128; const bf16* vp = kp + 1024;
          bf16x8 kk[4][2], vv[4][2];
#pragma unroll
          for (int t = 0; t < 4; ++t) { kk[t][0] = load8(kp + (size_t)(64 * t) * LDR + soff); kk[t][1] = load8(kp + (size_t)(64 * t + 32) * LDR + soff);
                                        vv[t][0] = load8(vp + (size_t)(64 * t) * LDR + soff); vv[t][1] = load8(vp + (size_t)(64 * t + 32) * LDR + soff); }
          if (tid < 16) { const unsigned c = tid > j ? CNT[(bh * 16 + tid) * 16 + j] : 0u; gt[16 + tid] = c; gt[tid] = (c + 31u) >> 5; }
#pragma unroll
          for (int t = 0; t < 4; ++t) { *(bf16x8*)(K_lds + t * SHM_K + kws) = kk[t][0]; *(bf16x8*)(K_lds + t * SHM_K + kws + 32 * 256) = kk[t][1];
                                        *(bf16x8*)(V_lds + t * SHM_V + vst0) = vv[t][0]; *(bf16x8*)(V_lds + t * SHM_V + vst1) = vv[t][1]; } }
        __syncthreads();
        int gtot = 0;
        for (int i = j + 1; i < 16; ++i) gtot += (int)gt[i];
        for (int g = wid; g < gtot; g += 8) {
            int i = j + 1, gl = g;
            while (gl >= (int)gt[i]) { gl -= (int)gt[i]; ++i; }
            const int cnt = (int)gt[16 + i], e = gl * 32 + r32; const bool valid = e < cnt;
            const unsigned ent = LIST[((size_t)(bh * 16 + i) * 16 + j) * 256 + (valid ? e : 0)];
            const int rowl = (int)(ent & 255u);
            if (hi == 0) rt[r32] = ent | (valid ? 0x10000u : 0u);
            bf16x8 qr[8];
            { const bf16* qb = qkv + ((size_t)b * SEQ + (size_t)i * QB + rowl) * LDR + h * 128 + hi * 8;
#pragma unroll
              for (int d0 = 0; d0 < 8; ++d0) qr[d0] = load8(qb + d0 * 16); }
            float m_reg = -1e30f, l_reg = 0.f; f32x16 o[4] = {};
            f32x16 pA0, pA1, pB0, pB1; float mnA, mnB, alA, alB; bf16x8 pa0, pa1, pa2, pa3;
#define RESC2(a) do { if (__any((a) < 1.f)) { if (hi == 0) al_l[r32] = (a); asm volatile("s_waitcnt lgkmcnt(0)" ::: "memory");              \
                     for (int d_ = 0; d_ < 4; ++d_) for (int r = 0; r < 16; ++r) o[d_][r] *= al_l[crow(r, hi)]; } } while (0)
            SBAR(); qkt<0>(pA0, pA1, K_lds, r32, hi, qr); partialSM(pA0, pA1, m_reg, mnA, alA);
            SBAR(); qkt<1>(pB0, pB1, K_lds, r32, hi, qr); finishSM(pA0, pA1, alA, l_reg, pa0, pa1, pa2, pa3); SBAR(); pv_tile<0>(o, vb0, pa0, pa1, pa2, pa3); partialSM(pB0, pB1, m_reg, mnB, alB); RESC2(alB);
            SBAR(); qkt<2>(pA0, pA1, K_lds, r32, hi, qr); finishSM(pB0, pB1, alB, l_reg, pa0, pa1, pa2, pa3); SBAR(); pv_tile<1>(o, vb0, pa0, pa1, pa2, pa3); partialSM(pA0, pA1, m_reg, mnA, alA); RESC2(alA);
            SBAR(); qkt<3>(pB0, pB1, K_lds, r32, hi, qr); finishSM(pA0, pA1, alA, l_reg, pa0, pa1, pa2, pa3); SBAR(); pv_tile<2>(o, vb0, pa0, pa1, pa2, pa3); partialSM(pB0, pB1, m_reg, mnB, alB); RESC2(alB);
            SBAR(); finishSM(pB0, pB1, alB, l_reg, pa0, pa1, pa2, pa3); SBAR(); pv_tile<3>(o, vb0, pa0, pa1, pa2, pa3);
#undef RESC2
            const size_t rowb = (size_t)bh * SEQ + (size_t)i * QB;
            if (hi == 0) { li_l[r32] = __builtin_amdgcn_rcpf(l_reg);
                if (valid) *(f32x2*)(PP.ML + ((size_t)(ent >> 8) * BATCH * NH * SEQ + rowb + rowl) * 2) = (f32x2){m_reg, l_reg}; }
            asm volatile("s_waitcnt lgkmcnt(0)" ::: "memory");
#pragma unroll
            for (int r = 0; r < 16; ++r) { const int rr = crow(r, hi); const unsigned en = rt[rr]; const float il = li_l[rr];
                bf16* pb = ((en >> 8) & 3u) == 0u ? PP.P[0] : ((en >> 8) & 3u) == 1u ? PP.P[1] : PP.P[2];
                bf16* prow = pb + (rowb + (en & 255u)) * 128 + r32;
#pragma unroll
                for (int d0 = 0; d0 < 4; ++d0) { const float v = o[d0][r] * il; const float vn = __shfl_xor(v, 1);
                    if ((r32 & 1) == 0 && (en & 0x10000u)) *(unsigned*)(prow + d0 * 32) = cvtpk(v, vn); } }
        }
    }
}
#ifndef MOBA_PP
#define MOBA_PP 0
#endif
constexpr int PP_OFF_WS = 4 * SHM_V + 4 * SHM_K, PP_OFF_KM = 139264 + 64, PP_LDS_BYTES = PP_OFF_KM + 15 * 128 * 4;
static_assert(PP_OFF_WS + NW * 64 * 4 <= 139264 && PP_LDS_BYTES <= 147456, "LDS map");
#define PPBAR() do { asm volatile("s_waitcnt lgkmcnt(0)" ::: "memory"); __builtin_amdgcn_s_barrier(); asm volatile("" ::: "memory"); } while (0)
__device__ __forceinline__ void moba_block_pp(const BlockRef& cur, char* lds, int tid_) {
    int tid = tid_; asm volatile("" : "+v"(tid));
    const int wid = __builtin_amdgcn_readfirstlane(tid >> 6), lane = tid & 63, r32 = lane & 31, hi = lane >> 5, half = wid >> 2;
    const int iblk = cur.iblk, NT = 4 * (iblk + 1), P0 = iblk * QB;
    const int qlo = P0 + wid * QBLK, qm = qlo + r32 - 4 * hi;
    char* V_lds = lds; char* K_lds = lds + 4 * SHM_V;
    float* KMs = (float*)(lds + PP_OFF_KM);
    float* ws = (float*)(lds + PP_OFF_WS) + wid * 64; float* li_l = ws, * al_l = ws + 32;
    const int sr = tid >> 4, sc = (tid & 15) * 8, vst0 = v_st(sr, sc), vst1 = v_st(32 + sr, sc), kws = KSWZ(sr, sc * 2);
    const unsigned soff = (unsigned)(sr * LDR + sc), qoff = (unsigned)(r32 * LDR + hi * 8);
    const int vb0 = (int)(uintptr_t)V_lds + v_rd_base(lane);
    const bf16* Kh = cur.K; const bf16* Vh = cur.V;
    Seam S;
    { const bf16* qb = cur.Q + (size_t)(wid * QBLK) * LDR;
#pragma unroll
      for (int d0 = 0; d0 < 8; ++d0) S.qr[d0] = load8(qb + (size_t)qoff + d0 * 16); }
    { int t4 = tid; asm volatile("" : "+v"(t4));
      const f32x4 kmv = *(const f32x4*)(cur.KM + t4 * 4);
      SLOAD_H(Kh, Vh, 0); VMW();
      if (t4 < 15 * 32) *(f32x4*)(KMs + t4 * 4) = kmv; SWRITE_H(0); }
    SLOAD_H(Kh, Vh, KVBLK);
    __syncthreads();
    unsigned sel = 0u;
    if (iblk > 0) {
        float v1 = -__builtin_inff(), v2 = v1, v3 = v1; int i1 = -1, i2 = -1, i3 = -1;
        for (int j = 0; j < iblk; ++j) {
            const float* km = KMs + j * 128 + 8 * hi; float a = 0.f;
#pragma unroll
            for (int d0 = 0; d0 < 8; ++d0) { const f32x4 k0 = *(const f32x4*)(km + 16 * d0), k1 = *(const f32x4*)(km + 16 * d0 + 4); const bf16x8 q = S.qr[d0];
#pragma unroll
                for (int e = 0; e < 4; ++e) { a = fmaf(__uint_as_float((unsigned)(unsigned short)q[e] << 16), k0[e], a); a = fmaf(__uint_as_float((unsigned)(unsigned short)q[e + 4] << 16), k1[e], a); } }
            a += __shfl_xor(a, 32);
            if (a > v1) { v3 = v2; i3 = i2; v2 = v1; i2 = i1; v1 = a; i1 = j; }
            else if (a > v2) { v3 = v2; i3 = i2; v2 = a; i2 = j; }
            else if (a > v3) { v3 = a; i3 = j; }
        }
        sel = (i1 >= 0 ? 1u << i1 : 0u) | (i2 >= 0 ? 1u << i2 : 0u) | (i3 >= 0 ? 1u << i3 : 0u);
    }
    VMW(); SWRITE_H(1); SLOAD_H(Kh, Vh, 2 * KVBLK);
    __syncthreads();
    float m_reg = -1e30f, l_reg = 0; f32x16 o[4] = {};
    f32x16 pA0, pA1, pB0 = {}, pB1 = {}; float mnA, mnB, alA = 1.f, alB = 1.f; bf16x8 pa0, pa1, pa2, pa3;
#define RESC(a) do { if (__any((a) < 1.f)) { if (hi == 0) al_l[r32] = (a); asm volatile("s_waitcnt lgkmcnt(0)" ::: "memory");              \
                     for (int d_ = 0; d_ < 4; ++d_) for (int r = 0; r < 16; ++r) o[d_][r] *= al_l[crow(r, hi)]; } } while (0)
#define MASKT(P0_, P1_, t) do { const int kb_ = (t) * KVBLK; const int bj_ = (t) >> 2; \
        if (bj_ == iblk) { if (kb_ + KVBLK - 1 > qlo) mask_causal(P0_, P1_, qm - kb_); } else mask_all(P0_, P1_, ((sel >> bj_) & 1u) != 0u); } while (0)
#define PP_STEP(t, SL, PX0, PX1, mnX, alX, PY0, PY1, alY, HASPREV) do {                                                              \
        __builtin_amdgcn_s_setprio(1); qkt<SL>(PX0, PX1, K_lds, r32, hi, S.qr); __builtin_amdgcn_s_setprio(0); PPBAR();                 \
        if (HASPREV) finishSM(PY0, PY1, alY, l_reg, pa0, pa1, pa2, pa3); PPBAR();                                                       \
        if (HASPREV) { __builtin_amdgcn_s_setprio(1); pv_tile<((SL) + 3) & 3>(o, vb0, pa0, pa1, pa2, pa3); __builtin_amdgcn_s_setprio(0); } PPBAR(); \
        MASKT(PX0, PX1, (t)); partialSM(PX0, PX1, m_reg, mnX, alX); RESC(alX);                                                          \
        if ((t) + 2 < NT) { VMW(); SWRITE_H(((SL) + 2) & 3); if ((t) + 3 < NT) SLOAD_H(Kh, Vh, ((t) + 3) * KVBLK); }                    \
        PPBAR(); } while (0)
    if (half == 1) PPBAR();
    for (int t = 0; t < NT; t += 4) {
        PP_STEP(t,     0, pA0, pA1, mnA, alA, pB0, pB1, alB, t > 0);
        PP_STEP(t + 1, 1, pB0, pB1, mnB, alB, pA0, pA1, alA, true);
        PP_STEP(t + 2, 2, pA0, pA1, mnA, alA, pB0, pB1, alB, true);
        PP_STEP(t + 3, 3, pB0, pB1, mnB, alB, pA0, pA1, alA, true);
    }
    if (half == 0) PPBAR();
    finishSM(pB0, pB1, alB, l_reg, pa0, pa1, pa2, pa3); SBAR(); pv_tile<3>(o, vb0, pa0, pa1, pa2, pa3);
    { int hi_e = hi; asm volatile("" : "+v"(hi_e));
      const int ldo = cur.ldo; bf16* Ow = cur.O + (size_t)(wid * QBLK) * ldo;
      const unsigned ooff = (unsigned)(4 * hi_e * ldo + r32);
      if (hi == 0) li_l[r32] = l_reg; asm volatile("s_waitcnt lgkmcnt(0)" ::: "memory");
      float rli[16];
#pragma unroll
      for (int r = 0; r < 16; ++r) rli[r] = __builtin_amdgcn_rcpf(li_l[crow(r, hi_e)]);
#pragma unroll
      for (int r = 0; r < 16; ++r) { bf16* orow = Ow + (size_t)((r & 3) + 8 * (r >> 2)) * ldo;
#pragma unroll
          for (int d0 = 0; d0 < 4; ++d0) { const float v = o[d0][r] * rli[r];
              const float vn = __shfl_xor(v, 1);
              if ((r32 & 1) == 0 && cur.store) *(unsigned*)(orow + (size_t)ooff + d0 * 32) = cvtpk(v, vn); } } }
    __syncthreads();
#undef PP_STEP
#undef MASKT
#undef RESC
}
#undef ROW
#undef VMW
#undef VMWN
#undef SLOAD_H
#undef SWRITE_HK
#undef SWRITE_HV
#undef SWRITE_H
#undef KSWZ
#undef SBAR

__device__ __forceinline__ void item_decode(int L, int G, int k, int bx, int& bh, int& x) {
    if (G == 256) { const int b = bx & 7, q = bx >> 3; bh = b * 8 + k * 4 + (q >> 3); x = q & 7; }
    else { bh = L >> 3; x = L & 7; }
}
__device__ __forceinline__ BlockRef make_ref(bf16* qkv, const float* kmean, bf16* ob, int ldo, int bh, int iblk, float mfix = 0.f) {
    const int b = bh >> 3, h = bh & 7; BlockRef r; bf16* base = qkv + (size_t)bh * 3 * ARR;
    r.Q = base + (size_t)iblk * QB * LDR; r.O = ob + ((size_t)b * SEQ + (size_t)iblk * QB) * ldo + h * 128; r.K = base + ARR; r.V = base + 2 * ARR; r.KM = kmean + (size_t)bh * 16 * 128; r.iblk = iblk; r.ldo = ldo; r.store = 1; r.bh = bh; r.mfix = mfix; return r;
}
__device__ __forceinline__ void attn_phase(bf16* qkv, const float* kmean, bf16* ob, int ldo, const Partials& PP, char* lds, int tid, const float* qg = nullptr, const float* kg = nullptr) {
    float mfix = 0.f;
    if (MOBA_CMAX) {
        const int ln = tid & 63; float a = fmaxf(fabsf(qg[ln]), fabsf(qg[ln + 64])), b = fmaxf(fabsf(kg[ln]), fabsf(kg[ln + 64]));
#pragma unroll
        for (int s = 32; s > 0; s >>= 1) { a = fmaxf(a, __shfl_xor(a, s)); b = fmaxf(b, __shfl_xor(b, s)); }
        mfix = __uint_as_float((unsigned)__builtin_amdgcn_readfirstlane((int)__float_as_uint(11.313708498984761f * 1.02f * a * b))); }
    const int G = gridDim.x, bx = blockIdx.x, real = BATCH * NH * 8, total = (PROBE_DUP & 16) ? 2 * real : real;
    int L = bx, k = 0; if (L >= total) return;
    int bh, x; item_decode(L % real, G, k & 1, bx, bh, x); int pass = 0;
    BlockRef cur = make_ref(qkv, kmean, ob, ldo, bh, x, mfix); cur.store = ((PROBE_DUP & 16) == 0) || L >= real;
    Seam S;
    moba_prime(cur, lds, S, tid);
    for (;;) {
        const bool more_pass = pass == 0, more_item = L + G < total, last = !more_pass && !more_item;
        int bhn = bh, xn = x, passn = pass + 1, Ln = L, kn = k;
        if (!more_pass) { passn = 0; if (more_item) { Ln = L + G; kn = k + 1; } item_decode(Ln % real, G, kn & 1, bx, bhn, xn); }
        BlockRef nxt = last ? cur : make_ref(qkv, kmean, ob, ldo, bhn, passn ? 15 - xn : xn, mfix); nxt.store = ((PROBE_DUP & 16) == 0) || Ln >= real;
        moba_block(cur, nxt, PP, lds, S, tid);
        if (last) break;
        cur = nxt; bh = bhn; x = xn; pass = passn; L = Ln; k = kn;
    }
}
__device__ __forceinline__ void attn_phase_pp(bf16* qkv, const float* kmean, bf16* ob, int ldo, char* lds, int tid) {
    const int G = gridDim.x, bx = blockIdx.x, real = BATCH * NH * 8, total = (PROBE_DUP & 16) ? 2 * real : real;
    int k = 0;
    for (int L = bx; L < total; L += G, ++k) {
        int bh, x; item_decode(L % real, G, k & 1, bx, bh, x);
#pragma unroll 1
        for (int pass = 0; pass < 2; ++pass) {
            BlockRef cur = make_ref(qkv, kmean, ob, ldo, bh, pass ? 15 - x : x); cur.store = ((PROBE_DUP & 16) == 0) || L >= real;
            moba_block_pp(cur, lds, tid);
        }
    }
}
}
namespace hg {
typedef short bf16x8 __attribute__((ext_vector_type(8)));
typedef short s16x4 __attribute__((ext_vector_type(4)));
typedef float f32x16 __attribute__((ext_vector_type(16)));
constexpr int LDB = 4096, CH = 64, NCH_SEG = 16, NSEG = 4;
constexpr int RS = 272, TS = 144, OST_RS = 528;
constexpr int OFF_QR = 0, OFF_KR = 17408, OFF_QI = 34816, OFF_KT = 52224, OFF_VT = 70656, OFF_DEC = 89088, OFF_OST = 89600, HG_LDS_BYTES = OFF_OST + 64 * OST_RS;
static_assert(HG_LDS_BYTES <= 131072, "HGRN LDS map");
__device__ __forceinline__ unsigned pk(float lo, float hi) { unsigned r; asm volatile("v_cvt_pk_bf16_f32 %0, %1, %2" : "=v"(r) : "v"(lo), "v"(hi)); return r; }
__device__ __forceinline__ bf16x8 join8(s16x4 a, s16x4 b) { return (bf16x8){a[0], a[1], a[2], a[3], b[0], b[1], b[2], b[3]}; }
__device__ __forceinline__ bf16x8 acc_frag(const f32x16& x, int s) {
    u32x4 w; w.x = pk(x[8 * s + 0], x[8 * s + 1]); w.y = pk(x[8 * s + 2], x[8 * s + 3]); w.z = pk(x[8 * s + 4], x[8 * s + 5]); w.w = pk(x[8 * s + 6], x[8 * s + 7]);
    return __builtin_bit_cast(bf16x8, w);
}
template <bool FULL> struct Raw { bf16 z[16], v[16], q[FULL ? 16 : 1]; };
struct Scan { float kk[16], G[16]; };
constexpr int OFF_TQ = 131072;
template <bool FULL>
__device__ __forceinline__ void load_z(Raw<FULL>& R, const bf16* __restrict__ base, int lane, int wave) {
    const bf16* p = base + (size_t)(16 * (wave >> 1)) * LDB + 64 * (wave & 1) + lane + 1024;
#pragma unroll
    for (int i = 0; i < 16; ++i) R.z[i] = p[(size_t)i * LDB];
}
template <bool FULL>
__device__ __forceinline__ void load_qv(Raw<FULL>& R, const bf16* __restrict__ base, int lane, int wave) {
    const bf16* p = base + (size_t)(16 * (wave >> 1)) * LDB + 64 * (wave & 1) + lane;
#pragma unroll
    for (int i = 0; i < 16; ++i) { R.v[i] = p[(size_t)i * LDB + 2048]; if (FULL) R.q[i] = p[(size_t)i * LDB]; }
}
template <bool FULL>
__device__ __forceinline__ void build_scan(Scan& C, const Raw<FULL>& R, float lb, LAS unsigned char* lds, int lane, int wave) {
    const int c = 64 * (wave & 1) + lane, qq = wave >> 1;
    float run = 0.f; const float omlb = 1.0f - lb;
#pragma unroll
    for (int i = 0; i < 16; ++i) { const float e = __expf(-bf2f(R.z[i])); const float sg = __builtin_amdgcn_rcpf(1.0f + e); C.kk[i] = omlb * (e * sg); run += __logf(lb + omlb * sg); C.G[i] = run; }
    *(LAS float*)(lds + OFF_TQ + 4 * (qq * 128 + c)) = run;
}
template <bool FULL>
__device__ __forceinline__ float build_ops(const Scan& C, const Raw<FULL>& R, LAS unsigned char* lds, int lane, int wave) {
    const int c = 64 * (wave & 1) + lane, qq = wave >> 1;
    const float T0 = *(const LAS float*)(lds + OFF_TQ + 4 * c), T1 = *(const LAS float*)(lds + OFF_TQ + 4 * (128 + c)), T2 = *(const LAS float*)(lds + OFF_TQ + 4 * (256 + c)), T3 = *(const LAS float*)(lds + OFF_TQ + 4 * (384 + c));
    const float gmid = T0 + T1, glast = gmid + (T2 + T3);
    const float off = qq == 0 ? 0.f : qq == 1 ? T0 : qq == 2 ? gmid : gmid + T2;
    const float Egm = __expf(gmid), Elm = __expf(glast - gmid);
    unsigned ktw[8], vtw[8];
#pragma unroll
    for (int i = 0; i < 16; i += 2) {
        float ks[2];
#pragma unroll
        for (int e = 0; e < 2; ++e) { const int t = 16 * qq + i + e; const float E1 = __expf(C.G[i + e] + off - gmid), R1 = __builtin_amdgcn_rcpf(E1);
            ks[e] = C.kk[i + e] * R1 * Elm;
            if (FULL) { const float qe = bf2f(R.q[FULL ? i + e : 0]) * QSCALE * E1;
                *(LAS bf16*)(lds + OFF_QR + t * RS + 2 * c) = (bf16)(pk(qe, 0.f) & 0xffffu);
                *(LAS bf16*)(lds + OFF_KR + t * RS + 2 * c) = (bf16)(pk(C.kk[i + e] * R1, 0.f) & 0xffffu);
                *(LAS bf16*)(lds + OFF_QI + t * RS + 2 * c) = (bf16)(pk(qe * Egm, 0.f) & 0xffffu); } }
        ktw[i >> 1] = pk(ks[0], ks[1]); vtw[i >> 1] = (unsigned)R.v[i] | ((unsigned)R.v[i + 1] << 16); }
    *(LAS u32x4*)(lds + OFF_KT + c * TS + 32 * qq) = (u32x4){ktw[0], ktw[1], ktw[2], ktw[3]}; *(LAS u32x4*)(lds + OFF_KT + c * TS + 32 * qq + 16) = (u32x4){ktw[4], ktw[5], ktw[6], ktw[7]};
    *(LAS u32x4*)(lds + OFF_VT + c * TS + 32 * qq) = (u32x4){vtw[0], vtw[1], vtw[2], vtw[3]}; *(LAS u32x4*)(lds + OFF_VT + c * TS + 32 * qq + 16) = (u32x4){vtw[4], vtw[5], vtw[6], vtw[7]};
    if (qq == 0) *(LAS float*)(lds + OFF_DEC + 4 * c) = __expf(glast);
    return glast;
}
__device__ __forceinline__ void state_update(f32x16 (&S)[4], LAS unsigned char* lds, int j, int c, int h) {
#pragma unroll
    for (int i = 0; i < 4; ++i) {
#pragma unroll
        for (int g4 = 0; g4 < 4; ++g4) { const f32x4 dc = *(const LAS f32x4*)(lds + OFF_DEC + 4 * (32 * i + 8 * g4 + 4 * h));
#pragma unroll
            for (int e = 0; e < 4; ++e) S[i][4 * g4 + e] *= dc[e]; }
#pragma unroll
        for (int ks = 0; ks < 4; ++ks) {
            const bf16x8 a = *(const LAS bf16x8*)(lds + OFF_KT + (32 * i + c) * TS + (16 * ks + 8 * h) * 2);
            const bf16x8 b = *(const LAS bf16x8*)(lds + OFF_VT + (32 * j + c) * TS + (16 * ks + 8 * h) * 2);
            S[i] = __builtin_amdgcn_mfma_f32_32x32x16_bf16(a, b, S[i], 0, 0, 0); }
    }
}
__device__ __forceinline__ int crow(int r, int h) { return (r & 3) + 8 * (r >> 2) + 4 * h; }

__device__ __forceinline__ void pass_a(const bf16* __restrict__ big, const float* __restrict__ lbv, float* __restrict__ Eg, float* __restrict__ Dg, LAS unsigned char* lds, int lane, int wave) {
    const int j = wave & 3, th = wave >> 2, c = lane & 31, h = lane >> 5;
    for (int u = blockIdx.x; u < BATCH * NH * NSEG; u += gridDim.x) {
        const int seg = u & 3, hh = (u >> 2) & 7, b = u >> 5;
        if (seg == NSEG - 1) continue;
        const int cch = 64 * (wave & 1) + lane;
        const float lb = lbv[hh * 128 + cch];
        f32x16 S[4];
#pragma unroll
        for (int i = 0; i < 4; ++i) S[i] = f32x16{};
        float dsum = 0.f;
        const bf16* base = big + (size_t)(b * SEQ + seg * NCH_SEG * CH) * LDB + hh * 128;
        Raw<false> R; load_z<false>(R, base, lane, wave); load_qv<false>(R, base, lane, wave);
        Scan C; build_scan<false>(C, R, lb, lds, lane, wave);
        load_z<false>(R, base + (size_t)CH * LDB, lane, wave);
        __syncthreads();
        for (int ch = 0; ch < NCH_SEG; ++ch) {
            dsum += build_ops<false>(C, R, lds, lane, wave);
            __syncthreads();
            if (ch + 1 < NCH_SEG) load_qv<false>(R, base + (size_t)(ch + 1) * CH * LDB, lane, wave);
            state_update(S, lds, j, c, h);
            if (ch + 1 < NCH_SEG) { build_scan<false>(C, R, lb, lds, lane, wave); if (ch + 2 < NCH_SEG) load_z<false>(R, base + (size_t)(ch + 2) * CH * LDB, lane, wave); }
            __syncthreads();
        }
        if ((wave >> 1) == 0) Dg[(size_t)u * 128 + cch] = dsum;
        if (th == 0) {
            float* E = Eg + (size_t)u * 16384;
#pragma unroll
            for (int i = 0; i < 4; ++i)
#pragma unroll
                for (int r = 0; r < 16; ++r) E[(size_t)(32 * i + crow(r, h)) * 128 + 32 * j + c] = S[i][r];
        }
    }
}
__device__ __forceinline__ void pass_b(bf16* big, bf16* outp, int ldo, int store, const float* __restrict__ lbv, const float* __restrict__ og, const float* __restrict__ Eg, const float* __restrict__ Dg, LAS unsigned char* lds, int lane, int wave) {
    const int j = wave & 3, th = wave >> 2, c = lane & 31, h = lane >> 5, tid = wave * 64 + lane;
    for (int u = blockIdx.x; u < BATCH * NH * NSEG; u += gridDim.x) {
        const int seg = u & 3, hh = (u >> 2) & 7, b = u >> 5;
        const float lb = lbv[hh * 128 + 64 * (wave & 1) + lane];
        f32x16 S[4];
#pragma unroll
        for (int i = 0; i < 4; ++i) S[i] = f32x16{};
        for (int sp = 0; sp < seg; ++sp) {
            const float* E = Eg + (size_t)(u - seg + sp) * 16384; const float* Dp = Dg + (size_t)(u - seg + sp) * 128;
#pragma unroll
            for (int i = 0; i < 4; ++i)
#pragma unroll
                for (int r = 0; r < 16; ++r) { const int d = 32 * i + crow(r, h); S[i][r] = __expf(Dp[d]) * S[i][r] + E[(size_t)d * 128 + 32 * j + c]; }
        }
        const bf16* base = big + ((size_t)b * SEQ + (size_t)seg * NCH_SEG * CH) * LDB + hh * 128;
        Raw<true> R; load_z<true>(R, base, lane, wave); load_qv<true>(R, base, lane, wave);
        Scan C; build_scan<true>(C, R, lb, lds, lane, wave);
        load_z<true>(R, base + (size_t)CH * LDB, lane, wave);
        __syncthreads();
        const int ot = tid >> 3, opart = tid & 7;
        u32x4 gn0, gn1;
        { const bf16* gp = base + (size_t)ot * LDB + 3072 + opart * 16; gn0 = *(const u32x4*)gp; gn1 = *(const u32x4*)(gp + 8); }
        for (int ch = 0; ch < NCH_SEG; ++ch) {
            const size_t row0 = (size_t)b * SEQ + (size_t)(seg * NCH_SEG + ch) * CH;
            if (store != 3) (void)build_ops<true>(C, R, lds, lane, wave);
            const u32x4 g0 = gn0, g1 = gn1;
            __syncthreads();
            if (ch + 1 < NCH_SEG) { const bf16* nb = base + (size_t)(ch + 1) * CH * LDB; load_qv<true>(R, nb, lane, wave);
                const bf16* gp = nb + (size_t)ot * LDB + 3072 + opart * 16; gn0 = *(const u32x4*)gp; gn1 = *(const u32x4*)(gp + 8); }
            if (store == 2) { __syncthreads(); continue; }
            bf16x8 P[2][2];
#pragma unroll
            for (int sh = 0; sh < 2; ++sh) {
                if (sh <= th) {
                    f32x16 X = f32x16{};
#pragma unroll
                    for (int ks = 0; ks < 8; ++ks) {
                        const bf16x8 a = *(const LAS bf16x8*)(lds + OFF_KR + (32 * sh + c) * RS + (16 * ks + 8 * h) * 2);
                        const bf16x8 bq = *(const LAS bf16x8*)(lds + OFF_QR + (32 * th + c) * RS + (16 * ks + 8 * h) * 2);
                        X = __builtin_amdgcn_mfma_f32_32x32x16_bf16(a, bq, X, 0, 0, 0); }
                    if (sh == th) {
#pragma unroll
                        for (int r = 0; r < 16; ++r) X[r] = crow(r, h) <= c ? X[r] : 0.f; }
                    P[sh][0] = acc_frag(X, 0); P[sh][1] = acc_frag(X, 1);
                } else { P[sh][0] = bf16x8{}; P[sh][1] = bf16x8{}; }
            }
            f32x16 o = f32x16{};
#pragma unroll
            for (int i = 0; i < 4; ++i)
#pragma unroll
                for (int s = 0; s < 2; ++s) {
                    const LAS unsigned char* qa = lds + OFF_QI + (32 * th + c) * RS + (32 * i + 16 * s + 4 * h) * 2;
                    const bf16x8 a = join8(*(const LAS s16x4*)qa, *(const LAS s16x4*)(qa + 16));
                    o = __builtin_amdgcn_mfma_f32_32x32x16_bf16(a, acc_frag(S[i], s), o, 0, 0, 0); }
#pragma unroll
            for (int sh = 0; sh < 2; ++sh) {
                if (sh <= th) {
#pragma unroll
                    for (int s = 0; s < 2; ++s) {
                        const LAS unsigned char* va = lds + OFF_VT + (32 * j + c) * TS + (32 * sh + 16 * s + 4 * h) * 2;
                        const bf16x8 bv = join8(*(const LAS s16x4*)va, *(const LAS s16x4*)(va + 16));
                        o = __builtin_amdgcn_mfma_f32_32x32x16_bf16(P[sh][s], bv, o, 0, 0, 0); } }
            }
            state_update(S, lds, j, c, h);
            if (ch + 1 < NCH_SEG) { build_scan<true>(C, R, lb, lds, lane, wave); if (ch + 2 < NCH_SEG) load_z<true>(R, base + (size_t)(ch + 2) * CH * LDB, lane, wave); }
#pragma unroll
            for (int r = 0; r < 16; ++r) *(LAS float*)(lds + OFF_OST + (32 * th + crow(r, h)) * OST_RS + (32 * j + c) * 4) = o[r];
            __syncthreads();
            {
                const int t = ot, part = opart;
                const LAS f32x4* op = (const LAS f32x4*)(lds + OFF_OST + t * OST_RS + part * 64);
                const f32x4 o0 = op[0], o1 = op[1], o2 = op[2], o3 = op[3];
                float ss = (o0[0] * o0[0] + o0[1] * o0[1]) + (o0[2] * o0[2] + o0[3] * o0[3]) + (o1[0] * o1[0] + o1[1] * o1[1]) + (o1[2] * o1[2] + o1[3] * o1[3])
                         + (o2[0] * o2[0] + o2[1] * o2[1]) + (o2[2] * o2[2] + o2[3] * o2[3]) + (o3[0] * o3[0] + o3[1] * o3[1]) + (o3[2] * o3[2] + o3[3] * o3[3]);
                ss += __shfl_xor(ss, 1); ss += __shfl_xor(ss, 2); ss += __shfl_xor(ss, 4);
                const float rstd = __builtin_amdgcn_rsqf(ss * (1.0f / 128.0f) + 1e-6f);
                bf16* yp = outp + (row0 + t) * ldo + hh * 128 + part * 16;
                const f32x4 w0 = *(const f32x4*)(og + part * 16), w1 = *(const f32x4*)(og + part * 16 + 4), w2 = *(const f32x4*)(og + part * 16 + 8), w3 = *(const f32x4*)(og + part * 16 + 12);
                const unsigned gw[8] = {g0.x, g0.y, g0.z, g0.w, g1.x, g1.y, g1.z, g1.w};
                const float ov[16] = {o0[0], o0[1], o0[2], o0[3], o1[0], o1[1], o1[2], o1[3], o2[0], o2[1], o2[2], o2[3], o3[0], o3[1], o3[2], o3[3]};
                const float wv[16] = {w0[0], w0[1], w0[2], w0[3], w1[0], w1[1], w1[2], w1[3], w2[0], w2[1], w2[2], w2[3], w3[0], w3[1], w3[2], w3[3]};
                unsigned ow[8];
#pragma unroll
                for (int e = 0; e < 8; ++e) { const float ga = __uint_as_float(gw[e] << 16), gb = __uint_as_float(gw[e] & 0xffff0000u);
                    const float ya = ov[2 * e] * rstd * wv[2 * e] * (ga * __builtin_amdgcn_rcpf(1.0f + __expf(-ga)));
                    const float yb = ov[2 * e + 1] * rstd * wv[2 * e + 1] * (gb * __builtin_amdgcn_rcpf(1.0f + __expf(-gb)));
                    ow[e] = pk(ya, yb); }
                if (store == 1) { *(u32x4*)yp = (u32x4){ow[0], ow[1], ow[2], ow[3]}; *(u32x4*)(yp + 8) = (u32x4){ow[4], ow[5], ow[6], ow[7]}; }
            }
        }
        __syncthreads();
    }
}
}
#ifndef HG2_A_CSEG
#define HG2_A_CSEG 1
#endif
#ifndef HG2_CSEG
#define HG2_CSEG 1
#endif
#ifndef HG2_BPRIO
#define HG2_BPRIO 0
#define HG2_CPRIO (HG2_CSEG ? 0 : 1)
#endif
#ifndef HG2_S0
#define HG2_S0 12
#define HG2_SN 29
#endif
#ifndef HG2_PAIR
#define HG2_PAIR 0
#endif
namespace hg2 {
#define HG2_BAR() do { asm volatile("s_waitcnt lgkmcnt(0)" ::: "memory"); __builtin_amdgcn_s_barrier(); asm volatile("" ::: "memory"); } while (0)
#if PROBE_STAMP == 11 || PROBE_STAMP == 12
#define HG2_BAR_T(ROLE) do { asm volatile("s_waitcnt lgkmcnt(0)" ::: "memory"); const unsigned t0_ = (unsigned)__builtin_amdgcn_s_memrealtime(); __builtin_amdgcn_s_barrier(); asm volatile("" ::: "memory"); \
        const unsigned t1_ = (unsigned)__builtin_amdgcn_s_memrealtime(); if (mode == 0 && PROBE_STAMP == 11 + (ROLE)) hw_acc += t1_ - t0_; } while (0)
#else
#define HG2_BAR_T(ROLE) HG2_BAR()
#endif
typedef short bf16x8 __attribute__((ext_vector_type(8)));
typedef short s16x4 __attribute__((ext_vector_type(4)));
typedef float f32x16 __attribute__((ext_vector_type(16)));
constexpr int LDB = 128, ARR = 4096 * 128, LDG = 1024, CH = 32, NCH_SEG = 32, NSEG = 4;
constexpr int RS = 272, TS = 80, OST_RS = 528;
constexpr int B_QR = 0, B_KR = 8704, B_KT = 17408, B_VT = 27648, B_DEC = 37888, B_EGM = 38400, BUF_BYTES = 38912;
constexpr int OFF_OST = 2 * BUF_BYTES, OST_BYTES = 32 * OST_RS, OFF_SCR = OFF_OST + 2 * OST_BYTES, HG2_LDS_BYTES = OFF_SCR + 4 * 2560;
static_assert(HG2_LDS_BYTES <= 131072, "HGRN LDS map");
__device__ __forceinline__ unsigned pk(float lo, float hi) { unsigned r; asm volatile("v_cvt_pk_bf16_f32 %0, %1, %2" : "=v"(r) : "v"(lo), "v"(hi)); return r; }
__device__ __forceinline__ bf16x8 join8(s16x4 a, s16x4 b) { return (bf16x8){a[0], a[1], a[2], a[3], b[0], b[1], b[2], b[3]}; }
__device__ __forceinline__ int crow(int r, int h) { return (r & 3) + 8 * (r >> 2) + 4 * h; }
__device__ __forceinline__ bf16x8 acc_frag_scaled(const f32x16& x, int s, const f32x4& e0, const f32x4& e1) {
    u32x4 w; w.x = pk(x[8 * s + 0] * e0[0], x[8 * s + 1] * e0[1]); w.y = pk(x[8 * s + 2] * e0[2], x[8 * s + 3] * e0[3]); w.z = pk(x[8 * s + 4] * e1[0], x[8 * s + 5] * e1[1]); w.w = pk(x[8 * s + 6] * e1[2], x[8 * s + 7] * e1[3]);
    return __builtin_bit_cast(bf16x8, w);
}
__device__ __forceinline__ bf16x8 acc_frag(const f32x16& x, int s) {
    u32x4 w; w.x = pk(x[8 * s + 0], x[8 * s + 1]); w.y = pk(x[8 * s + 2], x[8 * s + 3]); w.z = pk(x[8 * s + 4], x[8 * s + 5]); w.w = pk(x[8 * s + 6], x[8 * s + 7]);
    return __builtin_bit_cast(bf16x8, w);
}
template <bool FULL> struct Raw { u32x4 z[2], v[2], q[FULL ? 2 : 1]; };
constexpr int SCR_RS = 80, SCR_BYTES = 32 * SCR_RS;
template <bool FULL>
__device__ __forceinline__ void load_raw(Raw<FULL>& R, const bf16* __restrict__ base, int lane, int bw) {
    const bf16* p = base + (size_t)(lane >> 2) * LDB + 32 * bw + 8 * (lane & 3);
#pragma unroll
    for (int e = 0; e < 2; ++e) { R.z[e] = *(const u32x4*)(p + (size_t)(16 * e) * LDB + ARR); R.v[e] = *(const u32x4*)(p + (size_t)(16 * e) * LDB + 2 * ARR); if (FULL) R.q[e] = *(const u32x4*)(p + (size_t)(16 * e) * LDB); }
}
__device__ __forceinline__ void transpose16(float (&out)[16], const u32x4 (&src)[2], LAS unsigned char* scr, int lane) {
    *(LAS u32x4*)(scr + (lane >> 2) * SCR_RS + 16 * (lane & 3)) = src[0]; *(LAS u32x4*)(scr + ((lane >> 2) + 16) * SCR_RS + 16 * (lane & 3)) = src[1];
    asm volatile("s_waitcnt lgkmcnt(0)" ::: "memory");
#pragma unroll
    for (int i = 0; i < 16; ++i) out[i] = bf2f(*(const LAS bf16*)(scr + (16 * (lane >> 5) + i) * SCR_RS + 2 * (lane & 31)));
    asm volatile("s_waitcnt lgkmcnt(0)" ::: "memory");
}
template <bool FULL>
__device__ __forceinline__ float build_chunk(const Raw<FULL>& R, float lb, LAS unsigned char* buf, LAS unsigned char* scr, int lane, int bw) {
    const int c = 32 * bw + (lane & 31), half = lane >> 5;
    float Pr[16], kk[16]; float run = 1.f; const float omlb = 1.0f - lb;
    { float z[16]; transpose16(z, R.z, scr, lane);
#pragma unroll
      for (int i = 0; i < 16; ++i) { const float e = __expf(-z[i]); const float sg = __builtin_amdgcn_rcpf(1.0f + e); kk[i] = omlb * (e * sg); run *= lb + omlb * sg; Pr[i] = run; } }
    const float oth = __shfl_xor(run, 32);
    const float T0 = half ? oth : run, T1 = half ? run : oth;
    const float sc1 = half ? 1.0f : __builtin_amdgcn_rcpf(T0);
    const float Elm = T1;
    float qv[16];
    if constexpr (FULL) transpose16(qv, R.q, scr, lane);
    float vv[16]; transpose16(vv, R.v, scr, lane);
    unsigned ktw[8], vtw[8];
#pragma unroll
    for (int i = 0; i < 16; i += 2) {
        float ks[2];
#pragma unroll
        for (int e = 0; e < 2; ++e) { const int t = 16 * half + i + e; const float E1 = Pr[i + e] * sc1, R1 = __builtin_amdgcn_rcpf(E1);
            ks[e] = kk[i + e] * R1 * Elm;
            if (FULL) { *(LAS bf16*)(buf + B_QR + t * RS + 2 * c) = (bf16)(pk(qv[FULL ? i + e : 0] * QSCALE * E1, 0.f) & 0xffffu);
                        *(LAS bf16*)(buf + B_KR + t * RS + 2 * c) = (bf16)(pk(kk[i + e] * R1, 0.f) & 0xffffu); } }
        ktw[i >> 1] = pk(ks[0], ks[1]); vtw[i >> 1] = pk(vv[i], vv[i + 1]); }
    *(LAS u32x4*)(buf + B_KT + c * TS + 32 * half) = (u32x4){ktw[0], ktw[1], ktw[2], ktw[3]}; *(LAS u32x4*)(buf + B_KT + c * TS + 32 * half + 16) = (u32x4){ktw[4], ktw[5], ktw[6], ktw[7]};
    *(LAS u32x4*)(buf + B_VT + c * TS + 32 * half) = (u32x4){vtw[0], vtw[1], vtw[2], vtw[3]}; *(LAS u32x4*)(buf + B_VT + c * TS + 32 * half + 16) = (u32x4){vtw[4], vtw[5], vtw[6], vtw[7]};
    if (half == 0) { *(LAS float*)(buf + B_DEC + 4 * c) = T0 * T1; *(LAS float*)(buf + B_EGM + 4 * c) = T0; }
    return __logf(T0 * T1);
}
__device__ __forceinline__ void state_update(f32x16 (&S)[4], const LAS unsigned char* buf, int j, int c, int h) {
    bf16x8 a[4][2], bv[2]; f32x4 dc[4][4];
#pragma unroll
    for (int ks = 0; ks < 2; ++ks) bv[ks] = *(const LAS bf16x8*)(buf + B_VT + (32 * j + c) * TS + (16 * ks + 8 * h) * 2);
#pragma unroll
    for (int i = 0; i < 4; ++i) {
#pragma unroll
        for (int ks = 0; ks < 2; ++ks) a[i][ks] = *(const LAS bf16x8*)(buf + B_KT + (32 * i + c) * TS + (16 * ks + 8 * h) * 2);
#pragma unroll
        for (int g4 = 0; g4 < 4; ++g4) dc[i][g4] = *(const LAS f32x4*)(buf + B_DEC + 4 * (32 * i + 8 * g4 + 4 * h)); }
#pragma unroll
    for (int i = 0; i < 4; ++i) {
#pragma unroll
        for (int g4 = 0; g4 < 4; ++g4)
#pragma unroll
            for (int e = 0; e < 4; ++e) S[i][4 * g4 + e] *= dc[i][g4][e];
#pragma unroll
        for (int ks = 0; ks < 2; ++ks) S[i] = __builtin_amdgcn_mfma_f32_32x32x16_bf16(a[i][ks], bv[ks], S[i], 0, 0, 0);
    }
}
__device__ __forceinline__ void hg_geom(bool five, int seg, int& c0, int& nch) {
    if (five) { c0 = seg == 0 ? 0 : HG2_S0 + HG2_SN * (seg - 1); nch = seg == 0 ? HG2_S0 : HG2_SN; } else { c0 = seg * NCH_SEG; nch = NCH_SEG; }
}
__device__ __forceinline__ void pass_a(const bf16* __restrict__ big, const float* __restrict__ lbv, float* __restrict__ Eg, float* __restrict__ Dg, LAS unsigned char* lds, int lane, int wave) {
    const int ridx = HG2_PAIR ? ((wave & 1) | ((wave >> 2) << 1)) : (wave & 3);
    const bool builder = HG2_PAIR ? (wave & 2) != 0 : wave < 4; const int bw = ridx, j = ridx, c = lane & 31, h = lane >> 5;
    for (int v_ = blockIdx.x; v_ < BATCH * NH * NSEG; v_ += gridDim.x) {
        const bool five = gridDim.x == 256;
        const int u = five ? (((v_ & 7) << 5) | (v_ >> 3)) : v_;
        const int seg = u & 3, hh = (u >> 2) & 7, b = u >> 5;
        if (five ? seg == 0 : seg == NSEG - 1) continue;
        int c0, nch; hg_geom(five, seg, c0, nch);
        const bf16* base = big + ((size_t)(b * 8 + hh) * 3 * 4096 + (size_t)c0 * CH) * 128;
        if (builder) {
            __builtin_amdgcn_s_setprio(HG2_A_CSEG ? 0 : 1);
            const float lb = lbv[hh * 128 + 32 * bw + (lane & 31)];
            float dsum = 0.f; Raw<false> R0, R1;
            load_raw<false>(R0, base, lane, bw); load_raw<false>(R1, base + (size_t)CH * LDB, lane, bw);
#define HG2_A_ITER(kk_, RX) do { const int k_ = (kk_); if (k_ < nch) { dsum += build_chunk<false>(RX, lb, lds + (k_ & 1) * BUF_BYTES, lds + OFF_SCR + bw * 2560, lane, bw); \
                if (k_ + 2 < nch) load_raw<false>(RX, base + (size_t)(k_ + 2) * CH * LDB, lane, bw); } HG2_BAR(); } while (0)
            for (int k = 0; k < nch + 1; k += 2) { HG2_A_ITER(k, R0); if (k + 1 < nch + 1) HG2_A_ITER(k + 1, R1); }
#undef HG2_A_ITER
            if ((lane >> 5) == 0) Dg[(size_t)u * 128 + 32 * bw + (lane & 31)] = dsum;
            __builtin_amdgcn_s_setprio(0);
        } else {
            f32x16 S[4];
#pragma unroll
            for (int i = 0; i < 4; ++i) S[i] = f32x16{};
            for (int k = 0; k <= nch; ++k) {
                if (k > 0) { if (HG2_A_CSEG) __builtin_amdgcn_s_setprio(1); state_update(S, lds + ((k - 1) & 1) * BUF_BYTES, j, c, h); if (HG2_A_CSEG) __builtin_amdgcn_s_setprio(0); }
                HG2_BAR();
            }
            float* E = Eg + (size_t)u * 16384;
#pragma unroll
            for (int i = 0; i < 4; ++i)
#pragma unroll
                for (int r = 0; r < 16; ++r) E[(size_t)(32 * i + crow(r, h)) * 128 + 32 * j + c] = S[i][r];
        }
    }
}
__device__ __forceinline__ void pass_b(bf16* big, bf16* outp, int ldo, int store, const float* __restrict__ lbv, const float* __restrict__ og, float* __restrict__ Eg, float* __restrict__ Dg, LAS unsigned char* lds, int lane, int wave, int mode = 0) {
    const int ridx = HG2_PAIR ? ((wave & 1) | ((wave >> 2) << 1)) : (wave & 3);
    const bool builder = HG2_PAIR ? (wave & 2) != 0 : wave < 4; const int bw = ridx, j = ridx, c = lane & 31, h = lane >> 5, btid = ridx * 64 + lane;
    unsigned hw_acc = 0u; (void)hw_acc;
    for (int v_ = blockIdx.x; v_ < BATCH * NH * NSEG; v_ += gridDim.x) {
        const bool five = gridDim.x == 256;
        const int u0 = five ? (((v_ & 7) << 5) | (v_ >> 3)) : v_;
        const int slot = u0 & 3, hh = (u0 >> 2) & 7, b = u0 >> 5;
        if (mode == 1 && !(five && slot == 0)) continue;
        const int seg = mode == 1 ? 0 : (five ? slot + 1 : slot);
        const int u = u0 - slot + seg;
        int c0, nch; hg_geom(five, seg, c0, nch);
        const bf16* base = big + ((size_t)(b * 8 + hh) * 3 * 4096 + (size_t)c0 * CH) * 128;
        const bf16* gbase = big + (size_t)3 * MROWS * 1024 + ((size_t)b * SEQ + (size_t)c0 * CH) * LDG + hh * 128;
        if (builder) {
            __builtin_amdgcn_s_setprio(HG2_BPRIO);
            const float lb = lbv[hh * 128 + 32 * bw + (lane & 31)];
            Raw<true> R0, R1; float dsum = 0.f;
            load_raw<true>(R0, base, lane, bw); load_raw<true>(R1, base + (size_t)CH * LDB, lane, bw);
#define HG2_B_ITER(kk_, RX) do { const int k_ = (kk_); \
                if (k_ < nch) { if (store != 3) dsum += build_chunk<true>(RX, lb, lds + (k_ & 1) * BUF_BYTES, lds + OFF_SCR + bw * 2560, lane, bw); if (k_ + 2 < nch) load_raw<true>(RX, base + (size_t)(k_ + 2) * CH * LDB, lane, bw); } \
                HG2_BAR_T(0); } while (0)
            for (int k = 0; k < nch + 2; k += 2) { HG2_B_ITER(k, R0); if (k + 1 < nch + 2) HG2_B_ITER(k + 1, R1); }
#undef HG2_B_ITER
            if (mode == 1 && (lane >> 5) == 0) Dg[(size_t)(u0 - slot) * 128 + 32 * bw + (lane & 31)] = dsum;
            __builtin_amdgcn_s_setprio(0);
        } else {
            __builtin_amdgcn_s_setprio(HG2_CPRIO);
            f32x16 S[4];
#pragma unroll
            for (int i = 0; i < 4; ++i) S[i] = f32x16{};
            for (int sp = 0; sp < seg; ++sp) {
                const float* E = Eg + (size_t)(u - seg + sp) * 16384; const float* Dp = Dg + (size_t)(u - seg + sp) * 128;
                int cf = c, hf = h; asm volatile("" : "+v"(cf), "+v"(hf));
#pragma unroll
                for (int i = 0; i < 4; ++i)
#pragma unroll
                    for (int r = 0; r < 16; ++r) { const int d = 32 * i + crow(r, hf); S[i][r] = __expf(Dp[d]) * S[i][r] + E[(size_t)d * 128 + 32 * j + cf]; }
            }
            u32x4 gn0 = (u32x4){0u, 0u, 0u, 0u}, gn1 = gn0;
            const int ot = btid >> 3, opart = btid & 7;
            for (int k = 0; k <= nch + 1; ++k) {
                if (k >= 1 && k <= nch && store != 4) {
                if (HG2_CSEG) __builtin_amdgcn_s_setprio(1);
                const LAS unsigned char* buf = lds + ((k - 1) & 1) * BUF_BYTES;
                f32x16 X = f32x16{}, o = f32x16{};
#pragma unroll
                for (int ks = 0; ks < 8; ++ks) { const int i = ks >> 1, s = ks & 1;
                    const bf16x8 ka = *(const LAS bf16x8*)(buf + B_KR + c * RS + (16 * ks + 8 * h) * 2), qb = *(const LAS bf16x8*)(buf + B_QR + c * RS + (16 * ks + 8 * h) * 2);
                    const LAS unsigned char* qa = buf + B_QR + c * RS + (32 * i + 16 * s + 4 * h) * 2; const bf16x8 qa8 = join8(*(const LAS s16x4*)qa, *(const LAS s16x4*)(qa + 16));
                    const f32x4 eg0 = *(const LAS f32x4*)(buf + B_EGM + 4 * (32 * i + 16 * s + 4 * h)), eg1 = *(const LAS f32x4*)(buf + B_EGM + 4 * (32 * i + 16 * s + 8 + 4 * h));
                    X = __builtin_amdgcn_mfma_f32_32x32x16_bf16(ka, qb, X, 0, 0, 0);
                    o = __builtin_amdgcn_mfma_f32_32x32x16_bf16(qa8, acc_frag_scaled(S[i], s, eg0, eg1), o, 0, 0, 0); }
#pragma unroll
                for (int r = 0; r < 16; ++r) X[r] = crow(r, h) <= c ? X[r] : 0.f;
                const bf16x8 P0 = acc_frag(X, 0), P1 = acc_frag(X, 1);
#pragma unroll
                for (int s = 0; s < 2; ++s) {
                    const LAS unsigned char* va = buf + B_VT + (32 * j + c) * TS + (16 * s + 4 * h) * 2;
                    const bf16x8 bv = join8(*(const LAS s16x4*)va, *(const LAS s16x4*)(va + 16));
                    o = __builtin_amdgcn_mfma_f32_32x32x16_bf16(s ? P1 : P0, bv, o, 0, 0, 0); }
                state_update(S, buf, j, c, h);
#pragma unroll
                for (int r = 0; r < 16; ++r) *(LAS float*)(lds + OFF_OST + ((k - 1) & 1) * OST_BYTES + crow(r, h) * OST_RS + (32 * j + c) * 4) = o[r];
                }
                if (HG2_CSEG) __builtin_amdgcn_s_setprio(0);
                if (k >= 2 && store != 5) {
                    const int kc = k - 2; const u32x4 g0 = gn0, g1 = gn1;
                    const LAS f32x4* op = (const LAS f32x4*)(lds + OFF_OST + (kc & 1) * OST_BYTES + ot * OST_RS + opart * 64);
                    const f32x4 o0 = op[0], o1 = op[1], o2 = op[2], o3 = op[3];
                    float ss = (o0[0] * o0[0] + o0[1] * o0[1]) + (o0[2] * o0[2] + o0[3] * o0[3]) + (o1[0] * o1[0] + o1[1] * o1[1]) + (o1[2] * o1[2] + o1[3] * o1[3])
                             + (o2[0] * o2[0] + o2[1] * o2[1]) + (o2[2] * o2[2] + o2[3] * o2[3]) + (o3[0] * o3[0] + o3[1] * o3[1]) + (o3[2] * o3[2] + o3[3] * o3[3]);
                    ss += __shfl_xor(ss, 1); ss += __shfl_xor(ss, 2); ss += __shfl_xor(ss, 4);
                    const float rstd = __builtin_amdgcn_rsqf(ss * (1.0f / 128.0f) + 1e-6f);
                    int ot_y = ot; asm volatile("" : "+v"(ot_y));
                    const size_t row = (size_t)b * SEQ + (size_t)(c0 + kc) * CH + ot_y;
                    bf16* yp = outp + row * ldo + hh * 128 + opart * 16;
                    const f32x4 w0 = *(const f32x4*)(og + opart * 16), w1 = *(const f32x4*)(og + opart * 16 + 4), w2 = *(const f32x4*)(og + opart * 16 + 8), w3 = *(const f32x4*)(og + opart * 16 + 12);
                    const unsigned gw[8] = {g0.x, g0.y, g0.z, g0.w, g1.x, g1.y, g1.z, g1.w};
                    const float ov[16] = {o0[0], o0[1], o0[2], o0[3], o1[0], o1[1], o1[2], o1[3], o2[0], o2[1], o2[2], o2[3], o3[0], o3[1], o3[2], o3[3]};
                    const float wv[16] = {w0[0], w0[1], w0[2], w0[3], w1[0], w1[1], w1[2], w1[3], w2[0], w2[1], w2[2], w2[3], w3[0], w3[1], w3[2], w3[3]};
                    unsigned ow[8];
#pragma unroll
                    for (int e = 0; e < 8; ++e) { const float ga = __uint_as_float(gw[e] << 16), gb = __uint_as_float(gw[e] & 0xffff0000u);
                        const float ya = ov[2 * e] * rstd * wv[2 * e] * (ga * __builtin_amdgcn_rcpf(1.0f + __expf(-ga)));
                        const float yb = ov[2 * e + 1] * rstd * wv[2 * e + 1] * (gb * __builtin_amdgcn_rcpf(1.0f + __expf(-gb)));
                        ow[e] = pk(ya, yb); }
                    if (store == 1) { *(u32x4*)yp = (u32x4){ow[0], ow[1], ow[2], ow[3]}; *(u32x4*)(yp + 8) = (u32x4){ow[4], ow[5], ow[6], ow[7]}; }
                }
                if (k >= 1 && k - 1 < nch) { int ot_g = ot; asm volatile("" : "+v"(ot_g)); const bf16* gp = gbase + (size_t)((k - 1) * CH + ot_g) * LDG + opart * 16; gn0 = *(const u32x4*)gp; gn1 = *(const u32x4*)(gp + 8); }
                HG2_BAR_T(1);
            }
            __builtin_amdgcn_s_setprio(0);
            if (mode == 1) {
                float* E = Eg + (size_t)(u0 - slot) * 16384; int cf = c, hf = h; asm volatile("" : "+v"(cf), "+v"(hf));
#pragma unroll
                for (int i = 0; i < 4; ++i)
#pragma unroll
                    for (int r = 0; r < 16; ++r) E[(size_t)(32 * i + crow(r, hf)) * 128 + 32 * j + cf] = S[i][r];
            }
        }
#if PROBE_STAMP == 11 || PROBE_STAMP == 12
        if (lane == 0 && ridx == 0 && builder == (PROBE_STAMP == 11)) { volatile LAS unsigned long long* st_ = (volatile LAS unsigned long long*)(lds + 139264 + 256); st_[1] += (unsigned long long)hw_acc; }
#endif
    }
}
}
#define GAS __attribute__((address_space(1)))
constexpr int NWAVES = 8;
constexpr int RING_OFF = 0, RING_BYTES = 131072;
constexpr int XCH_OFF = 131072;
constexpr int MISC_OFF = 139264;
constexpr int LDS_BYTES = 147456;
constexpr int CW_Q = 2048;
constexpr int CW_BAR = 4096;
constexpr int N_PHASES = 25;
static_assert(pg8::STAGE_BYTES == RING_BYTES && XCH_OFF == RING_BYTES, "LDS map");
static_assert((CW_BAR + 3456) * 4 <= (int)CTL_ZERO_BYTES, "barrier words inside the memset region");

struct Params { const float* in[15]; float* out; unsigned char* ws; int ph_lo, ph_hi, bar_region, pad; };

#define LDS_WAIT() asm volatile("s_waitcnt lgkmcnt(0)" ::: "memory")
#define VM_WAIT() asm volatile("s_waitcnt vmcnt(0)" ::: "memory")

__device__ __forceinline__ void p0_conv_item(const float* __restrict__ W, const float* __restrict__ gain, int K, int N, bf16* __restrict__ WT, int upperm, LAS float* scr, int item, int lane) {
    const int nblk = N / 64, kb = item / nblk, nb = item % nblk, k0 = 64 * kb, n0 = 64 * nb;
    int src0 = n0;
    if (upperm == 1) { const int pn = n0 >> 8, r = n0 & 255, bj = r >> 7, c = r & 127; src0 = bj * 3072 + 128 * pn + c; }
    if (upperm == 2) { const int pn = n0 >> 8, type = pn >> 2; if (type < 2) src0 = type * 1024 + (2 * (pn & 3) + ((n0 >> 6) & 1)) * 128 + 64 * ((n0 >> 7) & 1); }
    const int kr = lane >> 4, n4 = (lane & 15) * 4;
    f32x4 v[16];
#pragma unroll
    for (int i = 0; i < 16; ++i) v[i] = *(const f32x4*)(W + (size_t)(k0 + 4 * i + kr) * N + src0 + n4);
#pragma unroll
    for (int i = 0; i < 16; ++i) { const int k = 4 * i + kr; const float gsc = gain ? gain[k0 + k] : 1.0f;
#pragma unroll
        for (int e = 0; e < 4; ++e) scr[(n4 + e) * 65 + k] = v[i][e] * gsc; }
    LDS_WAIT(); asm volatile("" ::: "memory");
    const int c = lane & 7;
#pragma unroll
    for (int j = 0; j < 8; ++j) { const int n = (lane >> 3) + 8 * j; const LAS float* s = scr + n * 65 + 8 * c;
        u32x4 o; o.x = f2bf(s[0]) | ((unsigned)f2bf(s[1]) << 16); o.y = f2bf(s[2]) | ((unsigned)f2bf(s[3]) << 16);
        o.z = f2bf(s[4]) | ((unsigned)f2bf(s[5]) << 16); o.w = f2bf(s[6]) | ((unsigned)f2bf(s[7]) << 16);
        *(u32x4*)(WT + (size_t)(n0 + n) * K + k0 + 8 * c) = o; }
    LDS_WAIT(); asm volatile("" ::: "memory");
}
__device__ __forceinline__ void p0_prologue(const Params& p, LAS unsigned char* lds, int gw, int NGW, int lane, int wave) {
    unsigned char* ws = p.ws;
    LAS float* scr = (LAS float*)(lds + RING_OFF + wave * 16640);
    const float* attn_norm = p.in[1]; const float* ffn_norm = p.in[2];
    constexpr int I_IN = 16 * 64, I_QKV = 16 * 48, I_O = 16 * 16, I_UP = 16 * 96, I_DN = 48 * 16;
    constexpr int NITEMS = 2 * I_IN + 2 * I_QKV + 4 * I_O + 4 * I_UP + 4 * I_DN;
    for (int it = gw; it < NITEMS; it += NGW) {
        int r = it;
        if (r < 2 * I_IN) { const int s = r / I_IN; p0_conv_item(p.in[3] + (size_t)s * 1024 * 4096, attn_norm + (2 * s) * 1024, 1024, 4096, (bf16*)(ws + WS_WIN) + (size_t)s * 4096 * 1024, 0, scr, r % I_IN, lane); continue; } r -= 2 * I_IN;
        if (r < 2 * I_QKV) { const int s = r / I_QKV; p0_conv_item(p.in[7] + (size_t)s * 1024 * 3072, attn_norm + (2 * s + 1) * 1024, 1024, 3072, (bf16*)(ws + WS_WQKV) + (size_t)s * 3072 * 1024, 2, scr, r % I_QKV, lane); continue; } r -= 2 * I_QKV;
        if (r < 2 * I_O) { const int s = r / I_O; p0_conv_item(p.in[6] + (size_t)s * 1024 * 1024, nullptr, 1024, 1024, (bf16*)(ws + WS_WOH) + (size_t)s * 1024 * 1024, 0, scr, r % I_O, lane); continue; } r -= 2 * I_O;
        if (r < 2 * I_O) { const int s = r / I_O; p0_conv_item(p.in[10] + (size_t)s * 1024 * 1024, nullptr, 1024, 1024, (bf16*)(ws + WS_WOM) + (size_t)s * 1024 * 1024, 0, scr, r % I_O, lane); continue; } r -= 2 * I_O;
        if (r < 4 * I_UP) { const int l = r / I_UP; p0_conv_item(p.in[11] + (size_t)l * 1024 * 6144, ffn_norm + l * 1024, 1024, 6144, (bf16*)(ws + WS_WUP) + (size_t)l * 6144 * 1024, 1, scr, r % I_UP, lane); continue; } r -= 4 * I_UP;
        { const int l = r / I_DN; p0_conv_item(p.in[14] + (size_t)l * 3072 * 1024, nullptr, 3072, 1024, (bf16*)(ws + WS_WDN) + (size_t)l * 1024 * 3072, 0, scr, r % I_DN, lane); }
    }
    const float* x = p.in[0]; bf16* xb = (bf16*)(ws + WS_XB); float* ss = (float*)(ws + WS_SS);
    for (int row0 = gw * 4; row0 < MROWS; row0 += NGW * 4) {
        f32x4 v[4][4];
#pragma unroll
        for (int r = 0; r < 4; ++r)
#pragma unroll
            for (int j = 0; j < 4; ++j) v[r][j] = ((const f32x4*)(x + (size_t)(row0 + r) * DM))[lane + 64 * j];
        float s4[4];
#pragma unroll
        for (int r = 0; r < 4; ++r) { float s = 0.f;
#pragma unroll
            for (int j = 0; j < 4; ++j) { const f32x4 t = v[r][j]; s += (t[0] * t[0] + t[1] * t[1]) + (t[2] * t[2] + t[3] * t[3]);
                unsigned long long w = (unsigned long long)(f2bf(t[0]) | ((unsigned)f2bf(t[1]) << 16)) | ((unsigned long long)(f2bf(t[2]) | ((unsigned)f2bf(t[3]) << 16)) << 32);
                *(unsigned long long*)(xb + (size_t)(row0 + r) * DM + 4 * (lane + 64 * j)) = w; }
            s4[r] = wave_sum(s); }
        { const int slot = lane >> 2, rr = lane & 3; const float sv = rr == 0 ? s4[0] : rr == 1 ? s4[1] : rr == 2 ? s4[2] : s4[3];
          ss[(size_t)slot * MROWS + row0 + rr] = slot == 0 ? sv : 0.f; }
    }
    float* lbv = (float*)(ws + WS_LBV); const float* hgrn_lb = p.in[4];
    if (gw == 0) ((float*)(ws + WS_INVF))[lane] = 1.0f / powf(10000.0f, (float)(2 * lane) / 128.0f);
    for (int idx = gw * 64 + lane; idx < 1024; idx += NGW * 64) { const float l0 = hgrn_lb[idx], l1 = hgrn_lb[1024 + idx]; const float mx = fmaxf(l0, l1), e0 = expf(l0 - mx), e1 = expf(l1 - mx); lbv[idx] = 0.f; lbv[1024 + idx] = e1 / (e0 + e1); }
}

__device__ __forceinline__ void kprep_phase(const bf16* qkv, bf16* qdst, bf16* kdst, int ldd, const float* __restrict__ qg, const float* __restrict__ kg, const float* __restrict__ cs, const float* __restrict__ sn, float* __restrict__ kmean,
                                            LAS unsigned char* lds, int lane, int wave) {
    const int tidk = wave * 64 + lane, rg = lane >> 4, cch = lane & 15;
    LAS float* red = (LAS float*)(lds + RING_OFF);
    for (int u = blockIdx.x; u < 2 * BATCH * NH * NBLK; u += gridDim.x) {
        const int which = u & 1, j = (u >> 1) & 15, h = (u >> 5) & 7, b = u >> 8;
        const float* g = which ? kg : qg; const f32x4 ga = *(const f32x4*)(g + 8 * cch), gb = *(const f32x4*)(g + 8 * cch + 4);
        const float gn[8] = {ga[0], ga[1], ga[2], ga[3], gb[0], gb[1], gb[2], gb[3]};
        const int pos0 = j * MBLK + wave * 32 + rg;
        const bf16* src = qkv + (size_t)(b * SEQ + pos0) * 3072 + which * 1024 + h * 128 + 8 * cch;
        bf16* dst = (which ? kdst : qdst) + (size_t)(b * SEQ + pos0) * ldd + h * 128 + 8 * cch;
        u32x4 raw[8];
#pragma unroll
        for (int it = 0; it < 8; ++it) raw[it] = *(const u32x4*)(src + (size_t)(4 * it) * 3072);
        float acc[8];
#pragma unroll
        for (int e = 0; e < 8; ++e) acc[e] = 0.f;
#pragma unroll
        for (int it = 0; it < 8; ++it) {
            const unsigned w[4] = {raw[it].x, raw[it].y, raw[it].z, raw[it].w};
            float x[8];
#pragma unroll
            for (int e = 0; e < 4; ++e) { x[2 * e] = __uint_as_float(w[e] << 16); x[2 * e + 1] = __uint_as_float(w[e] & 0xffff0000u); }
            float ss = 0.f;
#pragma unroll
            for (int e = 0; e < 8; ++e) ss += x[e] * x[e];
            ss += __shfl_xor(ss, 1); ss += __shfl_xor(ss, 2); ss += __shfl_xor(ss, 4); ss += __shfl_xor(ss, 8);
            const float r = rsqrtf(ss * (1.0f / 128.0f) + 1e-6f);
            const int pos = pos0 + 4 * it;
            const f32x4 c0 = *(const f32x4*)(cs + pos * 64 + 8 * (cch & 7)), c1 = *(const f32x4*)(cs + pos * 64 + 8 * (cch & 7) + 4);
            const f32x4 s0 = *(const f32x4*)(sn + pos * 64 + 8 * (cch & 7)), s1 = *(const f32x4*)(sn + pos * 64 + 8 * (cch & 7) + 4);
            const float cv[8] = {c0[0], c0[1], c0[2], c0[3], c1[0], c1[1], c1[2], c1[3]}, sv[8] = {s0[0], s0[1], s0[2], s0[3], s1[0], s1[1], s1[2], s1[3]};
            float o[8];
#pragma unroll
            for (int e = 0; e < 8; ++e) { const float y = x[e] * r * gn[e]; const float py = __shfl_xor(y, 8);
                float v = cch < 8 ? y * cv[e] - py * sv[e] : y * cv[e] + py * sv[e];
                if (!which) v *= QSCALE;
                o[e] = v; acc[e] += v; }
            u32x4 ow; ow.x = f2bf(o[0]) | ((unsigned)f2bf(o[1]) << 16); ow.y = f2bf(o[2]) | ((unsigned)f2bf(o[3]) << 16); ow.z = f2bf(o[4]) | ((unsigned)f2bf(o[5]) << 16); ow.w = f2bf(o[6]) | ((unsigned)f2bf(o[7]) << 16);
            *(u32x4*)(dst + (size_t)(4 * it) * ldd) = ow;
        }
        if (which) {
#pragma unroll
            for (int e = 0; e < 8; ++e) { acc[e] += __shfl_xor(acc[e], 16); acc[e] += __shfl_xor(acc[e], 32); }
            if (rg == 0) {
#pragma unroll
                for (int e = 0; e < 8; ++e) red[wave * 128 + 8 * cch + e] = acc[e]; }
            __syncthreads();
            if (tidk < 128) { float s = 0.f;
#pragma unroll
                for (int w = 0; w < 8; ++w) s += red[w * 128 + tidk];
                kmean[((size_t)(b * 8 + h) * 16 + j) * 128 + tidk] = s * (1.0f / 256.0f); }
            __syncthreads();
        }
    }
}

__device__ __forceinline__ void hg_naive_phase(bf16* __restrict__ big, const float* __restrict__ lbv, const float* __restrict__ og, LAS unsigned char* lds, const int tid) {
    LAS float* sq = (LAS float*)(lds + RING_OFF); LAS float* sf = sq + 128; LAS float* sk = sq + 256; LAS float* red = sq + 384;
    for (int u = blockIdx.x; u < BATCH * NH; u += gridDim.x) {
        const int b = u >> 3, h = u & 7;
        float S[128];
#pragma unroll
        for (int d = 0; d < 128; ++d) S[d] = 0.f;
        const float lb = tid < 128 ? lbv[h * 128 + tid] : 0.f, gain = tid < 128 ? og[tid] : 0.f;
        for (int t = 0; t < SEQ; ++t) {
            bf16* r = big + (size_t)(b * SEQ + t) * 4096 + h * 128 + (tid & 127);
            float q = 0.f, vv = 0.f, gg = 0.f;
            if (tid < 128) { q = bf2f(r[0]) * QSCALE; const float z = bf2f(r[1024]); vv = bf2f(r[2048]); gg = bf2f(r[3072]);
                const float sg = 1.0f / (1.0f + expf(-z)); const float f = lb + (1.0f - lb) * sg; const float k = (1.0f - lb) * (1.0f - sg);
                sq[tid] = q; sf[tid] = f; sk[tid] = k; }
            __syncthreads();
            float o = 0.f;
            if (tid < 128) {
#pragma unroll
                for (int d = 0; d < 128; ++d) { S[d] = sf[d] * S[d] + sk[d] * vv; o += sq[d] * S[d]; }
                const float w = wave_sum(o * o);
                if ((tid & 63) == 0) red[tid >> 6] = w; }
            __syncthreads();
            if (tid < 128) { const float tot = red[0] + red[1];
                const float on = o * rsqrtf(tot * (1.0f / 128.0f) + 1e-6f) * gain;
                r[3072] = f2bf(on * (gg / (1.0f + expf(-gg)))); }
        }
    }
}
__device__ __forceinline__ void attn_naive_phase(bf16* __restrict__ qkv, const float* __restrict__ kmean, LAS unsigned char* lds, int lane, int wave) {
    LAS float* sq = (LAS float*)(lds + RING_OFF) + wave * 128;
    LAS float* sp = (LAS float*)(lds + RING_OFF + 4096) + wave * 1024;
    for (long it0 = (long)blockIdx.x * 8; it0 < (long)MROWS * 8; it0 += (long)gridDim.x * 8) {
        const long item = it0 + wave; const int h = (int)(item & 7); const long row = item >> 3; const int b = (int)(row >> 12), s = (int)(row & (SEQ - 1)), i = s >> 8;
        bf16* qp = qkv + row * 3072 + h * 128;
        __syncthreads();
        sq[lane] = bf2f(qp[lane]); sq[lane + 64] = bf2f(qp[lane + 64]);
        __syncthreads();
        float gv = -INFINITY;
        if (lane < i) { const float* km = kmean + ((size_t)(b * 8 + h) * 16 + lane) * 128; float a = 0.f; for (int d = 0; d < 128; ++d) a += km[d] * sq[d]; gv = a; }
        const int nsel = i < 3 ? i : 3; int s0 = i, s1 = i, s2 = i;
#pragma unroll
        for (int n = 0; n < 3; ++n) {
            if (n < nsel) { const float m = wave_max(gv); const unsigned long long bal = __ballot(gv == m); const int idx = __ffsll((long long)bal) - 1; if (n == 0) s0 = idx; else if (n == 1) s1 = idx; else s2 = idx; if (lane == idx) gv = -INFINITY; } }
#define PICKB(bi) ((bi) == 0 ? s0 : (bi) == 1 ? s1 : (bi) == 2 ? s2 : i)
        float mx = -INFINITY;
        for (int bi = 0; bi <= nsel; ++bi) { const int kb = PICKB(bi) * MBLK;
            for (int c = 0; c < 4; ++c) { const int key = kb + c * 64 + lane;
                const bf16* kp = qkv + (size_t)(b * SEQ + key) * 3072 + 1024 + h * 128; float a = 0.f;
                for (int d8 = 0; d8 < 16; ++d8) { const u32x4 w = *(const u32x4*)(kp + d8 * 8);
                    const unsigned ww[4] = {w.x, w.y, w.z, w.w};
#pragma unroll
                    for (int e = 0; e < 4; ++e) { a += __uint_as_float(ww[e] << 16) * sq[d8 * 8 + 2 * e]; a += __uint_as_float(ww[e] & 0xffff0000u) * sq[d8 * 8 + 2 * e + 1]; } }
                if (bi == nsel && key > s) a = -INFINITY;
                sp[bi * 256 + c * 64 + lane] = a; mx = fmaxf(mx, a); } }
        mx = wave_max(mx);
        float l = 0.f;
        for (int e = lane; e < (nsel + 1) * 256; e += 64) { const float pr = __expf(sp[e] - mx); sp[e] = pr; l += pr; }
        l = wave_sum(l);
        __syncthreads();
        float o0 = 0.f, o1 = 0.f;
        for (int bi = 0; bi <= nsel; ++bi) { const bf16* vp = qkv + (size_t)(b * SEQ + PICKB(bi) * MBLK) * 3072 + 2048 + h * 128 + lane;
            for (int kk = 0; kk < 256; ++kk) { const float pr = sp[bi * 256 + kk]; o0 += pr * bf2f(vp[(size_t)kk * 3072]); o1 += pr * bf2f(vp[(size_t)kk * 3072 + 64]); } }
#undef PICKB
        const float il = 1.0f / l;
        qp[lane] = f2bf(o0 * il); qp[lane + 64] = f2bf(o1 * il);
    }
}

#ifndef HG_PIPE
#define HG_PIPE 1
#endif
#if HG_PIPE
#define HGNS hg2
#else
#define HGNS hg
#endif
#ifndef PROBE_BMODE
#define PROBE_BMODE 0
#endif
#ifndef LOCAL_SEAMS
#define LOCAL_SEAMS 1
#endif
#ifndef PROBE_STAMP
#define PROBE_STAMP 0
#endif
#ifndef STAMP_SEL
#define STAMP_SEL 0
#endif
#ifndef STAMP_LAYERS
#define STAMP_LAYERS 15
#endif
#ifndef STAMP_WG
#define STAMP_WG -1
#endif
#ifndef STAMP_AMP
#define STAMP_AMP 8
#endif
#ifndef STAGGER_TICKS
#define STAGGER_TICKS 0
#endif
__device__ __forceinline__ void phase_stagger() {
    if (STAGGER_TICKS > 0) { const unsigned q = (blockIdx.x >> 3) & 3u; const unsigned long long t0 = __builtin_amdgcn_s_memrealtime();
        while (__builtin_amdgcn_s_memrealtime() - t0 < (unsigned long long)(q * STAGGER_TICKS)) __builtin_amdgcn_s_sleep(8); }
}
__global__ void __launch_bounds__(NWAVES * 64, 2) mega_fwd(Params p) {
    extern __shared__ __attribute__((aligned(16))) unsigned char lds_raw[];
    LAS unsigned char* lds = (LAS unsigned char*)lds_raw;
    const int G = gridDim.x;
    unsigned char* ws = p.ws;
    for (int u = threadIdx.x; u < (LDS_BYTES - MISC_OFF) / 4; u += NWAVES * 64) ((LAS unsigned*)(lds + MISC_OFF))[u] = 0u;
    __syncthreads();
    if ((threadIdx.x & 63) == 0) *(volatile LAS unsigned*)(WG_TAB_ADDR + 4u * wg_slot()) = threadIdx.x >> 6;
    __syncthreads();
#define PHASE_IDS() int tid = wg_tid(); asm volatile("" : "+v"(tid)); const int lane = tid & 63, wave = __builtin_amdgcn_readfirstlane(tid >> 6); (void)lane; (void)wave
    const int lo = p.ph_lo, hi = p.ph_hi;
    XcdBarrier bar; bar.bar = (unsigned*)(ws + WS_CTL) + CW_BAR + p.bar_region * XCD_BAR_WORDS; bar.x = 0; bar.st = nullptr;
    if (hi - lo > 1) lb_post((unsigned*)(ws + WS_CTL));
    if (hi - lo > 1) bar = xcd_barrier_post((unsigned*)(ws + WS_CTL) + CW_BAR + p.bar_region * XCD_BAR_WORDS, (volatile LAS unsigned*)(lds + MISC_OFF));
#define IN(k) (lo <= (k) && (k) < hi)
#if PROBE_STAMP
#define STAMP_ST() ((volatile LAS unsigned long long*)(lds + MISC_OFF + 256))
#define STAMP_ARRIVE(k) do { if (wg_tid() == 0) { const unsigned long long now_ = __builtin_amdgcn_s_memrealtime(); volatile LAS unsigned long long* st_ = STAMP_ST(); const int ty_ = (k) == 0 ? 6 : ((k) - 1) % 6, ly_ = (k) == 0 ? 0 : ((k) - 1) / 6; \
        if (PROBE_STAMP == 2 && ty_ == STAMP_SEL && ((STAMP_LAYERS >> ly_) & 1)) st_[1] += now_ - st_[0]; if (PROBE_STAMP == 10 && ty_ == STAMP_SEL && ((STAMP_LAYERS >> ly_) & 1)) st_[1] += (__builtin_amdgcn_s_memtime() - st_[6]) >> 4; st_[2] = now_; } } while (0)
#define STAMP_EXIT(k) do { if (wg_tid() == 0) { const unsigned long long now_ = __builtin_amdgcn_s_memrealtime(); volatile LAS unsigned long long* st_ = STAMP_ST(); const int ty_ = (k) == 0 ? 6 : ((k) - 1) % 6, ly_ = (k) == 0 ? 0 : ((k) - 1) / 6; if (PROBE_STAMP == 1 || (PROBE_STAMP == 3 && ty_ == STAMP_SEL && ((STAMP_LAYERS >> ly_) & 1))) st_[1] += now_ - st_[2]; st_[0] = now_; if (PROBE_STAMP == 10) st_[6] = __builtin_amdgcn_s_memtime(); } } while (0)
#else
#define STAMP_ARRIVE(k) do { } while (0)
#define STAMP_EXIT(k) do { } while (0)
#endif
#if PROBE_STAMP == 4 || PROBE_STAMP == 5 || PROBE_STAMP == 6
#define STAMP_GEMM(ty, ly) do { int t_ = wg_tid(); asm volatile("" : "+v"(t_)); if (t_ == 0) { int f_ = ((ty) == STAMP_SEL && ((STAMP_LAYERS >> (ly)) & 1)) ? 1 : 0; asm volatile("" : "+s"(f_)); ((volatile LAS unsigned*)STAMP_ST())[6] = (unsigned)f_; if (PROBE_STAMP == 6 && f_) { volatile LAS unsigned long long* st_ = STAMP_ST(); st_[1] += __builtin_amdgcn_s_memrealtime() - st_[0]; } } __syncthreads(); } while (0)
#else
#define STAMP_GEMM(ty, ly) do { } while (0)
#endif
#define LSEAM_(k, SUB_, NB_, HD_) do { if (IN(k) && IN((k) + 1)) { STAMP_ARRIVE(k); if (LOCAL_SEAMS) { const __attribute__((address_space(4))) Params* pq_ = (const __attribute__((address_space(4))) Params*)__builtin_amdgcn_kernarg_segment_ptr(); asm volatile("" : "+s"(pq_)); local_or_grid_barrier<SUB_, NB_, HD_>(bar, (unsigned*)(pq_->ws + WS_CTL), (volatile LAS unsigned*)(lds + MISC_OFF + 64)); if (PROBE_DUP & 2048) local_or_grid_barrier<SUB_, NB_, HD_>(bar, (unsigned*)(pq_->ws + WS_CTL), (volatile LAS unsigned*)(lds + MISC_OFF + 64)); } else xcd_barrier(bar); STAMP_EXIT(k); } } while (0)
#define LSEAM(k) LSEAM_(k, false, false, false)
#define HSEAM(k) LSEAM_(k, true, false, true)
#define NSEAM(k) LSEAM_(k, true, true, false)
#define SSEAM(k) LSEAM_(k, true, false, false)
#define SEAM(k) do { if (IN(k) && IN((k) + 1)) { STAMP_ARRIVE(k); xcd_barrier(bar); if (PROBE_DUP & 1024) xcd_barrier(bar); STAMP_EXIT(k); } } while (0)
#define PHASE_ENV() PHASE_IDS(); const __attribute__((address_space(4))) Params* pp = (const __attribute__((address_space(4))) Params*)__builtin_amdgcn_kernarg_segment_ptr(); asm volatile("" : "+s"(pp)); \
    unsigned char* ws = pp->ws; float* out = pp->out; bf16* XB = (bf16*)(ws + WS_XB); bf16* BIG = (bf16*)(ws + WS_BIG); float* SS = (float*)(ws + WS_SS); \
    const float* COS = (const float*)(ws + WS_COS); const float* SIN = (const float*)(ws + WS_SIN); const float* LBV = (const float*)(ws + WS_LBV); float* KMEAN = (float*)(ws + WS_KMEAN); \
    float* TAIL = (float*)(ws + WS_TAIL); float* HEADA = (float*)(ws + WS_HEADA); float* HEADU = (float*)(ws + WS_HEADU); \
    (void)out; (void)XB; (void)BIG; (void)SS; (void)COS; (void)SIN; (void)LBV; (void)KMEAN; (void)TAIL; (void)HEADA; (void)HEADU

#if PROBE_STAMP
    if (wg_tid() == 0) STAMP_ST()[0] = __builtin_amdgcn_s_memrealtime();
#endif
    if (IN(0)) {
#pragma unroll 1
        for (int rep = (PROBE_DUP & 8) ? 0 : 1; rep < 2; ++rep) { PHASE_IDS(); p0_prologue(p, lds, blockIdx.x * NWAVES + wave, G * NWAVES, lane, wave); __syncthreads(); }
    }
    SEAM(0);
    if (LOCAL_SEAMS && hi - lo > 1 && IN(0) && IN(1)) lb_decide((unsigned*)(ws + WS_CTL), (volatile LAS unsigned*)(lds + MISC_OFF + 64));
    for (int l = 0; l < DEPTH; ++l) {
        const int pb = 1 + 6 * l, slot = l >> 1; const bool moba = (l & 1) != 0;
        if (IN(pb)) { PHASE_ENV();
            if (moba) {
                pg8::Gemm g{XB, (const bf16*)(ws + WS_WQKV) + (size_t)slot * 3072 * 1024, MROWS, 3072, 1024, 1024}; pg8::StaticOrder S; S.init(MROWS, 3072, G, (int)blockIdx.x);
                pg8::EpiQKV E{BIG, SS, pp->in[8] + slot * 128, pp->in[9] + slot * 128, (const float*)(ws + WS_INVF), KMEAN, 0, 0, pg8::rstd_tab_build(lds + RING_OFF, S, SS, tid)};
STAMP_GEMM(0, l);
#pragma unroll 1
                for (int rep = (PROBE_DUP & 65536) ? 0 : 1; rep < 2; ++rep) { E.dry = rep ? 0 : PROBE_BMODE; pg8::gemm_phase<pg8::EpiQKV, pg8::StaticOrder, true, true>(lds + RING_OFF, g, S, E); __syncthreads(); }
            } else {
                pg8::Gemm g{XB, (const bf16*)(ws + WS_WIN) + (size_t)slot * 4096 * 1024, MROWS, 4096, 1024, 1024}; pg8::StaticOrder S; S.init(MROWS, 4096, G, (int)blockIdx.x);
                pg8::EpiRowScale E{BIG, SS, 0, 0, pg8::rstd_tab_build(lds + RING_OFF, S, SS, tid)};
STAMP_GEMM(0, l);
#pragma unroll 1
                for (int rep = (PROBE_DUP & 1) ? 0 : 1; rep < 2; ++rep) { E.pad = ((PROBE_DUP & 128) && rep == 0) ? (PROBE_BMODE ? PROBE_BMODE : 1) : 0; pg8::gemm_phase<pg8::EpiRowScale, pg8::StaticOrder, true, true>(lds + RING_OFF, g, S, E); __syncthreads(); }
            }
        }
        LSEAM(pb);
        if (moba) {
#if MOBA_SPARSE
            if (IN(pb + 1)) { PHASE_ENV();
#pragma unroll 1
                for (int rep = (PROBE_DUP & 16384) ? 0 : 1; rep < 2; ++rep) { mb::sel_phase(BIG, KMEAN, (unsigned short*)(ws + WS_HGE), (unsigned*)(ws + WS_HGE + 8 * MiB), (char*)lds_raw, tid); __syncthreads(); } }
            LSEAM(pb + 1);
            if (IN(pb + 2)) { PHASE_ENV();
                mb::Partials PP; PP.P[0] = (bf16*)out; PP.P[1] = (bf16*)out + (size_t)BATCH * NH * SEQ * 128; PP.P[2] = (bf16*)(ws + WS_AU); PP.ML = (float*)(ws + WS_ML);
#pragma unroll 1
                for (int rep = (PROBE_DUP & 32768) ? 0 : 1; rep < 2; ++rep) {
                    mb::past_phase(BIG, (const unsigned short*)(ws + WS_HGE), (const unsigned*)(ws + WS_HGE + 8 * MiB), PP, (unsigned*)(ws + WS_CTL) + CW_Q + 64 * l + 32 * rep, (char*)lds_raw, tid); __syncthreads(); }
                xcd_barrier(bar);
                mb::attn_phase(BIG, KMEAN, BIG, 3072, PP, (char*)lds_raw, tid); }
#else
            if (IN(pb + 2)) { PHASE_ENV(); if (MOBA_PP) mb::attn_phase_pp(BIG, KMEAN, BIG + (size_t)3 * MROWS * 1024, 1024, (char*)lds_raw, tid); else { mb::Partials PP{}; mb::attn_phase(BIG, KMEAN, BIG + (size_t)3 * MROWS * 1024, 1024, PP, (char*)lds_raw, tid, pp->in[8] + slot * 128, pp->in[9] + slot * 128); } }
#endif
            LSEAM(pb + 2);
        } else {
#if defined(NAIVE_HG)
            LSEAM(pb + 1);
            if (IN(pb + 2)) { PHASE_ENV(); hg_naive_phase(BIG, LBV + slot * 1024, pp->in[5] + slot * 128, lds, tid); }
#elif !defined(NO_HG)
            if (IN(pb + 1)) { PHASE_ENV();
#pragma unroll 1
                for (int rep = (PROBE_DUP & 4) ? 0 : 1; rep < 2; ++rep) { HGNS::pass_a(BIG, LBV + slot * 1024, (float*)(ws + WS_HGE), (float*)(ws + WS_HGD), lds, lane, wave); __syncthreads(); }
                HGNS::pass_b(BIG, BIG + (size_t)3 * MROWS * 1024, 1024, 1, LBV + slot * 1024, pp->in[5] + slot * 128, (float*)(ws + WS_HGE), (float*)(ws + WS_HGD), lds, lane, wave, 1); __syncthreads(); }
            HSEAM(pb + 1);
            if (IN(pb + 2)) { PHASE_ENV();
#pragma unroll 1
                for (int rep = (PROBE_DUP & 32) ? 0 : 1; rep < 2; ++rep) {
                    HGNS::pass_b(BIG, BIG + (size_t)3 * MROWS * 1024, 1024, rep ? 1 : PROBE_BMODE, LBV + slot * 1024, pp->in[5] + slot * 128, (float*)(ws + WS_HGE), (float*)(ws + WS_HGD), lds, lane, wave); __syncthreads(); } }
#endif
            LSEAM(pb + 2);
        }
        if (IN(pb + 3)) { PHASE_ENV();
            const bf16* A = BIG + (size_t)3 * MROWS * 1024; const int lda = 1024;
            const bf16* Bt = moba ? (const bf16*)(ws + WS_WOM) + (size_t)slot * 1024 * 1024 : (const bf16*)(ws + WS_WOH) + (size_t)slot * 1024 * 1024;
            pg8::Gemm g{A, Bt, MROWS, 1024, 1024, lda}; pg8::StaticOrder S; S.init(MROWS, 1024, G, (int)blockIdx.x);
            pg8::EpiResid<0> E{l == 0 ? pp->in[0] : nullptr, nullptr, XB, SS, XB, SS, 0, 0};
STAMP_GEMM(3, l);
#pragma unroll 1
            for (int rep = (PROBE_DUP & (256 | 4096)) ? 0 : 1; rep < 2; ++rep) { E.dry = (rep == 0) && !((PROBE_DUP & 4096) && moba); if ((PROBE_DUP & 4096) && moba) { E.xbw = (rep || PROBE_BMODE >= 5) ? XB : (bf16*)(ws + WS_AU); E.ssw = (rep || PROBE_BMODE >= 5) ? SS : (float*)(ws + WS_END); E.dry = rep ? 0 : PROBE_BMODE; } pg8::gemm_phase<pg8::EpiResid<0>, pg8::StaticOrder, true, true>(lds + RING_OFF, g, S, E); __syncthreads(); }
        }
        SSEAM(pb + 3);
#ifndef NO_GLU
        if (IN(pb + 4)) { PHASE_ENV();
            const float* cw = pp->in[12] + (size_t)l * 3 * FF; const float* cb = pp->in[13] + (size_t)l * FF;
            pg8::Gemm g{XB, (const bf16*)(ws + WS_WUP) + (size_t)l * 6144 * 1024, MROWS, 6144, 1024, 1024}; pg8::StaticOrder S; S.init(MROWS, 6144, G, (int)blockIdx.x);
            pg8::EpiGLU E{BIG, SS, cw, cb, TAIL, HEADA, HEADU, 0, 0, pg8::rstd_tab_build(lds + RING_OFF, S, SS, tid)}; phase_stagger();
STAMP_GEMM(4, l);
#pragma unroll 1
            for (int rep = (PROBE_DUP & 2) ? 0 : 1; rep < 2; ++rep) { E.dry = rep ? 0 : PROBE_BMODE; E.G = (rep == 0 && PROBE_BMODE == 4) ? (bf16*)(ws + WS_END) : BIG; pg8::gemm_phase<pg8::EpiGLU, pg8::StaticOrder, true, true>(lds + RING_OFF, g, S, E); __syncthreads(); }
        }
#endif
        NSEAM(pb + 4);
        if (IN(pb + 5)) { PHASE_ENV();
            const float* cw = pp->in[12] + (size_t)l * 3 * FF; const float* cb = pp->in[13] + (size_t)l * FF;
            pg8::Gemm g{BIG, (const bf16*)(ws + WS_WDN) + (size_t)l * 1024 * 3072, MROWS, 1024, 3072, 3072}; pg8::StaticOrder S; S.init(MROWS, 1024, G, (int)blockIdx.x);
            pg8::Unit u; int pm_done = -1;
            for (int i = 0; S.next(i, u); ++i) {
                if (u.pm == pm_done) continue;
                pm_done = u.pm;
                const bool first = (u.pm & 15) == 0;
                const int qa = tid, qb = tid + NWAVES * 64 < FF / 4 ? tid + NWAVES * 64 : FF / 4 - 1;
                const f32x4 z4 = (f32x4){0.f, 0.f, 0.f, 0.f};
#define FX_LOAD(S_, q_) const size_t hb##S_ = (size_t)u.pm * 2 * FF + 4 * (q_), tb##S_ = (size_t)(u.pm - (first ? 0 : 1)) * 2 * FF + 4 * (q_); \
                const f32x4 A0##S_ = *(const f32x4*)(HEADA + hb##S_), A1##S_ = *(const f32x4*)(HEADA + hb##S_ + FF), U0##S_ = *(const f32x4*)(HEADU + hb##S_), U1##S_ = *(const f32x4*)(HEADU + hb##S_ + FF), \
                            L0##S_ = *(const f32x4*)(TAIL + tb##S_), L1##S_ = *(const f32x4*)(TAIL + tb##S_ + FF), \
                            W0##S_ = *(const f32x4*)(cw + 4 * (q_)), W1##S_ = *(const f32x4*)(cw + FF + 4 * (q_)), W2##S_ = *(const f32x4*)(cw + 2 * FF + 4 * (q_)), Bb##S_ = *(const f32x4*)(cb + 4 * (q_))
#define FX_STORE(S_, q_) do { const f32x4 T0 = first ? z4 : L0##S_, T1 = first ? z4 : L1##S_; unsigned r0[4], r1[4]; \
                    _Pragma("unroll") for (int j = 0; j < 4; ++j) {              \
                        const float c0 = W0##S_[j] * T0[j] + W1##S_[j] * T1[j] + W2##S_[j] * A0##S_[j] + Bb##S_[j]; \
                        const float c1 = W0##S_[j] * T1[j] + W1##S_[j] * A0##S_[j] + W2##S_[j] * A1##S_[j] + Bb##S_[j]; \
                        r0[j] = f2bf(c0 / (1.0f + __expf(-c0)) * (U0##S_[j] * -1.4426950408889634f)); r1[j] = f2bf(c1 / (1.0f + __expf(-c1)) * (U1##S_[j] * -1.4426950408889634f)); }   \
                    typedef unsigned u32x2_t __attribute__((ext_vector_type(2))); \
                    *(u32x2_t*)(BIG + ((size_t)u.pm * 256 + 0) * FF + 4 * (q_)) = (u32x2_t){r0[0] | (r0[1] << 16), r0[2] | (r0[3] << 16)}; \
                    *(u32x2_t*)(BIG + ((size_t)u.pm * 256 + 1) * FF + 4 * (q_)) = (u32x2_t){r1[0] | (r1[1] << 16), r1[2] | (r1[3] << 16)}; } while (0)
                FX_LOAD(a, qa); FX_LOAD(b, qb);
                FX_STORE(a, qa); FX_STORE(b, qb);
#undef FX_LOAD
#undef FX_STORE
            }
            VM_WAIT(); __syncthreads();
            pg8::EpiResid<1> E{nullptr, l == DEPTH - 1 ? out : nullptr, XB, SS, XB, SS, 0, 0};
            phase_stagger();
STAMP_GEMM(5, l);
#pragma unroll 1
            for (int rep = (PROBE_DUP & (512 | 8192)) ? 0 : 1; rep < 2; ++rep) { E.dry = (rep == 0) && !(PROBE_DUP & 8192); if (PROBE_DUP & 8192) { E.xbw = rep ? XB : (bf16*)(ws + WS_AU); E.ssw = rep ? SS : (float*)(ws + WS_END); E.out = (rep && l == DEPTH - 1) ? out : nullptr; } pg8::gemm_phase<pg8::EpiResid<1>, pg8::StaticOrder, true, true>(lds + RING_OFF, g, S, E); __syncthreads(); }
        }
        if (l < DEPTH - 1) LSEAM(pb + 5);
    }
#if PROBE_STAMP
    __syncthreads(); STAMP_ARRIVE(N_PHASES - 1);
    if (wg_tid() == 0 && (STAMP_WG < 0 || (int)blockIdx.x == STAMP_WG)) { const unsigned long long t0 = __builtin_amdgcn_s_memrealtime(), d = (unsigned long long)STAMP_AMP * STAMP_ST()[1];
        while (__builtin_amdgcn_s_memrealtime() - t0 < d) __builtin_amdgcn_s_sleep(16); }
#endif
#undef IN
#undef SEAM
#undef LSEAM
#undef SSEAM
#undef NSEAM
#undef HSEAM
#undef LSEAM_
}

#ifndef MK_PER_PHASE
#define MK_PER_PHASE 0
#endif
extern "C" void kernel_launch(void* const* d_in, const int* in_sizes, int n_in, void* d_out, int out_size, void* d_ws, size_t ws_size, hipStream_t stream) {
    static int grid = 0;
    if (grid == 0) {
        if (n_in != 15 || in_sizes[0] != MROWS * DM || out_size != MROWS * DM || ws_size < WS_END) {
            fprintf(stderr, "kernel_launch: unexpected shapes (n_in %d, in0 %d, out %d, ws %zu < %zu); nothing launched\n", n_in, n_in > 0 ? in_sizes[0] : -1, out_size, ws_size, (size_t)WS_END); grid = -1; return; }
        int dev = 0, cus = 0, per_cu = 0;
        if (hipGetDevice(&dev) != hipSuccess || hipDeviceGetAttribute(&cus, hipDeviceAttributeMultiprocessorCount, dev) != hipSuccess || cus <= 0) { fprintf(stderr, "kernel_launch: no device attributes\n"); grid = -1; return; }
        if (hipFuncSetAttribute((const void*)mega_fwd, hipFuncAttributeMaxDynamicSharedMemorySize, LDS_BYTES) != hipSuccess) { fprintf(stderr, "kernel_launch: hipFuncSetAttribute failed\n"); grid = -1; return; }
        if (hipOccupancyMaxActiveBlocksPerMultiprocessor(&per_cu, (const void*)mega_fwd, NWAVES * 64, LDS_BYTES) != hipSuccess || per_cu < 1)
            fprintf(stderr, "kernel_launch: note: occupancy query reports %d workgroups per CU; launching one per CU (144 KiB LDS each admits exactly one)\n", per_cu);
        (void)hipGetLastError();
        grid = cus;
    }
    if (grid < 0) return;
    (void)hipMemsetAsync((char*)d_ws + WS_CTL, 0, CTL_ZERO_BYTES, stream);
    Params p{};
    for (int i = 0; i < 15; ++i) p.in[i] = (const float*)d_in[i];
    p.out = (float*)d_out; p.ws = (unsigned char*)d_ws;
#if MK_PER_PHASE
    for (int k = 0; k < N_PHASES; ++k) { p.ph_lo = k; p.ph_hi = k + 1; p.bar_region = 0; hipLaunchKernelGGL(mega_fwd, dim3(grid), dim3(NWAVES * 64), LDS_BYTES, stream, p); }
#else
    p.ph_lo = 0; p.ph_hi = N_PHASES; p.bar_region = 0;
    hipLaunchKernelGGL(mega_fwd, dim3(grid), dim3(NWAVES * 64), LDS_BYTES, stream, p);
#endif
}
```
